# Optimizing an MI355X kernel written in HIP

```python
import math
import jax, jax.numpy as jnp
from jax import lax
import numpy as np

D_MODEL = 1024
BATCH = 16
SEQ = 2048
DEPTH = 2

HGRN_HEADS = 4
HGRN_DK = 128
HGRN_DV = 128
HGRN_WIDTH = HGRN_HEADS * HGRN_DK
HGRN_CHUNK = 64
ATT_HEADS = 8
ATT_DH = 64
ATT_WIDTH = ATT_HEADS * ATT_DH
IDX_HEADS = 8
IDX_DH = 64
TOPK_MAX = 256
Q_BLOCK = 128
REL_BUCKETS = 32
REL_MAX_DIST = 128
N_EXPERTS = 32
TOP_K = 4
D_FF = 1024
SWIGLU_ALPHA = 1.702
SWIGLU_LIMIT = 7.0
MOE_BLOCK = 256
NORM_EPS = 1e-6
N_MOD = 6

IN_WIDTHS = (
    HGRN_WIDTH, HGRN_WIDTH, HGRN_HEADS * HGRN_DV, HGRN_HEADS * HGRN_DV,
    ATT_WIDTH, ATT_DH, ATT_DH,
    IDX_HEADS * IDX_DH, IDX_DH, IDX_HEADS,
    D_MODEL, D_MODEL,
)
IN_COLS = sum(IN_WIDTHS)

kernel_name = "hybrid_hgrn2_dsa_moe_adaln"


def rms_norm(x, w):
    xf = x.astype(jnp.float32)
    y = xf * lax.rsqrt(jnp.mean(xf * xf, axis=-1, keepdims=True) + NORM_EPS)
    return (y * w.astype(jnp.float32)).astype(x.dtype)


def split_columns(z):
    parts, off = [], 0
    for w in IN_WIDTHS:
        parts.append(z[..., off:off + w])
        off += w
    return parts


def t5_bucket(rel):
    max_exact = REL_BUCKETS // 2
    rel_f = jnp.maximum(rel, 1).astype(jnp.float32)
    large = max_exact + (jnp.log(rel_f / max_exact) / math.log(REL_MAX_DIST / max_exact)
                         * (REL_BUCKETS - max_exact)).astype(jnp.int32)
    large = jnp.minimum(large, REL_BUCKETS - 1)
    return jnp.where(rel < max_exact, rel, large)


def hgrn2_chunk_scan(q, k, v, log_f):
    b_, seq_len, heads, dk = q.shape
    dv = v.shape[-1]
    n_chunks = seq_len // HGRN_CHUNK

    def to_chunks(t):
        return t.reshape(b_, n_chunks, HGRN_CHUNK, heads, t.shape[-1]).transpose(1, 0, 3, 2, 4)

    causal = jnp.tril(jnp.ones((HGRN_CHUNK, HGRN_CHUNK), bool))

    def step(state, inp):
        qc, kc, vc, gc = inp
        b = jnp.cumsum(gc, axis=2)
        diff = b[:, :, :, None, :] - b[:, :, None, :, :]
        decay = jnp.exp(jnp.where(causal[:, :, None], diff, -jnp.inf))
        a = jnp.einsum('bhtd,bhsd,bhtsd->bhts', qc, kc, decay)
        o = (jnp.einsum('bhts,bhsv->bhtv', a, vc)
             + jnp.einsum('bhtd,bhdv->bhtv', qc * jnp.exp(b), state))
        b_last = b[:, :, -1:, :]
        state = (jnp.exp(b_last[:, :, 0, :])[..., None] * state
                 + jnp.einsum('bhsd,bhsv->bhdv', kc * jnp.exp(b_last - b), vc))
        return state, o

    state0 = jnp.zeros((b_, heads, dk, dv), jnp.float32)
    _, o = lax.scan(step, state0, (to_chunks(q), to_chunks(k), to_chunks(v), to_chunks(log_f)))
    return o.transpose(1, 0, 3, 2, 4).reshape(b_, seq_len, heads, dv)


def hgrn2_branch(qa, fa, ia, ga, lb, norm_w):
    b_, seq_len, _ = qa.shape
    shp = (b_, seq_len, HGRN_HEADS, HGRN_DK)
    q = jax.nn.silu(qa.astype(jnp.float32)).reshape(shp)
    z = fa.astype(jnp.float32).reshape(shp)
    lbh = lb.reshape(HGRN_HEADS, HGRN_DK)
    log_f = jnp.logaddexp(jnp.log(lbh), jnp.log1p(-lbh) + jax.nn.log_sigmoid(z))
    k = (1.0 - lbh) * jax.nn.sigmoid(-z)
    v = ia.astype(jnp.float32).reshape(b_, seq_len, HGRN_HEADS, HGRN_DV)
    o = hgrn2_chunk_scan(q, k, v, log_f)
    o = o * lax.rsqrt(jnp.mean(o * o, axis=-1, keepdims=True) + NORM_EPS)
    o = o.reshape(b_, seq_len, HGRN_HEADS * HGRN_DV) * norm_w.astype(jnp.float32)
    return (o * jax.nn.silu(ga.astype(jnp.float32))).astype(qa.dtype)


def dsa_branch(qb, kb, vb, iq, ik, iw, rel_bias):
    b_, seq_len, _ = qb.shape
    top_k = min(TOPK_MAX, seq_len // 4)
    n_blocks = seq_len // Q_BLOCK
    q = qb.reshape(b_, seq_len, ATT_HEADS, ATT_DH)
    iq = iq.reshape(b_, seq_len, IDX_HEADS, IDX_DH).astype(jnp.float32)
    ik = ik.astype(jnp.float32)
    iw = iw.astype(jnp.float32) * (IDX_HEADS ** -0.5 * IDX_DH ** -0.5)
    key_pos = jnp.arange(seq_len)
    gather_rows = jax.vmap(lambda kv, ix: kv[ix])

    def block(i):
        start = i * Q_BLOCK
        t = start + jnp.arange(Q_BLOCK)
        q_b = lax.dynamic_slice_in_dim(q, start, Q_BLOCK, axis=1).astype(jnp.float32)
        iq_b = lax.dynamic_slice_in_dim(iq, start, Q_BLOCK, axis=1)
        iw_b = lax.dynamic_slice_in_dim(iw, start, Q_BLOCK, axis=1)
        s = jnp.einsum('bqhd,bsd->bqhs', iq_b, ik)
        score = jnp.einsum('bqh,bqhs->bqs', iw_b, jax.nn.relu(s))
        score = jnp.where(key_pos[None, None, :] <= t[None, :, None], score, -jnp.inf)
        _, idx = lax.top_k(score, top_k)
        valid = idx <= t[None, :, None]
        k_sel = gather_rows(kb, idx).astype(jnp.float32)
        v_sel = gather_rows(vb, idx).astype(jnp.float32)
        bias = rel_bias[t5_bucket(jnp.maximum(t[None, :, None] - idx, 0))]
        logits = (jnp.einsum('bqhd,bqkd->bqhk', q_b, k_sel) * ATT_DH ** -0.5
                  + bias.transpose(0, 1, 3, 2).astype(jnp.float32))
        logits = jnp.where(valid[:, :, None, :], logits, -jnp.inf)
        p = jax.nn.softmax(logits, axis=-1)
        return jnp.einsum('bqhk,bqkd->bqhd', p, v_sel).astype(qb.dtype)

    out = lax.map(block, jnp.arange(n_blocks))
    return out.transpose(1, 0, 2, 3, 4).reshape(b_, seq_len, ATT_WIDTH)


def mixer_block(h, w_in, lb, hgrn_norm_w, rel_bias, w_proj_a, w_proj_b, w_out):
    z = h @ w_in
    qa, fa, ia, ga, qb, kb, vb, iq, ik, iw, gate_a, gate_b = split_columns(z)
    y_a = hgrn2_branch(qa, fa, ia, ga, lb, hgrn_norm_w) @ w_proj_a
    y_b = dsa_branch(qb, kb, vb, iq, ik, iw, rel_bias) @ w_proj_b
    merged = jax.nn.sigmoid(gate_a) * y_a + jax.nn.sigmoid(gate_b) * y_b
    return merged @ w_out


def moe_block(h, w_router, b_router, w1, b1, w2, b2):
    n_tok, d = h.shape
    n_assign = n_tok * TOP_K
    logits = (h @ w_router + b_router).astype(jnp.float32)
    top_val, top_idx = lax.top_k(logits, TOP_K)
    gates = jax.nn.softmax(top_val, axis=-1).astype(h.dtype)
    flat_e = top_idx.reshape(-1)
    order = jnp.argsort(flat_e)
    sorted_e = flat_e[order]
    tok = order // TOP_K
    counts = jnp.bincount(flat_e, length=N_EXPERTS)
    padded = (counts + MOE_BLOCK - 1) // MOE_BLOCK * MOE_BLOCK
    pad_end = jnp.cumsum(padded)
    pad_start = pad_end - padded
    start = jnp.cumsum(counts) - counts
    dest = pad_start[sorted_e] + (jnp.arange(n_assign) - start[sorted_e])
    n_slots = -(-n_assign // MOE_BLOCK) * MOE_BLOCK + N_EXPERTS * MOE_BLOCK
    n_blk = n_slots // MOE_BLOCK
    slot_tok = jnp.full((n_slots,), n_tok, jnp.int32).at[dest].set(tok.astype(jnp.int32))
    h_pad = jnp.concatenate([h, jnp.zeros((1, d), h.dtype)], axis=0)
    xs = h_pad[slot_tok].reshape(n_blk, MOE_BLOCK, d)
    block_expert = jnp.minimum(
        jnp.searchsorted(pad_end, jnp.arange(n_blk) * MOE_BLOCK, side='right'), N_EXPERTS - 1)

    def expert_block(args):
        xb, e = args
        hm = xb @ w1[e] + b1[e]
        glu = jnp.minimum(hm[:, :D_FF], SWIGLU_LIMIT)
        lin = jnp.clip(hm[:, D_FF:], -SWIGLU_LIMIT, SWIGLU_LIMIT)
        act = glu * jax.nn.sigmoid(SWIGLU_ALPHA * glu) * (lin + 1.0)
        return act @ w2[e] + b2[e]

    y_slots = lax.map(expert_block, (xs, block_expert)).reshape(n_slots, d)
    dest_orig = jnp.zeros((n_assign,), jnp.int32).at[order].set(dest.astype(jnp.int32))
    y_sel = y_slots[dest_orig].reshape(n_tok, TOP_K, d)
    return jnp.einsum('tk,tkd->td', gates, y_sel)


def setup_inputs(seed: int = 0) -> dict:
    key = jax.random.key(seed)
    ks = jax.random.split(key, 20)

    def nrm(k, shape, fan_in, scale=1.0):
        return jax.random.normal(k, shape, jnp.float32) * (scale * fan_in ** -0.5)

    def gain(k, shape):
        return 1.0 + 0.02 * jax.random.normal(k, shape, jnp.float32)

    return {
        "x": jax.random.normal(ks[0], (BATCH, SEQ, D_MODEL), jnp.float32),
        "c": jax.random.normal(ks[1], (BATCH, D_MODEL), jnp.float32),
        "w_ada": nrm(ks[2], (DEPTH, D_MODEL, N_MOD * D_MODEL), D_MODEL, 0.5),
        "b_ada": 0.02 * jax.random.normal(ks[3], (DEPTH, N_MOD * D_MODEL), jnp.float32),
        "norm_mix_w": gain(ks[4], (DEPTH, D_MODEL)),
        "w_in": nrm(ks[5], (DEPTH, D_MODEL, IN_COLS), D_MODEL),
        "hgrn_lb_logits": 0.5 * jax.random.normal(ks[6], (DEPTH, HGRN_WIDTH), jnp.float32),
        "hgrn_norm_w": gain(ks[7], (DEPTH, HGRN_HEADS * HGRN_DV)),
        "rel_bias": 0.5 * jax.random.normal(ks[8], (REL_BUCKETS, ATT_HEADS), jnp.float32),
        "w_proj_a": nrm(ks[9], (DEPTH, HGRN_HEADS * HGRN_DV, D_MODEL), HGRN_HEADS * HGRN_DV),
        "w_proj_b": nrm(ks[10], (DEPTH, ATT_WIDTH, D_MODEL), ATT_WIDTH),
        "w_out": nrm(ks[11], (DEPTH, D_MODEL, D_MODEL), D_MODEL),
        "norm_ffn_w": gain(ks[12], (DEPTH, D_MODEL)),
        "w_router": nrm(ks[13], (DEPTH, D_MODEL, N_EXPERTS), D_MODEL),
        "b_router": 0.01 * jax.random.normal(ks[14], (DEPTH, N_EXPERTS), jnp.float32),
        "w_mlp1": nrm(ks[15], (DEPTH, N_EXPERTS, D_MODEL, 2 * D_FF), D_MODEL),
        "b_mlp1": 0.02 * jax.random.normal(ks[16], (DEPTH, N_EXPERTS, 2 * D_FF), jnp.float32),
        "w_mlp2": nrm(ks[17], (DEPTH, N_EXPERTS, D_FF, D_MODEL), D_FF),
        "b_mlp2": 0.02 * jax.random.normal(ks[18], (DEPTH, N_EXPERTS, D_MODEL), jnp.float32),
        "final_norm_w": gain(ks[19], (D_MODEL,)),
    }


def reference(x, c, w_ada, b_ada, norm_mix_w, w_in, hgrn_lb_logits, hgrn_norm_w, rel_bias,
              w_proj_a, w_proj_b, w_out, norm_ffn_w, w_router, b_router,
              w_mlp1, b_mlp1, w_mlp2, b_mlp2, final_norm_w):
    b_, seq_len, d = x.shape
    lb_all = jnp.cumsum(jax.nn.softmax(hgrn_lb_logits.astype(jnp.float32), axis=0), axis=0)
    lb_all = lb_all - lb_all[0]
    c_act = jax.nn.silu(c)
    for l in range(DEPTH):
        mod = c_act @ w_ada[l] + b_ada[l]
        shift_m, scale_m, gate_m, shift_f, scale_f, gate_f = jnp.split(mod, N_MOD, axis=-1)
        h = rms_norm(x, norm_mix_w[l]) * (1.0 + scale_m[:, None, :]) + shift_m[:, None, :]
        y = mixer_block(h, w_in[l], lb_all[l], hgrn_norm_w[l], rel_bias,
                        w_proj_a[l], w_proj_b[l], w_out[l])
        x = x + gate_m[:, None, :] * y
        h = rms_norm(x, norm_ffn_w[l]) * (1.0 + scale_f[:, None, :]) + shift_f[:, None, :]
        y = moe_block(h.reshape(b_ * seq_len, d), w_router[l], b_router[l],
                      w_mlp1[l], b_mlp1[l], w_mlp2[l], b_mlp2[l])
        x = x + gate_f[:, None, :] * y.reshape(b_, seq_len, d)
    return rms_norm(x, final_norm_w)
```

```cpp
#include <hip/hip_runtime.h>
#include <stdint.h>
#include <stdio.h>

typedef unsigned short bf16_t;
typedef short bf16x8 __attribute__((ext_vector_type(8)));
typedef float f32x4 __attribute__((ext_vector_type(4)));
typedef float f32x16 __attribute__((ext_vector_type(16)));
typedef unsigned u32x4 __attribute__((ext_vector_type(4)));
#define LAS __attribute__((address_space(3)))

constexpr int T = 32768, D = 1024, NB = 16, SEQ = 2048, DEPTH = 2;
constexpr int ZC = 5320, ZLD = 5376;
constexpr int C_QA = 0, C_FA = 512, C_IA = 1024, C_GA = 1536, C_QB = 2048, C_KB = 2560, C_VB = 2624, C_IQ = 2688, C_IK = 3200, C_IW = 3264, C_GTA = 3272, C_GTB = 4296;
constexpr int NE = 32, DFF = 1024, NSLOT = 131072 + 32 * 256, NBLK_MAX = NSLOT / 256;
constexpr int NMOD = 6 * D;
constexpr float EPS = 1e-6f;
constexpr int NTHREADS = 512, NWAVES = 8;
constexpr int LDS_BYTES = 144 * 1024;

constexpr size_t al256(size_t x) { return (x + 255) & ~(size_t)255; }
constexpr size_t WS_CTL = 0;
constexpr size_t CTL_BYTES = 65536;
constexpr size_t WS_MOD = WS_CTL + CTL_BYTES;
constexpr size_t WS_LB = WS_MOD + al256((size_t)DEPTH * NB * NMOD * 4);
constexpr size_t WS_WIN = WS_LB + al256((size_t)DEPTH * 512 * 4);
constexpr size_t WS_WPA = WS_WIN + (size_t)DEPTH * ZLD * D * 2;
constexpr size_t WS_WPB = WS_WPA + (size_t)DEPTH * D * 512 * 2;
constexpr size_t WS_WOUT = WS_WPB + (size_t)DEPTH * D * 512 * 2;
constexpr size_t WS_W1 = WS_WOUT + (size_t)DEPTH * D * D * 2;
constexpr size_t WS_W2 = WS_W1 + (size_t)DEPTH * NE * 2 * DFF * D * 2;
constexpr size_t WS_H = WS_W2 + (size_t)DEPTH * NE * D * DFF * 2;
constexpr size_t WS_Z = WS_H + (size_t)T * D * 2;
constexpr size_t WS_Y = WS_Z;
constexpr size_t WS_ACT = WS_Z + (size_t)T * ZLD * 4;
constexpr size_t WS_ORAW = WS_ACT;
constexpr size_t WS_TMP = WS_ACT + (size_t)T * 512 * 4;
constexpr size_t WS_HA = WS_ACT + (size_t)NSLOT * DFF * 2;
constexpr size_t WS_ATT = WS_HA + (size_t)T * 512 * 2;
constexpr size_t WS_MASK = WS_ATT + (size_t)T * 512 * 2;
constexpr size_t WS_MERGED = WS_MASK + (size_t)T * 64 * 4;
constexpr size_t WS_X1 = WS_MERGED + (size_t)T * D * 2;
constexpr size_t WS_X2 = WS_X1 + (size_t)T * D * 4;
constexpr size_t WS_TOKE = WS_X2 + (size_t)T * D * 4;
constexpr size_t WS_TOKG = WS_TOKE + (size_t)T * 4 * 4;
constexpr size_t WS_TOKP = WS_TOKG + (size_t)T * 4 * 4;
constexpr size_t WS_TOKS = WS_TOKP + (size_t)T * 4 * 4;
constexpr size_t WS_SLOTTOK = WS_TOKS + (size_t)T * 4 * 4;
constexpr size_t WS_BLKE = WS_SLOTTOK + (size_t)NSLOT * 4;
constexpr size_t WS_END = WS_BLKE + al256((size_t)(NBLK_MAX + 64) * 4);
static_assert((size_t)NSLOT * D * 4 <= (size_t)T * ZLD * 4, "Y must fit in Z");
static_assert((size_t)T * 512 * 4 + (size_t)T * D * 4 <= (size_t)NSLOT * DFF * 2, "ORAW+TMP must fit in ACT");
static_assert(WS_END <= ((size_t)1 << 31), "workspace layout exceeds 2 GiB");
constexpr int CW_CNT = 1024;
constexpr int CW_NBLK = 1200;

__device__ __forceinline__ bf16_t f2bf(float f) { unsigned u = __float_as_uint(f); u += 0x7fffu + ((u >> 16) & 1u); return (bf16_t)(u >> 16); }
__device__ __forceinline__ float bf2f(bf16_t b) { return __uint_as_float(((unsigned)b) << 16); }
__device__ __forceinline__ float sigmoidf_(float x) { return 1.0f / (1.0f + __expf(-x)); }
__device__ __forceinline__ float wave_sum(float v) {
#pragma unroll
    for (int o = 32; o >= 1; o >>= 1) v += __shfl_xor(v, o);
    return v;
}
__device__ __forceinline__ int wave_sum_i(int v) {
#pragma unroll
    for (int o = 32; o >= 1; o >>= 1) v += __shfl_xor(v, o);
    return v;
}
__device__ const unsigned char T5_BUCKET[128] = {
    0, 1, 2, 3, 4, 5, 6, 7, 8, 9, 10, 11, 12, 13, 14, 15, 16, 16, 16, 17, 17, 18, 18, 18, 19, 19, 19, 20, 20, 20, 20, 21, 21, 21, 21, 22, 22, 22, 22, 22, 23, 23, 23, 23, 23, 23, 24, 24, 24, 24, 24, 24, 25,
    25, 25, 25, 25, 25, 25, 26, 26, 26, 26, 26, 26, 26, 26, 27, 27, 27, 27, 27, 27, 27, 27, 27, 27, 28, 28, 28, 28, 28, 28, 28, 28, 28, 28, 29, 29, 29, 29, 29, 29, 29, 29, 29, 29, 29, 29, 30, 30, 30, 30, 30,
    30, 30, 30, 30, 30, 30, 30, 30, 30, 31, 31, 31, 31, 31, 31, 31, 31, 31, 31, 31, 31, 31, 31, 31};
__device__ __forceinline__ int t5_bucket(int rel) { return rel >= 128 ? 31 : (int)T5_BUCKET[rel]; }

struct Args { const float* in[20]; float* out; unsigned char* ws; int ph_lo, ph_hi; };
enum { I_X = 0, I_C, I_WADA, I_BADA, I_NMW, I_WIN, I_LBL, I_HNW, I_RELB, I_WPA, I_WPB, I_WOUT, I_NFW, I_WR, I_BR, I_W1, I_B1, I_W2, I_B2, I_FNW };

__device__ __forceinline__ void cvt_family(const float* src, bf16_t* dst, int K, int N, int Npad, int count, int mode, float* lt  ) {
    const int tid = threadIdx.x;
    const int tk = K / 64, tn = Npad / 64, per = tk * tn;
    for (long u = blockIdx.x; u < (long)per * count; u += gridDim.x) {
        const int mi = (int)(u / per), r = (int)(u % per), k0 = (r / tn) * 64, n0 = (r % tn) * 64;
        const float* s = src + (size_t)mi * K * N;
        bf16_t* d = dst + (size_t)mi * Npad * K;
        int sc0 = n0;
        if (mode == 1) { const int p = n0 >> 8, sel = (n0 >> 7) & 1, i = n0 & 127; sc0 = sel * 1024 + 128 * p + i; }
        __syncthreads();
        {
            const int i = tid >> 3, j0 = (tid & 7) * 8;
            float v[8];
            if (n0 + j0 < Npad && (mode == 1 || n0 + j0 < N)) {
                const f32x4 a = *(const f32x4*)(s + (size_t)(k0 + i) * N + sc0 + j0), b = *(const f32x4*)(s + (size_t)(k0 + i) * N + sc0 + j0 + 4);
                v[0] = a[0]; v[1] = a[1]; v[2] = a[2]; v[3] = a[3]; v[4] = b[0]; v[5] = b[1]; v[6] = b[2]; v[7] = b[3];
            } else {
#pragma unroll
                for (int q = 0; q < 8; ++q) v[q] = 0.f;
            }
#pragma unroll
            for (int q = 0; q < 8; ++q) lt[i * 65 + j0 + q] = v[q];
        }
        __syncthreads();
        {
            const int n = tid >> 3, kk = (tid & 7) * 8;
            unsigned w[4];
#pragma unroll
            for (int q = 0; q < 4; ++q) w[q] = (unsigned)f2bf(lt[(kk + 2 * q) * 65 + n]) | ((unsigned)f2bf(lt[(kk + 2 * q + 1) * 65 + n]) << 16);
            u32x4 o; o.x = w[0]; o.y = w[1]; o.z = w[2]; o.w = w[3];
            *(u32x4*)(d + (size_t)(n0 + n) * K + k0 + kk) = o;
        }
    }
    __syncthreads();
}

template <class Epi>
__device__ __forceinline__ void ngemm(const bf16_t* A, const int* rowidx, const bf16_t* Bt, const int* blk_e, size_t bt_stride, int M, int NT  , int K, int pair, const Epi& epi) {
    const int lane = threadIdx.x & 63, wave = threadIdx.x >> 6;
    const int r31 = lane & 31, hh = lane >> 5;
    const long ntile = (long)(M / 64) * NT;
    for (long tix = (long)blockIdx.x * NWAVES + wave; tix < ntile; tix += (long)gridDim.x * NWAVES) {
        const int tm = (int)(tix / NT), tn = (int)(tix % NT);
        const int r0 = tm * 64;
        const int c0 = pair ? (256 * (tn >> 2) + 32 * (tn & 3)) : 64 * tn, c1 = pair ? c0 + 128 : c0 + 32;
        const int e = blk_e ? blk_e[tm >> 2] : 0;
        const bf16_t* B = Bt + (size_t)e * bt_stride;
        const bf16_t* ap[2]; const bf16_t* bp[2];
#pragma unroll
        for (int mi = 0; mi < 2; ++mi) { const int row = r0 + 32 * mi + r31; const int ar = rowidx ? rowidx[row] : row; ap[mi] = A + (size_t)ar * K + 8 * hh; }
        bp[0] = B + (size_t)(c0 + r31) * K + 8 * hh; bp[1] = B + (size_t)(c1 + r31) * K + 8 * hh;
        f32x16 acc[2][2];
#pragma unroll
        for (int a = 0; a < 2; ++a)
#pragma unroll
            for (int b = 0; b < 2; ++b)
#pragma unroll
                for (int q = 0; q < 16; ++q) acc[a][b][q] = 0.f;
        for (int k = 0; k < K; k += 16) {
            const bf16x8 a0 = *(const bf16x8*)(ap[0] + k), a1 = *(const bf16x8*)(ap[1] + k), b0 = *(const bf16x8*)(bp[0] + k), b1 = *(const bf16x8*)(bp[1] + k);
            acc[0][0] = __builtin_amdgcn_mfma_f32_32x32x16_bf16(a0, b0, acc[0][0], 0, 0, 0);
            acc[0][1] = __builtin_amdgcn_mfma_f32_32x32x16_bf16(a0, b1, acc[0][1], 0, 0, 0);
            acc[1][0] = __builtin_amdgcn_mfma_f32_32x32x16_bf16(a1, b0, acc[1][0], 0, 0, 0);
            acc[1][1] = __builtin_amdgcn_mfma_f32_32x32x16_bf16(a1, b1, acc[1][1], 0, 0, 0);
        }
        epi(acc, r0, c0, c1, e, tn, lane);
    }
}
#define ACC_ROW(q, lane) (((q) & 3) + 8 * ((q) >> 2) + 4 * ((lane) >> 5))

struct EpiStoreF32 { float* C; int ldc;
    __device__ __forceinline__ void operator()(const f32x16 (&acc)[2][2], int r0, int c0, int c1, int, int, int lane) const {
#pragma unroll
        for (int mi = 0; mi < 2; ++mi)
#pragma unroll
            for (int q = 0; q < 16; ++q) { const int row = r0 + 32 * mi + ACC_ROW(q, lane); C[(size_t)row * ldc + c0 + (lane & 31)] = acc[mi][0][q]; C[(size_t)row * ldc + c1 + (lane & 31)] = acc[mi][1][q]; }
    } };
struct EpiMerge1 { float* tmp; const float* Z; int gcol;
    __device__ __forceinline__ void operator()(const f32x16 (&acc)[2][2], int r0, int c0, int c1, int, int, int lane) const {
#pragma unroll
        for (int mi = 0; mi < 2; ++mi)
#pragma unroll
            for (int q = 0; q < 16; ++q) { const int row = r0 + 32 * mi + ACC_ROW(q, lane);
#pragma unroll
                for (int ni = 0; ni < 2; ++ni) { const int col = (ni ? c1 : c0) + (lane & 31); tmp[(size_t)row * D + col] = sigmoidf_(Z[(size_t)row * ZLD + gcol + col]) * acc[mi][ni][q]; } }
    } };
struct EpiMerge2 { const float* tmp; bf16_t* merged; const float* Z; int gcol;
    __device__ __forceinline__ void operator()(const f32x16 (&acc)[2][2], int r0, int c0, int c1, int, int, int lane) const {
#pragma unroll
        for (int mi = 0; mi < 2; ++mi)
#pragma unroll
            for (int q = 0; q < 16; ++q) { const int row = r0 + 32 * mi + ACC_ROW(q, lane);
#pragma unroll
                for (int ni = 0; ni < 2; ++ni) { const int col = (ni ? c1 : c0) + (lane & 31); merged[(size_t)row * D + col] = f2bf(tmp[(size_t)row * D + col] + sigmoidf_(Z[(size_t)row * ZLD + gcol + col]) * acc[mi][ni][q]); } }
    } };
struct EpiOut { const float* xin; float* x1; const float* gate  ;
    __device__ __forceinline__ void operator()(const f32x16 (&acc)[2][2], int r0, int c0, int c1, int, int, int lane) const {
#pragma unroll
        for (int mi = 0; mi < 2; ++mi)
#pragma unroll
            for (int q = 0; q < 16; ++q) { const int row = r0 + 32 * mi + ACC_ROW(q, lane); const int b = row >> 11;
#pragma unroll
                for (int ni = 0; ni < 2; ++ni) { const int col = (ni ? c1 : c0) + (lane & 31); x1[(size_t)row * D + col] = xin[(size_t)row * D + col] + gate[(size_t)b * NMOD + col] * acc[mi][ni][q]; } }
    } };
struct EpiSwiglu { bf16_t* act; const float* b1  ;
    __device__ __forceinline__ void operator()(const f32x16 (&acc)[2][2], int r0, int, int, int e, int tn, int lane) const {
        const int col = 32 * tn + (lane & 31);
        const float bg = b1[(size_t)e * 2 * DFF + col], bl = b1[(size_t)e * 2 * DFF + DFF + col];
#pragma unroll
        for (int mi = 0; mi < 2; ++mi)
#pragma unroll
            for (int q = 0; q < 16; ++q) { const int row = r0 + 32 * mi + ACC_ROW(q, lane);
                float glu = fminf(acc[mi][0][q] + bg, 7.0f); float lin = fminf(fmaxf(acc[mi][1][q] + bl, -7.0f), 7.0f);
                act[(size_t)row * DFF + col] = f2bf(glu * sigmoidf_(1.702f * glu) * (lin + 1.0f)); }
    } };
struct EpiW2 { float* Y; const float* b2  ;
    __device__ __forceinline__ void operator()(const f32x16 (&acc)[2][2], int r0, int c0, int c1, int e, int, int lane) const {
#pragma unroll
        for (int mi = 0; mi < 2; ++mi)
#pragma unroll
            for (int q = 0; q < 16; ++q) { const int row = r0 + 32 * mi + ACC_ROW(q, lane);
#pragma unroll
                for (int ni = 0; ni < 2; ++ni) { const int col = (ni ? c1 : c0) + (lane & 31); Y[(size_t)row * D + col] = acc[mi][ni][q] + b2[(size_t)e * D + col]; } }
    } };

template <int KIND> __global__ void __launch_bounds__(NTHREADS, 2) fwd(Args args) {
    extern __shared__ __attribute__((aligned(16))) unsigned char lds[];
    const int tid = threadIdx.x, lane = tid & 63, wave = tid >> 6;
    const int G = gridDim.x;
    unsigned char* ws = args.ws;
    unsigned* ctl = (unsigned*)(ws + WS_CTL);
    float* MOD = (float*)(ws + WS_MOD); float* LB = (float*)(ws + WS_LB);
    bf16_t* WIN = (bf16_t*)(ws + WS_WIN); bf16_t* WPA = (bf16_t*)(ws + WS_WPA); bf16_t* WPB = (bf16_t*)(ws + WS_WPB); bf16_t* WOUT = (bf16_t*)(ws + WS_WOUT);
    bf16_t* W1 = (bf16_t*)(ws + WS_W1); bf16_t* W2 = (bf16_t*)(ws + WS_W2);
    bf16_t* H = (bf16_t*)(ws + WS_H); float* Z = (float*)(ws + WS_Z); float* Y = (float*)(ws + WS_Y); bf16_t* ACT = (bf16_t*)(ws + WS_ACT);
    float* ORAW = (float*)(ws + WS_ORAW); float* TMP = (float*)(ws + WS_TMP); bf16_t* HA = (bf16_t*)(ws + WS_HA); bf16_t* ATT = (bf16_t*)(ws + WS_ATT);
    unsigned* MASK = (unsigned*)(ws + WS_MASK); bf16_t* MERGED = (bf16_t*)(ws + WS_MERGED); float* X1 = (float*)(ws + WS_X1); float* X2 = (float*)(ws + WS_X2);
    int* TOKE = (int*)(ws + WS_TOKE); float* TOKG = (float*)(ws + WS_TOKG); int* TOKP = (int*)(ws + WS_TOKP); int* TOKS = (int*)(ws + WS_TOKS);
    int* SLOTTOK = (int*)(ws + WS_SLOTTOK); int* BLKE = (int*)(ws + WS_BLKE);
    const int lo = args.ph_lo, hi = args.ph_hi;
#define IN(k) (((k) == 0 ? KIND == 100 : KIND == ((k) - 1) % 11) && lo <= (k) && (k) < hi)

    if (IN(0)) {
        float* lt = (float*)lds;
        cvt_family(args.in[I_WIN], WIN, D, ZC, ZLD, DEPTH, 0, lt);
        cvt_family(args.in[I_WPA], WPA, 512, D, D, DEPTH, 0, lt);
        cvt_family(args.in[I_WPB], WPB, 512, D, D, DEPTH, 0, lt);
        cvt_family(args.in[I_WOUT], WOUT, D, D, D, DEPTH, 0, lt);
        cvt_family(args.in[I_W1], W1, D, 2 * DFF, 2 * DFF, DEPTH * NE, 1, lt);
        cvt_family(args.in[I_W2], W2, DFF, D, D, DEPTH * NE, 0, lt);
        {
            float* ca = (float*)lds;
            __syncthreads();
            for (int i = tid; i < NB * D; i += NTHREADS) { const float c = args.in[I_C][i]; ca[i] = c * sigmoidf_(c); }
            __syncthreads();
            for (int u = blockIdx.x; u < DEPTH * NMOD / NTHREADS; u += G) {
                const int ln = u * NTHREADS + tid, l = ln / NMOD, n = ln % NMOD;
                const float* w = args.in[I_WADA] + (size_t)l * D * NMOD + n;
                float acc[NB];
#pragma unroll
                for (int b = 0; b < NB; ++b) acc[b] = 0.f;
                for (int k = 0; k < D; ++k) { const float wv = w[(size_t)k * NMOD];
#pragma unroll
                    for (int b = 0; b < NB; ++b) acc[b] += ca[b * D + k] * wv; }
                const float bb = args.in[I_BADA][(size_t)l * NMOD + n];
#pragma unroll
                for (int b = 0; b < NB; ++b) MOD[((size_t)l * NB + b) * NMOD + n] = acc[b] + bb;
            }
            __syncthreads();
        }
        if (blockIdx.x == G - 1) {
            for (int j = tid; j < 512; j += NTHREADS) { const float a0 = args.in[I_LBL][j], a1 = args.in[I_LBL][512 + j]; LB[j] = 0.f; LB[512 + j] = 1.0f / (1.0f + __expf(a0 - a1)); }
        }
    }

    for (int l = 0; l < DEPTH; ++l) {
        const int P = 1 + 11 * l;
        const float* mod = MOD + (size_t)l * NB * NMOD;
        const float* xin = (l == 0) ? args.in[I_X] : X2;
        if (IN(P + 0) && l == 0) {
            const float* nw = args.in[I_NMW] + (size_t)l * D;
            for (int row = blockIdx.x * NWAVES + wave; row < T; row += G * NWAVES) {
                const int b = row >> 11; f32x4 v[4]; float ss = 0.f;
#pragma unroll
                for (int i = 0; i < 4; ++i) { v[i] = *(const f32x4*)(xin + (size_t)row * D + (lane + 64 * i) * 4); ss += v[i][0] * v[i][0] + v[i][1] * v[i][1] + v[i][2] * v[i][2] + v[i][3] * v[i][3]; }
                ss = wave_sum(ss); const float r = rsqrtf(ss * (1.0f / D) + EPS);
#pragma unroll
                for (int i = 0; i < 4; ++i) { const int c = (lane + 64 * i) * 4;
#pragma unroll
                    for (int j = 0; j < 4; ++j) H[(size_t)row * D + c + j] = f2bf(v[i][j] * r * nw[c + j] * (1.0f + mod[(size_t)b * NMOD + D + c + j]) + mod[(size_t)b * NMOD + c + j]); }
            }
        }
        if (IN(P + 1)) {
            EpiStoreF32 E{Z, ZLD};
            ngemm(H, nullptr, WIN + (size_t)l * ZLD * D, nullptr, 0, T, ZLD / 64, D, 0, E);
        }
        if (IN(P + 2)) {
            {
                float* qs = (float*)lds; float* fs = qs + 32 * 128; float* ks = fs + 32 * 128; float* op = ks + 32 * 128;
                const int dv = tid & 127, dkq = tid >> 7;
                for (int u = blockIdx.x; u < NB * 4; u += G) {
                    const int b = u >> 2, h = u & 3;
                    float S[32];
#pragma unroll
                    for (int i = 0; i < 32; ++i) S[i] = 0.f;
                    for (int c = 0; c < SEQ / 32; ++c) {
                        const int row0 = b * SEQ + c * 32;
                        for (int e = tid; e < 4096; e += NTHREADS) { const int tt = e >> 7, d = e & 127;
                            const float za = Z[(size_t)(row0 + tt) * ZLD + C_QA + h * 128 + d], zf = Z[(size_t)(row0 + tt) * ZLD + C_FA + h * 128 + d];
                            const float lb = LB[l * 512 + h * 128 + d];
                            const float sg = sigmoidf_(zf);
                            qs[e] = za * sigmoidf_(za); fs[e] = lb + (1.0f - lb) * sg; ks[e] = (1.0f - lb) * (1.0f / (1.0f + __expf(zf))); }
                        __syncthreads();
                        for (int tt = 0; tt < 32; ++tt) {
                            const float v = Z[(size_t)(row0 + tt) * ZLD + C_IA + h * 128 + dv]; float o = 0.f;
#pragma unroll
                            for (int i = 0; i < 32; ++i) { S[i] = fs[tt * 128 + 32 * dkq + i] * S[i] + ks[tt * 128 + 32 * dkq + i] * v; o += qs[tt * 128 + 32 * dkq + i] * S[i]; }
                            op[(tt * 4 + dkq) * 128 + dv] = o;
                        }
                        __syncthreads();
                        for (int e = tid; e < 4096; e += NTHREADS) { const int tt = e >> 7, d = e & 127;
                            ORAW[(size_t)(row0 + tt) * 512 + h * 128 + d] = (op[(tt * 4 + 0) * 128 + d] + op[(tt * 4 + 1) * 128 + d]) + (op[(tt * 4 + 2) * 128 + d] + op[(tt * 4 + 3) * 128 + d]); }
                        __syncthreads();
                    }
                }
            }
            {
                unsigned* kl = (unsigned*)lds; unsigned* cnt = kl + 2048; unsigned* mw = cnt + 64;
                for (int qi = blockIdx.x; qi < T; qi += G) {
                    const int b = qi >> 11, t = qi & 2047, n = t + 1;
                    __syncthreads();
                    if (tid < 64) { cnt[tid] = 0u; mw[tid] = 0u; }
                    if (n <= 256) {
                        __syncthreads();
                        if (tid < 64) { const int lo_ = tid * 32; unsigned m = 0u; if (n >= lo_ + 32) m = 0xffffffffu; else if (n > lo_) m = (1u << (n - lo_)) - 1u; MASK[(size_t)qi * 64 + tid] = m; }
                        continue;
                    }
                    const float* zq = Z + (size_t)qi * ZLD;
                    unsigned key[4];
#pragma unroll
                    for (int i = 0; i < 4; ++i) {
                        const int s = tid + 512 * i; key[i] = 0u;
                        if (s < n) {
                            const float* kr = Z + (size_t)(b * SEQ + s) * ZLD + C_IK; float kk[64];
#pragma unroll
                            for (int d4 = 0; d4 < 16; ++d4) { const f32x4 x = *(const f32x4*)(kr + 4 * d4); kk[4 * d4] = x[0]; kk[4 * d4 + 1] = x[1]; kk[4 * d4 + 2] = x[2]; kk[4 * d4 + 3] = x[3]; }
                            float sc = 0.f;
                            for (int h = 0; h < 8; ++h) { float dot = 0.f;
#pragma unroll
                                for (int d = 0; d < 64; ++d) dot += zq[C_IQ + h * 64 + d] * kk[d];
                                sc += (zq[C_IW + h] * 0.04419417382415922f) * fmaxf(dot, 0.f); }
                            unsigned u = __float_as_uint(sc); u = (u & 0x80000000u) ? ~u : (u | 0x80000000u); key[i] = u;
                        }
                        kl[s] = key[i];
                    }
                    __syncthreads();
                    unsigned tau = 0u;
                    for (int bit = 31; bit >= 0; --bit) {
                        const unsigned cand = tau | (1u << bit);
                        int c = (key[0] >= cand) + (key[1] >= cand) + (key[2] >= cand) + (key[3] >= cand);
                        c = wave_sum_i(c);
                        if (lane == 0 && c) atomicAdd(&cnt[bit], (unsigned)c);
                        __syncthreads();
                        if (cnt[bit] >= 256u) tau = cand;
                    }
                    { int c = (key[0] > tau) + (key[1] > tau) + (key[2] > tau) + (key[3] > tau); c = wave_sum_i(c); if (lane == 0 && c) atomicAdd(&cnt[32], (unsigned)c); }
                    __syncthreads();
                    const int r = 256 - (int)cnt[32];
#pragma unroll
                    for (int i = 0; i < 4; ++i) {
                        const int s = tid + 512 * i; bool sel = key[i] > tau;
                        if (key[i] == tau && s < n) { int rank = 0; for (int s2 = 0; s2 < s; ++s2) rank += (kl[s2] == tau); sel = rank < r; }
                        if (sel) atomicOr(&mw[s >> 5], 1u << (s & 31));
                    }
                    __syncthreads();
                    if (tid < 64) MASK[(size_t)qi * 64 + tid] = mw[tid];
                }
                __syncthreads();
            }
        }
        if (IN(P + 3)) {
            const float* hnw = args.in[I_HNW] + (size_t)l * 512;
            for (int row = blockIdx.x * NWAVES + wave; row < T; row += G * NWAVES) {
                const int c0 = lane * 8; float o[8]; float ss = 0.f;
#pragma unroll
                for (int j = 0; j < 8; ++j) { o[j] = ORAW[(size_t)row * 512 + c0 + j]; ss += o[j] * o[j]; }
                ss += __shfl_xor(ss, 1); ss += __shfl_xor(ss, 2); ss += __shfl_xor(ss, 4); ss += __shfl_xor(ss, 8);
                const float r = rsqrtf(ss * (1.0f / 128.0f) + EPS);
#pragma unroll
                for (int j = 0; j < 8; ++j) { const float g = Z[(size_t)row * ZLD + C_GA + c0 + j]; HA[(size_t)row * 512 + c0 + j] = f2bf(o[j] * r * hnw[c0 + j] * (g * sigmoidf_(g))); }
            }
            {
                unsigned* mw = (unsigned*)lds; int* idx = (int*)(mw + 64); int* nsel = idx + 256; float* ql = (float*)(nsel + 64); float* bl = ql + 512; float* lg = bl + 256; float* inv = lg + 8 * 256;
                __syncthreads();
                for (int i = tid; i < 256; i += NTHREADS) bl[i] = args.in[I_RELB][i];
                for (int qi = blockIdx.x; qi < T; qi += G) {
                    const int b = qi >> 11, t = qi & 2047;
                    __syncthreads();
                    if (tid < 64) mw[tid] = MASK[(size_t)qi * 64 + tid];
                    ql[tid] = Z[(size_t)qi * ZLD + C_QB + tid] * 0.125f;
                    __syncthreads();
                    if (tid < 64) { int base = 0; for (int w = 0; w < tid; ++w) base += __popc(mw[w]); unsigned m = mw[tid]; int j = base; while (m) { const int bp = __ffs(m) - 1; m &= m - 1u; if (j < 256) idx[j] = tid * 32 + bp; ++j; } if (tid == 63) nsel[0] = j < 256 ? j : 256; }
                    __syncthreads();
                    const int n = nsel[0];
                    {
                        const int j = tid & 255, hg = tid >> 8;
                        if (j < n) {
                            const int s = idx[j]; const float* kr = Z + (size_t)(b * SEQ + s) * ZLD + C_KB; float kk[64];
#pragma unroll
                            for (int d4 = 0; d4 < 16; ++d4) { const f32x4 x = *(const f32x4*)(kr + 4 * d4); kk[4 * d4] = x[0]; kk[4 * d4 + 1] = x[1]; kk[4 * d4 + 2] = x[2]; kk[4 * d4 + 3] = x[3]; }
                            const int bk = t5_bucket(t - s);
                            for (int h4 = 0; h4 < 4; ++h4) { const int h = hg * 4 + h4; float dot = 0.f;
#pragma unroll
                                for (int d = 0; d < 64; ++d) dot += ql[h * 64 + d] * kk[d];
                                lg[h * 256 + j] = dot + bl[bk * 8 + h]; }
                        } else { for (int h4 = 0; h4 < 4; ++h4) lg[(hg * 4 + h4) * 256 + j] = -INFINITY; }
                    }
                    __syncthreads();
                    {
                        float v[4]; float m = -INFINITY;
#pragma unroll
                        for (int i = 0; i < 4; ++i) { v[i] = lg[wave * 256 + lane + 64 * i]; m = fmaxf(m, v[i]); }
#pragma unroll
                        for (int o = 32; o >= 1; o >>= 1) m = fmaxf(m, __shfl_xor(m, o));
                        float s = 0.f;
#pragma unroll
                        for (int i = 0; i < 4; ++i) { v[i] = __expf(v[i] - m); s += v[i]; lg[wave * 256 + lane + 64 * i] = v[i]; }
                        s = wave_sum(s); if (lane == 0) inv[wave] = 1.0f / s;
                    }
                    __syncthreads();
                    {
                        const int h = tid >> 6, d = tid & 63; float acc = 0.f;
#pragma unroll 8
                        for (int j = 0; j < n; ++j) acc += lg[h * 256 + j] * Z[(size_t)(b * SEQ + idx[j]) * ZLD + C_VB + d];
                        ATT[(size_t)qi * 512 + h * 64 + d] = f2bf(acc * inv[h]);
                    }
                }
                __syncthreads();
            }
        }
        if (IN(P + 4)) {
            EpiMerge1 E1{TMP, Z, C_GTA}; ngemm(HA, nullptr, WPA + (size_t)l * D * 512, nullptr, 0, T, D / 64, 512, 0, E1);
            EpiMerge2 E2{TMP, MERGED, Z, C_GTB}; ngemm(ATT, nullptr, WPB + (size_t)l * D * 512, nullptr, 0, T, D / 64, 512, 0, E2);
        }
        if (IN(P + 5)) {
            EpiOut E{xin, X1, mod + 2 * D}; ngemm(MERGED, nullptr, WOUT + (size_t)l * D * D, nullptr, 0, T, D / 64, D, 0, E);
        }
        if (IN(P + 6)) {
            const float* nw = args.in[I_NFW] + (size_t)l * D; const float* wr = args.in[I_WR] + (size_t)l * D * NE; const float* br = args.in[I_BR] + (size_t)l * NE;
            float* hrow = (float*)lds + wave * D;
            for (int tok = blockIdx.x * NWAVES + wave; tok < T; tok += G * NWAVES) {
                const int b = tok >> 11; f32x4 v[4]; float ss = 0.f;
#pragma unroll
                for (int i = 0; i < 4; ++i) { v[i] = *(const f32x4*)(X1 + (size_t)tok * D + (lane + 64 * i) * 4); ss += v[i][0] * v[i][0] + v[i][1] * v[i][1] + v[i][2] * v[i][2] + v[i][3] * v[i][3]; }
                ss = wave_sum(ss); const float r = rsqrtf(ss * (1.0f / D) + EPS);
                __syncthreads();
#pragma unroll
                for (int i = 0; i < 4; ++i) { const int c = (lane + 64 * i) * 4;
#pragma unroll
                    for (int j = 0; j < 4; ++j) { const float hv = v[i][j] * r * nw[c + j] * (1.0f + mod[(size_t)b * NMOD + 4 * D + c + j]) + mod[(size_t)b * NMOD + 3 * D + c + j]; hrow[c + j] = hv; H[(size_t)tok * D + c + j] = f2bf(hv); } }
                __syncthreads();
                const int e = lane & 31, half = lane >> 5; float acc = 0.f;
                for (int k = half * 512; k < half * 512 + 512; ++k) acc += hrow[k] * wr[(size_t)k * NE + e];
                acc += __shfl_xor(acc, 32);
                float logit = acc + br[e];
                float tv[4]; int ti[4];
#pragma unroll
                for (int k = 0; k < 4; ++k) {
                    float bv = logit; int bi = e;
#pragma unroll
                    for (int o = 16; o >= 1; o >>= 1) { const float ov = __shfl_xor(bv, o); const int oi = __shfl_xor(bi, o); if (ov > bv || (ov == bv && oi < bi)) { bv = ov; bi = oi; } }
                    tv[k] = bv; ti[k] = bi; if (e == bi) logit = -INFINITY;
                }
                const float e1 = __expf(tv[1] - tv[0]), e2 = __expf(tv[2] - tv[0]), e3 = __expf(tv[3] - tv[0]); const float inv = 1.0f / (1.0f + e1 + e2 + e3);
                if (lane < 4) { const int ee = lane == 0 ? ti[0] : lane == 1 ? ti[1] : lane == 2 ? ti[2] : ti[3]; const float gg = (lane == 0 ? 1.0f : lane == 1 ? e1 : lane == 2 ? e2 : e3) * inv;
                    TOKE[tok * 4 + lane] = ee; TOKG[tok * 4 + lane] = gg; TOKP[tok * 4 + lane] = (int)atomicAdd(&ctl[CW_CNT + l * 32 + ee], 1u); }
            }
        }
        if (IN(P + 7)) {
            int* ps = (int*)lds;
            __syncthreads();
            if (tid == 0) { int a = 0; for (int e = 0; e < NE; ++e) { ps[e] = a; a += (int)((ctl[CW_CNT + l * 32 + e] + 255u) / 256u) * 256; } ps[NE] = a; }
            __syncthreads();
            const int gt = blockIdx.x * NTHREADS + tid, gn = G * NTHREADS;
            for (int i = gt; i < T * 4; i += gn) { const int e = TOKE[i]; const int slot = ps[e] + TOKP[i]; TOKS[i] = slot; SLOTTOK[slot] = i >> 2; }
            for (int i = gt; i < NE * 256; i += gn) { const int e = i >> 8, j = i & 255; const int c = (int)ctl[CW_CNT + l * 32 + e]; const int si = c + j; if (si < ps[e + 1] - ps[e]) SLOTTOK[ps[e] + si] = 0; }
            const int nblk = ps[NE] / 256;
            for (int mb = gt; mb < nblk; mb += gn) { int e = 0; while (e < NE - 1 && mb * 256 >= ps[e + 1]) ++e; BLKE[mb] = e; }
            if (gt == 0) ctl[CW_NBLK + l] = (unsigned)nblk;
            __syncthreads();
        }
        if (IN(P + 8)) {
            const int nblk = (int)ctl[CW_NBLK + l];
            EpiSwiglu E{ACT, args.in[I_B1] + (size_t)l * NE * 2 * DFF};
            ngemm(H, SLOTTOK, W1 + (size_t)l * NE * 2 * DFF * D, BLKE, (size_t)2 * DFF * D, nblk * 256, DFF / 32, D, 1, E);
        }
        if (IN(P + 9)) {
            const int nblk = (int)ctl[CW_NBLK + l];
            EpiW2 E{Y, args.in[I_B2] + (size_t)l * NE * D};
            ngemm(ACT, nullptr, W2 + (size_t)l * NE * D * DFF, BLKE, (size_t)D * DFF, nblk * 256, D / 64, DFF, 0, E);
        }
        if (IN(P + 10)) {
            const bool last = (l == DEPTH - 1);
            const float* nw = last ? args.in[I_FNW] : args.in[I_NMW] + (size_t)(l + 1) * D;
            const float* modn = MOD + (size_t)(l + 1) * NB * NMOD;
            for (int tok = blockIdx.x * NWAVES + wave; tok < T; tok += G * NWAVES) {
                const int b = tok >> 11; f32x4 v[4], a[4];
#pragma unroll
                for (int i = 0; i < 4; ++i) { v[i] = *(const f32x4*)(X1 + (size_t)tok * D + (lane + 64 * i) * 4); a[i] = (f32x4){0.f, 0.f, 0.f, 0.f}; }
                for (int k = 0; k < 4; ++k) { const int slot = TOKS[tok * 4 + k]; const float g = TOKG[tok * 4 + k];
#pragma unroll
                    for (int i = 0; i < 4; ++i) { const f32x4 y = *(const f32x4*)(Y + (size_t)slot * D + (lane + 64 * i) * 4); a[i] += g * y; } }
                float ss = 0.f;
#pragma unroll
                for (int i = 0; i < 4; ++i) { const int c = (lane + 64 * i) * 4; const f32x4 gf = *(const f32x4*)(mod + (size_t)b * NMOD + 5 * D + c); v[i] = v[i] + gf * a[i];
                    ss += v[i][0] * v[i][0] + v[i][1] * v[i][1] + v[i][2] * v[i][2] + v[i][3] * v[i][3]; }
                ss = wave_sum(ss); const float r = rsqrtf(ss * (1.0f / D) + EPS);
#pragma unroll
                for (int i = 0; i < 4; ++i) { const int c = (lane + 64 * i) * 4;
                    if (last) { f32x4 o;
#pragma unroll
                        for (int j = 0; j < 4; ++j) o[j] = v[i][j] * r * nw[c + j];
                        *(f32x4*)(args.out + (size_t)tok * D + c) = o;
                    } else {
                        *(f32x4*)(X2 + (size_t)tok * D + c) = v[i];
#pragma unroll
                        for (int j = 0; j < 4; ++j) H[(size_t)tok * D + c + j] = f2bf(v[i][j] * r * nw[c + j] * (1.0f + modn[(size_t)b * NMOD + D + c + j]) + modn[(size_t)b * NMOD + c + j]);
                    } }
            }
        }
    }
#undef IN
}

constexpr int N_PHASES = 1 + 11 * DEPTH;
typedef void (*kern_t)(Args);
template <int K> static kern_t kern_of() { return fwd<K>; }
static kern_t kern_for(int kind) {
    switch (kind) { case 0: return fwd<0>; case 1: return fwd<1>; case 2: return fwd<2>; case 3: return fwd<3>; case 4: return fwd<4>; case 5: return fwd<5>;
                    case 6: return fwd<6>; case 7: return fwd<7>; case 8: return fwd<8>; case 9: return fwd<9>; case 10: return fwd<10>; default: return fwd<100>; }
}

extern "C" void kernel_launch(void* const* d_in, const int* in_sizes, int n_in, void* d_out, int out_size, void* d_ws, size_t ws_size, hipStream_t stream) {
    static int grid = 0;
    if (grid == 0) {
        if (n_in != 20 || out_size != T * D || ws_size < WS_END) { fprintf(stderr, "kernel_launch: unexpected problem (n_in %d, out %d, ws %zu, need %zu)\n", n_in, out_size, ws_size, (size_t)WS_END); grid = -1; return; }
        int dev = 0, cus = 0;
        if (hipGetDevice(&dev) != hipSuccess || hipDeviceGetAttribute(&cus, hipDeviceAttributeMultiprocessorCount, dev) != hipSuccess) { grid = -1; return; }
        for (int k = 0; k <= 11; ++k) {
            if (hipFuncSetAttribute((const void*)kern_for(k), hipFuncAttributeMaxDynamicSharedMemorySize, LDS_BYTES) != hipSuccess) { fprintf(stderr, "kernel_launch: hipFuncSetAttribute failed\n"); grid = -1; return; }
        }
        grid = cus > 0 ? cus : 256;
    }
    if (grid < 0) return;
    (void)hipMemsetAsync((char*)d_ws + WS_CTL, 0, CTL_BYTES, stream);
    Args a{};
    for (int i = 0; i < 20; ++i) a.in[i] = (const float*)d_in[i];
    a.out = (float*)d_out; a.ws = (unsigned char*)d_ws;
    for (int p = 0; p < N_PHASES; ++p) {
        if (p == 1 + 11) continue;
        a.ph_lo = p; a.ph_hi = p + 1;
        const int kind = p == 0 ? 11 : (p - 1) % 11;
        hipLaunchKernelGGL(kern_for(kind), dim3(grid), dim3(NTHREADS), LDS_BYTES, stream, a);
    }
}
```

```cpp
#include <hip/hip_runtime.h>
#include <stdint.h>
#include <stdio.h>

typedef unsigned short bf16_t;
typedef short bf16x8 __attribute__((ext_vector_type(8)));
typedef float f32x4 __attribute__((ext_vector_type(4)));
typedef float f32x16 __attribute__((ext_vector_type(16)));
typedef unsigned u32x4 __attribute__((ext_vector_type(4)));
#define LAS __attribute__((address_space(3)))

constexpr int T = 32768, D = 1024, NB = 16, SEQ = 2048, DEPTH = 2;
constexpr int ZC = 5320, ZLD = 5376;
constexpr int C_QA = 0, C_FA = 512, C_IA = 1024, C_GA = 1536, C_QB = 2048, C_KB = 2560, C_VB = 2624, C_IQ = 2688, C_IK = 3200, C_IW = 3264, C_GTA = 3272, C_GTB = 4296;
constexpr int NE = 32, DFF = 1024, NSLOT = 131072 + 32 * 256, NBLK_MAX = NSLOT / 256;
constexpr int NMOD = 6 * D;
constexpr float EPS = 1e-6f;
constexpr int NTHREADS = 512, NWAVES = 8;
constexpr int LDS_BYTES = 144 * 1024;

constexpr size_t al256(size_t x) { return (x + 255) & ~(size_t)255; }
constexpr size_t WS_CTL = 0;
constexpr size_t CTL_BYTES = 65536;
constexpr size_t WS_MOD = WS_CTL + CTL_BYTES;
constexpr size_t WS_LB = WS_MOD + al256((size_t)DEPTH * NB * NMOD * 4);
constexpr size_t WS_WIN = WS_LB + al256((size_t)DEPTH * 512 * 4);
constexpr size_t WS_WPA = WS_WIN + (size_t)DEPTH * ZLD * D * 2;
constexpr size_t WS_WPB = WS_WPA + (size_t)DEPTH * D * 512 * 2;
constexpr size_t WS_WOUT = WS_WPB + (size_t)DEPTH * D * 512 * 2;
constexpr size_t WS_W1 = WS_WOUT + (size_t)DEPTH * D * D * 2;
constexpr size_t WS_W2 = WS_W1 + (size_t)DEPTH * NE * 2 * DFF * D * 2;
constexpr size_t WS_H = WS_W2 + (size_t)DEPTH * NE * D * DFF * 2;
constexpr size_t WS_Z = WS_H + (size_t)T * D * 2;
constexpr size_t WS_Y = WS_Z;
constexpr size_t WS_ACT = WS_Z + (size_t)T * ZLD * 4;
constexpr size_t WS_ORAW = WS_ACT;
constexpr size_t WS_TMP = WS_ACT + (size_t)T * 512 * 4;
constexpr size_t WS_HA = WS_ACT + (size_t)NSLOT * DFF * 2;
constexpr size_t WS_ATT = WS_HA + (size_t)T * 512 * 2;
constexpr size_t WS_MASK = WS_ATT + (size_t)T * 512 * 2;
constexpr size_t WS_MERGED = WS_MASK + (size_t)T * 64 * 4;
constexpr size_t WS_X1 = WS_MERGED + (size_t)T * D * 2;
constexpr size_t WS_X2 = WS_X1 + (size_t)T * D * 4;
constexpr size_t WS_TOKE = WS_X2 + (size_t)T * D * 4;
constexpr size_t WS_TOKG = WS_TOKE + (size_t)T * 4 * 4;
constexpr size_t WS_TOKP = WS_TOKG + (size_t)T * 4 * 4;
constexpr size_t WS_TOKS = WS_TOKP + (size_t)T * 4 * 4;
constexpr size_t WS_SLOTTOK = WS_TOKS + (size_t)T * 4 * 4;
constexpr size_t WS_BLKE = WS_SLOTTOK + (size_t)NSLOT * 4;
constexpr size_t WS_END = WS_BLKE + al256((size_t)(NBLK_MAX + 64) * 4);
static_assert((size_t)NSLOT * D * 4 <= (size_t)T * ZLD * 4, "Y must fit in Z");
static_assert((size_t)T * 512 * 4 + (size_t)T * D * 4 <= (size_t)NSLOT * DFF * 2, "ORAW+TMP must fit in ACT");
static_assert(WS_END <= ((size_t)1 << 31), "workspace layout exceeds 2 GiB");
constexpr int CW_CNT = 1024;
constexpr int CW_NBLK = 1200;

__device__ __forceinline__ bf16_t f2bf(float f) { unsigned u = __float_as_uint(f); u += 0x7fffu + ((u >> 16) & 1u); return (bf16_t)(u >> 16); }
__device__ __forceinline__ float bf2f(bf16_t b) { return __uint_as_float(((unsigned)b) << 16); }
__device__ __forceinline__ float sigmoidf_(float x) { return 1.0f / (1.0f + __expf(-x)); }
__device__ __forceinline__ float wave_sum(float v) {
#pragma unroll
    for (int o = 32; o >= 1; o >>= 1) v += __shfl_xor(v, o);
    return v;
}
__device__ __forceinline__ int wave_sum_i(int v) {
#pragma unroll
    for (int o = 32; o >= 1; o >>= 1) v += __shfl_xor(v, o);
    return v;
}
__device__ const unsigned char T5_BUCKET[128] = {
    0, 1, 2, 3, 4, 5, 6, 7, 8, 9, 10, 11, 12, 13, 14, 15, 16, 16, 16, 17, 17, 18, 18, 18, 19, 19, 19, 20, 20, 20, 20, 21, 21, 21, 21, 22, 22, 22, 22, 22, 23, 23, 23, 23, 23, 23, 24, 24, 24, 24, 24, 24, 25,
    25, 25, 25, 25, 25, 25, 26, 26, 26, 26, 26, 26, 26, 26, 27, 27, 27, 27, 27, 27, 27, 27, 27, 27, 28, 28, 28, 28, 28, 28, 28, 28, 28, 28, 29, 29, 29, 29, 29, 29, 29, 29, 29, 29, 29, 29, 30, 30, 30, 30, 30,
    30, 30, 30, 30, 30, 30, 30, 30, 30, 31, 31, 31, 31, 31, 31, 31, 31, 31, 31, 31, 31, 31, 31, 31};
__device__ __forceinline__ int t5_bucket(int rel) { return rel >= 128 ? 31 : (int)T5_BUCKET[rel]; }


#define XB_TMO      128
#define XB_XCNT(j)  (256  + 64 * (j))
#define XB_XSUB(j)  (1280 + 64 * (j))
#define XB_XGEN(j)  (2304 + 64 * (j))
#define XB_TOP      3328
#define XB_TOPGEN   3392
#define XCD_BAR_WORDS 3456
#define XB_SPIN_CAP (1u << 18)
__device__ __forceinline__ unsigned xb_ld(unsigned* p)              { return __hip_atomic_load(p, __ATOMIC_RELAXED, __HIP_MEMORY_SCOPE_AGENT); }
__device__ __forceinline__ unsigned xb_add(unsigned* p, unsigned v) { return __hip_atomic_fetch_add(p, v, __ATOMIC_RELAXED, __HIP_MEMORY_SCOPE_AGENT); }
__device__ __forceinline__ unsigned xb_xcc_id() { return (unsigned)__builtin_amdgcn_s_getreg((3 << 11) | 20) & 0xFu; }
#define XB_SPIN(cond, bar) do { unsigned _sp = 0; while (cond) { __builtin_amdgcn_s_sleep(1); \
    if ((++_sp & 255u) == 0u) { if (xb_ld(&(bar)[XB_TMO])) break; if (_sp > XB_SPIN_CAP) { atomicAdd(&(bar)[XB_TMO], 1u); break; } } } } while (0)
struct XcdBarrier { unsigned* bar; unsigned x; volatile LAS unsigned* st; };
__device__ __forceinline__ XcdBarrier xcd_barrier_post(unsigned* bar, volatile LAS unsigned* st) {
    XcdBarrier b; b.bar = bar; b.x = xb_xcc_id(); b.st = st;
    if (threadIdx.x == 0) (void)xb_add(&bar[XB_XCNT(b.x)], 1u);
    return b;
}
__device__ __forceinline__ void xcd_barrier_complete(unsigned* bar, unsigned x, unsigned& nloc, unsigned& nx) {
    const unsigned G = gridDim.x * gridDim.y * gridDim.z;
    unsigned sum, cnt, mine, sp = 0u;
    for (;;) {
        sum = 0u; cnt = 0u; mine = 0u;
#pragma unroll
        for (unsigned j = 0; j < 16; ++j) { const unsigned c = xb_ld(&bar[XB_XCNT(j)]); sum += c; cnt += (c > 0u) ? 1u : 0u; mine = (j == x) ? c : mine; }
        if (sum == G) break;
        __builtin_amdgcn_s_sleep(1);
        if ((++sp & 255u) == 0u) { if (xb_ld(&bar[XB_TMO])) break; if (sp > XB_SPIN_CAP) { atomicAdd(&bar[XB_TMO], 1u); break; } }
    }
    nloc = mine > 0u ? mine : 1u; nx = cnt > 0u ? cnt : 1u;
}
__device__ __forceinline__ void xcd_barrier(const XcdBarrier& b) {
    asm volatile("s_waitcnt vmcnt(0)" ::: "memory");
    __syncthreads();
    if (threadIdx.x == 0) {
        unsigned* bar = b.bar; asm volatile("" : "+s"(bar));
        __builtin_amdgcn_s_waitcnt(0);
        unsigned nloc = b.st[0], nx = b.st[1];
        if (nloc == 0u) { xcd_barrier_complete(bar, b.x, nloc, nx); b.st[0] = nloc; b.st[1] = nx; }
        const unsigned old = xb_add(&bar[XB_XSUB(b.x)], 1u);
        const unsigned gen = old / nloc;
        if (old + 1u == (gen + 1u) * nloc) {
            __builtin_amdgcn_fence(__ATOMIC_RELEASE, "agent");
            asm volatile("s_waitcnt vmcnt(0)" ::: "memory");
            const unsigned og = xb_add(&bar[XB_TOP], 1u);
            const unsigned tg = og / nx;
            if (og + 1u == (tg + 1u) * nx) xb_add(&bar[XB_TOPGEN], 1u);
            else XB_SPIN(xb_ld(&bar[XB_TOPGEN]) == tg, bar);
            __builtin_amdgcn_fence(__ATOMIC_ACQUIRE, "agent");
            xb_add(&bar[XB_XGEN(b.x)], 1u);
            asm volatile("s_waitcnt vmcnt(0)" ::: "memory");
        } else {
            XB_SPIN(xb_ld(&bar[XB_XGEN(b.x)]) == gen, bar);
            __builtin_amdgcn_fence(__ATOMIC_ACQUIRE, "agent");
            asm volatile("s_waitcnt vmcnt(0)" ::: "memory");
        }
    }
    __syncthreads();
}
constexpr int CW_BAR = 4096;

struct Args { const float* in[20]; float* out; unsigned char* ws; int ph_lo, ph_hi; };
enum { I_X = 0, I_C, I_WADA, I_BADA, I_NMW, I_WIN, I_LBL, I_HNW, I_RELB, I_WPA, I_WPB, I_WOUT, I_NFW, I_WR, I_BR, I_W1, I_B1, I_W2, I_B2, I_FNW };

__device__ __forceinline__ void cvt_family(const float* src, bf16_t* dst, int K, int N, int Npad, int count, int mode, float* lt  ) {
    const int tid = threadIdx.x;
    const int tk = K / 64, tn = Npad / 64, per = tk * tn;
    for (long u = blockIdx.x; u < (long)per * count; u += gridDim.x) {
        const int mi = (int)(u / per), r = (int)(u % per), k0 = (r / tn) * 64, n0 = (r % tn) * 64;
        const float* s = src + (size_t)mi * K * N;
        bf16_t* d = dst + (size_t)mi * Npad * K;
        int sc0 = n0;
        if (mode == 1) { const int p = n0 >> 8, sel = (n0 >> 7) & 1, i = n0 & 127; sc0 = sel * 1024 + 128 * p + i; }
        __syncthreads();
        {
            const int i = tid >> 3, j0 = (tid & 7) * 8;
            float v[8];
            if (n0 + j0 < Npad && (mode == 1 || n0 + j0 < N)) {
                const f32x4 a = *(const f32x4*)(s + (size_t)(k0 + i) * N + sc0 + j0), b = *(const f32x4*)(s + (size_t)(k0 + i) * N + sc0 + j0 + 4);
                v[0] = a[0]; v[1] = a[1]; v[2] = a[2]; v[3] = a[3]; v[4] = b[0]; v[5] = b[1]; v[6] = b[2]; v[7] = b[3];
            } else {
#pragma unroll
                for (int q = 0; q < 8; ++q) v[q] = 0.f;
            }
#pragma unroll
            for (int q = 0; q < 8; ++q) lt[i * 65 + j0 + q] = v[q];
        }
        __syncthreads();
        {
            const int n = tid >> 3, kk = (tid & 7) * 8;
            unsigned w[4];
#pragma unroll
            for (int q = 0; q < 4; ++q) w[q] = (unsigned)f2bf(lt[(kk + 2 * q) * 65 + n]) | ((unsigned)f2bf(lt[(kk + 2 * q + 1) * 65 + n]) << 16);
            u32x4 o; o.x = w[0]; o.y = w[1]; o.z = w[2]; o.w = w[3];
            *(u32x4*)(d + (size_t)(n0 + n) * K + k0 + kk) = o;
        }
    }
    __syncthreads();
}

template <class Epi>
__device__ __forceinline__ void ngemm(const bf16_t* A, const int* rowidx, const bf16_t* Bt, const int* blk_e, size_t bt_stride, int M, int NT  , int K, int pair, const Epi& epi) {
    const int lane = threadIdx.x & 63, wave = threadIdx.x >> 6;
    const int r31 = lane & 31, hh = lane >> 5;
    const long ntile = (long)(M / 64) * NT;
    for (long tix = (long)blockIdx.x * NWAVES + wave; tix < ntile; tix += (long)gridDim.x * NWAVES) {
        const int tm = (int)(tix / NT), tn = (int)(tix % NT);
        const int r0 = tm * 64;
        const int c0 = pair ? (256 * (tn >> 2) + 32 * (tn & 3)) : 64 * tn, c1 = pair ? c0 + 128 : c0 + 32;
        const int e = blk_e ? blk_e[tm >> 2] : 0;
        const bf16_t* B = Bt + (size_t)e * bt_stride;
        const bf16_t* ap[2]; const bf16_t* bp[2];
#pragma unroll
        for (int mi = 0; mi < 2; ++mi) { const int row = r0 + 32 * mi + r31; const int ar = rowidx ? rowidx[row] : row; ap[mi] = A + (size_t)ar * K + 8 * hh; }
        bp[0] = B + (size_t)(c0 + r31) * K + 8 * hh; bp[1] = B + (size_t)(c1 + r31) * K + 8 * hh;
        f32x16 acc[2][2];
#pragma unroll
        for (int a = 0; a < 2; ++a)
#pragma unroll
            for (int b = 0; b < 2; ++b)
#pragma unroll
                for (int q = 0; q < 16; ++q) acc[a][b][q] = 0.f;
        for (int k = 0; k < K; k += 16) {
            const bf16x8 a0 = *(const bf16x8*)(ap[0] + k), a1 = *(const bf16x8*)(ap[1] + k), b0 = *(const bf16x8*)(bp[0] + k), b1 = *(const bf16x8*)(bp[1] + k);
            acc[0][0] = __builtin_amdgcn_mfma_f32_32x32x16_bf16(a0, b0, acc[0][0], 0, 0, 0);
            acc[0][1] = __builtin_amdgcn_mfma_f32_32x32x16_bf16(a0, b1, acc[0][1], 0, 0, 0);
            acc[1][0] = __builtin_amdgcn_mfma_f32_32x32x16_bf16(a1, b0, acc[1][0], 0, 0, 0);
            acc[1][1] = __builtin_amdgcn_mfma_f32_32x32x16_bf16(a1, b1, acc[1][1], 0, 0, 0);
        }
        epi(acc, r0, c0, c1, e, tn, lane);
    }
}
#define ACC_ROW(q, lane) (((q) & 3) + 8 * ((q) >> 2) + 4 * ((lane) >> 5))

struct EpiStoreF32 { float* C; int ldc;
    __device__ __forceinline__ void operator()(const f32x16 (&acc)[2][2], int r0, int c0, int c1, int, int, int lane) const {
#pragma unroll
        for (int mi = 0; mi < 2; ++mi)
#pragma unroll
            for (int q = 0; q < 16; ++q) { const int row = r0 + 32 * mi + ACC_ROW(q, lane); C[(size_t)row * ldc + c0 + (lane & 31)] = acc[mi][0][q]; C[(size_t)row * ldc + c1 + (lane & 31)] = acc[mi][1][q]; }
    } };
struct EpiMerge1 { float* tmp; const float* Z; int gcol;
    __device__ __forceinline__ void operator()(const f32x16 (&acc)[2][2], int r0, int c0, int c1, int, int, int lane) const {
#pragma unroll
        for (int mi = 0; mi < 2; ++mi)
#pragma unroll
            for (int q = 0; q < 16; ++q) { const int row = r0 + 32 * mi + ACC_ROW(q, lane);
#pragma unroll
                for (int ni = 0; ni < 2; ++ni) { const int col = (ni ? c1 : c0) + (lane & 31); tmp[(size_t)row * D + col] = sigmoidf_(Z[(size_t)row * ZLD + gcol + col]) * acc[mi][ni][q]; } }
    } };
struct EpiMerge2 { const float* tmp; bf16_t* merged; const float* Z; int gcol;
    __device__ __forceinline__ void operator()(const f32x16 (&acc)[2][2], int r0, int c0, int c1, int, int, int lane) const {
#pragma unroll
        for (int mi = 0; mi < 2; ++mi)
#pragma unroll
            for (int q = 0; q < 16; ++q) { const int row = r0 + 32 * mi + ACC_ROW(q, lane);
#pragma unroll
                for (int ni = 0; ni < 2; ++ni) { const int col = (ni ? c1 : c0) + (lane & 31); merged[(size_t)row * D + col] = f2bf(tmp[(size_t)row * D + col] + sigmoidf_(Z[(size_t)row * ZLD + gcol + col]) * acc[mi][ni][q]); } }
    } };
struct EpiOut { const float* xin; float* x1; const float* gate  ;
    __device__ __forceinline__ void operator()(const f32x16 (&acc)[2][2], int r0, int c0, int c1, int, int, int lane) const {
#pragma unroll
        for (int mi = 0; mi < 2; ++mi)
#pragma unroll
            for (int q = 0; q < 16; ++q) { const int row = r0 + 32 * mi + ACC_ROW(q, lane); const int b = row >> 11;
#pragma unroll
                for (int ni = 0; ni < 2; ++ni) { const int col = (ni ? c1 : c0) + (lane & 31); x1[(size_t)row * D + col] = xin[(size_t)row * D + col] + gate[(size_t)b * NMOD + col] * acc[mi][ni][q]; } }
    } };
struct EpiSwiglu { bf16_t* act; const float* b1  ;
    __device__ __forceinline__ void operator()(const f32x16 (&acc)[2][2], int r0, int, int, int e, int tn, int lane) const {
        const int col = 32 * tn + (lane & 31);
        const float bg = b1[(size_t)e * 2 * DFF + col], bl = b1[(size_t)e * 2 * DFF + DFF + col];
#pragma unroll
        for (int mi = 0; mi < 2; ++mi)
#pragma unroll
            for (int q = 0; q < 16; ++q) { const int row = r0 + 32 * mi + ACC_ROW(q, lane);
                float glu = fminf(acc[mi][0][q] + bg, 7.0f); float lin = fminf(fmaxf(acc[mi][1][q] + bl, -7.0f), 7.0f);
                act[(size_t)row * DFF + col] = f2bf(glu * sigmoidf_(1.702f * glu) * (lin + 1.0f)); }
    } };
struct EpiW2 { float* Y; const float* b2  ;
    __device__ __forceinline__ void operator()(const f32x16 (&acc)[2][2], int r0, int c0, int c1, int e, int, int lane) const {
#pragma unroll
        for (int mi = 0; mi < 2; ++mi)
#pragma unroll
            for (int q = 0; q < 16; ++q) { const int row = r0 + 32 * mi + ACC_ROW(q, lane);
#pragma unroll
                for (int ni = 0; ni < 2; ++ni) { const int col = (ni ? c1 : c0) + (lane & 31); Y[(size_t)row * D + col] = acc[mi][ni][q] + b2[(size_t)e * D + col]; } }
    } };

template <int KIND> __global__ void __launch_bounds__(NTHREADS, 2) fwd(Args args) {
    extern __shared__ __attribute__((aligned(16))) unsigned char lds[];
    const int tid = threadIdx.x, lane = tid & 63, wave = tid >> 6;
    const int G = gridDim.x;
#define WS_OPAQUE() unsigned char* ws = args.ws; asm volatile("" : "+s"(ws))
#define ctl ((unsigned*)(ws + WS_CTL))
#define MOD ((float*)(ws + WS_MOD))
#define LB ((float*)(ws + WS_LB))
#define WIN ((bf16_t*)(ws + WS_WIN))
#define WPA ((bf16_t*)(ws + WS_WPA))
#define WPB ((bf16_t*)(ws + WS_WPB))
#define WOUT ((bf16_t*)(ws + WS_WOUT))
#define W1 ((bf16_t*)(ws + WS_W1))
#define W2 ((bf16_t*)(ws + WS_W2))
#define H ((bf16_t*)(ws + WS_H))
#define Z ((float*)(ws + WS_Z))
#define Y ((float*)(ws + WS_Y))
#define ACT ((bf16_t*)(ws + WS_ACT))
#define ORAW ((float*)(ws + WS_ORAW))
#define TMP ((float*)(ws + WS_TMP))
#define HA ((bf16_t*)(ws + WS_HA))
#define ATT ((bf16_t*)(ws + WS_ATT))
#define MASK ((unsigned*)(ws + WS_MASK))
#define MERGED ((bf16_t*)(ws + WS_MERGED))
#define X1 ((float*)(ws + WS_X1))
#define X2 ((float*)(ws + WS_X2))
#define TOKE ((int*)(ws + WS_TOKE))
#define TOKG ((float*)(ws + WS_TOKG))
#define TOKP ((int*)(ws + WS_TOKP))
#define TOKS ((int*)(ws + WS_TOKS))
#define SLOTTOK ((int*)(ws + WS_SLOTTOK))
#define BLKE ((int*)(ws + WS_BLKE))
    const int lo = args.ph_lo, hi = args.ph_hi;
#define IN(k) ((KIND < 0 || ((k) == 0 ? KIND == 100 : KIND == ((k) - 1) % 11)) && lo <= (k) && (k) < hi)
#define SEAM(k) do { if (KIND < 0 && IN(k) && IN((k) + 1)) xcd_barrier(bar); } while (0)
    XcdBarrier bar; bar.bar = (unsigned*)(args.ws + WS_CTL) + CW_BAR; bar.x = 0; bar.st = nullptr;
    if (KIND < 0) {
        volatile LAS unsigned* xbw = (volatile LAS unsigned*)((LAS unsigned char*)lds + (LDS_BYTES - 16));
        if (tid == 0) { xbw[0] = 0u; xbw[1] = 0u; xbw[2] = 0u; xbw[3] = 0u; }
        __syncthreads();
        bar = xcd_barrier_post((unsigned*)(args.ws + WS_CTL) + CW_BAR, xbw);
    }

    if (IN(0)) {
        WS_OPAQUE();
        float* lt = (float*)lds;
        cvt_family(args.in[I_WIN], WIN, D, ZC, ZLD, DEPTH, 0, lt);
        cvt_family(args.in[I_WPA], WPA, 512, D, D, DEPTH, 0, lt);
        cvt_family(args.in[I_WPB], WPB, 512, D, D, DEPTH, 0, lt);
        cvt_family(args.in[I_WOUT], WOUT, D, D, D, DEPTH, 0, lt);
        cvt_family(args.in[I_W1], W1, D, 2 * DFF, 2 * DFF, DEPTH * NE, 1, lt);
        cvt_family(args.in[I_W2], W2, DFF, D, D, DEPTH * NE, 0, lt);
        {
            float* ca = (float*)lds;
            __syncthreads();
            for (int i = tid; i < NB * D; i += NTHREADS) { const float c = args.in[I_C][i]; ca[i] = c * sigmoidf_(c); }
            __syncthreads();
            for (int u = blockIdx.x; u < DEPTH * NMOD / NTHREADS; u += G) {
                const int ln = u * NTHREADS + tid, l = ln / NMOD, n = ln % NMOD;
                const float* w = args.in[I_WADA] + (size_t)l * D * NMOD + n;
                float acc[NB];
#pragma unroll
                for (int b = 0; b < NB; ++b) acc[b] = 0.f;
                for (int k = 0; k < D; ++k) { const float wv = w[(size_t)k * NMOD];
#pragma unroll
                    for (int b = 0; b < NB; ++b) acc[b] += ca[b * D + k] * wv; }
                const float bb = args.in[I_BADA][(size_t)l * NMOD + n];
#pragma unroll
                for (int b = 0; b < NB; ++b) MOD[((size_t)l * NB + b) * NMOD + n] = acc[b] + bb;
            }
            __syncthreads();
        }
        if (blockIdx.x == G - 1) {
            for (int j = tid; j < 512; j += NTHREADS) { const float a0 = args.in[I_LBL][j], a1 = args.in[I_LBL][512 + j]; LB[j] = 0.f; LB[512 + j] = 1.0f / (1.0f + __expf(a0 - a1)); }
        }
    }

    SEAM(0);
#pragma unroll
    for (int l = 0; l < DEPTH; ++l) {
        const int P = 1 + 11 * l;
#define mod (MOD + (size_t)l * NB * NMOD)
#define xin ((l == 0) ? args.in[I_X] : (const float*)X2)
        if (IN(P + 0) && l == 0) {
            WS_OPAQUE();
            const float* nw = args.in[I_NMW] + (size_t)l * D;
            for (int row = blockIdx.x * NWAVES + wave; row < T; row += G * NWAVES) {
                const int b = row >> 11; f32x4 v[4]; float ss = 0.f;
#pragma unroll
                for (int i = 0; i < 4; ++i) { v[i] = *(const f32x4*)(xin + (size_t)row * D + (lane + 64 * i) * 4); ss += v[i][0] * v[i][0] + v[i][1] * v[i][1] + v[i][2] * v[i][2] + v[i][3] * v[i][3]; }
                ss = wave_sum(ss); const float r = rsqrtf(ss * (1.0f / D) + EPS);
#pragma unroll
                for (int i = 0; i < 4; ++i) { const int c = (lane + 64 * i) * 4;
#pragma unroll
                    for (int j = 0; j < 4; ++j) H[(size_t)row * D + c + j] = f2bf(v[i][j] * r * nw[c + j] * (1.0f + mod[(size_t)b * NMOD + D + c + j]) + mod[(size_t)b * NMOD + c + j]); }
            }
        }
        if (l == 0) SEAM(P + 0);
        if (IN(P + 1)) {
            WS_OPAQUE();
            EpiStoreF32 E{Z, ZLD};
            ngemm(H, nullptr, WIN + (size_t)l * ZLD * D, nullptr, 0, T, ZLD / 64, D, 0, E);
        }
        SEAM(P + 1);
        if (IN(P + 2)) {
            WS_OPAQUE();
            {
                float* qs = (float*)lds; float* fs = qs + 32 * 128; float* ks = fs + 32 * 128; float* op = ks + 32 * 128;
                const int dv = tid & 127, dkq = tid >> 7;
                for (int u = blockIdx.x; u < NB * 4; u += G) {
                    const int b = u >> 2, h = u & 3;
                    float S[32];
#pragma unroll
                    for (int i = 0; i < 32; ++i) S[i] = 0.f;
                    for (int c = 0; c < SEQ / 32; ++c) {
                        const int row0 = b * SEQ + c * 32;
                        for (int e = tid; e < 4096; e += NTHREADS) { const int tt = e >> 7, d = e & 127;
                            const float za = Z[(size_t)(row0 + tt) * ZLD + C_QA + h * 128 + d], zf = Z[(size_t)(row0 + tt) * ZLD + C_FA + h * 128 + d];
                            const float lb = LB[l * 512 + h * 128 + d];
                            const float sg = sigmoidf_(zf);
                            qs[e] = za * sigmoidf_(za); fs[e] = lb + (1.0f - lb) * sg; ks[e] = (1.0f - lb) * (1.0f / (1.0f + __expf(zf))); }
                        __syncthreads();
                        for (int tt = 0; tt < 32; ++tt) {
                            const float v = Z[(size_t)(row0 + tt) * ZLD + C_IA + h * 128 + dv]; float o = 0.f;
#pragma unroll
                            for (int i = 0; i < 32; ++i) { S[i] = fs[tt * 128 + 32 * dkq + i] * S[i] + ks[tt * 128 + 32 * dkq + i] * v; o += qs[tt * 128 + 32 * dkq + i] * S[i]; }
                            op[(tt * 4 + dkq) * 128 + dv] = o;
                        }
                        __syncthreads();
                        for (int e = tid; e < 4096; e += NTHREADS) { const int tt = e >> 7, d = e & 127;
                            ORAW[(size_t)(row0 + tt) * 512 + h * 128 + d] = (op[(tt * 4 + 0) * 128 + d] + op[(tt * 4 + 1) * 128 + d]) + (op[(tt * 4 + 2) * 128 + d] + op[(tt * 4 + 3) * 128 + d]); }
                        __syncthreads();
                    }
                }
            }
            {
                unsigned* kl = (unsigned*)lds; unsigned* cnt = kl + 2048; unsigned* mw = cnt + 64;
                for (int qi = blockIdx.x; qi < T; qi += G) {
                    const int b = qi >> 11, t = qi & 2047, n = t + 1;
                    __syncthreads();
                    if (tid < 64) { cnt[tid] = 0u; mw[tid] = 0u; }
                    if (n <= 256) {
                        __syncthreads();
                        if (tid < 64) { const int lo_ = tid * 32; unsigned m = 0u; if (n >= lo_ + 32) m = 0xffffffffu; else if (n > lo_) m = (1u << (n - lo_)) - 1u; MASK[(size_t)qi * 64 + tid] = m; }
                        continue;
                    }
                    const float* zq = Z + (size_t)qi * ZLD;
                    unsigned key[4];
#pragma unroll
                    for (int i = 0; i < 4; ++i) {
                        const int s = tid + 512 * i; key[i] = 0u;
                        if (s < n) {
                            const float* kr = Z + (size_t)(b * SEQ + s) * ZLD + C_IK; float kk[64];
#pragma unroll
                            for (int d4 = 0; d4 < 16; ++d4) { const f32x4 x = *(const f32x4*)(kr + 4 * d4); kk[4 * d4] = x[0]; kk[4 * d4 + 1] = x[1]; kk[4 * d4 + 2] = x[2]; kk[4 * d4 + 3] = x[3]; }
                            float sc = 0.f;
                            for (int h = 0; h < 8; ++h) { float dot = 0.f;
#pragma unroll
                                for (int d = 0; d < 64; ++d) dot += zq[C_IQ + h * 64 + d] * kk[d];
                                sc += (zq[C_IW + h] * 0.04419417382415922f) * fmaxf(dot, 0.f); }
                            unsigned u = __float_as_uint(sc); u = (u & 0x80000000u) ? ~u : (u | 0x80000000u); key[i] = u;
                        }
                        kl[s] = key[i];
                    }
                    __syncthreads();
                    unsigned tau = 0u;
                    for (int bit = 31; bit >= 0; --bit) {
                        const unsigned cand = tau | (1u << bit);
                        int c = (key[0] >= cand) + (key[1] >= cand) + (key[2] >= cand) + (key[3] >= cand);
                        c = wave_sum_i(c);
                        if (lane == 0 && c) atomicAdd(&cnt[bit], (unsigned)c);
                        __syncthreads();
                        if (cnt[bit] >= 256u) tau = cand;
                    }
                    { int c = (key[0] > tau) + (key[1] > tau) + (key[2] > tau) + (key[3] > tau); c = wave_sum_i(c); if (lane == 0 && c) atomicAdd(&cnt[32], (unsigned)c); }
                    __syncthreads();
                    const int r = 256 - (int)cnt[32];
#pragma unroll
                    for (int i = 0; i < 4; ++i) {
                        const int s = tid + 512 * i; bool sel = key[i] > tau;
                        if (key[i] == tau && s < n) { int rank = 0; for (int s2 = 0; s2 < s; ++s2) rank += (kl[s2] == tau); sel = rank < r; }
                        if (sel) atomicOr(&mw[s >> 5], 1u << (s & 31));
                    }
                    __syncthreads();
                    if (tid < 64) MASK[(size_t)qi * 64 + tid] = mw[tid];
                }
                __syncthreads();
            }
        }
        SEAM(P + 2);
        if (IN(P + 3)) {
            WS_OPAQUE();
            const float* hnw = args.in[I_HNW] + (size_t)l * 512;
            for (int row = blockIdx.x * NWAVES + wave; row < T; row += G * NWAVES) {
                const int c0 = lane * 8; float o[8]; float ss = 0.f;
#pragma unroll
                for (int j = 0; j < 8; ++j) { o[j] = ORAW[(size_t)row * 512 + c0 + j]; ss += o[j] * o[j]; }
                ss += __shfl_xor(ss, 1); ss += __shfl_xor(ss, 2); ss += __shfl_xor(ss, 4); ss += __shfl_xor(ss, 8);
                const float r = rsqrtf(ss * (1.0f / 128.0f) + EPS);
#pragma unroll
                for (int j = 0; j < 8; ++j) { const float g = Z[(size_t)row * ZLD + C_GA + c0 + j]; HA[(size_t)row * 512 + c0 + j] = f2bf(o[j] * r * hnw[c0 + j] * (g * sigmoidf_(g))); }
            }
            {
                unsigned* mw = (unsigned*)lds; int* idx = (int*)(mw + 64); int* nsel = idx + 256; float* ql = (float*)(nsel + 64); float* bl = ql + 512; float* lg = bl + 256; float* inv = lg + 8 * 256;
                __syncthreads();
                for (int i = tid; i < 256; i += NTHREADS) bl[i] = args.in[I_RELB][i];
                for (int qi = blockIdx.x; qi < T; qi += G) {
                    const int b = qi >> 11, t = qi & 2047;
                    __syncthreads();
                    if (tid < 64) mw[tid] = MASK[(size_t)qi * 64 + tid];
                    ql[tid] = Z[(size_t)qi * ZLD + C_QB + tid] * 0.125f;
                    __syncthreads();
                    if (tid < 64) { int base = 0; for (int w = 0; w < tid; ++w) base += __popc(mw[w]); unsigned m = mw[tid]; int j = base; while (m) { const int bp = __ffs(m) - 1; m &= m - 1u; if (j < 256) idx[j] = tid * 32 + bp; ++j; } if (tid == 63) nsel[0] = j < 256 ? j : 256; }
                    __syncthreads();
                    const int n = nsel[0];
                    {
                        const int j = tid & 255, hg = tid >> 8;
                        if (j < n) {
                            const int s = idx[j]; const float* kr = Z + (size_t)(b * SEQ + s) * ZLD + C_KB; float kk[64];
#pragma unroll
                            for (int d4 = 0; d4 < 16; ++d4) { const f32x4 x = *(const f32x4*)(kr + 4 * d4); kk[4 * d4] = x[0]; kk[4 * d4 + 1] = x[1]; kk[4 * d4 + 2] = x[2]; kk[4 * d4 + 3] = x[3]; }
                            const int bk = t5_bucket(t - s);
                            for (int h4 = 0; h4 < 4; ++h4) { const int h = hg * 4 + h4; float dot = 0.f;
#pragma unroll
                                for (int d = 0; d < 64; ++d) dot += ql[h * 64 + d] * kk[d];
                                lg[h * 256 + j] = dot + bl[bk * 8 + h]; }
                        } else { for (int h4 = 0; h4 < 4; ++h4) lg[(hg * 4 + h4) * 256 + j] = -INFINITY; }
                    }
                    __syncthreads();
                    {
                        float v[4]; float m = -INFINITY;
#pragma unroll
                        for (int i = 0; i < 4; ++i) { v[i] = lg[wave * 256 + lane + 64 * i]; m = fmaxf(m, v[i]); }
#pragma unroll
                        for (int o = 32; o >= 1; o >>= 1) m = fmaxf(m, __shfl_xor(m, o));
                        float s = 0.f;
#pragma unroll
                        for (int i = 0; i < 4; ++i) { v[i] = __expf(v[i] - m); s += v[i]; lg[wave * 256 + lane + 64 * i] = v[i]; }
                        s = wave_sum(s); if (lane == 0) inv[wave] = 1.0f / s;
                    }
                    __syncthreads();
                    {
                        const int h = tid >> 6, d = tid & 63; float acc = 0.f;
#pragma unroll 8
                        for (int j = 0; j < n; ++j) acc += lg[h * 256 + j] * Z[(size_t)(b * SEQ + idx[j]) * ZLD + C_VB + d];
                        ATT[(size_t)qi * 512 + h * 64 + d] = f2bf(acc * inv[h]);
                    }
                }
                __syncthreads();
            }
        }
        SEAM(P + 3);
        if (IN(P + 4)) {
            WS_OPAQUE();
            EpiMerge1 E1{TMP, Z, C_GTA}; ngemm(HA, nullptr, WPA + (size_t)l * D * 512, nullptr, 0, T, D / 64, 512, 0, E1);
            EpiMerge2 E2{TMP, MERGED, Z, C_GTB}; ngemm(ATT, nullptr, WPB + (size_t)l * D * 512, nullptr, 0, T, D / 64, 512, 0, E2);
        }
        SEAM(P + 4);
        if (IN(P + 5)) {
            WS_OPAQUE();
            EpiOut E{xin, X1, mod + 2 * D}; ngemm(MERGED, nullptr, WOUT + (size_t)l * D * D, nullptr, 0, T, D / 64, D, 0, E);
        }
        SEAM(P + 5);
        if (IN(P + 6)) {
            WS_OPAQUE();
            const float* nw = args.in[I_NFW] + (size_t)l * D; const float* wr = args.in[I_WR] + (size_t)l * D * NE; const float* br = args.in[I_BR] + (size_t)l * NE;
            float* hrow = (float*)lds + wave * D;
            for (int tok = blockIdx.x * NWAVES + wave; tok < T; tok += G * NWAVES) {
                const int b = tok >> 11; f32x4 v[4]; float ss = 0.f;
#pragma unroll
                for (int i = 0; i < 4; ++i) { v[i] = *(const f32x4*)(X1 + (size_t)tok * D + (lane + 64 * i) * 4); ss += v[i][0] * v[i][0] + v[i][1] * v[i][1] + v[i][2] * v[i][2] + v[i][3] * v[i][3]; }
                ss = wave_sum(ss); const float r = rsqrtf(ss * (1.0f / D) + EPS);
                __syncthreads();
#pragma unroll
                for (int i = 0; i < 4; ++i) { const int c = (lane + 64 * i) * 4;
#pragma unroll
                    for (int j = 0; j < 4; ++j) { const float hv = v[i][j] * r * nw[c + j] * (1.0f + mod[(size_t)b * NMOD + 4 * D + c + j]) + mod[(size_t)b * NMOD + 3 * D + c + j]; hrow[c + j] = hv; H[(size_t)tok * D + c + j] = f2bf(hv); } }
                __syncthreads();
                const int e = lane & 31, half = lane >> 5; float acc = 0.f;
                for (int k = half * 512; k < half * 512 + 512; ++k) acc += hrow[k] * wr[(size_t)k * NE + e];
                acc += __shfl_xor(acc, 32);
                float logit = acc + br[e];
                float tv[4]; int ti[4];
#pragma unroll
                for (int k = 0; k < 4; ++k) {
                    float bv = logit; int bi = e;
#pragma unroll
                    for (int o = 16; o >= 1; o >>= 1) { const float ov = __shfl_xor(bv, o); const int oi = __shfl_xor(bi, o); if (ov > bv || (ov == bv && oi < bi)) { bv = ov; bi = oi; } }
                    tv[k] = bv; ti[k] = bi; if (e == bi) logit = -INFINITY;
                }
                const float e1 = __expf(tv[1] - tv[0]), e2 = __expf(tv[2] - tv[0]), e3 = __expf(tv[3] - tv[0]); const float inv = 1.0f / (1.0f + e1 + e2 + e3);
                if (lane < 4) { const int ee = lane == 0 ? ti[0] : lane == 1 ? ti[1] : lane == 2 ? ti[2] : ti[3]; const float gg = (lane == 0 ? 1.0f : lane == 1 ? e1 : lane == 2 ? e2 : e3) * inv;
                    TOKE[tok * 4 + lane] = ee; TOKG[tok * 4 + lane] = gg; TOKP[tok * 4 + lane] = (int)atomicAdd(&ctl[CW_CNT + l * 32 + ee], 1u); }
            }
        }
        SEAM(P + 6);
        if (IN(P + 7)) {
            WS_OPAQUE();
            int* ps = (int*)lds;
            __syncthreads();
            if (tid == 0) { int a = 0; for (int e = 0; e < NE; ++e) { ps[e] = a; a += (int)((ctl[CW_CNT + l * 32 + e] + 255u) / 256u) * 256; } ps[NE] = a; }
            __syncthreads();
            const int gt = blockIdx.x * NTHREADS + tid, gn = G * NTHREADS;
            for (int i = gt; i < T * 4; i += gn) { const int e = TOKE[i]; const int slot = ps[e] + TOKP[i]; TOKS[i] = slot; SLOTTOK[slot] = i >> 2; }
            for (int i = gt; i < NE * 256; i += gn) { const int e = i >> 8, j = i & 255; const int c = (int)ctl[CW_CNT + l * 32 + e]; const int si = c + j; if (si < ps[e + 1] - ps[e]) SLOTTOK[ps[e] + si] = 0; }
            const int nblk = ps[NE] / 256;
            for (int mb = gt; mb < nblk; mb += gn) { int e = 0; while (e < NE - 1 && mb * 256 >= ps[e + 1]) ++e; BLKE[mb] = e; }
            if (gt == 0) ctl[CW_NBLK + l] = (unsigned)nblk;
            __syncthreads();
        }
        SEAM(P + 7);
        if (IN(P + 8)) {
            WS_OPAQUE();
            const int nblk = (int)ctl[CW_NBLK + l];
            EpiSwiglu E{ACT, args.in[I_B1] + (size_t)l * NE * 2 * DFF};
            ngemm(H, SLOTTOK, W1 + (size_t)l * NE * 2 * DFF * D, BLKE, (size_t)2 * DFF * D, nblk * 256, DFF / 32, D, 1, E);
        }
        SEAM(P + 8);
        if (IN(P + 9)) {
            WS_OPAQUE();
            const int nblk = (int)ctl[CW_NBLK + l];
            EpiW2 E{Y, args.in[I_B2] + (size_t)l * NE * D};
            ngemm(ACT, nullptr, W2 + (size_t)l * NE * D * DFF, BLKE, (size_t)D * DFF, nblk * 256, D / 64, DFF, 0, E);
        }
        SEAM(P + 9);
        if (IN(P + 10)) {
            WS_OPAQUE();
            const bool last = (l == DEPTH - 1);
            const float* nw = last ? args.in[I_FNW] : args.in[I_NMW] + (size_t)(l + 1) * D;
            const float* modn = MOD + (size_t)(l + 1) * NB * NMOD;
            for (int tok = blockIdx.x * NWAVES + wave; tok < T; tok += G * NWAVES) {
                const int b = tok >> 11; f32x4 v[4], a[4];
#pragma unroll
                for (int i = 0; i < 4; ++i) { v[i] = *(const f32x4*)(X1 + (size_t)tok * D + (lane + 64 * i) * 4); a[i] = (f32x4){0.f, 0.f, 0.f, 0.f}; }
                for (int k = 0; k < 4; ++k) { const int slot = TOKS[tok * 4 + k]; const float g = TOKG[tok * 4 + k];
#pragma unroll
                    for (int i = 0; i < 4; ++i) { const f32x4 y = *(const f32x4*)(Y + (size_t)slot * D + (lane + 64 * i) * 4); a[i] += g * y; } }
                float ss = 0.f;
#pragma unroll
                for (int i = 0; i < 4; ++i) { const int c = (lane + 64 * i) * 4; const f32x4 gf = *(const f32x4*)(mod + (size_t)b * NMOD + 5 * D + c); v[i] = v[i] + gf * a[i];
                    ss += v[i][0] * v[i][0] + v[i][1] * v[i][1] + v[i][2] * v[i][2] + v[i][3] * v[i][3]; }
                ss = wave_sum(ss); const float r = rsqrtf(ss * (1.0f / D) + EPS);
#pragma unroll
                for (int i = 0; i < 4; ++i) { const int c = (lane + 64 * i) * 4;
                    if (last) { f32x4 o;
#pragma unroll
                        for (int j = 0; j < 4; ++j) o[j] = v[i][j] * r * nw[c + j];
                        *(f32x4*)(args.out + (size_t)tok * D + c) = o;
                    } else {
                        *(f32x4*)(X2 + (size_t)tok * D + c) = v[i];
#pragma unroll
                        for (int j = 0; j < 4; ++j) H[(size_t)tok * D + c + j] = f2bf(v[i][j] * r * nw[c + j] * (1.0f + modn[(size_t)b * NMOD + D + c + j]) + modn[(size_t)b * NMOD + c + j]);
                    } }
            }
        }
        SEAM(P + 10);
    }
#undef IN
}

constexpr int N_PHASES = 1 + 11 * DEPTH;
typedef void (*kern_t)(Args);
template <int K> static kern_t kern_of() { return fwd<K>; }
static kern_t kern_for(int kind) {
    switch (kind) { case 0: return fwd<0>; case 1: return fwd<1>; case 2: return fwd<2>; case 3: return fwd<3>; case 4: return fwd<4>; case 5: return fwd<5>;
                    case 6: return fwd<6>; case 7: return fwd<7>; case 8: return fwd<8>; case 9: return fwd<9>; case 10: return fwd<10>; default: return fwd<100>; }
}

extern "C" void kernel_launch(void* const* d_in, const int* in_sizes, int n_in, void* d_out, int out_size, void* d_ws, size_t ws_size, hipStream_t stream) {
    static int grid = 0;
    if (grid == 0) {
        if (n_in != 20 || out_size != T * D || ws_size < WS_END) { fprintf(stderr, "kernel_launch: unexpected problem (n_in %d, out %d, ws %zu, need %zu)\n", n_in, out_size, ws_size, (size_t)WS_END); grid = -1; return; }
        int dev = 0, cus = 0;
        if (hipGetDevice(&dev) != hipSuccess || hipDeviceGetAttribute(&cus, hipDeviceAttributeMultiprocessorCount, dev) != hipSuccess) { grid = -1; return; }
        for (int k = 0; k <= 12; ++k) {
            if (hipFuncSetAttribute((const void*)(k == 12 ? (kern_t)fwd<-1> : kern_for(k)), hipFuncAttributeMaxDynamicSharedMemorySize, LDS_BYTES) != hipSuccess) { fprintf(stderr, "kernel_launch: hipFuncSetAttribute failed\n"); grid = -1; return; }
        }
        grid = cus > 0 ? cus : 256;
    }
    if (grid < 0) return;
    (void)hipMemsetAsync((char*)d_ws + WS_CTL, 0, CTL_BYTES, stream);
    Args a{};
    for (int i = 0; i < 20; ++i) a.in[i] = (const float*)d_in[i];
    a.out = (float*)d_out; a.ws = (unsigned char*)d_ws;
#if defined(MULTI_LAUNCH)
    for (int p = 0; p < N_PHASES; ++p) {
        if (p == 1 + 11) continue;
        a.ph_lo = p; a.ph_hi = p + 1;
        const int kind = p == 0 ? 11 : (p - 1) % 11;
        hipLaunchKernelGGL(kern_for(kind), dim3(grid), dim3(NTHREADS), LDS_BYTES, stream, a);
    }
#else
    a.ph_lo = 0; a.ph_hi = N_PHASES;
    hipLaunchKernelGGL(fwd<-1>, dim3(grid), dim3(NTHREADS), LDS_BYTES, stream, a);
#endif
}
```

```cpp
#include <hip/hip_runtime.h>
#include <stdint.h>
#include <stdio.h>

typedef unsigned short bf16_t;
typedef short bf16x8 __attribute__((ext_vector_type(8)));
typedef float f32x4 __attribute__((ext_vector_type(4)));
typedef float f32x16 __attribute__((ext_vector_type(16)));
typedef unsigned u32x4 __attribute__((ext_vector_type(4)));
#define LAS __attribute__((address_space(3)))

constexpr int T = 32768, D = 1024, NB = 16, SEQ = 2048, DEPTH = 2;
constexpr int ZC = 5320, ZLD = 5376;
constexpr int C_QA = 0, C_FA = 512, C_IA = 1024, C_GA = 1536, C_QB = 2048, C_KB = 2560, C_VB = 2624, C_IQ = 2688, C_IK = 3200, C_IW = 3264, C_GTA = 3272, C_GTB = 4296;
constexpr int NE = 32, DFF = 1024, NSLOT = 131072 + 32 * 256, NBLK_MAX = NSLOT / 256;
constexpr int NMOD = 6 * D;
constexpr float EPS = 1e-6f;
constexpr int NTHREADS = 512, NWAVES = 8;
constexpr int LDS_BYTES = 144 * 1024;

constexpr size_t al256(size_t x) { return (x + 255) & ~(size_t)255; }
constexpr size_t WS_CTL = 0;
constexpr size_t CTL_BYTES = 65536;
constexpr size_t WS_MOD = WS_CTL + CTL_BYTES;
constexpr size_t WS_LB = WS_MOD + al256((size_t)DEPTH * NB * NMOD * 4);
constexpr size_t WS_WIN = WS_LB + al256((size_t)DEPTH * 512 * 4);
constexpr size_t WS_WPA = WS_WIN + (size_t)DEPTH * ZLD * D * 2;
constexpr size_t WS_WPB = WS_WPA + (size_t)DEPTH * D * 512 * 2;
constexpr size_t WS_WOUT = WS_WPB + (size_t)DEPTH * D * 512 * 2;
constexpr size_t WS_W1 = WS_WOUT + (size_t)DEPTH * D * D * 2;
constexpr size_t WS_W2 = WS_W1 + (size_t)DEPTH * NE * 2 * DFF * D * 2;
constexpr size_t WS_H = WS_W2 + (size_t)DEPTH * NE * D * DFF * 2;
constexpr size_t WS_Z = WS_H + (size_t)T * D * 2;
constexpr size_t WS_Y = WS_Z;
constexpr size_t WS_XS = WS_Z + (size_t)NSLOT * D * 2;
constexpr size_t WS_ACT = WS_Z + (size_t)T * ZLD * 4;
constexpr size_t WS_ORAW = WS_ACT;
constexpr size_t WS_TMP = WS_ACT + (size_t)T * 512 * 4;
constexpr size_t WS_HA = WS_ACT + (size_t)NSLOT * DFF * 2;
constexpr size_t WS_ATT = WS_HA + (size_t)T * 512 * 2;
constexpr size_t WS_MASK = WS_ATT + (size_t)T * 512 * 2;
constexpr size_t WS_MERGED = WS_MASK + (size_t)T * 64 * 4;
constexpr size_t WS_X1 = WS_MERGED + (size_t)T * D * 2;
constexpr size_t WS_X2 = WS_X1 + (size_t)T * D * 4;
constexpr size_t WS_TOKE = WS_X2 + (size_t)T * D * 4;
constexpr size_t WS_TOKG = WS_TOKE + (size_t)T * 4 * 4;
constexpr size_t WS_TOKP = WS_TOKG + (size_t)T * 4 * 4;
constexpr size_t WS_TOKS = WS_TOKP + (size_t)T * 4 * 4;
constexpr size_t WS_SLOTTOK = WS_TOKS + (size_t)T * 4 * 4;
constexpr size_t WS_BLKE = WS_SLOTTOK + (size_t)NSLOT * 4;
constexpr size_t WS_END = WS_BLKE + al256((size_t)(NBLK_MAX + 64) * 4);
static_assert((size_t)NSLOT * D * 2 * 2 <= (size_t)T * ZLD * 4, "Y + XS must fit in Z");
static_assert((size_t)T * 512 * 4 + (size_t)T * D * 4 <= (size_t)NSLOT * DFF * 2, "ORAW+TMP must fit in ACT");
static_assert(WS_END <= ((size_t)1 << 31), "workspace layout exceeds 2 GiB");
constexpr int CW_CNT = 1024;
constexpr int CW_NBLK = 1200;

__device__ __forceinline__ bf16_t f2bf(float f) { unsigned u = __float_as_uint(f); u += 0x7fffu + ((u >> 16) & 1u); return (bf16_t)(u >> 16); }
__device__ __forceinline__ float bf2f(bf16_t b) { return __uint_as_float(((unsigned)b) << 16); }
__device__ __forceinline__ float sigmoidf_(float x) { return 1.0f / (1.0f + __expf(-x)); }
__device__ __forceinline__ float wave_sum(float v) {
#pragma unroll
    for (int o = 32; o >= 1; o >>= 1) v += __shfl_xor(v, o);
    return v;
}
__device__ __forceinline__ int wave_sum_i(int v) {
#pragma unroll
    for (int o = 32; o >= 1; o >>= 1) v += __shfl_xor(v, o);
    return v;
}
__device__ const unsigned char T5_BUCKET[128] = {
    0, 1, 2, 3, 4, 5, 6, 7, 8, 9, 10, 11, 12, 13, 14, 15, 16, 16, 16, 17, 17, 18, 18, 18, 19, 19, 19, 20, 20, 20, 20, 21, 21, 21, 21, 22, 22, 22, 22, 22, 23, 23, 23, 23, 23, 23, 24, 24, 24, 24, 24, 24, 25,
    25, 25, 25, 25, 25, 25, 26, 26, 26, 26, 26, 26, 26, 26, 27, 27, 27, 27, 27, 27, 27, 27, 27, 27, 28, 28, 28, 28, 28, 28, 28, 28, 28, 28, 29, 29, 29, 29, 29, 29, 29, 29, 29, 29, 29, 29, 30, 30, 30, 30, 30,
    30, 30, 30, 30, 30, 30, 30, 30, 30, 31, 31, 31, 31, 31, 31, 31, 31, 31, 31, 31, 31, 31, 31, 31};
__device__ __forceinline__ int t5_bucket(int rel) { return rel >= 128 ? 31 : (int)T5_BUCKET[rel]; }


#define XB_TMO      128
#define XB_XCNT(j)  (256  + 64 * (j))
#define XB_XSUB(j)  (1280 + 64 * (j))
#define XB_XGEN(j)  (2304 + 64 * (j))
#define XB_TOP      3328
#define XB_TOPGEN   3392
#define XCD_BAR_WORDS 3456
#define XB_SPIN_CAP (1u << 18)
__device__ __forceinline__ unsigned xb_ld(unsigned* p)              { return __hip_atomic_load(p, __ATOMIC_RELAXED, __HIP_MEMORY_SCOPE_AGENT); }
__device__ __forceinline__ unsigned xb_add(unsigned* p, unsigned v) { return __hip_atomic_fetch_add(p, v, __ATOMIC_RELAXED, __HIP_MEMORY_SCOPE_AGENT); }
__device__ __forceinline__ unsigned xb_xcc_id() { return (unsigned)__builtin_amdgcn_s_getreg((3 << 11) | 20) & 0xFu; }
#define XB_SPIN(cond, bar) do { unsigned _sp = 0; while (cond) { __builtin_amdgcn_s_sleep(1); \
    if ((++_sp & 255u) == 0u) { if (xb_ld(&(bar)[XB_TMO])) break; if (_sp > XB_SPIN_CAP) { atomicAdd(&(bar)[XB_TMO], 1u); break; } } } } while (0)
struct XcdBarrier { unsigned* bar; unsigned x; volatile LAS unsigned* st; };
__device__ __forceinline__ XcdBarrier xcd_barrier_post(unsigned* bar, volatile LAS unsigned* st) {
    XcdBarrier b; b.bar = bar; b.x = xb_xcc_id(); b.st = st;
    if (threadIdx.x == 0) (void)xb_add(&bar[XB_XCNT(b.x)], 1u);
    return b;
}
__device__ __forceinline__ void xcd_barrier_complete(unsigned* bar, unsigned x, unsigned& nloc, unsigned& nx) {
    const unsigned G = gridDim.x * gridDim.y * gridDim.z;
    unsigned sum, cnt, mine, sp = 0u;
    for (;;) {
        sum = 0u; cnt = 0u; mine = 0u;
#pragma unroll
        for (unsigned j = 0; j < 16; ++j) { const unsigned c = xb_ld(&bar[XB_XCNT(j)]); sum += c; cnt += (c > 0u) ? 1u : 0u; mine = (j == x) ? c : mine; }
        if (sum == G) break;
        __builtin_amdgcn_s_sleep(1);
        if ((++sp & 255u) == 0u) { if (xb_ld(&bar[XB_TMO])) break; if (sp > XB_SPIN_CAP) { atomicAdd(&bar[XB_TMO], 1u); break; } }
    }
    nloc = mine > 0u ? mine : 1u; nx = cnt > 0u ? cnt : 1u;
}
__device__ __forceinline__ void xcd_barrier(const XcdBarrier& b) {
    asm volatile("s_waitcnt vmcnt(0)" ::: "memory");
    __syncthreads();
    if (threadIdx.x == 0) {
        unsigned* bar = b.bar; asm volatile("" : "+s"(bar));
        __builtin_amdgcn_s_waitcnt(0);
        unsigned nloc = b.st[0], nx = b.st[1];
        if (nloc == 0u) { xcd_barrier_complete(bar, b.x, nloc, nx); b.st[0] = nloc; b.st[1] = nx; }
        const unsigned old = xb_add(&bar[XB_XSUB(b.x)], 1u);
        const unsigned gen = old / nloc;
        if (old + 1u == (gen + 1u) * nloc) {
            __builtin_amdgcn_fence(__ATOMIC_RELEASE, "agent");
            asm volatile("s_waitcnt vmcnt(0)" ::: "memory");
            const unsigned og = xb_add(&bar[XB_TOP], 1u);
            const unsigned tg = og / nx;
            if (og + 1u == (tg + 1u) * nx) xb_add(&bar[XB_TOPGEN], 1u);
            else XB_SPIN(xb_ld(&bar[XB_TOPGEN]) == tg, bar);
            __builtin_amdgcn_fence(__ATOMIC_ACQUIRE, "agent");
            xb_add(&bar[XB_XGEN(b.x)], 1u);
            asm volatile("s_waitcnt vmcnt(0)" ::: "memory");
        } else {
            XB_SPIN(xb_ld(&bar[XB_XGEN(b.x)]) == gen, bar);
            __builtin_amdgcn_fence(__ATOMIC_ACQUIRE, "agent");
            asm volatile("s_waitcnt vmcnt(0)" ::: "memory");
        }
    }
    __syncthreads();
}
constexpr int CW_BAR = 4096;

struct Args { const float* in[20]; float* out; unsigned char* ws; int ph_lo, ph_hi; };
enum { I_X = 0, I_C, I_WADA, I_BADA, I_NMW, I_WIN, I_LBL, I_HNW, I_RELB, I_WPA, I_WPB, I_WOUT, I_NFW, I_WR, I_BR, I_W1, I_B1, I_W2, I_B2, I_FNW };

__device__ __forceinline__ void cvt_family(const int tid, const float* src, bf16_t* dst, int K, int N, int Npad, int count, int mode, float* lt  ) {
    const int tk = K / 64, tn = Npad / 64, per = tk * tn;
    for (long u = blockIdx.x; u < (long)per * count; u += gridDim.x) {
        const int mi = (int)(u / per), r = (int)(u % per), k0 = (r / tn) * 64, n0 = (r % tn) * 64;
        const float* s = src + (size_t)mi * K * N;
        bf16_t* d = dst + (size_t)mi * Npad * K;
        int sc0 = n0;
        if (mode == 1) { const int p = n0 >> 8, sel = (n0 >> 7) & 1, i = n0 & 127; sc0 = sel * 1024 + 128 * p + i; }
        __syncthreads();
        {
            const int i = tid >> 3, j0 = (tid & 7) * 8;
            float v[8];
            if (n0 + j0 < Npad && (mode == 1 || n0 + j0 < N)) {
                const f32x4 a = *(const f32x4*)(s + (size_t)(k0 + i) * N + sc0 + j0), b = *(const f32x4*)(s + (size_t)(k0 + i) * N + sc0 + j0 + 4);
                v[0] = a[0]; v[1] = a[1]; v[2] = a[2]; v[3] = a[3]; v[4] = b[0]; v[5] = b[1]; v[6] = b[2]; v[7] = b[3];
            } else {
#pragma unroll
                for (int q = 0; q < 8; ++q) v[q] = 0.f;
            }
#pragma unroll
            for (int q = 0; q < 8; ++q) lt[i * 65 + j0 + q] = v[q];
        }
        __syncthreads();
        {
            const int n = tid >> 3, kk = (tid & 7) * 8;
            unsigned w[4];
#pragma unroll
            for (int q = 0; q < 4; ++q) w[q] = (unsigned)f2bf(lt[(kk + 2 * q) * 65 + n]) | ((unsigned)f2bf(lt[(kk + 2 * q + 1) * 65 + n]) << 16);
            u32x4 o; o.x = w[0]; o.y = w[1]; o.z = w[2]; o.w = w[3];
            *(u32x4*)(d + (size_t)(n0 + n) * K + k0 + kk) = o;
        }
    }
    __syncthreads();
}

template <class Epi>
__device__ __forceinline__ void ngemm(const bf16_t* A, const int* rowidx, const bf16_t* Bt, const int* blk_e, size_t bt_stride, int M, int NT  , int K, int pair, const Epi& epi) {
    const int lane = threadIdx.x & 63, wave = threadIdx.x >> 6;
    const int r31 = lane & 31, hh = lane >> 5;
    const long ntile = (long)(M / 64) * NT;
    for (long tix = (long)blockIdx.x * NWAVES + wave; tix < ntile; tix += (long)gridDim.x * NWAVES) {
        const int tm = (int)(tix / NT), tn = (int)(tix % NT);
        const int r0 = tm * 64;
        const int c0 = pair ? (256 * (tn >> 2) + 32 * (tn & 3)) : 64 * tn, c1 = pair ? c0 + 128 : c0 + 32;
        const int e = blk_e ? blk_e[tm >> 2] : 0;
        const bf16_t* B = Bt + (size_t)e * bt_stride;
        const bf16_t* ap[2]; const bf16_t* bp[2];
#pragma unroll
        for (int mi = 0; mi < 2; ++mi) { const int row = r0 + 32 * mi + r31; const int ar = rowidx ? rowidx[row] : row; ap[mi] = A + (size_t)ar * K + 8 * hh; }
        bp[0] = B + (size_t)(c0 + r31) * K + 8 * hh; bp[1] = B + (size_t)(c1 + r31) * K + 8 * hh;
        f32x16 acc[2][2];
#pragma unroll
        for (int a = 0; a < 2; ++a)
#pragma unroll
            for (int b = 0; b < 2; ++b)
#pragma unroll
                for (int q = 0; q < 16; ++q) acc[a][b][q] = 0.f;
        for (int k = 0; k < K; k += 16) {
            const bf16x8 a0 = *(const bf16x8*)(ap[0] + k), a1 = *(const bf16x8*)(ap[1] + k), b0 = *(const bf16x8*)(bp[0] + k), b1 = *(const bf16x8*)(bp[1] + k);
            acc[0][0] = __builtin_amdgcn_mfma_f32_32x32x16_bf16(a0, b0, acc[0][0], 0, 0, 0);
            acc[0][1] = __builtin_amdgcn_mfma_f32_32x32x16_bf16(a0, b1, acc[0][1], 0, 0, 0);
            acc[1][0] = __builtin_amdgcn_mfma_f32_32x32x16_bf16(a1, b0, acc[1][0], 0, 0, 0);
            acc[1][1] = __builtin_amdgcn_mfma_f32_32x32x16_bf16(a1, b1, acc[1][1], 0, 0, 0);
        }
        epi(acc, r0, c0, c1, e, tn, lane);
    }
}
#define ACC_ROW(q, lane) (((q) & 3) + 8 * ((q) >> 2) + 4 * ((lane) >> 5))

struct EpiStoreF32 { float* C; int ldc;
    __device__ __forceinline__ void operator()(const f32x16 (&acc)[2][2], int r0, int c0, int c1, int, int, int lane) const {
#pragma unroll
        for (int mi = 0; mi < 2; ++mi)
#pragma unroll
            for (int q = 0; q < 16; ++q) { const int row = r0 + 32 * mi + ACC_ROW(q, lane); C[(size_t)row * ldc + c0 + (lane & 31)] = acc[mi][0][q]; C[(size_t)row * ldc + c1 + (lane & 31)] = acc[mi][1][q]; }
    } };
struct EpiMerge1 { float* tmp; const float* Z; int gcol;
    __device__ __forceinline__ void operator()(const f32x16 (&acc)[2][2], int r0, int c0, int c1, int, int, int lane) const {
#pragma unroll
        for (int mi = 0; mi < 2; ++mi)
#pragma unroll
            for (int q = 0; q < 16; ++q) { const int row = r0 + 32 * mi + ACC_ROW(q, lane);
#pragma unroll
                for (int ni = 0; ni < 2; ++ni) { const int col = (ni ? c1 : c0) + (lane & 31); tmp[(size_t)row * D + col] = sigmoidf_(Z[(size_t)row * ZLD + gcol + col]) * acc[mi][ni][q]; } }
    } };
struct EpiMerge2 { const float* tmp; bf16_t* merged; const float* Z; int gcol;
    __device__ __forceinline__ void operator()(const f32x16 (&acc)[2][2], int r0, int c0, int c1, int, int, int lane) const {
#pragma unroll
        for (int mi = 0; mi < 2; ++mi)
#pragma unroll
            for (int q = 0; q < 16; ++q) { const int row = r0 + 32 * mi + ACC_ROW(q, lane);
#pragma unroll
                for (int ni = 0; ni < 2; ++ni) { const int col = (ni ? c1 : c0) + (lane & 31); merged[(size_t)row * D + col] = f2bf(tmp[(size_t)row * D + col] + sigmoidf_(Z[(size_t)row * ZLD + gcol + col]) * acc[mi][ni][q]); } }
    } };
struct EpiOut { const float* xin; float* x1; const float* gate  ;
    __device__ __forceinline__ void operator()(const f32x16 (&acc)[2][2], int r0, int c0, int c1, int, int, int lane) const {
#pragma unroll
        for (int mi = 0; mi < 2; ++mi)
#pragma unroll
            for (int q = 0; q < 16; ++q) { const int row = r0 + 32 * mi + ACC_ROW(q, lane); const int b = row >> 11;
#pragma unroll
                for (int ni = 0; ni < 2; ++ni) { const int col = (ni ? c1 : c0) + (lane & 31); x1[(size_t)row * D + col] = xin[(size_t)row * D + col] + gate[(size_t)b * NMOD + col] * acc[mi][ni][q]; } }
    } };
struct EpiSwiglu { bf16_t* act; const float* b1  ;
    __device__ __forceinline__ void operator()(const f32x16 (&acc)[2][2], int r0, int, int, int e, int tn, int lane) const {
        const int col = 32 * tn + (lane & 31);
        const float bg = b1[(size_t)e * 2 * DFF + col], bl = b1[(size_t)e * 2 * DFF + DFF + col];
#pragma unroll
        for (int mi = 0; mi < 2; ++mi)
#pragma unroll
            for (int q = 0; q < 16; ++q) { const int row = r0 + 32 * mi + ACC_ROW(q, lane);
                float glu = fminf(acc[mi][0][q] + bg, 7.0f); float lin = fminf(fmaxf(acc[mi][1][q] + bl, -7.0f), 7.0f);
                act[(size_t)row * DFF + col] = f2bf(glu * sigmoidf_(1.702f * glu) * (lin + 1.0f)); }
    } };
struct EpiW2 { float* Y; const float* b2  ;
    __device__ __forceinline__ void operator()(const f32x16 (&acc)[2][2], int r0, int c0, int c1, int e, int, int lane) const {
#pragma unroll
        for (int mi = 0; mi < 2; ++mi)
#pragma unroll
            for (int q = 0; q < 16; ++q) { const int row = r0 + 32 * mi + ACC_ROW(q, lane);
#pragma unroll
                for (int ni = 0; ni < 2; ++ni) { const int col = (ni ? c1 : c0) + (lane & 31); Y[(size_t)row * D + col] = acc[mi][ni][q] + b2[(size_t)e * D + col]; } }
    } };


namespace pg8 {
#define PG8_LAS __attribute__((address_space(3)))
constexpr int BM = 256, BK = 64, HALF = 128, HTB = HALF * BK * 2, STAGE_BYTES = 8 * HTB, NXCD = 8, WGM = 8;
__host__ __device__ __forceinline__ int lds_byte(int r, int c) { const int st = (r >> 4) * 2 + (c >> 5), rr = r & 15, cc = c & 31, ob = rr * 64 + cc * 2; return st * 1024 + (ob ^ (((ob >> 9) & 1) << 5)); }
__host__ __device__ __forceinline__ void stage_rc(int b, int& R, int& C) { const int st = b / 1024, sb = b % 1024, swz = sb ^ (((sb >> 9) & 1) << 5); R = (st >> 1) * 16 + swz / 64; C = (st & 1) * 32 + (swz % 64) / 2; }
__host__ __device__ __forceinline__ int perm32(int rho) { const int n = rho >> 4, i = rho & 15; return 8 * (i >> 2) + 4 * n + (i & 3); }
struct Unit { int pm, pn, brow, e; };
struct Gemm { const bf16_t* A; const bf16_t* Bt; int M, N, K; };
struct StaticOrder {
    int nM, nN, nwg, G, c;
    __device__ void init(int M, int N, int G_, int c_) { nM = M / BM; nN = N / BM; nwg = nM * nN; G = G_; c = c_; }
    __device__ bool next(int i, Unit& u) const {
        const long L = (long)i * G + c; if (L >= nwg) return false;
        int wgid = (int)L; { const int q = nwg / NXCD, r = nwg % NXCD, xcd = wgid % NXCD, off = wgid / NXCD; wgid = (xcd < r ? xcd * (q + 1) : r * (q + 1) + (xcd - r) * q) + off; }
        const int nig = WGM * nN, gid = wgid / nig, fm = gid * WGM, gsz = (nM - fm) < WGM ? (nM - fm) : WGM;
        u.pm = fm + ((wgid % nig) % gsz); u.pn = (wgid % nig) / gsz; u.brow = u.pn * BM; u.e = 0; return true;
    }
    __device__ __forceinline__ void a_ready(const Unit&) const {}
    __device__ __forceinline__ void done(const Unit&) const {}
};
template <int NN> struct MoeOrder {
    int nwg, G, c; const int* blke;
    __device__ void init(int nM, int G_, int c_, const int* blke_) { nwg = nM * NN; G = G_; c = c_; blke = blke_; }
    __device__ bool next(int i, Unit& u) const {
        const int L = i * G + c; if (L >= nwg) return false;
        const int wgid = (L & 7) * (nwg >> 3) + (L >> 3);
        const int gid = wgid / (8 * NN), rem = wgid % (8 * NN);
        u.pm = gid * 8 + (rem & 7); u.pn = rem >> 3; u.e = __builtin_amdgcn_readfirstlane(blke[u.pm]); u.brow = u.e * (NN * BM) + u.pn * BM; return true;
    }
    __device__ __forceinline__ void a_ready(const Unit&) const {}
    __device__ __forceinline__ void done(const Unit&) const {}
};
__device__ __forceinline__ unsigned cvt_pk_bf16(float lo, float hi) { unsigned r; asm volatile("v_cvt_pk_bf16_f32 %0, %1, %2" : "=v"(r) : "v"(lo), "v"(hi)); return r; }


struct EpiZ {
    static constexpr bool PERM = false, AFTER_DRAIN = false;
    float* C; int ldc;
    __device__ __forceinline__ void operator()(const f32x4 (&acc)[2][2][4][2], const Unit& u, int wr, int wc, int fr, int fq) const {
        const int row0 = u.pm * BM + wr * 64 + fr, col0 = u.pn * BM + wc * 32 + 4 * fq;
#pragma unroll
        for (int ai = 0; ai < 2; ++ai)
#pragma unroll
            for (int m = 0; m < 4; ++m) { float* rowp = C + (size_t)(row0 + ai * HALF + m * 16) * ldc + col0;
#pragma unroll
                for (int bj = 0; bj < 2; ++bj)
#pragma unroll
                    for (int n = 0; n < 2; ++n) *(f32x4*)(rowp + bj * HALF + n * 16) = acc[ai][bj][m][n]; }
    }
};
__device__ __forceinline__ f32x4 sig4(f32x4 g) { f32x4 r; r[0] = sigmoidf_(g[0]); r[1] = sigmoidf_(g[1]); r[2] = sigmoidf_(g[2]); r[3] = sigmoidf_(g[3]); return r; }
template <bool SECOND> struct EpiMerge {
    static constexpr bool PERM = true, AFTER_DRAIN = false;
    float* tmp; bf16_t* merged; const float* Zg  ;
    __device__ __forceinline__ void operator()(const f32x4 (&acc)[2][2][4][2], const Unit& u, int wr, int wc, int fr, int fq) const {
        const int row0 = u.pm * BM + wr * 64 + fr, col0 = u.pn * BM + wc * 32 + 8 * fq;
#pragma unroll
        for (int ai = 0; ai < 2; ++ai)
#pragma unroll
            for (int m = 0; m < 4; ++m) { const size_t row = (size_t)(row0 + ai * HALF + m * 16);
#pragma unroll
                for (int bj = 0; bj < 2; ++bj) { const int col = col0 + bj * HALF;
                    const f32x4 g0 = sig4(*(const f32x4*)(Zg + row * ZLD + col)), g1 = sig4(*(const f32x4*)(Zg + row * ZLD + col + 4));
                    f32x4 v0 = g0 * acc[ai][bj][m][0], v1 = g1 * acc[ai][bj][m][1];
                    if (!SECOND) { *(f32x4*)(tmp + row * D + col) = v0; *(f32x4*)(tmp + row * D + col + 4) = v1; }
                    else { v0 += *(const f32x4*)(tmp + row * D + col); v1 += *(const f32x4*)(tmp + row * D + col + 4);
                        u32x4 w; w.x = cvt_pk_bf16(v0[0], v0[1]); w.y = cvt_pk_bf16(v0[2], v0[3]); w.z = cvt_pk_bf16(v1[0], v1[1]); w.w = cvt_pk_bf16(v1[2], v1[3]);
                        *(u32x4*)(merged + row * D + col) = w; } } }
    }
};
struct EpiOutG {
    static constexpr bool PERM = false, AFTER_DRAIN = false;
    const float* xin; float* x1; const float* gate  ;
    __device__ __forceinline__ void operator()(const f32x4 (&acc)[2][2][4][2], const Unit& u, int wr, int wc, int fr, int fq) const {
        const int row0 = u.pm * BM + wr * 64 + fr, col0 = u.pn * BM + wc * 32 + 4 * fq; const int b = (u.pm * BM) >> 11;
        f32x4 gv[2][2];
#pragma unroll
        for (int bj = 0; bj < 2; ++bj)
#pragma unroll
            for (int n = 0; n < 2; ++n) gv[bj][n] = *(const f32x4*)(gate + (size_t)b * NMOD + col0 + bj * HALF + n * 16);
#pragma unroll
        for (int ai = 0; ai < 2; ++ai)
#pragma unroll
            for (int m = 0; m < 4; ++m) { const size_t off = (size_t)(row0 + ai * HALF + m * 16) * D + col0;
#pragma unroll
                for (int bj = 0; bj < 2; ++bj)
#pragma unroll
                    for (int n = 0; n < 2; ++n) *(f32x4*)(x1 + off + bj * HALF + n * 16) = *(const f32x4*)(xin + off + bj * HALF + n * 16) + gv[bj][n] * acc[ai][bj][m][n]; }
    }
};
struct EpiSwigluG {
    static constexpr bool PERM = true, AFTER_DRAIN = false;
    bf16_t* act; const float* b1  ;
    __device__ __forceinline__ void operator()(const f32x4 (&acc)[2][2][4][2], const Unit& u, int wr, int wc, int fr, int fq) const {
        const int row0 = u.pm * BM + wr * 64 + fr, col0 = u.pn * HALF + wc * 32 + 8 * fq;
        f32x4 bg[2], bl[2];
#pragma unroll
        for (int n = 0; n < 2; ++n) { bg[n] = *(const f32x4*)(b1 + (size_t)u.e * 2 * DFF + col0 + 4 * n); bl[n] = *(const f32x4*)(b1 + (size_t)u.e * 2 * DFF + DFF + col0 + 4 * n); }
#pragma unroll
        for (int ai = 0; ai < 2; ++ai)
#pragma unroll
            for (int m = 0; m < 4; ++m) { float o[8];
#pragma unroll
                for (int n = 0; n < 2; ++n) { const f32x4 gl = acc[ai][0][m][n] + bg[n], li = acc[ai][1][m][n] + bl[n];
#pragma unroll
                    for (int j = 0; j < 4; ++j) { const float g = fminf(gl[j], 7.0f), l = fminf(fmaxf(li[j], -7.0f), 7.0f); o[4 * n + j] = g * sigmoidf_(1.702f * g) * (l + 1.0f); } }
                u32x4 w; w.x = cvt_pk_bf16(o[0], o[1]); w.y = cvt_pk_bf16(o[2], o[3]); w.z = cvt_pk_bf16(o[4], o[5]); w.w = cvt_pk_bf16(o[6], o[7]);
                *(u32x4*)(act + (size_t)(row0 + ai * HALF + m * 16) * DFF + col0) = w; }
    }
};
struct EpiYG {
    static constexpr bool PERM = true, AFTER_DRAIN = false;
    bf16_t* Yb; const float* b2  ;
    __device__ __forceinline__ void operator()(const f32x4 (&acc)[2][2][4][2], const Unit& u, int wr, int wc, int fr, int fq) const {
        const int row0 = u.pm * BM + wr * 64 + fr, col0 = u.pn * BM + wc * 32 + 8 * fq;
        f32x4 bv[2][2];
#pragma unroll
        for (int bj = 0; bj < 2; ++bj)
#pragma unroll
            for (int n = 0; n < 2; ++n) bv[bj][n] = *(const f32x4*)(b2 + (size_t)u.e * D + col0 + bj * HALF + 4 * n);
#pragma unroll
        for (int ai = 0; ai < 2; ++ai)
#pragma unroll
            for (int m = 0; m < 4; ++m) { bf16_t* rowp = Yb + (size_t)(row0 + ai * HALF + m * 16) * D + col0;
#pragma unroll
                for (int bj = 0; bj < 2; ++bj) { const f32x4 v0 = acc[ai][bj][m][0] + bv[bj][0], v1 = acc[ai][bj][m][1] + bv[bj][1];
                    u32x4 w; w.x = cvt_pk_bf16(v0[0], v0[1]); w.y = cvt_pk_bf16(v0[2], v0[3]); w.z = cvt_pk_bf16(v1[0], v1[1]); w.w = cvt_pk_bf16(v1[2], v1[3]);
                    *(u32x4*)(rowp + bj * HALF) = w; } }
    }
};

template <class Epi, class Sched>
__device__ __forceinline__ void gemm_phase(PG8_LAS unsigned char* lds, const int tid, const Gemm g, const Sched& S, const Epi& E) {
    const int wid = __builtin_amdgcn_readfirstlane(tid >> 6), lane = tid & 63, wr = wid >> 2, wc = wid & 3, fr = lane & 15, fq = lane >> 4;
    const int K = g.K, nt = K / BK;
    unsigned voffA[2], voffB[2];
#pragma unroll
    for (int i = 0; i < 2; ++i) { int R, C; stage_rc(tid * 16 + i * 8192, R, C); const int Rb = Epi::PERM ? ((R & ~31) + perm32(R & 31)) : R;
        voffA[i] = (unsigned)(R * K + C) * 2u; voffB[i] = (unsigned)(Rb * K + C) * 2u; }
    const size_t kstep = (size_t)(BK * 2);
    const size_t hstep = (size_t)HALF * K * 2;
    const size_t tstep = 2 * hstep;
    const unsigned ldsw = (unsigned)wid * 1024u;
    const int aoff = lds_byte(wr * 64 + fr, fq * 8), boff = lds_byte(wc * 32 + fr, fq * 8);
#define PG8_SA(b, h) (((b) * 2 + (h)) * HTB)
#define PG8_SB(b, h) ((4 + (b) * 2 + (h)) * HTB)
#define PG8_STAGE(bufoff, gbase, voff) do { _Pragma("unroll") for (int _i = 0; _i < 2; ++_i) \
        __builtin_amdgcn_global_load_lds((const unsigned*)((const char*)(gbase) + (voff)[_i]), (PG8_LAS unsigned*)(lds + (bufoff) + ldsw + _i * 8192), 16, 0, 0); } while (0)
#define PG8_LDA(dst, b, h) do { _Pragma("unroll") for (int m = 0; m < 4; ++m) _Pragma("unroll") for (int k = 0; k < 2; ++k) dst[m][k] = *(const PG8_LAS bf16x8*)(lds + PG8_SA(b, h) + aoff + m * 2048 + k * 1024); } while (0)
#define PG8_LDB(dst, b, h) do { _Pragma("unroll") for (int n = 0; n < 2; ++n) _Pragma("unroll") for (int k = 0; k < 2; ++k) dst[n][k] = *(const PG8_LAS bf16x8*)(lds + PG8_SB(b, h) + boff + n * 2048 + k * 1024); } while (0)
#define PG8_MMA(ai, bj, At, Bt) do { __builtin_amdgcn_s_setprio(1); _Pragma("unroll") for (int m = 0; m < 4; ++m) _Pragma("unroll") for (int n = 0; n < 2; ++n) _Pragma("unroll") for (int k = 0; k < 2; ++k) \
        acc[ai][bj][m][n] = __builtin_amdgcn_mfma_f32_16x16x32_bf16(Bt[n][k], At[m][k], acc[ai][bj][m][n], 0, 0, 0); __builtin_amdgcn_s_setprio(0); } while (0)
#define PG8_WAIT_V(n) asm volatile("s_waitcnt vmcnt(" #n ")" ::: "memory")
#define PG8_WAIT_L(n) asm volatile("s_waitcnt lgkmcnt(" #n ")" ::: "memory")
#define PG8_BAR __builtin_amdgcn_s_barrier()
#define PG8_SCHED __builtin_amdgcn_sched_barrier(0)
    Unit cur, nxt; int ui = 0;
    if (!S.next(0, cur)) return;
    f32x4 acc[2][2][4][2];
#pragma unroll
    for (int a = 0; a < 2; ++a)
#pragma unroll
        for (int b = 0; b < 2; ++b)
#pragma unroll
            for (int m = 0; m < 4; ++m)
#pragma unroll
                for (int n = 0; n < 2; ++n) acc[a][b][m][n] = (f32x4){0.f, 0.f, 0.f, 0.f};
    bf16x8 At[4][2], B0[2][2], B1[2][2];
    const char* cA = (const char*)g.A + (size_t)cur.pm * tstep; const char* cB = (const char*)g.Bt + (size_t)cur.brow * K * 2;
    S.a_ready(cur);
    PG8_STAGE(PG8_SB(0, 0), cB, voffB); PG8_STAGE(PG8_SA(0, 0), cA, voffA); PG8_STAGE(PG8_SB(0, 1), cB + hstep, voffB); PG8_STAGE(PG8_SA(0, 1), cA + hstep, voffA);
    if (wr == 1) PG8_BAR;
    PG8_WAIT_V(4); PG8_BAR;
    PG8_STAGE(PG8_SB(1, 0), cB + kstep, voffB); PG8_STAGE(PG8_SA(1, 0), cA + kstep, voffA); PG8_STAGE(PG8_SB(1, 1), cB + hstep + kstep, voffB);
    PG8_WAIT_V(6); PG8_BAR;
    for (;;) {
        const bool has_next = S.next(ui + 1, nxt);
        const char* nA = has_next ? (const char*)g.A + (size_t)nxt.pm * tstep : cA; const char* nB = has_next ? (const char*)g.Bt + (size_t)nxt.brow * K * 2 : cB;
        for (int t = 0; t < nt; t += 2) {
            const bool last = (t == nt - 2);
            const char* a1 = cA + (size_t)(t + 1) * kstep;
            const char* a2 = last ? nA : cA + (size_t)(t + 2) * kstep; const char* b2 = last ? nB : cB + (size_t)(t + 2) * kstep;
            const char* a3 = a2 + kstep; const char* b3 = b2 + kstep;
            if (last && has_next) S.a_ready(nxt);
            PG8_LDB(B0, 0, 0); PG8_SCHED; PG8_LDA(At, 0, 0); PG8_STAGE(PG8_SA(1, 1), a1 + hstep, voffA);
            PG8_WAIT_L(8); PG8_BAR; PG8_WAIT_L(0); PG8_MMA(0, 0, At, B0); PG8_BAR; PG8_SCHED;
            PG8_LDB(B1, 0, 1); PG8_STAGE(PG8_SB(0, 0), b2, voffB);
            PG8_BAR; PG8_WAIT_L(0); PG8_MMA(0, 1, At, B1); PG8_BAR;
            PG8_LDA(At, 0, 1); PG8_STAGE(PG8_SA(0, 0), a2, voffA);
            PG8_BAR; PG8_WAIT_L(0); PG8_MMA(1, 0, At, B0); PG8_BAR; PG8_SCHED;
            PG8_STAGE(PG8_SB(0, 1), b2 + hstep, voffB);
            PG8_WAIT_V(6); PG8_BAR; PG8_MMA(1, 1, At, B1); PG8_BAR;
            PG8_LDB(B0, 1, 0); PG8_SCHED; PG8_LDA(At, 1, 0); PG8_STAGE(PG8_SA(0, 1), a2 + hstep, voffA);
            PG8_WAIT_L(8); PG8_BAR; PG8_WAIT_L(0); PG8_MMA(0, 0, At, B0); PG8_BAR; PG8_SCHED;
            PG8_LDB(B1, 1, 1); PG8_STAGE(PG8_SB(1, 0), b3, voffB);
            PG8_BAR; PG8_WAIT_L(0); PG8_MMA(0, 1, At, B1); PG8_BAR;
            PG8_LDA(At, 1, 1); PG8_STAGE(PG8_SA(1, 0), a3, voffA);
            PG8_BAR; PG8_WAIT_L(0); PG8_MMA(1, 0, At, B0); PG8_BAR; PG8_SCHED;
            PG8_STAGE(PG8_SB(1, 1), b3 + hstep, voffB);
            PG8_WAIT_V(6); PG8_BAR; PG8_MMA(1, 1, At, B1); PG8_BAR;
        }
        if constexpr (!Epi::AFTER_DRAIN) { E(acc, cur, wr, wc, fr, fq); S.done(cur); }
        if (!has_next) break;
#pragma unroll
        for (int a = 0; a < 2; ++a)
#pragma unroll
            for (int b = 0; b < 2; ++b)
#pragma unroll
                for (int m = 0; m < 4; ++m)
#pragma unroll
                    for (int n = 0; n < 2; ++n) acc[a][b][m][n] = (f32x4){0.f, 0.f, 0.f, 0.f};
        cur = nxt; cA = nA; cB = nB; ++ui;
    }
    PG8_WAIT_V(0);
    if (wr == 0) PG8_BAR;
    PG8_BAR;
    if constexpr (Epi::AFTER_DRAIN) { E.fused(acc, cur, wr, wc, fr, fq, lds, wid, lane); S.done(cur); }
#undef PG8_SA
#undef PG8_SB
#undef PG8_STAGE
#undef PG8_LDA
#undef PG8_LDB
#undef PG8_MMA
#undef PG8_WAIT_V
#undef PG8_WAIT_L
#undef PG8_BAR
#undef PG8_SCHED
}
}

template <int KIND> __global__ void __launch_bounds__(NTHREADS, 2) fwd(Args args) {
    extern __shared__ __attribute__((aligned(16))) unsigned char lds[];
    const int tid = threadIdx.x, lane = tid & 63, wave = tid >> 6;
    const int G = gridDim.x;
    PG8_LAS unsigned char* const lds3 = (PG8_LAS unsigned char*)lds;
#define WS_OPAQUE() unsigned char* ws = args.ws; asm volatile("" : "+s"(ws)); int tid = threadIdx.x; asm volatile("" : "+v"(tid)); const int lane = tid & 63, wave = tid >> 6; (void)lane; (void)wave
#define ctl ((unsigned*)(ws + WS_CTL))
#define MOD ((float*)(ws + WS_MOD))
#define LB ((float*)(ws + WS_LB))
#define WIN ((bf16_t*)(ws + WS_WIN))
#define WPA ((bf16_t*)(ws + WS_WPA))
#define WPB ((bf16_t*)(ws + WS_WPB))
#define WOUT ((bf16_t*)(ws + WS_WOUT))
#define W1 ((bf16_t*)(ws + WS_W1))
#define W2 ((bf16_t*)(ws + WS_W2))
#define H ((bf16_t*)(ws + WS_H))
#define Z ((float*)(ws + WS_Z))
#define Y ((bf16_t*)(ws + WS_Y))
#define XS ((bf16_t*)(ws + WS_XS))
#define ACT ((bf16_t*)(ws + WS_ACT))
#define ORAW ((float*)(ws + WS_ORAW))
#define TMP ((float*)(ws + WS_TMP))
#define HA ((bf16_t*)(ws + WS_HA))
#define ATT ((bf16_t*)(ws + WS_ATT))
#define MASK ((unsigned*)(ws + WS_MASK))
#define MERGED ((bf16_t*)(ws + WS_MERGED))
#define X1 ((float*)(ws + WS_X1))
#define X2 ((float*)(ws + WS_X2))
#define TOKE ((int*)(ws + WS_TOKE))
#define TOKG ((float*)(ws + WS_TOKG))
#define TOKP ((int*)(ws + WS_TOKP))
#define TOKS ((int*)(ws + WS_TOKS))
#define SLOTTOK ((int*)(ws + WS_SLOTTOK))
#define BLKE ((int*)(ws + WS_BLKE))
    const int lo = args.ph_lo, hi = args.ph_hi;
#define IN(k) ((KIND < 0 || ((k) == 0 ? KIND == 100 : KIND == ((k) - 1) % 11)) && lo <= (k) && (k) < hi)
#define SEAM(k) do { if (KIND < 0 && IN(k) && IN((k) + 1)) xcd_barrier(bar); } while (0)
    XcdBarrier bar; bar.bar = (unsigned*)(args.ws + WS_CTL) + CW_BAR; bar.x = 0; bar.st = nullptr;
    if (KIND < 0) {
        volatile LAS unsigned* xbw = (volatile LAS unsigned*)((LAS unsigned char*)lds + (LDS_BYTES - 16));
        if (tid == 0) { xbw[0] = 0u; xbw[1] = 0u; xbw[2] = 0u; xbw[3] = 0u; }
        __syncthreads();
        bar = xcd_barrier_post((unsigned*)(args.ws + WS_CTL) + CW_BAR, xbw);
    }

    if (IN(0)) {
        WS_OPAQUE();
        float* lt = (float*)lds;
        cvt_family(tid, args.in[I_WIN], WIN, D, ZC, ZLD, DEPTH, 0, lt);
        cvt_family(tid, args.in[I_WPA], WPA, 512, D, D, DEPTH, 0, lt);
        cvt_family(tid, args.in[I_WPB], WPB, 512, D, D, DEPTH, 0, lt);
        cvt_family(tid, args.in[I_WOUT], WOUT, D, D, D, DEPTH, 0, lt);
        cvt_family(tid, args.in[I_W1], W1, D, 2 * DFF, 2 * DFF, DEPTH * NE, 1, lt);
        cvt_family(tid, args.in[I_W2], W2, DFF, D, D, DEPTH * NE, 0, lt);
        {
            float* ca = (float*)lds;
            __syncthreads();
            for (int i = tid; i < NB * D; i += NTHREADS) { const float c = args.in[I_C][i]; ca[i] = c * sigmoidf_(c); }
            __syncthreads();
            for (int u = blockIdx.x; u < DEPTH * NMOD / NTHREADS; u += G) {
                const int ln = u * NTHREADS + tid, l = ln / NMOD, n = ln % NMOD;
                const float* w = args.in[I_WADA] + (size_t)l * D * NMOD + n;
                float acc[NB];
#pragma unroll
                for (int b = 0; b < NB; ++b) acc[b] = 0.f;
                for (int k = 0; k < D; ++k) { const float wv = w[(size_t)k * NMOD];
#pragma unroll
                    for (int b = 0; b < NB; ++b) acc[b] += ca[b * D + k] * wv; }
                const float bb = args.in[I_BADA][(size_t)l * NMOD + n];
#pragma unroll
                for (int b = 0; b < NB; ++b) MOD[((size_t)l * NB + b) * NMOD + n] = acc[b] + bb;
            }
            __syncthreads();
        }
        if (blockIdx.x == G - 1) {
            for (int j = tid; j < 512; j += NTHREADS) { const float a0 = args.in[I_LBL][j], a1 = args.in[I_LBL][512 + j]; LB[j] = 0.f; LB[512 + j] = 1.0f / (1.0f + __expf(a0 - a1)); }
        }
    }

    SEAM(0);
#pragma unroll
    for (int l = 0; l < DEPTH; ++l) {
        const int P = 1 + 11 * l;
#define mod (MOD + (size_t)l * NB * NMOD)
#define xin ((l == 0) ? args.in[I_X] : (const float*)X2)
        if (IN(P + 0) && l == 0) {
            WS_OPAQUE();
            const float* nw = args.in[I_NMW] + (size_t)l * D;
            for (int row = blockIdx.x * NWAVES + wave; row < T; row += G * NWAVES) {
                const int b = row >> 11; f32x4 v[4]; float ss = 0.f;
#pragma unroll
                for (int i = 0; i < 4; ++i) { v[i] = *(const f32x4*)(xin + (size_t)row * D + (lane + 64 * i) * 4); ss += v[i][0] * v[i][0] + v[i][1] * v[i][1] + v[i][2] * v[i][2] + v[i][3] * v[i][3]; }
                ss = wave_sum(ss); const float r = rsqrtf(ss * (1.0f / D) + EPS);
#pragma unroll
                for (int i = 0; i < 4; ++i) { const int c = (lane + 64 * i) * 4;
#pragma unroll
                    for (int j = 0; j < 4; ++j) H[(size_t)row * D + c + j] = f2bf(v[i][j] * r * nw[c + j] * (1.0f + mod[(size_t)b * NMOD + D + c + j]) + mod[(size_t)b * NMOD + c + j]); }
            }
        }
        if (l == 0) SEAM(P + 0);
        if (IN(P + 1)) {
            WS_OPAQUE();
            pg8::Gemm g{H, WIN + (size_t)l * ZLD * D, T, ZLD, D}; pg8::StaticOrder S; S.init(T, ZLD, G, (int)blockIdx.x);
            pg8::EpiZ E{Z, ZLD};
            pg8::gemm_phase(lds3, tid, g, S, E);
        }
        SEAM(P + 1);
        if (IN(P + 2)) {
            WS_OPAQUE();
            {
                float* qs = (float*)lds; float* fs = qs + 32 * 128; float* ks = fs + 32 * 128; float* op = ks + 32 * 128;
                const int dv = tid & 127, dkq = tid >> 7;
                for (int u = blockIdx.x; u < NB * 4; u += G) {
                    const int b = u >> 2, h = u & 3;
                    float S[32];
#pragma unroll
                    for (int i = 0; i < 32; ++i) S[i] = 0.f;
                    for (int c = 0; c < SEQ / 32; ++c) {
                        const int row0 = b * SEQ + c * 32;
                        for (int e = tid; e < 4096; e += NTHREADS) { const int tt = e >> 7, d = e & 127;
                            const float za = Z[(size_t)(row0 + tt) * ZLD + C_QA + h * 128 + d], zf = Z[(size_t)(row0 + tt) * ZLD + C_FA + h * 128 + d];
                            const float lb = LB[l * 512 + h * 128 + d];
                            const float sg = sigmoidf_(zf);
                            qs[e] = za * sigmoidf_(za); fs[e] = lb + (1.0f - lb) * sg; ks[e] = (1.0f - lb) * (1.0f / (1.0f + __expf(zf))); }
                        __syncthreads();
                        for (int tt = 0; tt < 32; ++tt) {
                            const float v = Z[(size_t)(row0 + tt) * ZLD + C_IA + h * 128 + dv]; float o = 0.f;
#pragma unroll
                            for (int i = 0; i < 32; ++i) { S[i] = fs[tt * 128 + 32 * dkq + i] * S[i] + ks[tt * 128 + 32 * dkq + i] * v; o += qs[tt * 128 + 32 * dkq + i] * S[i]; }
                            op[(tt * 4 + dkq) * 128 + dv] = o;
                        }
                        __syncthreads();
                        for (int e = tid; e < 4096; e += NTHREADS) { const int tt = e >> 7, d = e & 127;
                            ORAW[(size_t)(row0 + tt) * 512 + h * 128 + d] = (op[(tt * 4 + 0) * 128 + d] + op[(tt * 4 + 1) * 128 + d]) + (op[(tt * 4 + 2) * 128 + d] + op[(tt * 4 + 3) * 128 + d]); }
                        __syncthreads();
                    }
                }
            }
            {
                unsigned* kl = (unsigned*)lds; unsigned* cnt = kl + 2048; unsigned* mw = cnt + 64;
                for (int qi = blockIdx.x; qi < T; qi += G) {
                    const int b = qi >> 11, t = qi & 2047, n = t + 1;
                    __syncthreads();
                    if (tid < 64) { cnt[tid] = 0u; mw[tid] = 0u; }
                    if (n <= 256) {
                        __syncthreads();
                        if (tid < 64) { const int lo_ = tid * 32; unsigned m = 0u; if (n >= lo_ + 32) m = 0xffffffffu; else if (n > lo_) m = (1u << (n - lo_)) - 1u; MASK[(size_t)qi * 64 + tid] = m; }
                        continue;
                    }
                    const float* zq = Z + (size_t)qi * ZLD;
                    unsigned key[4];
#pragma unroll
                    for (int i = 0; i < 4; ++i) {
                        const int s = tid + 512 * i; key[i] = 0u;
                        if (s < n) {
                            const float* kr = Z + (size_t)(b * SEQ + s) * ZLD + C_IK; float kk[64];
#pragma unroll
                            for (int d4 = 0; d4 < 16; ++d4) { const f32x4 x = *(const f32x4*)(kr + 4 * d4); kk[4 * d4] = x[0]; kk[4 * d4 + 1] = x[1]; kk[4 * d4 + 2] = x[2]; kk[4 * d4 + 3] = x[3]; }
                            float sc = 0.f;
                            for (int h = 0; h < 8; ++h) { float dot = 0.f;
#pragma unroll
                                for (int d = 0; d < 64; ++d) dot += zq[C_IQ + h * 64 + d] * kk[d];
                                sc += (zq[C_IW + h] * 0.04419417382415922f) * fmaxf(dot, 0.f); }
                            unsigned u = __float_as_uint(sc); u = (u & 0x80000000u) ? ~u : (u | 0x80000000u); key[i] = u;
                        }
                        kl[s] = key[i];
                    }
                    __syncthreads();
                    unsigned tau = 0u;
                    for (int bit = 31; bit >= 0; --bit) {
                        const unsigned cand = tau | (1u << bit);
                        int c = (key[0] >= cand) + (key[1] >= cand) + (key[2] >= cand) + (key[3] >= cand);
                        c = wave_sum_i(c);
                        if (lane == 0 && c) atomicAdd(&cnt[bit], (unsigned)c);
                        __syncthreads();
                        if (cnt[bit] >= 256u) tau = cand;
                    }
                    { int c = (key[0] > tau) + (key[1] > tau) + (key[2] > tau) + (key[3] > tau); c = wave_sum_i(c); if (lane == 0 && c) atomicAdd(&cnt[32], (unsigned)c); }
                    __syncthreads();
                    const int r = 256 - (int)cnt[32];
#pragma unroll
                    for (int i = 0; i < 4; ++i) {
                        const int s = tid + 512 * i; bool sel = key[i] > tau;
                        if (key[i] == tau && s < n) { int rank = 0; for (int s2 = 0; s2 < s; ++s2) rank += (kl[s2] == tau); sel = rank < r; }
                        if (sel) atomicOr(&mw[s >> 5], 1u << (s & 31));
                    }
                    __syncthreads();
                    if (tid < 64) MASK[(size_t)qi * 64 + tid] = mw[tid];
                }
                __syncthreads();
            }
        }
        SEAM(P + 2);
        if (IN(P + 3)) {
            WS_OPAQUE();
            const float* hnw = args.in[I_HNW] + (size_t)l * 512;
            for (int row = blockIdx.x * NWAVES + wave; row < T; row += G * NWAVES) {
                const int c0 = lane * 8; float o[8]; float ss = 0.f;
#pragma unroll
                for (int j = 0; j < 8; ++j) { o[j] = ORAW[(size_t)row * 512 + c0 + j]; ss += o[j] * o[j]; }
                ss += __shfl_xor(ss, 1); ss += __shfl_xor(ss, 2); ss += __shfl_xor(ss, 4); ss += __shfl_xor(ss, 8);
                const float r = rsqrtf(ss * (1.0f / 128.0f) + EPS);
#pragma unroll
                for (int j = 0; j < 8; ++j) { const float g = Z[(size_t)row * ZLD + C_GA + c0 + j]; HA[(size_t)row * 512 + c0 + j] = f2bf(o[j] * r * hnw[c0 + j] * (g * sigmoidf_(g))); }
            }
            {
                unsigned* mw = (unsigned*)lds; int* idx = (int*)(mw + 64); int* nsel = idx + 256; float* ql = (float*)(nsel + 64); float* bl = ql + 512; float* lg = bl + 256; float* inv = lg + 8 * 256;
                __syncthreads();
                for (int i = tid; i < 256; i += NTHREADS) bl[i] = args.in[I_RELB][i];
                for (int qi = blockIdx.x; qi < T; qi += G) {
                    const int b = qi >> 11, t = qi & 2047;
                    __syncthreads();
                    if (tid < 64) mw[tid] = MASK[(size_t)qi * 64 + tid];
                    ql[tid] = Z[(size_t)qi * ZLD + C_QB + tid] * 0.125f;
                    __syncthreads();
                    if (tid < 64) { int base = 0; for (int w = 0; w < tid; ++w) base += __popc(mw[w]); unsigned m = mw[tid]; int j = base; while (m) { const int bp = __ffs(m) - 1; m &= m - 1u; if (j < 256) idx[j] = tid * 32 + bp; ++j; } if (tid == 63) nsel[0] = j < 256 ? j : 256; }
                    __syncthreads();
                    const int n = nsel[0];
                    {
                        const int j = tid & 255, hg = tid >> 8;
                        if (j < n) {
                            const int s = idx[j]; const float* kr = Z + (size_t)(b * SEQ + s) * ZLD + C_KB; float kk[64];
#pragma unroll
                            for (int d4 = 0; d4 < 16; ++d4) { const f32x4 x = *(const f32x4*)(kr + 4 * d4); kk[4 * d4] = x[0]; kk[4 * d4 + 1] = x[1]; kk[4 * d4 + 2] = x[2]; kk[4 * d4 + 3] = x[3]; }
                            const int bk = t5_bucket(t - s);
                            for (int h4 = 0; h4 < 4; ++h4) { const int h = hg * 4 + h4; float dot = 0.f;
#pragma unroll
                                for (int d = 0; d < 64; ++d) dot += ql[h * 64 + d] * kk[d];
                                lg[h * 256 + j] = dot + bl[bk * 8 + h]; }
                        } else { for (int h4 = 0; h4 < 4; ++h4) lg[(hg * 4 + h4) * 256 + j] = -INFINITY; }
                    }
                    __syncthreads();
                    {
                        float v[4]; float m = -INFINITY;
#pragma unroll
                        for (int i = 0; i < 4; ++i) { v[i] = lg[wave * 256 + lane + 64 * i]; m = fmaxf(m, v[i]); }
#pragma unroll
                        for (int o = 32; o >= 1; o >>= 1) m = fmaxf(m, __shfl_xor(m, o));
                        float s = 0.f;
#pragma unroll
                        for (int i = 0; i < 4; ++i) { v[i] = __expf(v[i] - m); s += v[i]; lg[wave * 256 + lane + 64 * i] = v[i]; }
                        s = wave_sum(s); if (lane == 0) inv[wave] = 1.0f / s;
                    }
                    __syncthreads();
                    {
                        const int h = tid >> 6, d = tid & 63; float acc = 0.f;
#pragma unroll 8
                        for (int j = 0; j < n; ++j) acc += lg[h * 256 + j] * Z[(size_t)(b * SEQ + idx[j]) * ZLD + C_VB + d];
                        ATT[(size_t)qi * 512 + h * 64 + d] = f2bf(acc * inv[h]);
                    }
                }
                __syncthreads();
            }
        }
        SEAM(P + 3);
        if (IN(P + 4)) {
            WS_OPAQUE();
            pg8::StaticOrder S; S.init(T, D, G, (int)blockIdx.x);
            { pg8::Gemm g{HA, WPA + (size_t)l * D * 512, T, D, 512}; pg8::EpiMerge<false> E{TMP, MERGED, Z + C_GTA}; pg8::gemm_phase(lds3, tid, g, S, E); }
            { pg8::Gemm g{ATT, WPB + (size_t)l * D * 512, T, D, 512}; pg8::EpiMerge<true> E{TMP, MERGED, Z + C_GTB}; pg8::gemm_phase(lds3, tid, g, S, E); }
        }
        SEAM(P + 4);
        if (IN(P + 5)) {
            WS_OPAQUE();
            pg8::Gemm g{MERGED, WOUT + (size_t)l * D * D, T, D, D}; pg8::StaticOrder S; S.init(T, D, G, (int)blockIdx.x);
            pg8::EpiOutG E{xin, X1, mod + 2 * D}; pg8::gemm_phase(lds3, tid, g, S, E);
        }
        SEAM(P + 5);
        if (IN(P + 6)) {
            WS_OPAQUE();
            const float* nw = args.in[I_NFW] + (size_t)l * D; const float* wr = args.in[I_WR] + (size_t)l * D * NE; const float* br = args.in[I_BR] + (size_t)l * NE;
            float* hrow = (float*)lds + wave * D;
            for (int tok = blockIdx.x * NWAVES + wave; tok < T; tok += G * NWAVES) {
                const int b = tok >> 11; f32x4 v[4]; float ss = 0.f;
#pragma unroll
                for (int i = 0; i < 4; ++i) { v[i] = *(const f32x4*)(X1 + (size_t)tok * D + (lane + 64 * i) * 4); ss += v[i][0] * v[i][0] + v[i][1] * v[i][1] + v[i][2] * v[i][2] + v[i][3] * v[i][3]; }
                ss = wave_sum(ss); const float r = rsqrtf(ss * (1.0f / D) + EPS);
                __syncthreads();
#pragma unroll
                for (int i = 0; i < 4; ++i) { const int c = (lane + 64 * i) * 4;
#pragma unroll
                    for (int j = 0; j < 4; ++j) { const float hv = v[i][j] * r * nw[c + j] * (1.0f + mod[(size_t)b * NMOD + 4 * D + c + j]) + mod[(size_t)b * NMOD + 3 * D + c + j]; hrow[c + j] = hv; H[(size_t)tok * D + c + j] = f2bf(hv); } }
                __syncthreads();
                const int e = lane & 31, half = lane >> 5; float acc = 0.f;
                for (int k = half * 512; k < half * 512 + 512; ++k) acc += hrow[k] * wr[(size_t)k * NE + e];
                acc += __shfl_xor(acc, 32);
                float logit = acc + br[e];
                float tv[4]; int ti[4];
#pragma unroll
                for (int k = 0; k < 4; ++k) {
                    float bv = logit; int bi = e;
#pragma unroll
                    for (int o = 16; o >= 1; o >>= 1) { const float ov = __shfl_xor(bv, o); const int oi = __shfl_xor(bi, o); if (ov > bv || (ov == bv && oi < bi)) { bv = ov; bi = oi; } }
                    tv[k] = bv; ti[k] = bi; if (e == bi) logit = -INFINITY;
                }
                const float e1 = __expf(tv[1] - tv[0]), e2 = __expf(tv[2] - tv[0]), e3 = __expf(tv[3] - tv[0]); const float inv = 1.0f / (1.0f + e1 + e2 + e3);
                if (lane < 4) { const int ee = lane == 0 ? ti[0] : lane == 1 ? ti[1] : lane == 2 ? ti[2] : ti[3]; const float gg = (lane == 0 ? 1.0f : lane == 1 ? e1 : lane == 2 ? e2 : e3) * inv;
                    TOKE[tok * 4 + lane] = ee; TOKG[tok * 4 + lane] = gg; TOKP[tok * 4 + lane] = (int)atomicAdd(&ctl[CW_CNT + l * 32 + ee], 1u); }
            }
        }
        SEAM(P + 6);
        if (IN(P + 7)) {
            WS_OPAQUE();
            int* ps = (int*)lds;
            __syncthreads();
            if (tid == 0) { int a = 0; for (int e = 0; e < NE; ++e) { ps[e] = a; a += (int)((ctl[CW_CNT + l * 32 + e] + 255u) / 256u) * 256; } ps[NE] = a; }
            __syncthreads();
            const int gt = blockIdx.x * NTHREADS + tid, gn = G * NTHREADS;
            for (int tok = blockIdx.x * NWAVES + wave; tok < T; tok += G * NWAVES) {
                const u32x4 r0 = *(const u32x4*)(H + (size_t)tok * D + lane * 8), r1 = *(const u32x4*)(H + (size_t)tok * D + 512 + lane * 8);
#pragma unroll
                for (int k = 0; k < 4; ++k) { const int e = TOKE[tok * 4 + k]; const int slot = ps[e] + TOKP[tok * 4 + k]; if (lane == 0) TOKS[tok * 4 + k] = slot;
                    *(u32x4*)(XS + (size_t)slot * D + lane * 8) = r0; *(u32x4*)(XS + (size_t)slot * D + 512 + lane * 8) = r1; }
            }
            for (int i = blockIdx.x * NWAVES + wave; i < NE * 256; i += G * NWAVES) {
                const int e = i >> 8, j = i & 255; const int c = (int)ctl[CW_CNT + l * 32 + e]; const int si = c + j;
                if (si < ps[e + 1] - ps[e]) { const u32x4 z = {0u, 0u, 0u, 0u}; *(u32x4*)(XS + (size_t)(ps[e] + si) * D + lane * 8) = z; *(u32x4*)(XS + (size_t)(ps[e] + si) * D + 512 + lane * 8) = z; } }
            const int nblk = ps[NE] / 256, nblk8 = (nblk + 7) & ~7;
            for (int mb = gt; mb < nblk8; mb += gn) { int e = 0; if (mb < nblk) { while (e < NE - 1 && mb * 256 >= ps[e + 1]) ++e; } BLKE[mb] = e; }
            if (gt == 0) ctl[CW_NBLK + l] = (unsigned)nblk8;
            __syncthreads();
        }
        SEAM(P + 7);
        if (IN(P + 8)) {
            WS_OPAQUE();
            const int nblk = __builtin_amdgcn_readfirstlane((int)ctl[CW_NBLK + l]);
            pg8::Gemm g{XS, W1 + (size_t)l * NE * 2 * DFF * D, nblk * 256, 2 * DFF, D}; pg8::MoeOrder<8> S; S.init(nblk, G, (int)blockIdx.x, BLKE);
            pg8::EpiSwigluG E{ACT, args.in[I_B1] + (size_t)l * NE * 2 * DFF}; pg8::gemm_phase(lds3, tid, g, S, E);
        }
        SEAM(P + 8);
        if (IN(P + 9)) {
            WS_OPAQUE();
            const int nblk = __builtin_amdgcn_readfirstlane((int)ctl[CW_NBLK + l]);
            pg8::Gemm g{ACT, W2 + (size_t)l * NE * D * DFF, nblk * 256, D, DFF}; pg8::MoeOrder<4> S; S.init(nblk, G, (int)blockIdx.x, BLKE);
            pg8::EpiYG E{Y, args.in[I_B2] + (size_t)l * NE * D}; pg8::gemm_phase(lds3, tid, g, S, E);
        }
        SEAM(P + 9);
        if (IN(P + 10)) {
            WS_OPAQUE();
            const bool last = (l == DEPTH - 1);
            const float* nw = last ? args.in[I_FNW] : args.in[I_NMW] + (size_t)(l + 1) * D;
            const float* modn = MOD + (size_t)(l + 1) * NB * NMOD;
            for (int tok = blockIdx.x * NWAVES + wave; tok < T; tok += G * NWAVES) {
                const int b = tok >> 11; f32x4 v[4], a[4];
#pragma unroll
                for (int i = 0; i < 4; ++i) { v[i] = *(const f32x4*)(X1 + (size_t)tok * D + (lane + 64 * i) * 4); a[i] = (f32x4){0.f, 0.f, 0.f, 0.f}; }
                for (int k = 0; k < 4; ++k) { const int slot = TOKS[tok * 4 + k]; const float g = TOKG[tok * 4 + k];
#pragma unroll
                    for (int i = 0; i < 4; ++i) { const unsigned* yp = (const unsigned*)(Y + (size_t)slot * D + (lane + 64 * i) * 4); const unsigned y0 = yp[0], y1 = yp[1];
                        f32x4 y; y[0] = __uint_as_float(y0 << 16); y[1] = __uint_as_float(y0 & 0xffff0000u); y[2] = __uint_as_float(y1 << 16); y[3] = __uint_as_float(y1 & 0xffff0000u); a[i] += g * y; } }
                float ss = 0.f;
#pragma unroll
                for (int i = 0; i < 4; ++i) { const int c = (lane + 64 * i) * 4; const f32x4 gf = *(const f32x4*)(mod + (size_t)b * NMOD + 5 * D + c); v[i] = v[i] + gf * a[i];
                    ss += v[i][0] * v[i][0] + v[i][1] * v[i][1] + v[i][2] * v[i][2] + v[i][3] * v[i][3]; }
                ss = wave_sum(ss); const float r = rsqrtf(ss * (1.0f / D) + EPS);
#pragma unroll
                for (int i = 0; i < 4; ++i) { const int c = (lane + 64 * i) * 4;
                    if (last) { f32x4 o;
#pragma unroll
                        for (int j = 0; j < 4; ++j) o[j] = v[i][j] * r * nw[c + j];
                        *(f32x4*)(args.out + (size_t)tok * D + c) = o;
                    } else {
                        *(f32x4*)(X2 + (size_t)tok * D + c) = v[i];
#pragma unroll
                        for (int j = 0; j < 4; ++j) H[(size_t)tok * D + c + j] = f2bf(v[i][j] * r * nw[c + j] * (1.0f + modn[(size_t)b * NMOD + D + c + j]) + modn[(size_t)b * NMOD + c + j]);
                    } }
            }
        }
        SEAM(P + 10);
    }
#undef IN
}

constexpr int N_PHASES = 1 + 11 * DEPTH;
typedef void (*kern_t)(Args);
template <int K> static kern_t kern_of() { return fwd<K>; }
static kern_t kern_for(int kind) {
    switch (kind) { case 0: return fwd<0>; case 1: return fwd<1>; case 2: return fwd<2>; case 3: return fwd<3>; case 4: return fwd<4>; case 5: return fwd<5>;
                    case 6: return fwd<6>; case 7: return fwd<7>; case 8: return fwd<8>; case 9: return fwd<9>; case 10: return fwd<10>; default: return fwd<100>; }
}

extern "C" void kernel_launch(void* const* d_in, const int* in_sizes, int n_in, void* d_out, int out_size, void* d_ws, size_t ws_size, hipStream_t stream) {
    static int grid = 0;
    if (grid == 0) {
        if (n_in != 20 || out_size != T * D || ws_size < WS_END) { fprintf(stderr, "kernel_launch: unexpected problem (n_in %d, out %d, ws %zu, need %zu)\n", n_in, out_size, ws_size, (size_t)WS_END); grid = -1; return; }
        int dev = 0, cus = 0;
        if (hipGetDevice(&dev) != hipSuccess || hipDeviceGetAttribute(&cus, hipDeviceAttributeMultiprocessorCount, dev) != hipSuccess) { grid = -1; return; }
        for (int k = 0; k <= 12; ++k) {
            if (hipFuncSetAttribute((const void*)(k == 12 ? (kern_t)fwd<-1> : kern_for(k)), hipFuncAttributeMaxDynamicSharedMemorySize, LDS_BYTES) != hipSuccess) { fprintf(stderr, "kernel_launch: hipFuncSetAttribute failed\n"); grid = -1; return; }
        }
        grid = cus > 0 ? cus : 256;
    }
    if (grid < 0) return;
    (void)hipMemsetAsync((char*)d_ws + WS_CTL, 0, CTL_BYTES, stream);
    Args a{};
    for (int i = 0; i < 20; ++i) a.in[i] = (const float*)d_in[i];
    a.out = (float*)d_out; a.ws = (unsigned char*)d_ws;
#if defined(MULTI_LAUNCH)
    for (int p = 0; p < N_PHASES; ++p) {
        if (p == 1 + 11) continue;
        a.ph_lo = p; a.ph_hi = p + 1;
        const int kind = p == 0 ? 11 : (p - 1) % 11;
        hipLaunchKernelGGL(kern_for(kind), dim3(grid), dim3(NTHREADS), LDS_BYTES, stream, a);
    }
#else
    a.ph_lo = 0; a.ph_hi = N_PHASES;
    hipLaunchKernelGGL(fwd<-1>, dim3(grid), dim3(NTHREADS), LDS_BYTES, stream, a);
#endif
}
```

```cpp
#include <hip/hip_runtime.h>
#include <stdint.h>
#include <stdio.h>

typedef unsigned short bf16_t;
typedef short bf16x8 __attribute__((ext_vector_type(8)));
typedef float f32x4 __attribute__((ext_vector_type(4)));
typedef float f32x16 __attribute__((ext_vector_type(16)));
typedef unsigned u32x4 __attribute__((ext_vector_type(4)));
#define LAS __attribute__((address_space(3)))

constexpr int T = 32768, D = 1024, NB = 16, SEQ = 2048, DEPTH = 2;
constexpr int ZC = 5320, ZLD = 5376;
constexpr int C_QA = 0, C_FA = 512, C_IA = 1024, C_GA = 1536, C_QB = 2048, C_KB = 2560, C_VB = 2624, C_IQ = 2688, C_IK = 3200, C_IW = 3264, C_GTA = 3272, C_GTB = 4296;
constexpr int NE = 32, DFF = 1024, NSLOT = 131072 + 32 * 256, NBLK_MAX = NSLOT / 256;
constexpr int NMOD = 6 * D;
constexpr float EPS = 1e-6f;
constexpr int NTHREADS = 512, NWAVES = 8;
constexpr int LDS_BYTES = 144 * 1024;

constexpr size_t al256(size_t x) { return (x + 255) & ~(size_t)255; }
constexpr size_t WS_CTL = 0;
constexpr size_t CTL_BYTES = 65536;
constexpr size_t WS_MOD = WS_CTL + CTL_BYTES;
constexpr size_t WS_LB = WS_MOD + al256((size_t)DEPTH * NB * NMOD * 4);
constexpr size_t WS_WIN = WS_LB + al256((size_t)DEPTH * 512 * 4);
constexpr size_t WS_WPA = WS_WIN + (size_t)DEPTH * ZLD * D * 2;
constexpr size_t WS_WPB = WS_WPA + (size_t)DEPTH * D * 512 * 2;
constexpr size_t WS_WOUT = WS_WPB + (size_t)DEPTH * D * 512 * 2;
constexpr size_t WS_W1 = WS_WOUT + (size_t)DEPTH * D * D * 2;
constexpr size_t WS_W2 = WS_W1 + (size_t)DEPTH * NE * 2 * DFF * D * 2;
constexpr size_t WS_H = WS_W2 + (size_t)DEPTH * NE * D * DFF * 2;
constexpr size_t WS_Z = WS_H + (size_t)T * D * 2;
constexpr size_t WS_Y = WS_Z;
constexpr size_t WS_ACT = WS_Z + (size_t)T * ZLD * 2;
constexpr size_t WS_ORAW = WS_ACT;
constexpr size_t WS_TMP = WS_ACT + (size_t)T * 512 * 4;
constexpr size_t WS_XS = WS_ACT + (size_t)NSLOT * DFF * 2;
constexpr size_t WS_HA = WS_XS + (size_t)NSLOT * D * 2;
constexpr size_t WS_ATT = WS_HA + (size_t)T * 512 * 2;
constexpr size_t WS_MASK = WS_ATT + (size_t)T * 512 * 2;
constexpr size_t WS_VBT = WS_MASK + (size_t)T * 64 * 4;
constexpr size_t WS_MERGED = WS_VBT + (size_t)T * 64 * 2;
constexpr size_t WS_X1 = WS_MERGED + (size_t)T * D * 2;
constexpr size_t WS_X2 = WS_X1 + (size_t)T * D * 4;
constexpr size_t WS_TOKE = WS_X2 + (size_t)T * D * 4;
constexpr size_t WS_TOKG = WS_TOKE + (size_t)T * 4 * 4;
constexpr size_t WS_TOKP = WS_TOKG + (size_t)T * 4 * 4;
constexpr size_t WS_TOKS = WS_TOKP + (size_t)T * 4 * 4;
constexpr size_t WS_BLKE = WS_TOKS + (size_t)T * 4 * 4;
constexpr size_t WS_END = WS_BLKE + al256((size_t)(NBLK_MAX + 64) * 4);
static_assert((size_t)NSLOT * D * 2 <= (size_t)T * ZLD * 2, "Y must fit in Z");
static_assert((size_t)T * 512 * 4 + (size_t)T * D * 4 <= (size_t)NSLOT * DFF * 2, "ORAW+TMP must fit in ACT");
static_assert(WS_END <= ((size_t)1 << 31), "workspace layout exceeds 2 GiB");
constexpr int CW_CNT = 1024;
constexpr int CW_NBLK = 1200;

__device__ __forceinline__ bf16_t f2bf(float f) { unsigned u = __float_as_uint(f); u += 0x7fffu + ((u >> 16) & 1u); return (bf16_t)(u >> 16); }
__device__ __forceinline__ float bf2f(bf16_t b) { return __uint_as_float(((unsigned)b) << 16); }
__device__ __forceinline__ float sigmoidf_(float x) { return 1.0f / (1.0f + __expf(-x)); }
__device__ __forceinline__ float wave_sum(float v) {
#pragma unroll
    for (int o = 32; o >= 1; o >>= 1) v += __shfl_xor(v, o);
    return v;
}
__device__ __forceinline__ int wave_sum_i(int v) {
#pragma unroll
    for (int o = 32; o >= 1; o >>= 1) v += __shfl_xor(v, o);
    return v;
}
__device__ const unsigned char T5_BUCKET[128] = {
    0, 1, 2, 3, 4, 5, 6, 7, 8, 9, 10, 11, 12, 13, 14, 15, 16, 16, 16, 17, 17, 18, 18, 18, 19, 19, 19, 20, 20, 20, 20, 21, 21, 21, 21, 22, 22, 22, 22, 22, 23, 23, 23, 23, 23, 23, 24, 24, 24, 24, 24, 24, 25,
    25, 25, 25, 25, 25, 25, 26, 26, 26, 26, 26, 26, 26, 26, 27, 27, 27, 27, 27, 27, 27, 27, 27, 27, 28, 28, 28, 28, 28, 28, 28, 28, 28, 28, 29, 29, 29, 29, 29, 29, 29, 29, 29, 29, 29, 29, 30, 30, 30, 30, 30,
    30, 30, 30, 30, 30, 30, 30, 30, 30, 31, 31, 31, 31, 31, 31, 31, 31, 31, 31, 31, 31, 31, 31, 31};
__device__ __forceinline__ int t5_bucket(int rel) { return rel >= 128 ? 31 : (int)T5_BUCKET[rel]; }


#define XB_TMO      128
#define XB_XCNT(j)  (256  + 64 * (j))
#define XB_XSUB(j)  (1280 + 64 * (j))
#define XB_XGEN(j)  (2304 + 64 * (j))
#define XB_TOP      3328
#define XB_TOPGEN   3392
#define XCD_BAR_WORDS 3456
#define XB_SPIN_CAP (1u << 18)
__device__ __forceinline__ unsigned xb_ld(unsigned* p)              { return __hip_atomic_load(p, __ATOMIC_RELAXED, __HIP_MEMORY_SCOPE_AGENT); }
__device__ __forceinline__ unsigned xb_add(unsigned* p, unsigned v) { return __hip_atomic_fetch_add(p, v, __ATOMIC_RELAXED, __HIP_MEMORY_SCOPE_AGENT); }
__device__ __forceinline__ unsigned xb_xcc_id() { return (unsigned)__builtin_amdgcn_s_getreg((3 << 11) | 20) & 0xFu; }
#define XB_SPIN(cond, bar) do { unsigned _sp = 0; while (cond) { __builtin_amdgcn_s_sleep(1); \
    if ((++_sp & 255u) == 0u) { if (xb_ld(&(bar)[XB_TMO])) break; if (_sp > XB_SPIN_CAP) { atomicAdd(&(bar)[XB_TMO], 1u); break; } } } } while (0)
struct XcdBarrier { unsigned* bar; unsigned x; volatile LAS unsigned* st; };
__device__ __forceinline__ XcdBarrier xcd_barrier_post(unsigned* bar, volatile LAS unsigned* st) {
    XcdBarrier b; b.bar = bar; b.x = xb_xcc_id(); b.st = st;
    if (threadIdx.x == 0) (void)xb_add(&bar[XB_XCNT(b.x)], 1u);
    return b;
}
__device__ __forceinline__ void xcd_barrier_complete(unsigned* bar, unsigned x, unsigned& nloc, unsigned& nx) {
    const unsigned G = gridDim.x * gridDim.y * gridDim.z;
    unsigned sum, cnt, mine, sp = 0u;
    for (;;) {
        sum = 0u; cnt = 0u; mine = 0u;
#pragma unroll
        for (unsigned j = 0; j < 16; ++j) { const unsigned c = xb_ld(&bar[XB_XCNT(j)]); sum += c; cnt += (c > 0u) ? 1u : 0u; mine = (j == x) ? c : mine; }
        if (sum == G) break;
        __builtin_amdgcn_s_sleep(1);
        if ((++sp & 255u) == 0u) { if (xb_ld(&bar[XB_TMO])) break; if (sp > XB_SPIN_CAP) { atomicAdd(&bar[XB_TMO], 1u); break; } }
    }
    nloc = mine > 0u ? mine : 1u; nx = cnt > 0u ? cnt : 1u;
}
__device__ __forceinline__ void xcd_barrier(const XcdBarrier& b) {
    asm volatile("s_waitcnt vmcnt(0)" ::: "memory");
    __syncthreads();
    if (threadIdx.x == 0) {
        unsigned* bar = b.bar; asm volatile("" : "+s"(bar));
        __builtin_amdgcn_s_waitcnt(0);
        unsigned nloc = b.st[0], nx = b.st[1];
        if (nloc == 0u) { xcd_barrier_complete(bar, b.x, nloc, nx); b.st[0] = nloc; b.st[1] = nx; }
        const unsigned old = xb_add(&bar[XB_XSUB(b.x)], 1u);
        const unsigned gen = old / nloc;
        if (old + 1u == (gen + 1u) * nloc) {
            __builtin_amdgcn_fence(__ATOMIC_RELEASE, "agent");
            asm volatile("s_waitcnt vmcnt(0)" ::: "memory");
            const unsigned og = xb_add(&bar[XB_TOP], 1u);
            const unsigned tg = og / nx;
            if (og + 1u == (tg + 1u) * nx) xb_add(&bar[XB_TOPGEN], 1u);
            else XB_SPIN(xb_ld(&bar[XB_TOPGEN]) == tg, bar);
            __builtin_amdgcn_fence(__ATOMIC_ACQUIRE, "agent");
            xb_add(&bar[XB_XGEN(b.x)], 1u);
            asm volatile("s_waitcnt vmcnt(0)" ::: "memory");
        } else {
            XB_SPIN(xb_ld(&bar[XB_XGEN(b.x)]) == gen, bar);
            __builtin_amdgcn_fence(__ATOMIC_ACQUIRE, "agent");
            asm volatile("s_waitcnt vmcnt(0)" ::: "memory");
        }
    }
    __syncthreads();
}
constexpr int CW_BAR = 4096;

struct Args { const float* in[20]; float* out; unsigned char* ws; int ph_lo, ph_hi; };
enum { I_X = 0, I_C, I_WADA, I_BADA, I_NMW, I_WIN, I_LBL, I_HNW, I_RELB, I_WPA, I_WPB, I_WOUT, I_NFW, I_WR, I_BR, I_W1, I_B1, I_W2, I_B2, I_FNW };

__device__ __forceinline__ void cvt_family(const int tid, const float* src, bf16_t* dst, int K, int N, int Npad, int count, int mode, float* lt  ) {
    const int tk = K / 64, tn = Npad / 64, per = tk * tn;
    for (long u = blockIdx.x; u < (long)per * count; u += gridDim.x) {
        const int mi = (int)(u / per), r = (int)(u % per), k0 = (r / tn) * 64, n0 = (r % tn) * 64;
        const float* s = src + (size_t)mi * K * N;
        bf16_t* d = dst + (size_t)mi * Npad * K;
        int sc0 = n0;
        if (mode == 1) { const int p = n0 >> 8, sel = (n0 >> 7) & 1, i = n0 & 127; sc0 = sel * 1024 + 128 * p + i; }
        __syncthreads();
        {
            const int i = tid >> 3, j0 = (tid & 7) * 8;
            float v[8];
            if (n0 + j0 < Npad && (mode == 1 || n0 + j0 < N)) {
                const f32x4 a = *(const f32x4*)(s + (size_t)(k0 + i) * N + sc0 + j0), b = *(const f32x4*)(s + (size_t)(k0 + i) * N + sc0 + j0 + 4);
                v[0] = a[0]; v[1] = a[1]; v[2] = a[2]; v[3] = a[3]; v[4] = b[0]; v[5] = b[1]; v[6] = b[2]; v[7] = b[3];
            } else {
#pragma unroll
                for (int q = 0; q < 8; ++q) v[q] = 0.f;
            }
#pragma unroll
            for (int q = 0; q < 8; ++q) lt[i * 65 + j0 + q] = v[q];
        }
        __syncthreads();
        {
            const int n = tid >> 3, kk = (tid & 7) * 8;
            unsigned w[4];
#pragma unroll
            for (int q = 0; q < 4; ++q) w[q] = (unsigned)f2bf(lt[(kk + 2 * q) * 65 + n]) | ((unsigned)f2bf(lt[(kk + 2 * q + 1) * 65 + n]) << 16);
            u32x4 o; o.x = w[0]; o.y = w[1]; o.z = w[2]; o.w = w[3];
            *(u32x4*)(d + (size_t)(n0 + n) * K + k0 + kk) = o;
        }
    }
    __syncthreads();
}

namespace pg8 {
#define PG8_LAS __attribute__((address_space(3)))
constexpr int BM = 256, BK = 64, HALF = 128, HTB = HALF * BK * 2, STAGE_BYTES = 8 * HTB, NXCD = 8, WGM = 8;
__host__ __device__ __forceinline__ int lds_byte(int r, int c) { const int st = (r >> 4) * 2 + (c >> 5), rr = r & 15, cc = c & 31, ob = rr * 64 + cc * 2; return st * 1024 + (ob ^ (((ob >> 9) & 1) << 5)); }
__host__ __device__ __forceinline__ void stage_rc(int b, int& R, int& C) { const int st = b / 1024, sb = b % 1024, swz = sb ^ (((sb >> 9) & 1) << 5); R = (st >> 1) * 16 + swz / 64; C = (st & 1) * 32 + (swz % 64) / 2; }
__host__ __device__ __forceinline__ int perm32(int rho) { const int n = rho >> 4, i = rho & 15; return 8 * (i >> 2) + 4 * n + (i & 3); }
struct Unit { int pm, pn, brow, e; };
struct Gemm { const bf16_t* A; const bf16_t* Bt; int M, N, K; };
struct StaticOrder {
    int nM, nN, nwg, G, c;
    __device__ void init(int M, int N, int G_, int c_) { nM = M / BM; nN = N / BM; nwg = nM * nN; G = G_; c = c_; }
    __device__ bool next(int i, Unit& u) const {
        const long L = (long)i * G + c; if (L >= nwg) return false;
        int wgid = (int)L; { const int q = nwg / NXCD, r = nwg % NXCD, xcd = wgid % NXCD, off = wgid / NXCD; wgid = (xcd < r ? xcd * (q + 1) : r * (q + 1) + (xcd - r) * q) + off; }
        const int nig = WGM * nN, gid = wgid / nig, fm = gid * WGM, gsz = (nM - fm) < WGM ? (nM - fm) : WGM;
        u.pm = fm + ((wgid % nig) % gsz); u.pn = (wgid % nig) / gsz; u.brow = u.pn * BM; u.e = 0; return true;
    }
    __device__ __forceinline__ void a_ready(const Unit&) const {}
    __device__ __forceinline__ void done(const Unit&) const {}
};
template <int NN> struct MoeOrder {
    int nwg, G, c; const int* blke;
    __device__ void init(int nM, int G_, int c_, const int* blke_) { nwg = nM * NN; G = G_; c = c_; blke = blke_; }
    __device__ bool next(int i, Unit& u) const {
        const int L = i * G + c; if (L >= nwg) return false;
        const int wgid = (L & 7) * (nwg >> 3) + (L >> 3);
        const int gid = wgid / (8 * NN), rem = wgid % (8 * NN);
        u.pm = gid * 8 + (rem & 7); u.pn = rem >> 3; u.e = __builtin_amdgcn_readfirstlane(blke[u.pm]); u.brow = u.e * (NN * BM) + u.pn * BM; return true;
    }
    __device__ __forceinline__ void a_ready(const Unit&) const {}
    __device__ __forceinline__ void done(const Unit&) const {}
};
__device__ __forceinline__ unsigned cvt_pk_bf16(float lo, float hi) { unsigned r; asm volatile("v_cvt_pk_bf16_f32 %0, %1, %2" : "=v"(r) : "v"(lo), "v"(hi)); return r; }


struct EpiZ {
    static constexpr bool PERM = true, AFTER_DRAIN = false;
    bf16_t* C; int ldc;
    __device__ __forceinline__ void operator()(const f32x4 (&acc)[2][2][4][2], const Unit& u, int wr, int wc, int fr, int fq) const {
        const int row0 = u.pm * BM + wr * 64 + fr, col0 = u.pn * BM + wc * 32 + 8 * fq;
#pragma unroll
        for (int ai = 0; ai < 2; ++ai)
#pragma unroll
            for (int m = 0; m < 4; ++m) { bf16_t* rowp = C + (size_t)(row0 + ai * HALF + m * 16) * ldc + col0;
#pragma unroll
                for (int bj = 0; bj < 2; ++bj) { const f32x4 v0 = acc[ai][bj][m][0], v1 = acc[ai][bj][m][1];
                    u32x4 w; w.x = cvt_pk_bf16(v0[0], v0[1]); w.y = cvt_pk_bf16(v0[2], v0[3]); w.z = cvt_pk_bf16(v1[0], v1[1]); w.w = cvt_pk_bf16(v1[2], v1[3]);
                    *(u32x4*)(rowp + bj * HALF) = w; } }
    }
};
__device__ __forceinline__ void bf8_to_f32(const u32x4 w, f32x4& lo, f32x4& hi) {
    lo[0] = __uint_as_float(w.x << 16); lo[1] = __uint_as_float(w.x & 0xffff0000u); lo[2] = __uint_as_float(w.y << 16); lo[3] = __uint_as_float(w.y & 0xffff0000u);
    hi[0] = __uint_as_float(w.z << 16); hi[1] = __uint_as_float(w.z & 0xffff0000u); hi[2] = __uint_as_float(w.w << 16); hi[3] = __uint_as_float(w.w & 0xffff0000u);
}
__device__ __forceinline__ f32x4 sig4(f32x4 g) { f32x4 r; r[0] = sigmoidf_(g[0]); r[1] = sigmoidf_(g[1]); r[2] = sigmoidf_(g[2]); r[3] = sigmoidf_(g[3]); return r; }
template <bool SECOND> struct EpiMerge {
    static constexpr bool PERM = true, AFTER_DRAIN = false;
    float* tmp; bf16_t* merged; const bf16_t* Zg  ;
    __device__ __forceinline__ void operator()(const f32x4 (&acc)[2][2][4][2], const Unit& u, int wr, int wc, int fr, int fq) const {
        const int row0 = u.pm * BM + wr * 64 + fr, col0 = u.pn * BM + wc * 32 + 8 * fq;
#pragma unroll
        for (int ai = 0; ai < 2; ++ai)
#pragma unroll
            for (int m = 0; m < 4; ++m) { const size_t row = (size_t)(row0 + ai * HALF + m * 16);
#pragma unroll
                for (int bj = 0; bj < 2; ++bj) { const int col = col0 + bj * HALF;
                    f32x4 g0, g1; bf8_to_f32(*(const u32x4*)(Zg + row * ZLD + col), g0, g1); g0 = sig4(g0); g1 = sig4(g1);
                    f32x4 v0 = g0 * acc[ai][bj][m][0], v1 = g1 * acc[ai][bj][m][1];
                    if (!SECOND) { *(f32x4*)(tmp + row * D + col) = v0; *(f32x4*)(tmp + row * D + col + 4) = v1; }
                    else { v0 += *(const f32x4*)(tmp + row * D + col); v1 += *(const f32x4*)(tmp + row * D + col + 4);
                        u32x4 w; w.x = cvt_pk_bf16(v0[0], v0[1]); w.y = cvt_pk_bf16(v0[2], v0[3]); w.z = cvt_pk_bf16(v1[0], v1[1]); w.w = cvt_pk_bf16(v1[2], v1[3]);
                        *(u32x4*)(merged + row * D + col) = w; } } }
    }
};
struct EpiOutG {
    static constexpr bool PERM = false, AFTER_DRAIN = false;
    const float* xin; float* x1; const float* gate  ;
    __device__ __forceinline__ void operator()(const f32x4 (&acc)[2][2][4][2], const Unit& u, int wr, int wc, int fr, int fq) const {
        const int row0 = u.pm * BM + wr * 64 + fr, col0 = u.pn * BM + wc * 32 + 4 * fq; const int b = (u.pm * BM) >> 11;
        f32x4 gv[2][2];
#pragma unroll
        for (int bj = 0; bj < 2; ++bj)
#pragma unroll
            for (int n = 0; n < 2; ++n) gv[bj][n] = *(const f32x4*)(gate + (size_t)b * NMOD + col0 + bj * HALF + n * 16);
#pragma unroll
        for (int ai = 0; ai < 2; ++ai)
#pragma unroll
            for (int m = 0; m < 4; ++m) { const size_t off = (size_t)(row0 + ai * HALF + m * 16) * D + col0;
#pragma unroll
                for (int bj = 0; bj < 2; ++bj)
#pragma unroll
                    for (int n = 0; n < 2; ++n) *(f32x4*)(x1 + off + bj * HALF + n * 16) = *(const f32x4*)(xin + off + bj * HALF + n * 16) + gv[bj][n] * acc[ai][bj][m][n]; }
    }
};
struct EpiSwigluG {
    static constexpr bool PERM = true, AFTER_DRAIN = false;
    bf16_t* act; const float* b1  ;
    __device__ __forceinline__ void operator()(const f32x4 (&acc)[2][2][4][2], const Unit& u, int wr, int wc, int fr, int fq) const {
        const int row0 = u.pm * BM + wr * 64 + fr, col0 = u.pn * HALF + wc * 32 + 8 * fq;
        f32x4 bg[2], bl[2];
#pragma unroll
        for (int n = 0; n < 2; ++n) { bg[n] = *(const f32x4*)(b1 + (size_t)u.e * 2 * DFF + col0 + 4 * n); bl[n] = *(const f32x4*)(b1 + (size_t)u.e * 2 * DFF + DFF + col0 + 4 * n); }
#pragma unroll
        for (int ai = 0; ai < 2; ++ai)
#pragma unroll
            for (int m = 0; m < 4; ++m) { float o[8];
#pragma unroll
                for (int n = 0; n < 2; ++n) { const f32x4 gl = acc[ai][0][m][n] + bg[n], li = acc[ai][1][m][n] + bl[n];
#pragma unroll
                    for (int j = 0; j < 4; ++j) { const float g = fminf(gl[j], 7.0f), l = fminf(fmaxf(li[j], -7.0f), 7.0f); o[4 * n + j] = g * sigmoidf_(1.702f * g) * (l + 1.0f); } }
                u32x4 w; w.x = cvt_pk_bf16(o[0], o[1]); w.y = cvt_pk_bf16(o[2], o[3]); w.z = cvt_pk_bf16(o[4], o[5]); w.w = cvt_pk_bf16(o[6], o[7]);
                *(u32x4*)(act + (size_t)(row0 + ai * HALF + m * 16) * DFF + col0) = w; }
    }
};
struct EpiYG {
    static constexpr bool PERM = true, AFTER_DRAIN = false;
    bf16_t* Yb; const float* b2  ;
    __device__ __forceinline__ void operator()(const f32x4 (&acc)[2][2][4][2], const Unit& u, int wr, int wc, int fr, int fq) const {
        const int row0 = u.pm * BM + wr * 64 + fr, col0 = u.pn * BM + wc * 32 + 8 * fq;
        f32x4 bv[2][2];
#pragma unroll
        for (int bj = 0; bj < 2; ++bj)
#pragma unroll
            for (int n = 0; n < 2; ++n) bv[bj][n] = *(const f32x4*)(b2 + (size_t)u.e * D + col0 + bj * HALF + 4 * n);
#pragma unroll
        for (int ai = 0; ai < 2; ++ai)
#pragma unroll
            for (int m = 0; m < 4; ++m) { bf16_t* rowp = Yb + (size_t)(row0 + ai * HALF + m * 16) * D + col0;
#pragma unroll
                for (int bj = 0; bj < 2; ++bj) { const f32x4 v0 = acc[ai][bj][m][0] + bv[bj][0], v1 = acc[ai][bj][m][1] + bv[bj][1];
                    u32x4 w; w.x = cvt_pk_bf16(v0[0], v0[1]); w.y = cvt_pk_bf16(v0[2], v0[3]); w.z = cvt_pk_bf16(v1[0], v1[1]); w.w = cvt_pk_bf16(v1[2], v1[3]);
                    *(u32x4*)(rowp + bj * HALF) = w; } }
    }
};

template <class Epi, class Sched>
__device__ __forceinline__ void gemm_phase(PG8_LAS unsigned char* lds, const int tid, const Gemm g, const Sched& S, const Epi& E) {
    const int wid = __builtin_amdgcn_readfirstlane(tid >> 6), lane = tid & 63, wr = wid >> 2, wc = wid & 3, fr = lane & 15, fq = lane >> 4;
    const int K = g.K, nt = K / BK;
    unsigned voffA[2], voffB[2];
#pragma unroll
    for (int i = 0; i < 2; ++i) { int R, C; stage_rc(tid * 16 + i * 8192, R, C); const int Rb = Epi::PERM ? ((R & ~31) + perm32(R & 31)) : R;
        voffA[i] = (unsigned)(R * K + C) * 2u; voffB[i] = (unsigned)(Rb * K + C) * 2u; }
    const size_t kstep = (size_t)(BK * 2);
    const size_t hstep = (size_t)HALF * K * 2;
    const size_t tstep = 2 * hstep;
    const unsigned ldsw = (unsigned)wid * 1024u;
    const int aoff = lds_byte(wr * 64 + fr, fq * 8), boff = lds_byte(wc * 32 + fr, fq * 8);
#define PG8_SA(b, h) (((b) * 2 + (h)) * HTB)
#define PG8_SB(b, h) ((4 + (b) * 2 + (h)) * HTB)
#define PG8_STAGE(bufoff, gbase, voff) do { _Pragma("unroll") for (int _i = 0; _i < 2; ++_i) \
        __builtin_amdgcn_global_load_lds((const unsigned*)((const char*)(gbase) + (voff)[_i]), (PG8_LAS unsigned*)(lds + (bufoff) + ldsw + _i * 8192), 16, 0, 0); } while (0)
#define PG8_LDA(dst, b, h) do { _Pragma("unroll") for (int m = 0; m < 4; ++m) _Pragma("unroll") for (int k = 0; k < 2; ++k) dst[m][k] = *(const PG8_LAS bf16x8*)(lds + PG8_SA(b, h) + aoff + m * 2048 + k * 1024); } while (0)
#define PG8_LDB(dst, b, h) do { _Pragma("unroll") for (int n = 0; n < 2; ++n) _Pragma("unroll") for (int k = 0; k < 2; ++k) dst[n][k] = *(const PG8_LAS bf16x8*)(lds + PG8_SB(b, h) + boff + n * 2048 + k * 1024); } while (0)
#define PG8_MMA(ai, bj, At, Bt) do { __builtin_amdgcn_s_setprio(1); _Pragma("unroll") for (int m = 0; m < 4; ++m) _Pragma("unroll") for (int n = 0; n < 2; ++n) _Pragma("unroll") for (int k = 0; k < 2; ++k) \
        acc[ai][bj][m][n] = __builtin_amdgcn_mfma_f32_16x16x32_bf16(Bt[n][k], At[m][k], acc[ai][bj][m][n], 0, 0, 0); __builtin_amdgcn_s_setprio(0); } while (0)
#define PG8_WAIT_V(n) asm volatile("s_waitcnt vmcnt(" #n ")" ::: "memory")
#define PG8_WAIT_L(n) asm volatile("s_waitcnt lgkmcnt(" #n ")" ::: "memory")
#define PG8_BAR __builtin_amdgcn_s_barrier()
#define PG8_SCHED __builtin_amdgcn_sched_barrier(0)
    Unit cur, nxt; int ui = 0;
    if (!S.next(0, cur)) return;
    f32x4 acc[2][2][4][2];
#pragma unroll
    for (int a = 0; a < 2; ++a)
#pragma unroll
        for (int b = 0; b < 2; ++b)
#pragma unroll
            for (int m = 0; m < 4; ++m)
#pragma unroll
                for (int n = 0; n < 2; ++n) acc[a][b][m][n] = (f32x4){0.f, 0.f, 0.f, 0.f};
    bf16x8 At[4][2], B0[2][2], B1[2][2];
    const char* cA = (const char*)g.A + (size_t)cur.pm * tstep; const char* cB = (const char*)g.Bt + (size_t)cur.brow * K * 2;
    S.a_ready(cur);
    PG8_STAGE(PG8_SB(0, 0), cB, voffB); PG8_STAGE(PG8_SA(0, 0), cA, voffA); PG8_STAGE(PG8_SB(0, 1), cB + hstep, voffB); PG8_STAGE(PG8_SA(0, 1), cA + hstep, voffA);
    if (wr == 1) PG8_BAR;
    PG8_WAIT_V(4); PG8_BAR;
    PG8_STAGE(PG8_SB(1, 0), cB + kstep, voffB); PG8_STAGE(PG8_SA(1, 0), cA + kstep, voffA); PG8_STAGE(PG8_SB(1, 1), cB + hstep + kstep, voffB);
    PG8_WAIT_V(6); PG8_BAR;
    for (;;) {
        const bool has_next = S.next(ui + 1, nxt);
        const char* nA = has_next ? (const char*)g.A + (size_t)nxt.pm * tstep : cA; const char* nB = has_next ? (const char*)g.Bt + (size_t)nxt.brow * K * 2 : cB;
        for (int t = 0; t < nt; t += 2) {
            const bool last = (t == nt - 2);
            const char* a1 = cA + (size_t)(t + 1) * kstep;
            const char* a2 = last ? nA : cA + (size_t)(t + 2) * kstep; const char* b2 = last ? nB : cB + (size_t)(t + 2) * kstep;
            const char* a3 = a2 + kstep; const char* b3 = b2 + kstep;
            if (last && has_next) S.a_ready(nxt);
            PG8_LDB(B0, 0, 0); PG8_SCHED; PG8_LDA(At, 0, 0); PG8_STAGE(PG8_SA(1, 1), a1 + hstep, voffA);
            PG8_WAIT_L(8); PG8_BAR; PG8_WAIT_L(0); PG8_MMA(0, 0, At, B0); PG8_BAR; PG8_SCHED;
            PG8_LDB(B1, 0, 1); PG8_STAGE(PG8_SB(0, 0), b2, voffB);
            PG8_BAR; PG8_WAIT_L(0); PG8_MMA(0, 1, At, B1); PG8_BAR;
            PG8_LDA(At, 0, 1); PG8_STAGE(PG8_SA(0, 0), a2, voffA);
            PG8_BAR; PG8_WAIT_L(0); PG8_MMA(1, 0, At, B0); PG8_BAR; PG8_SCHED;
            PG8_STAGE(PG8_SB(0, 1), b2 + hstep, voffB);
            PG8_WAIT_V(6); PG8_BAR; PG8_MMA(1, 1, At, B1); PG8_BAR;
            PG8_LDB(B0, 1, 0); PG8_SCHED; PG8_LDA(At, 1, 0); PG8_STAGE(PG8_SA(0, 1), a2 + hstep, voffA);
            PG8_WAIT_L(8); PG8_BAR; PG8_WAIT_L(0); PG8_MMA(0, 0, At, B0); PG8_BAR; PG8_SCHED;
            PG8_LDB(B1, 1, 1); PG8_STAGE(PG8_SB(1, 0), b3, voffB);
            PG8_BAR; PG8_WAIT_L(0); PG8_MMA(0, 1, At, B1); PG8_BAR;
            PG8_LDA(At, 1, 1); PG8_STAGE(PG8_SA(1, 0), a3, voffA);
            PG8_BAR; PG8_WAIT_L(0); PG8_MMA(1, 0, At, B0); PG8_BAR; PG8_SCHED;
            PG8_STAGE(PG8_SB(1, 1), b3 + hstep, voffB);
            PG8_WAIT_V(6); PG8_BAR; PG8_MMA(1, 1, At, B1); PG8_BAR;
        }
        if constexpr (!Epi::AFTER_DRAIN) { E(acc, cur, wr, wc, fr, fq); S.done(cur); }
        if (!has_next) break;
#pragma unroll
        for (int a = 0; a < 2; ++a)
#pragma unroll
            for (int b = 0; b < 2; ++b)
#pragma unroll
                for (int m = 0; m < 4; ++m)
#pragma unroll
                    for (int n = 0; n < 2; ++n) acc[a][b][m][n] = (f32x4){0.f, 0.f, 0.f, 0.f};
        cur = nxt; cA = nA; cB = nB; ++ui;
    }
    PG8_WAIT_V(0);
    if (wr == 0) PG8_BAR;
    PG8_BAR;
    if constexpr (Epi::AFTER_DRAIN) { E.fused(acc, cur, wr, wc, fr, fq, lds, wid, lane); S.done(cur); }
#undef PG8_SA
#undef PG8_SB
#undef PG8_STAGE
#undef PG8_LDA
#undef PG8_LDB
#undef PG8_MMA
#undef PG8_WAIT_V
#undef PG8_WAIT_L
#undef PG8_BAR
#undef PG8_SCHED
}
}


__device__ __forceinline__ unsigned ordered_key(float f) { const unsigned u = __float_as_uint(f); return (u & 0x80000000u) ? ~u : (u | 0x80000000u); }
__device__ __forceinline__ void indexer_unit(const bf16_t* __restrict__ zb, unsigned* __restrict__ maskp, unsigned* sc  , unsigned* hist  ,
                                             const int b, const int t0, const int tid) {
    const int lane = tid & 63, wave = tid >> 6;
    const int r31 = lane & 31, hh = lane >> 5;
    {
        const int g = wave & 3, par = wave >> 2;
        const int head = (r31 & 3) + 4 * ((r31 >> 3) & 1), ql = 2 * ((r31 >> 4) & 1) + ((r31 >> 2) & 1);
        const bf16_t* ap = zb + (size_t)(b * SEQ + t0 + 4 * g + ql) * ZLD + C_IQ + head * 64 + 8 * hh;
        bf16x8 a[4];
#pragma unroll
        for (int s4 = 0; s4 < 4; ++s4) a[s4] = *(const bf16x8*)(ap + 16 * s4);
        float wq[16];
        {
            const int qa = t0 + 4 * g + hh, qb = qa + 2;
            f32x4 w0, w1, w2, w3; pg8::bf8_to_f32(*(const u32x4*)(zb + (size_t)(b * SEQ + qa) * ZLD + C_IW), w0, w1); pg8::bf8_to_f32(*(const u32x4*)(zb + (size_t)(b * SEQ + qb) * ZLD + C_IW), w2, w3);
#pragma unroll
            for (int i = 0; i < 4; ++i) { wq[i] = w0[i] * 0.04419417382415922f; wq[4 + i] = w1[i] * 0.04419417382415922f; wq[8 + i] = w2[i] * 0.04419417382415922f; wq[12 + i] = w3[i] * 0.04419417382415922f; }
        }
        const int ta = t0 + 4 * g + hh, tb_ = ta + 2;
        const int kt_max = (t0 + 15) >> 5;
        const bf16_t* kp = zb + (size_t)(b * SEQ + r31) * ZLD + C_IK + 8 * hh;
        for (int kt = par; kt <= kt_max; kt += 2) {
            bf16x8 bk[4];
#pragma unroll
            for (int s4 = 0; s4 < 4; ++s4) bk[s4] = *(const bf16x8*)(kp + (size_t)kt * 32 * ZLD + 16 * s4);
            f32x16 acc;
#pragma unroll
            for (int q = 0; q < 16; ++q) acc[q] = 0.f;
#pragma unroll
            for (int s4 = 0; s4 < 4; ++s4) acc = __builtin_amdgcn_mfma_f32_32x32x16_bf16(a[s4], bk[s4], acc, 0, 0, 0);
            float sa = 0.f, sb = 0.f;
#pragma unroll
            for (int i = 0; i < 8; ++i) { sa += wq[i] * fmaxf(acc[i], 0.f); sb += wq[8 + i] * fmaxf(acc[8 + i], 0.f); }
            const int key = kt * 32 + r31;
            sc[(4 * g + hh) * 2048 + key] = key <= ta ? ordered_key(sa) : 0u;
            sc[(4 * g + 2 + hh) * 2048 + key] = key <= tb_ ? ordered_key(sb) : 0u;
        }
    }
    __syncthreads();
    for (int qq = 2 * wave; qq < 2 * wave + 2; ++qq) {
        const int t = t0 + qq;
        unsigned kreg[32];
#pragma unroll
        for (int i = 0; i < 32; ++i) { const int p = lane + 64 * i; kreg[i] = (p <= t) ? sc[qq * 2048 + p] : 0u; }
        unsigned prefix = 0u, mhi = 0u; int kk = 256;
#pragma unroll
        for (int pass = 3; pass >= 0; --pass) {
            const int shift = 8 * pass;
#pragma unroll
            for (int j = 0; j < 4; ++j) hist[lane * 4 + j] = 0u;
            asm volatile("s_waitcnt lgkmcnt(0)" ::: "memory");
#pragma unroll
            for (int i = 0; i < 32; ++i) { if ((kreg[i] & mhi) == prefix) atomicAdd(&hist[(kreg[i] >> shift) & 255u], 1u); }
            asm volatile("s_waitcnt lgkmcnt(0)" ::: "memory");
            const unsigned h0 = hist[lane * 4], h1 = hist[lane * 4 + 1], h2 = hist[lane * 4 + 2], h3 = hist[lane * 4 + 3];
            const int c4 = (int)(h0 + h1 + h2 + h3);
            int suf = c4;
#pragma unroll
            for (int o = 1; o < 64; o <<= 1) { const int v = __shfl_down(suf, o); if (lane + o < 64) suf += v; }
            const unsigned long long bal = __ballot(suf >= kk);
            const int L = 63 - __builtin_clzll(bal);
            int d = 0, kn = 0;
            {
                int cum = suf - c4;
                if (cum + (int)h3 >= kk) { d = 3; kn = kk - cum; } else { cum += (int)h3;
                if (cum + (int)h2 >= kk) { d = 2; kn = kk - cum; } else { cum += (int)h2;
                if (cum + (int)h1 >= kk) { d = 1; kn = kk - cum; } else { cum += (int)h1; d = 0; kn = kk - cum; } } }
            }
            d = __builtin_amdgcn_readlane(d, L); kn = __builtin_amdgcn_readlane(kn, L);
            prefix |= (unsigned)(4 * L + d) << shift; mhi |= 0xffu << shift; kk = kn;
        }
        unsigned myword = 0u; int eqbefore = 0;
#pragma unroll
        for (int i = 0; i < 32; ++i) {
            const bool eq = kreg[i] == prefix;
            const unsigned long long beq = __ballot(eq);
            const int rank = eqbefore + __popcll(beq & ((1ull << lane) - 1ull));
            const bool sel = kreg[i] > prefix || (eq && rank < kk);
            const unsigned long long bs = __ballot(sel);
            eqbefore += __popcll(beq);
            if (lane == 2 * i) myword = (unsigned)bs;
            if (lane == 2 * i + 1) myword = (unsigned)(bs >> 32);
        }
        maskp[(size_t)(b * SEQ + t) * 64 + lane] = myword;
    }
    __syncthreads();
}

__device__ __forceinline__ void attn_wave(const bf16_t* __restrict__ zb, const bf16_t* __restrict__ vbt, const unsigned* __restrict__ maskp, bf16_t* __restrict__ att, const float* tb  ,
                                          const int b, const int t0w, const int lane) {
    const int c = lane & 31, hh = lane >> 5, h = c & 7;
    const int tq = t0w + (c >> 3);
    const size_t rowq = (size_t)b * SEQ + tq;
    bf16x8 bq[4];
#pragma unroll
    for (int s4 = 0; s4 < 4; ++s4) bq[s4] = *(const bf16x8*)(zb + rowq * ZLD + C_QB + h * 64 + 16 * s4 + 8 * hh);
    const int kt_max = (t0w + 3) >> 5;
    const float bfar = tb[127 * 8 + h];
    const float LOG2E = 1.4426950408889634f;
    float m = -1e30f, lsum = 0.f;
    f32x16 O0, O1;
#pragma unroll
    for (int q = 0; q < 16; ++q) { O0[q] = 0.f; O1[q] = 0.f; }
    const bf16_t* kbase = zb + ((size_t)b * SEQ + c) * ZLD + C_KB + 8 * hh;
    const bf16_t* vbase = vbt + ((size_t)b * 64 + c) * SEQ + 4 * hh;
    const unsigned* mbase = maskp + rowq * 64;
    typedef unsigned long long u64;
    bf16x8 ak[4]; u64 av[2][2][2]; unsigned mw;
#pragma unroll
    for (int s4 = 0; s4 < 4; ++s4) ak[s4] = *(const bf16x8*)(kbase + 16 * s4);
#pragma unroll
    for (int mt = 0; mt < 2; ++mt)
#pragma unroll
        for (int s2 = 0; s2 < 2; ++s2) { av[mt][s2][0] = *(const u64*)(vbase + (size_t)mt * 32 * SEQ + 16 * s2); av[mt][s2][1] = *(const u64*)(vbase + (size_t)mt * 32 * SEQ + 16 * s2 + 8); }
    mw = mbase[0];
    for (int kt = 0; kt <= kt_max; ++kt) {
        const int key0 = kt * 32;
        bf16x8 cak[4]; u64 cav[2][2][2]; const unsigned cmw = mw >> (4 * hh);
#pragma unroll
        for (int s4 = 0; s4 < 4; ++s4) cak[s4] = ak[s4];
#pragma unroll
        for (int mt = 0; mt < 2; ++mt)
#pragma unroll
            for (int s2 = 0; s2 < 2; ++s2) { cav[mt][s2][0] = av[mt][s2][0]; cav[mt][s2][1] = av[mt][s2][1]; }
        {
            const int kn = kt < kt_max ? kt + 1 : kt;
#pragma unroll
            for (int s4 = 0; s4 < 4; ++s4) ak[s4] = *(const bf16x8*)(kbase + (size_t)kn * 32 * ZLD + 16 * s4);
#pragma unroll
            for (int mt = 0; mt < 2; ++mt)
#pragma unroll
                for (int s2 = 0; s2 < 2; ++s2) { av[mt][s2][0] = *(const u64*)(vbase + (size_t)mt * 32 * SEQ + kn * 32 + 16 * s2); av[mt][s2][1] = *(const u64*)(vbase + (size_t)mt * 32 * SEQ + kn * 32 + 16 * s2 + 8); }
            mw = mbase[kn];
        }
        f32x16 S;
#pragma unroll
        for (int q = 0; q < 16; ++q) S[q] = 0.f;
#pragma unroll
        for (int s4 = 0; s4 < 4; ++s4) S = __builtin_amdgcn_mfma_f32_32x32x16_bf16(cak[s4], bq[s4], S, 0, 0, 0);
        const bool nearb = (t0w - key0 - 31) < 113;
        float x[16]; float tmax = -1e30f;
        const int relb = tq - key0 - 4 * hh;
#pragma unroll
        for (int i = 0; i < 16; ++i) {
            const int ko = (i & 3) + 8 * (i >> 2);
            float bias = bfar;
            if (nearb) { int rel = relb - ko; rel = rel < 0 ? 0 : (rel > 127 ? 127 : rel); bias = tb[rel * 8 + h]; }
            x[i] = S[i] * 0.125f + bias;
            if ((cmw >> ko) & 1u) tmax = fmaxf(tmax, x[i]);
        }
        tmax = fmaxf(tmax, __shfl_xor(tmax, 32));
        const float mn = fmaxf(m, tmax);
        if (__ballot(mn > m) != 0ull) {
            const float scl = __builtin_amdgcn_exp2f((m - mn) * LOG2E);
            lsum *= scl;
#pragma unroll
            for (int q = 0; q < 16; ++q) { O0[q] *= scl; O1[q] *= scl; }
        }
        m = mn;
        float p[16];
#pragma unroll
        for (int i = 0; i < 16; ++i) { const int ko = (i & 3) + 8 * (i >> 2); p[i] = ((cmw >> ko) & 1u) ? __builtin_amdgcn_exp2f((x[i] - m) * LOG2E) : 0.f; lsum += p[i]; }
        union { unsigned u[4]; bf16x8 v; } pb0, pb1;
#pragma unroll
        for (int j = 0; j < 4; ++j) { pb0.u[j] = pg8::cvt_pk_bf16(p[2 * j], p[2 * j + 1]); pb1.u[j] = pg8::cvt_pk_bf16(p[8 + 2 * j], p[8 + 2 * j + 1]); }
        union { u64 q[2]; bf16x8 v; } a00, a01, a10, a11;
        a00.q[0] = cav[0][0][0]; a00.q[1] = cav[0][0][1]; a01.q[0] = cav[0][1][0]; a01.q[1] = cav[0][1][1];
        a10.q[0] = cav[1][0][0]; a10.q[1] = cav[1][0][1]; a11.q[0] = cav[1][1][0]; a11.q[1] = cav[1][1][1];
        O0 = __builtin_amdgcn_mfma_f32_32x32x16_bf16(a00.v, pb0.v, O0, 0, 0, 0);
        O0 = __builtin_amdgcn_mfma_f32_32x32x16_bf16(a01.v, pb1.v, O0, 0, 0, 0);
        O1 = __builtin_amdgcn_mfma_f32_32x32x16_bf16(a10.v, pb0.v, O1, 0, 0, 0);
        O1 = __builtin_amdgcn_mfma_f32_32x32x16_bf16(a11.v, pb1.v, O1, 0, 0, 0);
    }
    lsum += __shfl_xor(lsum, 32);
    const float inv = 1.0f / lsum;
    bf16_t* op = att + rowq * 512 + h * 64 + 4 * hh;
#pragma unroll
    for (int g4 = 0; g4 < 4; ++g4) {
        unsigned w0 = pg8::cvt_pk_bf16(O0[4 * g4] * inv, O0[4 * g4 + 1] * inv), w1 = pg8::cvt_pk_bf16(O0[4 * g4 + 2] * inv, O0[4 * g4 + 3] * inv);
        *(u64*)(op + 8 * g4) = (u64)w0 | ((u64)w1 << 32);
        w0 = pg8::cvt_pk_bf16(O1[4 * g4] * inv, O1[4 * g4 + 1] * inv); w1 = pg8::cvt_pk_bf16(O1[4 * g4 + 2] * inv, O1[4 * g4 + 3] * inv);
        *(u64*)(op + 32 + 8 * g4) = (u64)w0 | ((u64)w1 << 32);
    }
}

template <int KIND> __global__ void __launch_bounds__(NTHREADS, 2) fwd(Args args) {
    extern __shared__ __attribute__((aligned(16))) unsigned char lds[];
    const int tid = threadIdx.x, lane = tid & 63, wave = tid >> 6;
    const int G = gridDim.x;
    PG8_LAS unsigned char* const lds3 = (PG8_LAS unsigned char*)lds;
#define WS_OPAQUE() unsigned char* ws = args.ws; asm volatile("" : "+s"(ws)); int tid = threadIdx.x; asm volatile("" : "+v"(tid)); const int lane = tid & 63, wave = tid >> 6; (void)lane; (void)wave
#define ctl ((unsigned*)(ws + WS_CTL))
#define MOD ((float*)(ws + WS_MOD))
#define LB ((float*)(ws + WS_LB))
#define WIN ((bf16_t*)(ws + WS_WIN))
#define WPA ((bf16_t*)(ws + WS_WPA))
#define WPB ((bf16_t*)(ws + WS_WPB))
#define WOUT ((bf16_t*)(ws + WS_WOUT))
#define W1 ((bf16_t*)(ws + WS_W1))
#define W2 ((bf16_t*)(ws + WS_W2))
#define H ((bf16_t*)(ws + WS_H))
#define ZB ((bf16_t*)(ws + WS_Z))
#define VBT ((bf16_t*)(ws + WS_VBT))
#define Y ((bf16_t*)(ws + WS_Y))
#define XS ((bf16_t*)(ws + WS_XS))
#define ACT ((bf16_t*)(ws + WS_ACT))
#define ORAW ((float*)(ws + WS_ORAW))
#define TMP ((float*)(ws + WS_TMP))
#define HA ((bf16_t*)(ws + WS_HA))
#define ATT ((bf16_t*)(ws + WS_ATT))
#define MASK ((unsigned*)(ws + WS_MASK))
#define MERGED ((bf16_t*)(ws + WS_MERGED))
#define X1 ((float*)(ws + WS_X1))
#define X2 ((float*)(ws + WS_X2))
#define TOKE ((int*)(ws + WS_TOKE))
#define TOKG ((float*)(ws + WS_TOKG))
#define TOKP ((int*)(ws + WS_TOKP))
#define TOKS ((int*)(ws + WS_TOKS))
#define BLKE ((int*)(ws + WS_BLKE))
    const int lo = args.ph_lo, hi = args.ph_hi;
#define IN(k) ((KIND < 0 || ((k) == 0 ? KIND == 100 : KIND == ((k) - 1) % 11)) && lo <= (k) && (k) < hi)
#define SEAM(k) do { if (KIND < 0 && IN(k) && IN((k) + 1)) xcd_barrier(bar); } while (0)
    XcdBarrier bar; bar.bar = (unsigned*)(args.ws + WS_CTL) + CW_BAR; bar.x = 0; bar.st = nullptr;
    if (KIND < 0) {
        volatile LAS unsigned* xbw = (volatile LAS unsigned*)((LAS unsigned char*)lds + (LDS_BYTES - 16));
        if (tid == 0) { xbw[0] = 0u; xbw[1] = 0u; xbw[2] = 0u; xbw[3] = 0u; }
        __syncthreads();
        bar = xcd_barrier_post((unsigned*)(args.ws + WS_CTL) + CW_BAR, xbw);
    }

    if (IN(0)) {
        WS_OPAQUE();
        float* lt = (float*)lds;
        cvt_family(tid, args.in[I_WIN], WIN, D, ZC, ZLD, DEPTH, 0, lt);
        cvt_family(tid, args.in[I_WPA], WPA, 512, D, D, DEPTH, 0, lt);
        cvt_family(tid, args.in[I_WPB], WPB, 512, D, D, DEPTH, 0, lt);
        cvt_family(tid, args.in[I_WOUT], WOUT, D, D, D, DEPTH, 0, lt);
        cvt_family(tid, args.in[I_W1], W1, D, 2 * DFF, 2 * DFF, DEPTH * NE, 1, lt);
        cvt_family(tid, args.in[I_W2], W2, DFF, D, D, DEPTH * NE, 0, lt);
        {
            float* ca = (float*)lds;
            __syncthreads();
            for (int i = tid; i < NB * D; i += NTHREADS) { const float c = args.in[I_C][i]; ca[i] = c * sigmoidf_(c); }
            __syncthreads();
            for (int u = blockIdx.x; u < DEPTH * NMOD / NTHREADS; u += G) {
                const int ln = u * NTHREADS + tid, l = ln / NMOD, n = ln % NMOD;
                const float* w = args.in[I_WADA] + (size_t)l * D * NMOD + n;
                float acc[NB];
#pragma unroll
                for (int b = 0; b < NB; ++b) acc[b] = 0.f;
                for (int k = 0; k < D; ++k) { const float wv = w[(size_t)k * NMOD];
#pragma unroll
                    for (int b = 0; b < NB; ++b) acc[b] += ca[b * D + k] * wv; }
                const float bb = args.in[I_BADA][(size_t)l * NMOD + n];
#pragma unroll
                for (int b = 0; b < NB; ++b) MOD[((size_t)l * NB + b) * NMOD + n] = acc[b] + bb;
            }
            __syncthreads();
        }
        if (blockIdx.x == G - 1) {
            for (int j = tid; j < 512; j += NTHREADS) { const float a0 = args.in[I_LBL][j], a1 = args.in[I_LBL][512 + j]; LB[j] = 0.f; LB[512 + j] = 1.0f / (1.0f + __expf(a0 - a1)); }
        }
    }

    SEAM(0);
#pragma unroll
    for (int l = 0; l < DEPTH; ++l) {
        const int P = 1 + 11 * l;
#define mod (MOD + (size_t)l * NB * NMOD)
#define xin ((l == 0) ? args.in[I_X] : (const float*)X2)
        if (IN(P + 0) && l == 0) {
            WS_OPAQUE();
            const float* nw = args.in[I_NMW] + (size_t)l * D;
            for (int row = blockIdx.x * NWAVES + wave; row < T; row += G * NWAVES) {
                const int b = row >> 11; f32x4 v[4]; float ss = 0.f;
#pragma unroll
                for (int i = 0; i < 4; ++i) { v[i] = *(const f32x4*)(xin + (size_t)row * D + (lane + 64 * i) * 4); ss += v[i][0] * v[i][0] + v[i][1] * v[i][1] + v[i][2] * v[i][2] + v[i][3] * v[i][3]; }
                ss = wave_sum(ss); const float r = rsqrtf(ss * (1.0f / D) + EPS);
#pragma unroll
                for (int i = 0; i < 4; ++i) { const int c = (lane + 64 * i) * 4;
#pragma unroll
                    for (int j = 0; j < 4; ++j) H[(size_t)row * D + c + j] = f2bf(v[i][j] * r * nw[c + j] * (1.0f + mod[(size_t)b * NMOD + D + c + j]) + mod[(size_t)b * NMOD + c + j]); }
            }
        }
        if (l == 0) SEAM(P + 0);
        if (IN(P + 1)) {
            WS_OPAQUE();
            pg8::Gemm g{H, WIN + (size_t)l * ZLD * D, T, ZLD, D}; pg8::StaticOrder S; S.init(T, ZLD, G, (int)blockIdx.x);
            pg8::EpiZ E{ZB, ZLD};
            pg8::gemm_phase(lds3, tid, g, S, E);
        }
        SEAM(P + 1);
        if (IN(P + 2)) {
            WS_OPAQUE();
            {
                float* qs = (float*)lds; float* fs = qs + 32 * 128; float* ks = fs + 32 * 128; float* op = ks + 32 * 128;
                const int dv = tid & 127, dkq = tid >> 7;
                for (int u = blockIdx.x; u < NB * 4; u += G) {
                    const int b = u >> 2, h = u & 3;
                    float S[32];
#pragma unroll
                    for (int i = 0; i < 32; ++i) S[i] = 0.f;
                    for (int c = 0; c < SEQ / 32; ++c) {
                        const int row0 = b * SEQ + c * 32;
                        for (int e = tid; e < 4096; e += NTHREADS) { const int tt = e >> 7, d = e & 127;
                            const float za = bf2f(ZB[(size_t)(row0 + tt) * ZLD + C_QA + h * 128 + d]), zf = bf2f(ZB[(size_t)(row0 + tt) * ZLD + C_FA + h * 128 + d]);
                            const float lb = LB[l * 512 + h * 128 + d];
                            const float sg = sigmoidf_(zf);
                            qs[e] = za * sigmoidf_(za); fs[e] = lb + (1.0f - lb) * sg; ks[e] = (1.0f - lb) * (1.0f / (1.0f + __expf(zf))); }
                        __syncthreads();
                        for (int tt = 0; tt < 32; ++tt) {
                            const float v = bf2f(ZB[(size_t)(row0 + tt) * ZLD + C_IA + h * 128 + dv]); float o = 0.f;
#pragma unroll
                            for (int i = 0; i < 32; ++i) { S[i] = fs[tt * 128 + 32 * dkq + i] * S[i] + ks[tt * 128 + 32 * dkq + i] * v; o += qs[tt * 128 + 32 * dkq + i] * S[i]; }
                            op[(tt * 4 + dkq) * 128 + dv] = o;
                        }
                        __syncthreads();
                        for (int e = tid; e < 4096; e += NTHREADS) { const int tt = e >> 7, d = e & 127;
                            ORAW[(size_t)(row0 + tt) * 512 + h * 128 + d] = (op[(tt * 4 + 0) * 128 + d] + op[(tt * 4 + 1) * 128 + d]) + (op[(tt * 4 + 2) * 128 + d] + op[(tt * 4 + 3) * 128 + d]); }
                        __syncthreads();
                    }
                }
            }
            {
                for (int wt = blockIdx.x * NWAVES + wave; wt < (T / 64) * 8; wt += G * NWAVES) {
                    const int rg = wt >> 3, dg = wt & 7; const int row = rg * 64 + lane, bb = row >> 11, sidx = row & 2047;
                    const u32x4 w = *(const u32x4*)(ZB + (size_t)row * ZLD + C_VB + dg * 8);
                    bf16_t* vp = VBT + ((size_t)bb * 64 + dg * 8) * SEQ + sidx;
                    vp[0] = (bf16_t)(w.x & 0xffffu); vp[SEQ] = (bf16_t)(w.x >> 16); vp[2 * SEQ] = (bf16_t)(w.y & 0xffffu); vp[3 * SEQ] = (bf16_t)(w.y >> 16);
                    vp[4 * SEQ] = (bf16_t)(w.z & 0xffffu); vp[5 * SEQ] = (bf16_t)(w.z >> 16); vp[6 * SEQ] = (bf16_t)(w.w & 0xffffu); vp[7 * SEQ] = (bf16_t)(w.w >> 16);
                }
            }
            {
                unsigned* sc = (unsigned*)lds; unsigned* hist = sc + 16 * 2048 + wave * 256;
                __syncthreads();
                for (int u = blockIdx.x; u < T / 16; u += G) {
                    const int cc = u & 255, j = u >> 8; const int b = cc & 15, x = cc >> 4, pr = x + 16 * (j >> 1); const int q16 = (j & 1) ? 127 - pr : pr; const int t0 = q16 * 16;
                    if (t0 < 256) {
                        for (int i = tid; i < 16 * 64; i += NTHREADS) { const int qq = i >> 6, w = i & 63, n = t0 + qq + 1, lo_ = w * 32;
                            unsigned mm = 0u; if (n >= lo_ + 32) mm = 0xffffffffu; else if (n > lo_) mm = (1u << (n - lo_)) - 1u; MASK[(size_t)(b * SEQ + t0 + qq) * 64 + w] = mm; }
                    } else indexer_unit(ZB, MASK, sc, hist, b, t0, tid);
                }
                __syncthreads();
            }
        }
        SEAM(P + 2);
        if (IN(P + 3)) {
            WS_OPAQUE();
            const float* hnw = args.in[I_HNW] + (size_t)l * 512;
            for (int row = blockIdx.x * NWAVES + wave; row < T; row += G * NWAVES) {
                const int c0 = lane * 8; float o[8]; float ss = 0.f;
#pragma unroll
                for (int j = 0; j < 8; ++j) { o[j] = ORAW[(size_t)row * 512 + c0 + j]; ss += o[j] * o[j]; }
                ss += __shfl_xor(ss, 1); ss += __shfl_xor(ss, 2); ss += __shfl_xor(ss, 4); ss += __shfl_xor(ss, 8);
                const float r = rsqrtf(ss * (1.0f / 128.0f) + EPS);
#pragma unroll
                for (int j = 0; j < 8; ++j) { const float g = bf2f(ZB[(size_t)row * ZLD + C_GA + c0 + j]); HA[(size_t)row * 512 + c0 + j] = f2bf(o[j] * r * hnw[c0 + j] * (g * sigmoidf_(g))); }
            }
            {
                float* tb = (float*)lds;
                __syncthreads();
                for (int i = tid; i < 1024; i += NTHREADS) tb[i] = args.in[I_RELB][(int)T5_BUCKET[i >> 3] * 8 + (i & 7)];
                __syncthreads();
                for (int u = blockIdx.x; u < T / 32; u += G) {
                    const int cc = u & 255, j = u >> 8; const int b = cc & 15, x = cc >> 4, pr = x + 16 * (j >> 1); const int qt = (j & 1) ? 63 - pr : pr;
                    attn_wave(ZB, VBT, MASK, ATT, tb, b, qt * 32 + 4 * wave, lane);
                }
                __syncthreads();
            }
        }
        SEAM(P + 3);
        if (IN(P + 4)) {
            WS_OPAQUE();
            pg8::StaticOrder S; S.init(T, D, G, (int)blockIdx.x);
            { pg8::Gemm g{HA, WPA + (size_t)l * D * 512, T, D, 512}; pg8::EpiMerge<false> E{TMP, MERGED, ZB + C_GTA}; pg8::gemm_phase(lds3, tid, g, S, E); }
            { pg8::Gemm g{ATT, WPB + (size_t)l * D * 512, T, D, 512}; pg8::EpiMerge<true> E{TMP, MERGED, ZB + C_GTB}; pg8::gemm_phase(lds3, tid, g, S, E); }
        }
        SEAM(P + 4);
        if (IN(P + 5)) {
            WS_OPAQUE();
            pg8::Gemm g{MERGED, WOUT + (size_t)l * D * D, T, D, D}; pg8::StaticOrder S; S.init(T, D, G, (int)blockIdx.x);
            pg8::EpiOutG E{xin, X1, mod + 2 * D}; pg8::gemm_phase(lds3, tid, g, S, E);
        }
        SEAM(P + 5);
        if (IN(P + 6)) {
            WS_OPAQUE();
            const float* nw = args.in[I_NFW] + (size_t)l * D; const float* wr = args.in[I_WR] + (size_t)l * D * NE; const float* br = args.in[I_BR] + (size_t)l * NE;
            float* hrow = (float*)lds + wave * D;
            for (int tok = blockIdx.x * NWAVES + wave; tok < T; tok += G * NWAVES) {
                const int b = tok >> 11; f32x4 v[4]; float ss = 0.f;
#pragma unroll
                for (int i = 0; i < 4; ++i) { v[i] = *(const f32x4*)(X1 + (size_t)tok * D + (lane + 64 * i) * 4); ss += v[i][0] * v[i][0] + v[i][1] * v[i][1] + v[i][2] * v[i][2] + v[i][3] * v[i][3]; }
                ss = wave_sum(ss); const float r = rsqrtf(ss * (1.0f / D) + EPS);
                __syncthreads();
#pragma unroll
                for (int i = 0; i < 4; ++i) { const int c = (lane + 64 * i) * 4;
#pragma unroll
                    for (int j = 0; j < 4; ++j) { const float hv = v[i][j] * r * nw[c + j] * (1.0f + mod[(size_t)b * NMOD + 4 * D + c + j]) + mod[(size_t)b * NMOD + 3 * D + c + j]; hrow[c + j] = hv; H[(size_t)tok * D + c + j] = f2bf(hv); } }
                __syncthreads();
                const int e = lane & 31, half = lane >> 5; float acc = 0.f;
                for (int k = half * 512; k < half * 512 + 512; ++k) acc += hrow[k] * wr[(size_t)k * NE + e];
                acc += __shfl_xor(acc, 32);
                float logit = acc + br[e];
                float tv[4]; int ti[4];
#pragma unroll
                for (int k = 0; k < 4; ++k) {
                    float bv = logit; int bi = e;
#pragma unroll
                    for (int o = 16; o >= 1; o >>= 1) { const float ov = __shfl_xor(bv, o); const int oi = __shfl_xor(bi, o); if (ov > bv || (ov == bv && oi < bi)) { bv = ov; bi = oi; } }
                    tv[k] = bv; ti[k] = bi; if (e == bi) logit = -INFINITY;
                }
                const float e1 = __expf(tv[1] - tv[0]), e2 = __expf(tv[2] - tv[0]), e3 = __expf(tv[3] - tv[0]); const float inv = 1.0f / (1.0f + e1 + e2 + e3);
                if (lane < 4) { const int ee = lane == 0 ? ti[0] : lane == 1 ? ti[1] : lane == 2 ? ti[2] : ti[3]; const float gg = (lane == 0 ? 1.0f : lane == 1 ? e1 : lane == 2 ? e2 : e3) * inv;
                    TOKE[tok * 4 + lane] = ee; TOKG[tok * 4 + lane] = gg; TOKP[tok * 4 + lane] = (int)atomicAdd(&ctl[CW_CNT + l * 32 + ee], 1u); }
            }
        }
        SEAM(P + 6);
        if (IN(P + 7)) {
            WS_OPAQUE();
            int* ps = (int*)lds;
            __syncthreads();
            if (tid == 0) { int a = 0; for (int e = 0; e < NE; ++e) { ps[e] = a; a += (int)((ctl[CW_CNT + l * 32 + e] + 255u) / 256u) * 256; } ps[NE] = a; }
            __syncthreads();
            const int gt = blockIdx.x * NTHREADS + tid, gn = G * NTHREADS;
            for (int tok = blockIdx.x * NWAVES + wave; tok < T; tok += G * NWAVES) {
                const u32x4 r0 = *(const u32x4*)(H + (size_t)tok * D + lane * 8), r1 = *(const u32x4*)(H + (size_t)tok * D + 512 + lane * 8);
#pragma unroll
                for (int k = 0; k < 4; ++k) { const int e = TOKE[tok * 4 + k]; const int slot = ps[e] + TOKP[tok * 4 + k]; if (lane == 0) TOKS[tok * 4 + k] = slot;
                    *(u32x4*)(XS + (size_t)slot * D + lane * 8) = r0; *(u32x4*)(XS + (size_t)slot * D + 512 + lane * 8) = r1; }
            }
            for (int i = blockIdx.x * NWAVES + wave; i < NE * 256; i += G * NWAVES) {
                const int e = i >> 8, j = i & 255; const int c = (int)ctl[CW_CNT + l * 32 + e]; const int si = c + j;
                if (si < ps[e + 1] - ps[e]) { const u32x4 z = {0u, 0u, 0u, 0u}; *(u32x4*)(XS + (size_t)(ps[e] + si) * D + lane * 8) = z; *(u32x4*)(XS + (size_t)(ps[e] + si) * D + 512 + lane * 8) = z; } }
            const int nblk = ps[NE] / 256, nblk8 = (nblk + 7) & ~7;
            for (int mb = gt; mb < nblk8; mb += gn) { int e = 0; if (mb < nblk) { while (e < NE - 1 && mb * 256 >= ps[e + 1]) ++e; } BLKE[mb] = e; }
            if (gt == 0) ctl[CW_NBLK + l] = (unsigned)nblk8;
            __syncthreads();
        }
        SEAM(P + 7);
        if (IN(P + 8)) {
            WS_OPAQUE();
            const int nblk = __builtin_amdgcn_readfirstlane((int)ctl[CW_NBLK + l]);
            pg8::Gemm g{XS, W1 + (size_t)l * NE * 2 * DFF * D, nblk * 256, 2 * DFF, D}; pg8::MoeOrder<8> S; S.init(nblk, G, (int)blockIdx.x, BLKE);
            pg8::EpiSwigluG E{ACT, args.in[I_B1] + (size_t)l * NE * 2 * DFF}; pg8::gemm_phase(lds3, tid, g, S, E);
        }
        SEAM(P + 8);
        if (IN(P + 9)) {
            WS_OPAQUE();
            const int nblk = __builtin_amdgcn_readfirstlane((int)ctl[CW_NBLK + l]);
            pg8::Gemm g{ACT, W2 + (size_t)l * NE * D * DFF, nblk * 256, D, DFF}; pg8::MoeOrder<4> S; S.init(nblk, G, (int)blockIdx.x, BLKE);
            pg8::EpiYG E{Y, args.in[I_B2] + (size_t)l * NE * D}; pg8::gemm_phase(lds3, tid, g, S, E);
        }
        SEAM(P + 9);
        if (IN(P + 10)) {
            WS_OPAQUE();
            const bool last = (l == DEPTH - 1);
            const float* nw = last ? args.in[I_FNW] : args.in[I_NMW] + (size_t)(l + 1) * D;
            const float* modn = MOD + (size_t)(l + 1) * NB * NMOD;
            for (int tok = blockIdx.x * NWAVES + wave; tok < T; tok += G * NWAVES) {
                const int b = tok >> 11; f32x4 v[4], a[4];
#pragma unroll
                for (int i = 0; i < 4; ++i) { v[i] = *(const f32x4*)(X1 + (size_t)tok * D + (lane + 64 * i) * 4); a[i] = (f32x4){0.f, 0.f, 0.f, 0.f}; }
                for (int k = 0; k < 4; ++k) { const int slot = TOKS[tok * 4 + k]; const float g = TOKG[tok * 4 + k];
#pragma unroll
                    for (int i = 0; i < 4; ++i) { const unsigned* yp = (const unsigned*)(Y + (size_t)slot * D + (lane + 64 * i) * 4); const unsigned y0 = yp[0], y1 = yp[1];
                        f32x4 y; y[0] = __uint_as_float(y0 << 16); y[1] = __uint_as_float(y0 & 0xffff0000u); y[2] = __uint_as_float(y1 << 16); y[3] = __uint_as_float(y1 & 0xffff0000u); a[i] += g * y; } }
                float ss = 0.f;
#pragma unroll
                for (int i = 0; i < 4; ++i) { const int c = (lane + 64 * i) * 4; const f32x4 gf = *(const f32x4*)(mod + (size_t)b * NMOD + 5 * D + c); v[i] = v[i] + gf * a[i];
                    ss += v[i][0] * v[i][0] + v[i][1] * v[i][1] + v[i][2] * v[i][2] + v[i][3] * v[i][3]; }
                ss = wave_sum(ss); const float r = rsqrtf(ss * (1.0f / D) + EPS);
#pragma unroll
                for (int i = 0; i < 4; ++i) { const int c = (lane + 64 * i) * 4;
                    if (last) { f32x4 o;
#pragma unroll
                        for (int j = 0; j < 4; ++j) o[j] = v[i][j] * r * nw[c + j];
                        *(f32x4*)(args.out + (size_t)tok * D + c) = o;
                    } else {
                        *(f32x4*)(X2 + (size_t)tok * D + c) = v[i];
#pragma unroll
                        for (int j = 0; j < 4; ++j) H[(size_t)tok * D + c + j] = f2bf(v[i][j] * r * nw[c + j] * (1.0f + modn[(size_t)b * NMOD + D + c + j]) + modn[(size_t)b * NMOD + c + j]);
                    } }
            }
        }
        SEAM(P + 10);
    }
#undef IN
}

constexpr int N_PHASES = 1 + 11 * DEPTH;
typedef void (*kern_t)(Args);
template <int K> static kern_t kern_of() { return fwd<K>; }
static kern_t kern_for(int kind) {
    switch (kind) { case 0: return fwd<0>; case 1: return fwd<1>; case 2: return fwd<2>; case 3: return fwd<3>; case 4: return fwd<4>; case 5: return fwd<5>;
                    case 6: return fwd<6>; case 7: return fwd<7>; case 8: return fwd<8>; case 9: return fwd<9>; case 10: return fwd<10>; default: return fwd<100>; }
}

extern "C" void kernel_launch(void* const* d_in, const int* in_sizes, int n_in, void* d_out, int out_size, void* d_ws, size_t ws_size, hipStream_t stream) {
    static int grid = 0;
    if (grid == 0) {
        if (n_in != 20 || out_size != T * D || ws_size < WS_END) { fprintf(stderr, "kernel_launch: unexpected problem (n_in %d, out %d, ws %zu, need %zu)\n", n_in, out_size, ws_size, (size_t)WS_END); grid = -1; return; }
        int dev = 0, cus = 0;
        if (hipGetDevice(&dev) != hipSuccess || hipDeviceGetAttribute(&cus, hipDeviceAttributeMultiprocessorCount, dev) != hipSuccess) { grid = -1; return; }
        for (int k = 0; k <= 12; ++k) {
            if (hipFuncSetAttribute((const void*)(k == 12 ? (kern_t)fwd<-1> : kern_for(k)), hipFuncAttributeMaxDynamicSharedMemorySize, LDS_BYTES) != hipSuccess) { fprintf(stderr, "kernel_launch: hipFuncSetAttribute failed\n"); grid = -1; return; }
        }
        grid = cus > 0 ? cus : 256;
    }
    if (grid < 0) return;
    (void)hipMemsetAsync((char*)d_ws + WS_CTL, 0, CTL_BYTES, stream);
    Args a{};
    for (int i = 0; i < 20; ++i) a.in[i] = (const float*)d_in[i];
    a.out = (float*)d_out; a.ws = (unsigned char*)d_ws;
#if defined(MULTI_LAUNCH)
    for (int p = 0; p < N_PHASES; ++p) {
        if (p == 1 + 11) continue;
        a.ph_lo = p; a.ph_hi = p + 1;
        const int kind = p == 0 ? 11 : (p - 1) % 11;
        hipLaunchKernelGGL(kern_for(kind), dim3(grid), dim3(NTHREADS), LDS_BYTES, stream, a);
    }
#else
    a.ph_lo = 0; a.ph_hi = N_PHASES;
    hipLaunchKernelGGL(fwd<-1>, dim3(grid), dim3(NTHREADS), LDS_BYTES, stream, a);
#endif
}
```

```cpp
#include <hip/hip_runtime.h>
#include <stdint.h>
#include <stdio.h>

typedef unsigned short bf16_t;
typedef short bf16x8 __attribute__((ext_vector_type(8)));
typedef float f32x4 __attribute__((ext_vector_type(4)));
typedef float f32x16 __attribute__((ext_vector_type(16)));
typedef unsigned u32x4 __attribute__((ext_vector_type(4)));
#define LAS __attribute__((address_space(3)))

constexpr int T = 32768, D = 1024, NB = 16, SEQ = 2048, DEPTH = 2;
constexpr int ZC = 5320, ZLD = 5376;
constexpr int C_QA = 0, C_FA = 512, C_IA = 1024, C_GA = 1536, C_QB = 2048, C_KB = 2560, C_VB = 2624, C_IQ = 2688, C_IK = 3200, C_IW = 3264, C_GTA = 3272, C_GTB = 4296;
constexpr int NE = 32, DFF = 1024, NSLOT = 131072 + 32 * 256, NBLK_MAX = NSLOT / 256;
constexpr int NMOD = 6 * D;
constexpr float EPS = 1e-6f;
constexpr int NTHREADS = 512, NWAVES = 8;
constexpr int LDS_BYTES = 144 * 1024;

constexpr size_t al256(size_t x) { return (x + 255) & ~(size_t)255; }
constexpr size_t WS_CTL = 0;
constexpr size_t CTL_BYTES = 65536;
constexpr size_t WS_MOD = WS_CTL + CTL_BYTES;
constexpr size_t WS_LB = WS_MOD + al256((size_t)DEPTH * NB * NMOD * 4);
constexpr size_t WS_WIN = WS_LB + al256((size_t)DEPTH * 512 * 4);
constexpr size_t WS_WPA = WS_WIN + (size_t)DEPTH * ZLD * D * 2;
constexpr size_t WS_WPB = WS_WPA + (size_t)DEPTH * D * 512 * 2;
constexpr size_t WS_WOUT = WS_WPB + (size_t)DEPTH * D * 512 * 2;
constexpr size_t WS_W1 = WS_WOUT + (size_t)DEPTH * D * D * 2;
constexpr size_t WS_W2 = WS_W1 + (size_t)DEPTH * NE * 2 * DFF * D * 2;
constexpr size_t WS_H = WS_W2 + (size_t)DEPTH * NE * D * DFF * 2;
constexpr size_t WS_Z = WS_H + (size_t)T * D * 2;
constexpr size_t WS_Y = WS_Z;
constexpr size_t WS_ACT = WS_Z + (size_t)T * ZLD * 2;
constexpr size_t WS_ORAW = WS_ACT;
constexpr size_t WS_TMP = WS_ACT + (size_t)T * 512 * 4;
constexpr size_t WS_XS = WS_ACT + (size_t)NSLOT * DFF * 2;
constexpr size_t WS_HA = WS_XS + (size_t)NSLOT * D * 2;
constexpr size_t WS_ATT = WS_HA + (size_t)T * 512 * 2;
constexpr size_t WS_MASK = WS_ATT + (size_t)T * 512 * 2;
constexpr size_t WS_VBT = WS_MASK + (size_t)T * 64 * 4;
constexpr size_t WS_MERGED = WS_VBT + (size_t)T * 64 * 2;
constexpr size_t WS_X1 = WS_MERGED + (size_t)T * D * 2;
constexpr size_t WS_X2 = WS_X1 + (size_t)T * D * 4;
constexpr size_t WS_TOKE = WS_X2 + (size_t)T * D * 4;
constexpr size_t WS_TOKG = WS_TOKE + (size_t)T * 4 * 4;
constexpr size_t WS_TOKP = WS_TOKG + (size_t)T * 4 * 4;
constexpr size_t WS_TOKS = WS_TOKP + (size_t)T * 4 * 4;
constexpr size_t WS_BLKE = WS_TOKS + (size_t)T * 4 * 4;
constexpr size_t WS_END = WS_BLKE + al256((size_t)(NBLK_MAX + 64) * 4);
static_assert((size_t)NSLOT * D * 2 <= (size_t)T * ZLD * 2, "Y must fit in Z");
static_assert((size_t)T * 512 * 4 + (size_t)T * D * 4 <= (size_t)NSLOT * DFF * 2, "ORAW+TMP must fit in ACT");
static_assert(WS_END <= ((size_t)1 << 31), "workspace layout exceeds 2 GiB");
constexpr int CW_CNT = 1024;
constexpr int CW_NBLK = 1200;

__device__ __forceinline__ bf16_t f2bf(float f) { unsigned u = __float_as_uint(f); u += 0x7fffu + ((u >> 16) & 1u); return (bf16_t)(u >> 16); }
__device__ __forceinline__ float bf2f(bf16_t b) { return __uint_as_float(((unsigned)b) << 16); }
__device__ __forceinline__ float sigmoidf_(float x) { return 1.0f / (1.0f + __expf(-x)); }
__device__ __forceinline__ float wave_sum(float v) {
#pragma unroll
    for (int o = 32; o >= 1; o >>= 1) v += __shfl_xor(v, o);
    return v;
}
__device__ __forceinline__ int wave_sum_i(int v) {
#pragma unroll
    for (int o = 32; o >= 1; o >>= 1) v += __shfl_xor(v, o);
    return v;
}
__device__ const unsigned char T5_BUCKET[128] = {
    0, 1, 2, 3, 4, 5, 6, 7, 8, 9, 10, 11, 12, 13, 14, 15, 16, 16, 16, 17, 17, 18, 18, 18, 19, 19, 19, 20, 20, 20, 20, 21, 21, 21, 21, 22, 22, 22, 22, 22, 23, 23, 23, 23, 23, 23, 24, 24, 24, 24, 24, 24, 25,
    25, 25, 25, 25, 25, 25, 26, 26, 26, 26, 26, 26, 26, 26, 27, 27, 27, 27, 27, 27, 27, 27, 27, 27, 28, 28, 28, 28, 28, 28, 28, 28, 28, 28, 29, 29, 29, 29, 29, 29, 29, 29, 29, 29, 29, 29, 30, 30, 30, 30, 30,
    30, 30, 30, 30, 30, 30, 30, 30, 30, 31, 31, 31, 31, 31, 31, 31, 31, 31, 31, 31, 31, 31, 31, 31};
__device__ __forceinline__ int t5_bucket(int rel) { return rel >= 128 ? 31 : (int)T5_BUCKET[rel]; }


#define XB_TMO      128
#define XB_XCNT(j)  (256  + 64 * (j))
#define XB_XSUB(j)  (1280 + 64 * (j))
#define XB_XGEN(j)  (2304 + 64 * (j))
#define XB_TOP      3328
#define XB_TOPGEN   3392
#define XCD_BAR_WORDS 3456
#define XB_SPIN_CAP (1u << 18)
__device__ __forceinline__ unsigned xb_ld(unsigned* p)              { return __hip_atomic_load(p, __ATOMIC_RELAXED, __HIP_MEMORY_SCOPE_AGENT); }
__device__ __forceinline__ unsigned xb_add(unsigned* p, unsigned v) { return __hip_atomic_fetch_add(p, v, __ATOMIC_RELAXED, __HIP_MEMORY_SCOPE_AGENT); }
__device__ __forceinline__ unsigned xb_xcc_id() { return (unsigned)__builtin_amdgcn_s_getreg((3 << 11) | 20) & 0xFu; }
#define XB_SPIN(cond, bar) do { unsigned _sp = 0; while (cond) { __builtin_amdgcn_s_sleep(1); \
    if ((++_sp & 255u) == 0u) { if (xb_ld(&(bar)[XB_TMO])) break; if (_sp > XB_SPIN_CAP) { atomicAdd(&(bar)[XB_TMO], 1u); break; } } } } while (0)
struct XcdBarrier { unsigned* bar; unsigned x; volatile LAS unsigned* st; };
__device__ __forceinline__ XcdBarrier xcd_barrier_post(unsigned* bar, volatile LAS unsigned* st) {
    XcdBarrier b; b.bar = bar; b.x = xb_xcc_id(); b.st = st;
    if (threadIdx.x == 0) (void)xb_add(&bar[XB_XCNT(b.x)], 1u);
    return b;
}
__device__ __forceinline__ void xcd_barrier_complete(unsigned* bar, unsigned x, unsigned& nloc, unsigned& nx) {
    const unsigned G = gridDim.x * gridDim.y * gridDim.z;
    unsigned sum, cnt, mine, sp = 0u;
    for (;;) {
        sum = 0u; cnt = 0u; mine = 0u;
#pragma unroll
        for (unsigned j = 0; j < 16; ++j) { const unsigned c = xb_ld(&bar[XB_XCNT(j)]); sum += c; cnt += (c > 0u) ? 1u : 0u; mine = (j == x) ? c : mine; }
        if (sum == G) break;
        __builtin_amdgcn_s_sleep(1);
        if ((++sp & 255u) == 0u) { if (xb_ld(&bar[XB_TMO])) break; if (sp > XB_SPIN_CAP) { atomicAdd(&bar[XB_TMO], 1u); break; } }
    }
    nloc = mine > 0u ? mine : 1u; nx = cnt > 0u ? cnt : 1u;
}
__device__ __forceinline__ void xcd_barrier(const XcdBarrier& b) {
    asm volatile("s_waitcnt vmcnt(0)" ::: "memory");
    __syncthreads();
    if (threadIdx.x == 0) {
        unsigned* bar = b.bar; asm volatile("" : "+s"(bar));
        __builtin_amdgcn_s_waitcnt(0);
        unsigned nloc = b.st[0], nx = b.st[1];
        if (nloc == 0u) { xcd_barrier_complete(bar, b.x, nloc, nx); b.st[0] = nloc; b.st[1] = nx; }
        const unsigned old = xb_add(&bar[XB_XSUB(b.x)], 1u);
        const unsigned gen = old / nloc;
        if (old + 1u == (gen + 1u) * nloc) {
            __builtin_amdgcn_fence(__ATOMIC_RELEASE, "agent");
            asm volatile("s_waitcnt vmcnt(0)" ::: "memory");
            const unsigned og = xb_add(&bar[XB_TOP], 1u);
            const unsigned tg = og / nx;
            if (og + 1u == (tg + 1u) * nx) xb_add(&bar[XB_TOPGEN], 1u);
            else XB_SPIN(xb_ld(&bar[XB_TOPGEN]) == tg, bar);
            __builtin_amdgcn_fence(__ATOMIC_ACQUIRE, "agent");
            xb_add(&bar[XB_XGEN(b.x)], 1u);
            asm volatile("s_waitcnt vmcnt(0)" ::: "memory");
        } else {
            XB_SPIN(xb_ld(&bar[XB_XGEN(b.x)]) == gen, bar);
            __builtin_amdgcn_fence(__ATOMIC_ACQUIRE, "agent");
            asm volatile("s_waitcnt vmcnt(0)" ::: "memory");
        }
    }
    __syncthreads();
}
constexpr int CW_BAR = 4096;

struct Args { const float* in[20]; float* out; unsigned char* ws; int ph_lo, ph_hi; };
enum { I_X = 0, I_C, I_WADA, I_BADA, I_NMW, I_WIN, I_LBL, I_HNW, I_RELB, I_WPA, I_WPB, I_WOUT, I_NFW, I_WR, I_BR, I_W1, I_B1, I_W2, I_B2, I_FNW };

__device__ __forceinline__ void cvt_family(const int tid, const float* src, bf16_t* dst, int K, int N, int Npad, int count, int mode, float* lt  ) {
    const int tk = K / 64, tn = Npad / 64, per = tk * tn;
    for (long u = blockIdx.x; u < (long)per * count; u += gridDim.x) {
        const int mi = (int)(u / per), r = (int)(u % per), k0 = (r / tn) * 64, n0 = (r % tn) * 64;
        const float* s = src + (size_t)mi * K * N;
        bf16_t* d = dst + (size_t)mi * Npad * K;
        int sc0 = n0;
        if (mode == 1) { const int p = n0 >> 8, sel = (n0 >> 7) & 1, i = n0 & 127; sc0 = sel * 1024 + 128 * p + i; }
        __syncthreads();
        {
            const int i = tid >> 3, j0 = (tid & 7) * 8;
            float v[8];
            if (n0 + j0 < Npad && (mode == 1 || n0 + j0 < N)) {
                const f32x4 a = *(const f32x4*)(s + (size_t)(k0 + i) * N + sc0 + j0), b = *(const f32x4*)(s + (size_t)(k0 + i) * N + sc0 + j0 + 4);
                v[0] = a[0]; v[1] = a[1]; v[2] = a[2]; v[3] = a[3]; v[4] = b[0]; v[5] = b[1]; v[6] = b[2]; v[7] = b[3];
            } else {
#pragma unroll
                for (int q = 0; q < 8; ++q) v[q] = 0.f;
            }
#pragma unroll
            for (int q = 0; q < 8; ++q) lt[i * 65 + j0 + q] = v[q];
        }
        __syncthreads();
        {
            const int n = tid >> 3, kk = (tid & 7) * 8;
            unsigned w[4];
#pragma unroll
            for (int q = 0; q < 4; ++q) w[q] = (unsigned)f2bf(lt[(kk + 2 * q) * 65 + n]) | ((unsigned)f2bf(lt[(kk + 2 * q + 1) * 65 + n]) << 16);
            u32x4 o; o.x = w[0]; o.y = w[1]; o.z = w[2]; o.w = w[3];
            *(u32x4*)(d + (size_t)(n0 + n) * K + k0 + kk) = o;
        }
    }
    __syncthreads();
}

namespace pg8 {
#define PG8_LAS __attribute__((address_space(3)))
constexpr int BM = 256, BK = 64, HALF = 128, HTB = HALF * BK * 2, STAGE_BYTES = 8 * HTB, NXCD = 8, WGM = 8;
__host__ __device__ __forceinline__ int lds_byte(int r, int c) { const int st = (r >> 4) * 2 + (c >> 5), rr = r & 15, cc = c & 31, ob = rr * 64 + cc * 2; return st * 1024 + (ob ^ (((ob >> 9) & 1) << 5)); }
__host__ __device__ __forceinline__ void stage_rc(int b, int& R, int& C) { const int st = b / 1024, sb = b % 1024, swz = sb ^ (((sb >> 9) & 1) << 5); R = (st >> 1) * 16 + swz / 64; C = (st & 1) * 32 + (swz % 64) / 2; }
__host__ __device__ __forceinline__ int perm32(int rho) { const int n = rho >> 4, i = rho & 15; return 8 * (i >> 2) + 4 * n + (i & 3); }
struct Unit { int pm, pn, brow, e; };
struct Gemm { const bf16_t* A; const bf16_t* Bt; int M, N, K; };
struct StaticOrder {
    int nM, nN, nwg, G, c;
    __device__ void init(int M, int N, int G_, int c_) { nM = M / BM; nN = N / BM; nwg = nM * nN; G = G_; c = c_; }
    __device__ bool next(int i, Unit& u) const {
        const long L = (long)i * G + c; if (L >= nwg) return false;
        int wgid = (int)L; { const int q = nwg / NXCD, r = nwg % NXCD, xcd = wgid % NXCD, off = wgid / NXCD; wgid = (xcd < r ? xcd * (q + 1) : r * (q + 1) + (xcd - r) * q) + off; }
        const int nig = WGM * nN, gid = wgid / nig, fm = gid * WGM, gsz = (nM - fm) < WGM ? (nM - fm) : WGM;
        u.pm = fm + ((wgid % nig) % gsz); u.pn = (wgid % nig) / gsz; u.brow = u.pn * BM; u.e = 0; return true;
    }
    __device__ __forceinline__ void a_ready(const Unit&) const {}
    __device__ __forceinline__ void done(const Unit&) const {}
};
template <int NN> struct MoeOrder {
    int nwg, G, c; const int* blke;
    __device__ void init(int nM, int G_, int c_, const int* blke_) { nwg = nM * NN; G = G_; c = c_; blke = blke_; }
    __device__ bool next(int i, Unit& u) const {
        const int L = i * G + c; if (L >= nwg) return false;
        const int wgid = (L & 7) * (nwg >> 3) + (L >> 3);
        const int gid = wgid / (8 * NN), rem = wgid % (8 * NN);
        u.pm = gid * 8 + (rem & 7); u.pn = rem >> 3; u.e = __builtin_amdgcn_readfirstlane(blke[u.pm]); u.brow = u.e * (NN * BM) + u.pn * BM; return true;
    }
    __device__ __forceinline__ void a_ready(const Unit&) const {}
    __device__ __forceinline__ void done(const Unit&) const {}
};
typedef __bf16 bf16x2v_t __attribute__((ext_vector_type(2)));
typedef float f32x2v_t __attribute__((ext_vector_type(2)));
__device__ __forceinline__ unsigned cvt_pk_bf16(float lo, float hi) { const f32x2v_t v = {lo, hi}; const bf16x2v_t r = __builtin_convertvector(v, bf16x2v_t); return __builtin_bit_cast(unsigned, r); }


struct EpiZ {
    static constexpr bool PERM = true, AFTER_DRAIN = false;
    bf16_t* C; int ldc;
    __device__ __forceinline__ void operator()(const f32x4 (&acc)[2][2][4][2], const Unit& u, int wr, int wc, int fr, int fq) const {
        const int row0 = u.pm * BM + wr * 64 + fr, col0 = u.pn * BM + wc * 32 + 8 * fq;
#pragma unroll
        for (int ai = 0; ai < 2; ++ai)
#pragma unroll
            for (int m = 0; m < 4; ++m) { bf16_t* rowp = C + (size_t)(row0 + ai * HALF + m * 16) * ldc + col0;
#pragma unroll
                for (int bj = 0; bj < 2; ++bj) { const f32x4 v0 = acc[ai][bj][m][0], v1 = acc[ai][bj][m][1];
                    u32x4 w; w.x = cvt_pk_bf16(v0[0], v0[1]); w.y = cvt_pk_bf16(v0[2], v0[3]); w.z = cvt_pk_bf16(v1[0], v1[1]); w.w = cvt_pk_bf16(v1[2], v1[3]);
                    *(u32x4*)(rowp + bj * HALF) = w; } }
    }
};
__device__ __forceinline__ void bf8_to_f32(const u32x4 w, f32x4& lo, f32x4& hi) {
    lo[0] = __uint_as_float(w.x << 16); lo[1] = __uint_as_float(w.x & 0xffff0000u); lo[2] = __uint_as_float(w.y << 16); lo[3] = __uint_as_float(w.y & 0xffff0000u);
    hi[0] = __uint_as_float(w.z << 16); hi[1] = __uint_as_float(w.z & 0xffff0000u); hi[2] = __uint_as_float(w.w << 16); hi[3] = __uint_as_float(w.w & 0xffff0000u);
}
__device__ __forceinline__ f32x4 sig4(f32x4 g) { f32x4 r; r[0] = sigmoidf_(g[0]); r[1] = sigmoidf_(g[1]); r[2] = sigmoidf_(g[2]); r[3] = sigmoidf_(g[3]); return r; }
template <bool SECOND> struct EpiMerge {
    static constexpr bool PERM = true, AFTER_DRAIN = false;
    float* tmp; bf16_t* merged; const bf16_t* Zg  ;
    __device__ __forceinline__ void operator()(const f32x4 (&acc)[2][2][4][2], const Unit& u, int wr, int wc, int fr, int fq) const {
        const int row0 = u.pm * BM + wr * 64 + fr, col0 = u.pn * BM + wc * 32 + 8 * fq;
#pragma unroll
        for (int ai = 0; ai < 2; ++ai)
#pragma unroll
            for (int m = 0; m < 4; ++m) { const size_t row = (size_t)(row0 + ai * HALF + m * 16);
#pragma unroll
                for (int bj = 0; bj < 2; ++bj) { const int col = col0 + bj * HALF;
                    f32x4 g0, g1; bf8_to_f32(*(const u32x4*)(Zg + row * ZLD + col), g0, g1); g0 = sig4(g0); g1 = sig4(g1);
                    f32x4 v0 = g0 * acc[ai][bj][m][0], v1 = g1 * acc[ai][bj][m][1];
                    if (!SECOND) { *(f32x4*)(tmp + row * D + col) = v0; *(f32x4*)(tmp + row * D + col + 4) = v1; }
                    else { v0 += *(const f32x4*)(tmp + row * D + col); v1 += *(const f32x4*)(tmp + row * D + col + 4);
                        u32x4 w; w.x = cvt_pk_bf16(v0[0], v0[1]); w.y = cvt_pk_bf16(v0[2], v0[3]); w.z = cvt_pk_bf16(v1[0], v1[1]); w.w = cvt_pk_bf16(v1[2], v1[3]);
                        *(u32x4*)(merged + row * D + col) = w; } } }
    }
};
struct EpiOutG {
    static constexpr bool PERM = false, AFTER_DRAIN = false;
    const float* xin; float* x1; const float* gate  ;
    __device__ __forceinline__ void operator()(const f32x4 (&acc)[2][2][4][2], const Unit& u, int wr, int wc, int fr, int fq) const {
        const int row0 = u.pm * BM + wr * 64 + fr, col0 = u.pn * BM + wc * 32 + 4 * fq; const int b = (u.pm * BM) >> 11;
        f32x4 gv[2][2];
#pragma unroll
        for (int bj = 0; bj < 2; ++bj)
#pragma unroll
            for (int n = 0; n < 2; ++n) gv[bj][n] = *(const f32x4*)(gate + (size_t)b * NMOD + col0 + bj * HALF + n * 16);
#pragma unroll
        for (int ai = 0; ai < 2; ++ai)
#pragma unroll
            for (int m = 0; m < 4; ++m) { const size_t off = (size_t)(row0 + ai * HALF + m * 16) * D + col0;
#pragma unroll
                for (int bj = 0; bj < 2; ++bj)
#pragma unroll
                    for (int n = 0; n < 2; ++n) *(f32x4*)(x1 + off + bj * HALF + n * 16) = *(const f32x4*)(xin + off + bj * HALF + n * 16) + gv[bj][n] * acc[ai][bj][m][n]; }
    }
};
struct EpiSwigluG {
    static constexpr bool PERM = true, AFTER_DRAIN = false;
    bf16_t* act; const float* b1  ;
    __device__ __forceinline__ void operator()(const f32x4 (&acc)[2][2][4][2], const Unit& u, int wr, int wc, int fr, int fq) const {
        const int row0 = u.pm * BM + wr * 64 + fr, col0 = u.pn * HALF + wc * 32 + 8 * fq;
        f32x4 bg[2], bl[2];
#pragma unroll
        for (int n = 0; n < 2; ++n) { bg[n] = *(const f32x4*)(b1 + (size_t)u.e * 2 * DFF + col0 + 4 * n); bl[n] = *(const f32x4*)(b1 + (size_t)u.e * 2 * DFF + DFF + col0 + 4 * n); }
#pragma unroll
        for (int ai = 0; ai < 2; ++ai)
#pragma unroll
            for (int m = 0; m < 4; ++m) { float o[8];
#pragma unroll
                for (int n = 0; n < 2; ++n) { const f32x4 gl = acc[ai][0][m][n] + bg[n], li = acc[ai][1][m][n] + bl[n];
#pragma unroll
                    for (int j = 0; j < 4; ++j) { const float g = fminf(gl[j], 7.0f), l = fminf(fmaxf(li[j], -7.0f), 7.0f); o[4 * n + j] = g * sigmoidf_(1.702f * g) * (l + 1.0f); } }
                u32x4 w; w.x = cvt_pk_bf16(o[0], o[1]); w.y = cvt_pk_bf16(o[2], o[3]); w.z = cvt_pk_bf16(o[4], o[5]); w.w = cvt_pk_bf16(o[6], o[7]);
                *(u32x4*)(act + (size_t)(row0 + ai * HALF + m * 16) * DFF + col0) = w; }
    }
};
struct EpiYG {
    static constexpr bool PERM = true, AFTER_DRAIN = false;
    bf16_t* Yb; const float* b2  ;
    __device__ __forceinline__ void operator()(const f32x4 (&acc)[2][2][4][2], const Unit& u, int wr, int wc, int fr, int fq) const {
        const int row0 = u.pm * BM + wr * 64 + fr, col0 = u.pn * BM + wc * 32 + 8 * fq;
        f32x4 bv[2][2];
#pragma unroll
        for (int bj = 0; bj < 2; ++bj)
#pragma unroll
            for (int n = 0; n < 2; ++n) bv[bj][n] = *(const f32x4*)(b2 + (size_t)u.e * D + col0 + bj * HALF + 4 * n);
#pragma unroll
        for (int ai = 0; ai < 2; ++ai)
#pragma unroll
            for (int m = 0; m < 4; ++m) { bf16_t* rowp = Yb + (size_t)(row0 + ai * HALF + m * 16) * D + col0;
#pragma unroll
                for (int bj = 0; bj < 2; ++bj) { const f32x4 v0 = acc[ai][bj][m][0] + bv[bj][0], v1 = acc[ai][bj][m][1] + bv[bj][1];
                    u32x4 w; w.x = cvt_pk_bf16(v0[0], v0[1]); w.y = cvt_pk_bf16(v0[2], v0[3]); w.z = cvt_pk_bf16(v1[0], v1[1]); w.w = cvt_pk_bf16(v1[2], v1[3]);
                    *(u32x4*)(rowp + bj * HALF) = w; } }
    }
};

template <class Epi, class Sched>
__device__ __forceinline__ void gemm_phase(PG8_LAS unsigned char* lds, const int tid, const Gemm g, const Sched& S, const Epi& E) {
    const int wid = __builtin_amdgcn_readfirstlane(tid >> 6), lane = tid & 63, wr = wid >> 2, wc = wid & 3, fr = lane & 15, fq = lane >> 4;
    const int K = g.K, nt = K / BK;
    unsigned voffA[2], voffB[2];
#pragma unroll
    for (int i = 0; i < 2; ++i) { int R, C; stage_rc(tid * 16 + i * 8192, R, C); const int Rb = Epi::PERM ? ((R & ~31) + perm32(R & 31)) : R;
        voffA[i] = (unsigned)(R * K + C) * 2u; voffB[i] = (unsigned)(Rb * K + C) * 2u; }
    const size_t kstep = (size_t)(BK * 2);
    const size_t hstep = (size_t)HALF * K * 2;
    const size_t tstep = 2 * hstep;
    const unsigned ldsw = (unsigned)wid * 1024u;
    const int aoff = lds_byte(wr * 64 + fr, fq * 8), boff = lds_byte(wc * 32 + fr, fq * 8);
#define PG8_SA(b, h) (((b) * 2 + (h)) * HTB)
#define PG8_SB(b, h) ((4 + (b) * 2 + (h)) * HTB)
#define PG8_STAGE(bufoff, gbase, voff) do { _Pragma("unroll") for (int _i = 0; _i < 2; ++_i) \
        __builtin_amdgcn_global_load_lds((const unsigned*)((const char*)(gbase) + (voff)[_i]), (PG8_LAS unsigned*)(lds + (bufoff) + ldsw + _i * 8192), 16, 0, 0); } while (0)
#define PG8_LDA(dst, b, h) do { _Pragma("unroll") for (int m = 0; m < 4; ++m) _Pragma("unroll") for (int k = 0; k < 2; ++k) dst[m][k] = *(const PG8_LAS bf16x8*)(lds + PG8_SA(b, h) + aoff + m * 2048 + k * 1024); } while (0)
#define PG8_LDB(dst, b, h) do { _Pragma("unroll") for (int n = 0; n < 2; ++n) _Pragma("unroll") for (int k = 0; k < 2; ++k) dst[n][k] = *(const PG8_LAS bf16x8*)(lds + PG8_SB(b, h) + boff + n * 2048 + k * 1024); } while (0)
#define PG8_MMA(ai, bj, At, Bt) do { __builtin_amdgcn_s_setprio(1); _Pragma("unroll") for (int m = 0; m < 4; ++m) _Pragma("unroll") for (int n = 0; n < 2; ++n) _Pragma("unroll") for (int k = 0; k < 2; ++k) \
        acc[ai][bj][m][n] = __builtin_amdgcn_mfma_f32_16x16x32_bf16(Bt[n][k], At[m][k], acc[ai][bj][m][n], 0, 0, 0); __builtin_amdgcn_s_setprio(0); } while (0)
#define PG8_WAIT_V(n) asm volatile("s_waitcnt vmcnt(" #n ")" ::: "memory")
#define PG8_WAIT_L(n) asm volatile("s_waitcnt lgkmcnt(" #n ")" ::: "memory")
#define PG8_BAR __builtin_amdgcn_s_barrier()
#define PG8_SCHED __builtin_amdgcn_sched_barrier(0)
    Unit cur, nxt; int ui = 0;
    if (!S.next(0, cur)) return;
    f32x4 acc[2][2][4][2];
#pragma unroll
    for (int a = 0; a < 2; ++a)
#pragma unroll
        for (int b = 0; b < 2; ++b)
#pragma unroll
            for (int m = 0; m < 4; ++m)
#pragma unroll
                for (int n = 0; n < 2; ++n) acc[a][b][m][n] = (f32x4){0.f, 0.f, 0.f, 0.f};
    bf16x8 At[4][2], B0[2][2], B1[2][2];
    const char* cA = (const char*)g.A + (size_t)cur.pm * tstep; const char* cB = (const char*)g.Bt + (size_t)cur.brow * K * 2;
    S.a_ready(cur);
    PG8_STAGE(PG8_SB(0, 0), cB, voffB); PG8_STAGE(PG8_SA(0, 0), cA, voffA); PG8_STAGE(PG8_SB(0, 1), cB + hstep, voffB); PG8_STAGE(PG8_SA(0, 1), cA + hstep, voffA);
    if (wr == 1) PG8_BAR;
    PG8_WAIT_V(4); PG8_BAR;
    PG8_STAGE(PG8_SB(1, 0), cB + kstep, voffB); PG8_STAGE(PG8_SA(1, 0), cA + kstep, voffA); PG8_STAGE(PG8_SB(1, 1), cB + hstep + kstep, voffB);
    PG8_WAIT_V(6); PG8_BAR;
    for (;;) {
        const bool has_next = S.next(ui + 1, nxt);
        const char* nA = has_next ? (const char*)g.A + (size_t)nxt.pm * tstep : cA; const char* nB = has_next ? (const char*)g.Bt + (size_t)nxt.brow * K * 2 : cB;
        for (int t = 0; t < nt; t += 2) {
            const bool last = (t == nt - 2);
            const char* a1 = cA + (size_t)(t + 1) * kstep;
            const char* a2 = last ? nA : cA + (size_t)(t + 2) * kstep; const char* b2 = last ? nB : cB + (size_t)(t + 2) * kstep;
            const char* a3 = a2 + kstep; const char* b3 = b2 + kstep;
            if (last && has_next) S.a_ready(nxt);
            PG8_LDB(B0, 0, 0); PG8_SCHED; PG8_LDA(At, 0, 0); PG8_STAGE(PG8_SA(1, 1), a1 + hstep, voffA);
            PG8_WAIT_L(8); PG8_BAR; PG8_WAIT_L(0); PG8_MMA(0, 0, At, B0); PG8_BAR; PG8_SCHED;
            PG8_LDB(B1, 0, 1); PG8_STAGE(PG8_SB(0, 0), b2, voffB);
            PG8_BAR; PG8_WAIT_L(0); PG8_MMA(0, 1, At, B1); PG8_BAR;
            PG8_LDA(At, 0, 1); PG8_STAGE(PG8_SA(0, 0), a2, voffA);
            PG8_BAR; PG8_WAIT_L(0); PG8_MMA(1, 0, At, B0); PG8_BAR; PG8_SCHED;
            PG8_STAGE(PG8_SB(0, 1), b2 + hstep, voffB);
            PG8_WAIT_V(6); PG8_BAR; PG8_MMA(1, 1, At, B1); PG8_BAR;
            PG8_LDB(B0, 1, 0); PG8_SCHED; PG8_LDA(At, 1, 0); PG8_STAGE(PG8_SA(0, 1), a2 + hstep, voffA);
            PG8_WAIT_L(8); PG8_BAR; PG8_WAIT_L(0); PG8_MMA(0, 0, At, B0); PG8_BAR; PG8_SCHED;
            PG8_LDB(B1, 1, 1); PG8_STAGE(PG8_SB(1, 0), b3, voffB);
            PG8_BAR; PG8_WAIT_L(0); PG8_MMA(0, 1, At, B1); PG8_BAR;
            PG8_LDA(At, 1, 1); PG8_STAGE(PG8_SA(1, 0), a3, voffA);
            PG8_BAR; PG8_WAIT_L(0); PG8_MMA(1, 0, At, B0); PG8_BAR; PG8_SCHED;
            PG8_STAGE(PG8_SB(1, 1), b3 + hstep, voffB);
            PG8_WAIT_V(6); PG8_BAR; PG8_MMA(1, 1, At, B1); PG8_BAR;
        }
        if constexpr (!Epi::AFTER_DRAIN) { E(acc, cur, wr, wc, fr, fq); S.done(cur); }
        if (!has_next) break;
#pragma unroll
        for (int a = 0; a < 2; ++a)
#pragma unroll
            for (int b = 0; b < 2; ++b)
#pragma unroll
                for (int m = 0; m < 4; ++m)
#pragma unroll
                    for (int n = 0; n < 2; ++n) acc[a][b][m][n] = (f32x4){0.f, 0.f, 0.f, 0.f};
        cur = nxt; cA = nA; cB = nB; ++ui;
    }
    PG8_WAIT_V(0);
    if (wr == 0) PG8_BAR;
    PG8_BAR;
    if constexpr (Epi::AFTER_DRAIN) { E.fused(acc, cur, wr, wc, fr, fq, lds, wid, lane); S.done(cur); }
#undef PG8_SA
#undef PG8_SB
#undef PG8_STAGE
#undef PG8_LDA
#undef PG8_LDB
#undef PG8_MMA
#undef PG8_WAIT_V
#undef PG8_WAIT_L
#undef PG8_BAR
#undef PG8_SCHED
}
}


__device__ __forceinline__ void hgrn_item(const bf16_t* __restrict__ zb, const float* __restrict__ lbv, float* __restrict__ oraw, unsigned char* ldsb, const int b, const int h, const int dvq, const int tid) {
    typedef unsigned long long u64;
    const int lane = tid & 63, wave = tid >> 6, r31 = lane & 31, hh = lane >> 5;
    bf16_t* QE = (bf16_t*)ldsb;
    bf16_t* KE = QE + 64 * 136;
    bf16_t* KET = KE + 64 * 136;
    bf16_t* VT = KET + 128 * 72;
    bf16_t* SBT = VT + 32 * 72;
    float* ex = (float*)(SBT + 32 * 136);
    float* er = ex + 512; float* el = er + 128; float* elr = el + 128;
    const int d = tid & 127, tg = tid >> 7;
    const float lb = lbv[h * 128 + d], oml = 1.0f - lb;
    const int vs = tid & 63, v0 = (tid >> 6) * 4;
    const bf16_t* fbase = zb + (size_t)(b * SEQ + 16 * tg) * ZLD + C_FA + h * 128 + d;
    const bf16_t* qbase = zb + (size_t)(b * SEQ + 16 * tg) * ZLD + C_QA + h * 128 + d;
    const bf16_t* vbase = zb + (size_t)(b * SEQ + vs) * ZLD + C_IA + h * 128 + dvq * 32 + v0;
    bf16_t nf[16], nq[16]; u64 nv;
#pragma unroll
    for (int j = 0; j < 16; ++j) { nf[j] = fbase[(size_t)j * ZLD]; nq[j] = qbase[(size_t)j * ZLD]; }
    nv = *(const u64*)vbase;
    f32x16 Sacc;
#pragma unroll
    for (int i = 0; i < 16; ++i) Sacc[i] = 0.f;
    for (int c = 0; c < SEQ / 64; ++c) {
        const int row0 = b * SEQ + c * 64;
        float g[16], kk[16], qv[16]; float run = 0.f;
#pragma unroll
        for (int j = 0; j < 16; ++j) {
            const float zf = fminf(fmaxf(bf2f(nf[j]), -60.f), 60.f), zq = bf2f(nq[j]);
            const float e = __expf(-zf), sg = 1.0f / (1.0f + e);
            run += __logf(lb + oml * sg); g[j] = run; kk[j] = oml * e * sg; qv[j] = zq * sigmoidf_(zq);
        }
        const u64 cv = nv;
        ex[tg * 128 + d] = run;
        __syncthreads();
        {
            const float e0 = ex[d], e1 = ex[128 + d], e2 = ex[256 + d], e3 = ex[384 + d];
            const float pre = tg == 0 ? 0.f : tg == 1 ? e0 : tg == 2 ? e0 + e1 : e0 + e1 + e2;
            const float r = e0 + e1, tot = (e0 + e1) + (e2 + e3);
            unsigned kt[8];
#pragma unroll
            for (int j = 0; j < 16; j += 2) {
                const float bt0 = pre + g[j], bt1 = pre + g[j + 1];
                const float qe0 = qv[j] * __expf(fminf(bt0 - r, 80.f)), qe1 = qv[j + 1] * __expf(fminf(bt1 - r, 80.f));
                const float ke0 = kk[j] * __expf(fminf(r - bt0, 80.f)), ke1 = kk[j + 1] * __expf(fminf(r - bt1, 80.f));
                const unsigned qp = pg8::cvt_pk_bf16(qe0, qe1), kp = pg8::cvt_pk_bf16(ke0, ke1);
                QE[(16 * tg + j) * 136 + d] = (bf16_t)(qp & 0xffffu); QE[(16 * tg + j + 1) * 136 + d] = (bf16_t)(qp >> 16);
                KE[(16 * tg + j) * 136 + d] = (bf16_t)(kp & 0xffffu); KE[(16 * tg + j + 1) * 136 + d] = (bf16_t)(kp >> 16);
                kt[j >> 1] = kp;
            }
            u32x4 w0, w1; w0.x = kt[0]; w0.y = kt[1]; w0.z = kt[2]; w0.w = kt[3]; w1.x = kt[4]; w1.y = kt[5]; w1.z = kt[6]; w1.w = kt[7];
            *(u32x4*)(KET + d * 72 + 16 * tg) = w0; *(u32x4*)(KET + d * 72 + 16 * tg + 8) = w1;
            if (tg == 0) { er[d] = __expf(r); el[d] = __expf(tot); elr[d] = __expf(tot - r); }
            VT[(v0 + 0) * 72 + vs] = (bf16_t)(cv & 0xffffu); VT[(v0 + 1) * 72 + vs] = (bf16_t)((cv >> 16) & 0xffffu); VT[(v0 + 2) * 72 + vs] = (bf16_t)((cv >> 32) & 0xffffu); VT[(v0 + 3) * 72 + vs] = (bf16_t)(cv >> 48);
        }
        __syncthreads();
        if (c + 1 < SEQ / 64) {
#pragma unroll
            for (int j = 0; j < 16; ++j) { nf[j] = fbase[(size_t)((c + 1) * 64 + j) * ZLD]; nq[j] = qbase[(size_t)((c + 1) * 64 + j) * ZLD]; }
            nv = *(const u64*)(vbase + (size_t)(c + 1) * 64 * ZLD);
        }
        if (wave >= 2 && wave < 6) {
            const int dq = wave - 2;
#pragma unroll
            for (int g4 = 0; g4 < 4; ++g4) {
                const int dd = 32 * dq + 8 * g4 + 4 * hh;
                const unsigned a0 = pg8::cvt_pk_bf16(er[dd] * Sacc[4 * g4], er[dd + 1] * Sacc[4 * g4 + 1]), a1 = pg8::cvt_pk_bf16(er[dd + 2] * Sacc[4 * g4 + 2], er[dd + 3] * Sacc[4 * g4 + 3]);
                *(u64*)(SBT + r31 * 136 + dd) = (u64)a0 | ((u64)a1 << 32);
            }
        }
        __syncthreads();
        if (wave < 2) {
            const int tt = wave;
            f32x16 Oacc;
#pragma unroll
            for (int i = 0; i < 16; ++i) Oacc[i] = 0.f;
            bf16x8 qf[8];
#pragma unroll
            for (int ks = 0; ks < 8; ++ks) qf[ks] = *(const bf16x8*)(QE + (32 * tt + r31) * 136 + 16 * ks + 8 * hh);
#pragma unroll
            for (int ks = 0; ks < 8; ++ks) { const bf16x8 sa = *(const bf16x8*)(SBT + r31 * 136 + 16 * ks + 8 * hh); Oacc = __builtin_amdgcn_mfma_f32_32x32x16_bf16(sa, qf[ks], Oacc, 0, 0, 0); }
            for (int st = 0; st <= tt; ++st) {
                f32x16 At;
#pragma unroll
                for (int i = 0; i < 16; ++i) At[i] = 0.f;
#pragma unroll
                for (int ks = 0; ks < 8; ++ks) { const bf16x8 ka = *(const bf16x8*)(KE + (32 * st + r31) * 136 + 16 * ks + 8 * hh); At = __builtin_amdgcn_mfma_f32_32x32x16_bf16(ka, qf[ks], At, 0, 0, 0); }
                if (st == tt) {
#pragma unroll
                    for (int i = 0; i < 16; ++i) { const int sl = (i & 3) + 8 * (i >> 2) + 4 * hh; if (sl > r31) At[i] = 0.f; }
                }
                union { unsigned u[4]; bf16x8 v; } pb0, pb1;
#pragma unroll
                for (int j = 0; j < 4; ++j) { pb0.u[j] = pg8::cvt_pk_bf16(At[2 * j], At[2 * j + 1]); pb1.u[j] = pg8::cvt_pk_bf16(At[8 + 2 * j], At[8 + 2 * j + 1]); }
                union { u64 q[2]; bf16x8 v; } a0, a1;
                a0.q[0] = *(const u64*)(VT + r31 * 72 + 32 * st + 4 * hh); a0.q[1] = *(const u64*)(VT + r31 * 72 + 32 * st + 8 + 4 * hh);
                a1.q[0] = *(const u64*)(VT + r31 * 72 + 32 * st + 16 + 4 * hh); a1.q[1] = *(const u64*)(VT + r31 * 72 + 32 * st + 24 + 4 * hh);
                Oacc = __builtin_amdgcn_mfma_f32_32x32x16_bf16(a0.v, pb0.v, Oacc, 0, 0, 0);
                Oacc = __builtin_amdgcn_mfma_f32_32x32x16_bf16(a1.v, pb1.v, Oacc, 0, 0, 0);
            }
            float* op = oraw + (size_t)(row0 + 32 * tt + r31) * 512 + h * 128 + dvq * 32 + 4 * hh;
#pragma unroll
            for (int g4 = 0; g4 < 4; ++g4) { f32x4 o; o[0] = Oacc[4 * g4]; o[1] = Oacc[4 * g4 + 1]; o[2] = Oacc[4 * g4 + 2]; o[3] = Oacc[4 * g4 + 3]; *(f32x4*)(op + 8 * g4) = o; }
        } else if (wave < 6) {
            const int dq = wave - 2;
            f32x16 dS;
#pragma unroll
            for (int i = 0; i < 16; ++i) dS[i] = 0.f;
#pragma unroll
            for (int ks = 0; ks < 4; ++ks) { const bf16x8 ka = *(const bf16x8*)(KET + (32 * dq + r31) * 72 + 16 * ks + 8 * hh), vb = *(const bf16x8*)(VT + r31 * 72 + 16 * ks + 8 * hh);
                dS = __builtin_amdgcn_mfma_f32_32x32x16_bf16(ka, vb, dS, 0, 0, 0); }
#pragma unroll
            for (int i = 0; i < 16; ++i) { const int dd = 32 * dq + (i & 3) + 8 * (i >> 2) + 4 * hh; Sacc[i] = el[dd] * Sacc[i] + elr[dd] * dS[i]; }
        }
        __syncthreads();
    }
}

__device__ __forceinline__ unsigned ordered_key(float f) { const unsigned u = __float_as_uint(f); return (u & 0x80000000u) ? ~u : (u | 0x80000000u); }
__device__ __forceinline__ void indexer_unit(const bf16_t* __restrict__ zb, unsigned* __restrict__ maskp, unsigned* sc  , unsigned* hist  ,
                                             const int b, const int t0, const int tid) {
    const int lane = tid & 63, wave = tid >> 6;
    const int r31 = lane & 31, hh = lane >> 5;
    {
        const int g = wave & 3, par = wave >> 2;
        const int head = (r31 & 3) + 4 * ((r31 >> 3) & 1), ql = 2 * ((r31 >> 4) & 1) + ((r31 >> 2) & 1);
        const bf16_t* ap = zb + (size_t)(b * SEQ + t0 + 4 * g + ql) * ZLD + C_IQ + head * 64 + 8 * hh;
        bf16x8 a[4];
#pragma unroll
        for (int s4 = 0; s4 < 4; ++s4) a[s4] = *(const bf16x8*)(ap + 16 * s4);
        float wq[16];
        {
            const int qa = t0 + 4 * g + hh, qb = qa + 2;
            f32x4 w0, w1, w2, w3; pg8::bf8_to_f32(*(const u32x4*)(zb + (size_t)(b * SEQ + qa) * ZLD + C_IW), w0, w1); pg8::bf8_to_f32(*(const u32x4*)(zb + (size_t)(b * SEQ + qb) * ZLD + C_IW), w2, w3);
#pragma unroll
            for (int i = 0; i < 4; ++i) { wq[i] = w0[i] * 0.04419417382415922f; wq[4 + i] = w1[i] * 0.04419417382415922f; wq[8 + i] = w2[i] * 0.04419417382415922f; wq[12 + i] = w3[i] * 0.04419417382415922f; }
        }
        const int ta = t0 + 4 * g + hh, tb_ = ta + 2;
        const int kt_max = (t0 + 15) >> 5;
        const bf16_t* kp = zb + (size_t)(b * SEQ + r31) * ZLD + C_IK + 8 * hh;
        for (int kt = par; kt <= kt_max; kt += 2) {
            bf16x8 bk[4];
#pragma unroll
            for (int s4 = 0; s4 < 4; ++s4) bk[s4] = *(const bf16x8*)(kp + (size_t)kt * 32 * ZLD + 16 * s4);
            f32x16 acc;
#pragma unroll
            for (int q = 0; q < 16; ++q) acc[q] = 0.f;
#pragma unroll
            for (int s4 = 0; s4 < 4; ++s4) acc = __builtin_amdgcn_mfma_f32_32x32x16_bf16(a[s4], bk[s4], acc, 0, 0, 0);
            float sa = 0.f, sb = 0.f;
#pragma unroll
            for (int i = 0; i < 8; ++i) { sa += wq[i] * fmaxf(acc[i], 0.f); sb += wq[8 + i] * fmaxf(acc[8 + i], 0.f); }
            const int key = kt * 32 + r31;
            sc[(4 * g + hh) * 2048 + key] = key <= ta ? ordered_key(sa) : 0u;
            sc[(4 * g + 2 + hh) * 2048 + key] = key <= tb_ ? ordered_key(sb) : 0u;
        }
    }
    __syncthreads();
    for (int qq = 2 * wave; qq < 2 * wave + 2; ++qq) {
        const int t = t0 + qq;
        unsigned kreg[32];
#pragma unroll
        for (int i = 0; i < 32; ++i) { const int p = lane + 64 * i; kreg[i] = (p <= t) ? sc[qq * 2048 + p] : 0u; }
        unsigned prefix = 0u, mhi = 0u; int kk = 256;
#pragma unroll
        for (int pass = 3; pass >= 0; --pass) {
            const int shift = 8 * pass;
#pragma unroll
            for (int j = 0; j < 4; ++j) hist[lane * 4 + j] = 0u;
            asm volatile("s_waitcnt lgkmcnt(0)" ::: "memory");
#pragma unroll
            for (int i = 0; i < 32; ++i) { if ((kreg[i] & mhi) == prefix) atomicAdd(&hist[(kreg[i] >> shift) & 255u], 1u); }
            asm volatile("s_waitcnt lgkmcnt(0)" ::: "memory");
            const unsigned h0 = hist[lane * 4], h1 = hist[lane * 4 + 1], h2 = hist[lane * 4 + 2], h3 = hist[lane * 4 + 3];
            const int c4 = (int)(h0 + h1 + h2 + h3);
            int suf = c4;
#pragma unroll
            for (int o = 1; o < 64; o <<= 1) { const int v = __shfl_down(suf, o); if (lane + o < 64) suf += v; }
            const unsigned long long bal = __ballot(suf >= kk);
            const int L = 63 - __builtin_clzll(bal);
            int d = 0, kn = 0;
            {
                int cum = suf - c4;
                if (cum + (int)h3 >= kk) { d = 3; kn = kk - cum; } else { cum += (int)h3;
                if (cum + (int)h2 >= kk) { d = 2; kn = kk - cum; } else { cum += (int)h2;
                if (cum + (int)h1 >= kk) { d = 1; kn = kk - cum; } else { cum += (int)h1; d = 0; kn = kk - cum; } } }
            }
            d = __builtin_amdgcn_readlane(d, L); kn = __builtin_amdgcn_readlane(kn, L);
            prefix |= (unsigned)(4 * L + d) << shift; mhi |= 0xffu << shift; kk = kn;
        }
        unsigned myword = 0u; int eqbefore = 0;
#pragma unroll
        for (int i = 0; i < 32; ++i) {
            const bool eq = kreg[i] == prefix;
            const unsigned long long beq = __ballot(eq);
            const int rank = eqbefore + __popcll(beq & ((1ull << lane) - 1ull));
            const bool sel = kreg[i] > prefix || (eq && rank < kk);
            const unsigned long long bs = __ballot(sel);
            eqbefore += __popcll(beq);
            if (lane == 2 * i) myword = (unsigned)bs;
            if (lane == 2 * i + 1) myword = (unsigned)(bs >> 32);
        }
        maskp[(size_t)(b * SEQ + t) * 64 + lane] = myword;
    }
    __syncthreads();
}

__device__ __forceinline__ void attn_wave(const bf16_t* __restrict__ zb, const bf16_t* __restrict__ vbt, const unsigned* __restrict__ maskp, bf16_t* __restrict__ att, const float* tb  ,
                                          const int b, const int t0w, const int lane) {
    const int c = lane & 31, hh = lane >> 5, h = c & 7;
    const int tq = t0w + (c >> 3);
    const size_t rowq = (size_t)b * SEQ + tq;
    bf16x8 bq[4];
#pragma unroll
    for (int s4 = 0; s4 < 4; ++s4) bq[s4] = *(const bf16x8*)(zb + rowq * ZLD + C_QB + h * 64 + 16 * s4 + 8 * hh);
    const int kt_max = (t0w + 3) >> 5;
    const float bfar = tb[127 * 8 + h];
    const float LOG2E = 1.4426950408889634f;
    float m = -1e30f, lsum = 0.f;
    f32x16 O0, O1;
#pragma unroll
    for (int q = 0; q < 16; ++q) { O0[q] = 0.f; O1[q] = 0.f; }
    const bf16_t* kbase = zb + ((size_t)b * SEQ + c) * ZLD + C_KB + 8 * hh;
    const bf16_t* vbase = vbt + ((size_t)b * 64 + c) * SEQ + 4 * hh;
    const unsigned* mbase = maskp + rowq * 64;
    typedef unsigned long long u64;
    bf16x8 ak[4]; u64 av[2][2][2]; unsigned mw;
#pragma unroll
    for (int s4 = 0; s4 < 4; ++s4) ak[s4] = *(const bf16x8*)(kbase + 16 * s4);
#pragma unroll
    for (int mt = 0; mt < 2; ++mt)
#pragma unroll
        for (int s2 = 0; s2 < 2; ++s2) { av[mt][s2][0] = *(const u64*)(vbase + (size_t)mt * 32 * SEQ + 16 * s2); av[mt][s2][1] = *(const u64*)(vbase + (size_t)mt * 32 * SEQ + 16 * s2 + 8); }
    mw = mbase[0];
    for (int kt = 0; kt <= kt_max; ++kt) {
        const int key0 = kt * 32;
        bf16x8 cak[4]; u64 cav[2][2][2]; const unsigned cmw = mw >> (4 * hh);
#pragma unroll
        for (int s4 = 0; s4 < 4; ++s4) cak[s4] = ak[s4];
#pragma unroll
        for (int mt = 0; mt < 2; ++mt)
#pragma unroll
            for (int s2 = 0; s2 < 2; ++s2) { cav[mt][s2][0] = av[mt][s2][0]; cav[mt][s2][1] = av[mt][s2][1]; }
        {
            const int kn = kt < kt_max ? kt + 1 : kt;
#pragma unroll
            for (int s4 = 0; s4 < 4; ++s4) ak[s4] = *(const bf16x8*)(kbase + (size_t)kn * 32 * ZLD + 16 * s4);
#pragma unroll
            for (int mt = 0; mt < 2; ++mt)
#pragma unroll
                for (int s2 = 0; s2 < 2; ++s2) { av[mt][s2][0] = *(const u64*)(vbase + (size_t)mt * 32 * SEQ + kn * 32 + 16 * s2); av[mt][s2][1] = *(const u64*)(vbase + (size_t)mt * 32 * SEQ + kn * 32 + 16 * s2 + 8); }
            mw = mbase[kn];
        }
        f32x16 S;
#pragma unroll
        for (int q = 0; q < 16; ++q) S[q] = 0.f;
#pragma unroll
        for (int s4 = 0; s4 < 4; ++s4) S = __builtin_amdgcn_mfma_f32_32x32x16_bf16(cak[s4], bq[s4], S, 0, 0, 0);
        const bool nearb = (t0w - key0 - 31) < 113;
        float x[16]; float tmax = -1e30f;
        const int relb = tq - key0 - 4 * hh;
#pragma unroll
        for (int i = 0; i < 16; ++i) {
            const int ko = (i & 3) + 8 * (i >> 2);
            float bias = bfar;
            if (nearb) { int rel = relb - ko; rel = rel < 0 ? 0 : (rel > 127 ? 127 : rel); bias = tb[rel * 8 + h]; }
            x[i] = S[i] * 0.125f + bias;
            if ((cmw >> ko) & 1u) tmax = fmaxf(tmax, x[i]);
        }
        tmax = fmaxf(tmax, __shfl_xor(tmax, 32));
        const float mn = fmaxf(m, tmax);
        if (__ballot(mn > m) != 0ull) {
            const float scl = __builtin_amdgcn_exp2f((m - mn) * LOG2E);
            lsum *= scl;
#pragma unroll
            for (int q = 0; q < 16; ++q) { O0[q] *= scl; O1[q] *= scl; }
        }
        m = mn;
        float p[16];
#pragma unroll
        for (int i = 0; i < 16; ++i) { const int ko = (i & 3) + 8 * (i >> 2); p[i] = ((cmw >> ko) & 1u) ? __builtin_amdgcn_exp2f((x[i] - m) * LOG2E) : 0.f; lsum += p[i]; }
        union { unsigned u[4]; bf16x8 v; } pb0, pb1;
#pragma unroll
        for (int j = 0; j < 4; ++j) { pb0.u[j] = pg8::cvt_pk_bf16(p[2 * j], p[2 * j + 1]); pb1.u[j] = pg8::cvt_pk_bf16(p[8 + 2 * j], p[8 + 2 * j + 1]); }
        union { u64 q[2]; bf16x8 v; } a00, a01, a10, a11;
        a00.q[0] = cav[0][0][0]; a00.q[1] = cav[0][0][1]; a01.q[0] = cav[0][1][0]; a01.q[1] = cav[0][1][1];
        a10.q[0] = cav[1][0][0]; a10.q[1] = cav[1][0][1]; a11.q[0] = cav[1][1][0]; a11.q[1] = cav[1][1][1];
        O0 = __builtin_amdgcn_mfma_f32_32x32x16_bf16(a00.v, pb0.v, O0, 0, 0, 0);
        O0 = __builtin_amdgcn_mfma_f32_32x32x16_bf16(a01.v, pb1.v, O0, 0, 0, 0);
        O1 = __builtin_amdgcn_mfma_f32_32x32x16_bf16(a10.v, pb0.v, O1, 0, 0, 0);
        O1 = __builtin_amdgcn_mfma_f32_32x32x16_bf16(a11.v, pb1.v, O1, 0, 0, 0);
    }
    lsum += __shfl_xor(lsum, 32);
    const float inv = 1.0f / lsum;
    bf16_t* op = att + rowq * 512 + h * 64 + 4 * hh;
#pragma unroll
    for (int g4 = 0; g4 < 4; ++g4) {
        unsigned w0 = pg8::cvt_pk_bf16(O0[4 * g4] * inv, O0[4 * g4 + 1] * inv), w1 = pg8::cvt_pk_bf16(O0[4 * g4 + 2] * inv, O0[4 * g4 + 3] * inv);
        *(u64*)(op + 8 * g4) = (u64)w0 | ((u64)w1 << 32);
        w0 = pg8::cvt_pk_bf16(O1[4 * g4] * inv, O1[4 * g4 + 1] * inv); w1 = pg8::cvt_pk_bf16(O1[4 * g4 + 2] * inv, O1[4 * g4 + 3] * inv);
        *(u64*)(op + 32 + 8 * g4) = (u64)w0 | ((u64)w1 << 32);
    }
}

template <int KIND> __global__ void __launch_bounds__(NTHREADS, 2) fwd(Args args) {
    extern __shared__ __attribute__((aligned(16))) unsigned char lds[];
    const int tid = threadIdx.x, lane = tid & 63, wave = tid >> 6;
    const int G = gridDim.x;
    PG8_LAS unsigned char* const lds3 = (PG8_LAS unsigned char*)lds;
#define WS_OPAQUE() unsigned char* ws = args.ws; asm volatile("" : "+s"(ws)); int tid = threadIdx.x; asm volatile("" : "+v"(tid)); const int lane = tid & 63, wave = tid >> 6; (void)lane; (void)wave
#define ctl ((unsigned*)(ws + WS_CTL))
#define MOD ((float*)(ws + WS_MOD))
#define LB ((float*)(ws + WS_LB))
#define WIN ((bf16_t*)(ws + WS_WIN))
#define WPA ((bf16_t*)(ws + WS_WPA))
#define WPB ((bf16_t*)(ws + WS_WPB))
#define WOUT ((bf16_t*)(ws + WS_WOUT))
#define W1 ((bf16_t*)(ws + WS_W1))
#define W2 ((bf16_t*)(ws + WS_W2))
#define H ((bf16_t*)(ws + WS_H))
#define ZB ((bf16_t*)(ws + WS_Z))
#define VBT ((bf16_t*)(ws + WS_VBT))
#define Y ((bf16_t*)(ws + WS_Y))
#define XS ((bf16_t*)(ws + WS_XS))
#define ACT ((bf16_t*)(ws + WS_ACT))
#define ORAW ((float*)(ws + WS_ORAW))
#define TMP ((float*)(ws + WS_TMP))
#define HA ((bf16_t*)(ws + WS_HA))
#define ATT ((bf16_t*)(ws + WS_ATT))
#define MASK ((unsigned*)(ws + WS_MASK))
#define MERGED ((bf16_t*)(ws + WS_MERGED))
#define X1 ((float*)(ws + WS_X1))
#define X2 ((float*)(ws + WS_X2))
#define TOKE ((int*)(ws + WS_TOKE))
#define TOKG ((float*)(ws + WS_TOKG))
#define TOKP ((int*)(ws + WS_TOKP))
#define TOKS ((int*)(ws + WS_TOKS))
#define BLKE ((int*)(ws + WS_BLKE))
    const int lo = args.ph_lo, hi = args.ph_hi;
#define IN(k) ((KIND < 0 || ((k) == 0 ? KIND == 100 : KIND == ((k) - 1) % 11)) && lo <= (k) && (k) < hi)
#define SEAM(k) do { if (KIND < 0 && IN(k) && IN((k) + 1)) xcd_barrier(bar); } while (0)
    XcdBarrier bar; bar.bar = (unsigned*)(args.ws + WS_CTL) + CW_BAR; bar.x = 0; bar.st = nullptr;
    if (KIND < 0) {
        volatile LAS unsigned* xbw = (volatile LAS unsigned*)((LAS unsigned char*)lds + (LDS_BYTES - 16));
        if (tid == 0) { xbw[0] = 0u; xbw[1] = 0u; xbw[2] = 0u; xbw[3] = 0u; }
        __syncthreads();
        bar = xcd_barrier_post((unsigned*)(args.ws + WS_CTL) + CW_BAR, xbw);
    }

    if (IN(0)) {
        WS_OPAQUE();
        float* lt = (float*)lds;
        cvt_family(tid, args.in[I_WIN], WIN, D, ZC, ZLD, DEPTH, 0, lt);
        cvt_family(tid, args.in[I_WPA], WPA, 512, D, D, DEPTH, 0, lt);
        cvt_family(tid, args.in[I_WPB], WPB, 512, D, D, DEPTH, 0, lt);
        cvt_family(tid, args.in[I_WOUT], WOUT, D, D, D, DEPTH, 0, lt);
        cvt_family(tid, args.in[I_W1], W1, D, 2 * DFF, 2 * DFF, DEPTH * NE, 1, lt);
        cvt_family(tid, args.in[I_W2], W2, DFF, D, D, DEPTH * NE, 0, lt);
        {
            float* ca = (float*)lds;
            __syncthreads();
            for (int i = tid; i < NB * D; i += NTHREADS) { const float c = args.in[I_C][i]; ca[i] = c * sigmoidf_(c); }
            __syncthreads();
            for (int u = blockIdx.x; u < DEPTH * NMOD / NTHREADS; u += G) {
                const int ln = u * NTHREADS + tid, l = ln / NMOD, n = ln % NMOD;
                const float* w = args.in[I_WADA] + (size_t)l * D * NMOD + n;
                float acc[NB];
#pragma unroll
                for (int b = 0; b < NB; ++b) acc[b] = 0.f;
                for (int k = 0; k < D; ++k) { const float wv = w[(size_t)k * NMOD];
#pragma unroll
                    for (int b = 0; b < NB; ++b) acc[b] += ca[b * D + k] * wv; }
                const float bb = args.in[I_BADA][(size_t)l * NMOD + n];
#pragma unroll
                for (int b = 0; b < NB; ++b) MOD[((size_t)l * NB + b) * NMOD + n] = acc[b] + bb;
            }
            __syncthreads();
        }
        if (blockIdx.x == G - 1) {
            for (int j = tid; j < 512; j += NTHREADS) { const float a0 = args.in[I_LBL][j], a1 = args.in[I_LBL][512 + j]; LB[j] = 0.f; LB[512 + j] = 1.0f / (1.0f + __expf(a0 - a1)); }
        }
    }

    SEAM(0);
#pragma unroll
    for (int l = 0; l < DEPTH; ++l) {
        const int P = 1 + 11 * l;
#define mod (MOD + (size_t)l * NB * NMOD)
#define xin ((l == 0) ? args.in[I_X] : (const float*)X2)
        if (IN(P + 0) && l == 0) {
            WS_OPAQUE();
            const float* nw = args.in[I_NMW] + (size_t)l * D;
            for (int row = blockIdx.x * NWAVES + wave; row < T; row += G * NWAVES) {
                const int b = row >> 11; f32x4 v[4]; float ss = 0.f;
#pragma unroll
                for (int i = 0; i < 4; ++i) { v[i] = *(const f32x4*)(xin + (size_t)row * D + (lane + 64 * i) * 4); ss += v[i][0] * v[i][0] + v[i][1] * v[i][1] + v[i][2] * v[i][2] + v[i][3] * v[i][3]; }
                ss = wave_sum(ss); const float r = rsqrtf(ss * (1.0f / D) + EPS);
#pragma unroll
                for (int i = 0; i < 4; ++i) { const int c = (lane + 64 * i) * 4;
#pragma unroll
                    for (int j = 0; j < 4; ++j) H[(size_t)row * D + c + j] = f2bf(v[i][j] * r * nw[c + j] * (1.0f + mod[(size_t)b * NMOD + D + c + j]) + mod[(size_t)b * NMOD + c + j]); }
            }
        }
        if (l == 0) SEAM(P + 0);
        if (IN(P + 1)) {
            WS_OPAQUE();
            pg8::Gemm g{H, WIN + (size_t)l * ZLD * D, T, ZLD, D}; pg8::StaticOrder S; S.init(T, ZLD, G, (int)blockIdx.x);
            pg8::EpiZ E{ZB, ZLD};
            pg8::gemm_phase(lds3, tid, g, S, E);
        }
        SEAM(P + 1);
        if (IN(P + 2)) {
            WS_OPAQUE();
            for (int u = blockIdx.x; u < NB * 4 * 4; u += G) hgrn_item(ZB, LB + l * 512, ORAW, lds, u >> 4, (u >> 2) & 3, u & 3, tid);
            {
                for (int wt = blockIdx.x * NWAVES + wave; wt < (T / 64) * 8; wt += G * NWAVES) {
                    const int rg = wt >> 3, dg = wt & 7; const int row = rg * 64 + lane, bb = row >> 11, sidx = row & 2047;
                    const u32x4 w = *(const u32x4*)(ZB + (size_t)row * ZLD + C_VB + dg * 8);
                    bf16_t* vp = VBT + ((size_t)bb * 64 + dg * 8) * SEQ + sidx;
                    vp[0] = (bf16_t)(w.x & 0xffffu); vp[SEQ] = (bf16_t)(w.x >> 16); vp[2 * SEQ] = (bf16_t)(w.y & 0xffffu); vp[3 * SEQ] = (bf16_t)(w.y >> 16);
                    vp[4 * SEQ] = (bf16_t)(w.z & 0xffffu); vp[5 * SEQ] = (bf16_t)(w.z >> 16); vp[6 * SEQ] = (bf16_t)(w.w & 0xffffu); vp[7 * SEQ] = (bf16_t)(w.w >> 16);
                }
            }
            {
                unsigned* sc = (unsigned*)lds; unsigned* hist = sc + 16 * 2048 + wave * 256;
                __syncthreads();
                for (int u = blockIdx.x; u < T / 16; u += G) {
                    const int cc = u & 255, j = u >> 8; const int b = cc & 15, x = cc >> 4, pr = x + 16 * (j >> 1); const int q16 = (j & 1) ? 127 - pr : pr; const int t0 = q16 * 16;
                    if (t0 < 256) {
                        for (int i = tid; i < 16 * 64; i += NTHREADS) { const int qq = i >> 6, w = i & 63, n = t0 + qq + 1, lo_ = w * 32;
                            unsigned mm = 0u; if (n >= lo_ + 32) mm = 0xffffffffu; else if (n > lo_) mm = (1u << (n - lo_)) - 1u; MASK[(size_t)(b * SEQ + t0 + qq) * 64 + w] = mm; }
                    } else indexer_unit(ZB, MASK, sc, hist, b, t0, tid);
                }
                __syncthreads();
            }
        }
        SEAM(P + 2);
        if (IN(P + 3)) {
            WS_OPAQUE();
            const float* hnw = args.in[I_HNW] + (size_t)l * 512;
            for (int row = blockIdx.x * NWAVES + wave; row < T; row += G * NWAVES) {
                const int c0 = lane * 8; float o[8]; float ss = 0.f;
#pragma unroll
                for (int j = 0; j < 8; ++j) { o[j] = ORAW[(size_t)row * 512 + c0 + j]; ss += o[j] * o[j]; }
                ss += __shfl_xor(ss, 1); ss += __shfl_xor(ss, 2); ss += __shfl_xor(ss, 4); ss += __shfl_xor(ss, 8);
                const float r = rsqrtf(ss * (1.0f / 128.0f) + EPS);
#pragma unroll
                for (int j = 0; j < 8; ++j) { const float g = bf2f(ZB[(size_t)row * ZLD + C_GA + c0 + j]); HA[(size_t)row * 512 + c0 + j] = f2bf(o[j] * r * hnw[c0 + j] * (g * sigmoidf_(g))); }
            }
            {
                float* tb = (float*)lds;
                __syncthreads();
                for (int i = tid; i < 1024; i += NTHREADS) tb[i] = args.in[I_RELB][(int)T5_BUCKET[i >> 3] * 8 + (i & 7)];
                __syncthreads();
                for (int u = blockIdx.x; u < T / 32; u += G) {
                    const int cc = u & 255, j = u >> 8; const int b = cc & 15, x = cc >> 4, pr = x + 16 * (j >> 1); const int qt = (j & 1) ? 63 - pr : pr;
                    attn_wave(ZB, VBT, MASK, ATT, tb, b, qt * 32 + 4 * wave, lane);
                }
                __syncthreads();
            }
        }
        SEAM(P + 3);
        if (IN(P + 4)) {
            WS_OPAQUE();
            pg8::StaticOrder S; S.init(T, D, G, (int)blockIdx.x);
            { pg8::Gemm g{HA, WPA + (size_t)l * D * 512, T, D, 512}; pg8::EpiMerge<false> E{TMP, MERGED, ZB + C_GTA}; pg8::gemm_phase(lds3, tid, g, S, E); }
            { pg8::Gemm g{ATT, WPB + (size_t)l * D * 512, T, D, 512}; pg8::EpiMerge<true> E{TMP, MERGED, ZB + C_GTB}; pg8::gemm_phase(lds3, tid, g, S, E); }
        }
        SEAM(P + 4);
        if (IN(P + 5)) {
            WS_OPAQUE();
            pg8::Gemm g{MERGED, WOUT + (size_t)l * D * D, T, D, D}; pg8::StaticOrder S; S.init(T, D, G, (int)blockIdx.x);
            pg8::EpiOutG E{xin, X1, mod + 2 * D}; pg8::gemm_phase(lds3, tid, g, S, E);
        }
        SEAM(P + 5);
        if (IN(P + 6)) {
            WS_OPAQUE();
            const float* nw = args.in[I_NFW] + (size_t)l * D; const float* wr = args.in[I_WR] + (size_t)l * D * NE; const float* br = args.in[I_BR] + (size_t)l * NE;
            float* hrow = (float*)lds + wave * D;
            for (int tok = blockIdx.x * NWAVES + wave; tok < T; tok += G * NWAVES) {
                const int b = tok >> 11; f32x4 v[4]; float ss = 0.f;
#pragma unroll
                for (int i = 0; i < 4; ++i) { v[i] = *(const f32x4*)(X1 + (size_t)tok * D + (lane + 64 * i) * 4); ss += v[i][0] * v[i][0] + v[i][1] * v[i][1] + v[i][2] * v[i][2] + v[i][3] * v[i][3]; }
                ss = wave_sum(ss); const float r = rsqrtf(ss * (1.0f / D) + EPS);
                __syncthreads();
#pragma unroll
                for (int i = 0; i < 4; ++i) { const int c = (lane + 64 * i) * 4;
#pragma unroll
                    for (int j = 0; j < 4; ++j) { const float hv = v[i][j] * r * nw[c + j] * (1.0f + mod[(size_t)b * NMOD + 4 * D + c + j]) + mod[(size_t)b * NMOD + 3 * D + c + j]; hrow[c + j] = hv; H[(size_t)tok * D + c + j] = f2bf(hv); } }
                __syncthreads();
                const int e = lane & 31, half = lane >> 5; float acc = 0.f;
                for (int k = half * 512; k < half * 512 + 512; ++k) acc += hrow[k] * wr[(size_t)k * NE + e];
                acc += __shfl_xor(acc, 32);
                float logit = acc + br[e];
                float tv[4]; int ti[4];
#pragma unroll
                for (int k = 0; k < 4; ++k) {
                    float bv = logit; int bi = e;
#pragma unroll
                    for (int o = 16; o >= 1; o >>= 1) { const float ov = __shfl_xor(bv, o); const int oi = __shfl_xor(bi, o); if (ov > bv || (ov == bv && oi < bi)) { bv = ov; bi = oi; } }
                    tv[k] = bv; ti[k] = bi; if (e == bi) logit = -INFINITY;
                }
                const float e1 = __expf(tv[1] - tv[0]), e2 = __expf(tv[2] - tv[0]), e3 = __expf(tv[3] - tv[0]); const float inv = 1.0f / (1.0f + e1 + e2 + e3);
                if (lane < 4) { const int ee = lane == 0 ? ti[0] : lane == 1 ? ti[1] : lane == 2 ? ti[2] : ti[3]; const float gg = (lane == 0 ? 1.0f : lane == 1 ? e1 : lane == 2 ? e2 : e3) * inv;
                    TOKE[tok * 4 + lane] = ee; TOKG[tok * 4 + lane] = gg; TOKP[tok * 4 + lane] = (int)atomicAdd(&ctl[CW_CNT + l * 32 + ee], 1u); }
            }
        }
        SEAM(P + 6);
        if (IN(P + 7)) {
            WS_OPAQUE();
            int* ps = (int*)lds;
            __syncthreads();
            if (tid == 0) { int a = 0; for (int e = 0; e < NE; ++e) { ps[e] = a; a += (int)((ctl[CW_CNT + l * 32 + e] + 255u) / 256u) * 256; } ps[NE] = a; }
            __syncthreads();
            const int gt = blockIdx.x * NTHREADS + tid, gn = G * NTHREADS;
            for (int tok = blockIdx.x * NWAVES + wave; tok < T; tok += G * NWAVES) {
                const u32x4 r0 = *(const u32x4*)(H + (size_t)tok * D + lane * 8), r1 = *(const u32x4*)(H + (size_t)tok * D + 512 + lane * 8);
#pragma unroll
                for (int k = 0; k < 4; ++k) { const int e = TOKE[tok * 4 + k]; const int slot = ps[e] + TOKP[tok * 4 + k]; if (lane == 0) TOKS[tok * 4 + k] = slot;
                    *(u32x4*)(XS + (size_t)slot * D + lane * 8) = r0; *(u32x4*)(XS + (size_t)slot * D + 512 + lane * 8) = r1; }
            }
            for (int i = blockIdx.x * NWAVES + wave; i < NE * 256; i += G * NWAVES) {
                const int e = i >> 8, j = i & 255; const int c = (int)ctl[CW_CNT + l * 32 + e]; const int si = c + j;
                if (si < ps[e + 1] - ps[e]) { const u32x4 z = {0u, 0u, 0u, 0u}; *(u32x4*)(XS + (size_t)(ps[e] + si) * D + lane * 8) = z; *(u32x4*)(XS + (size_t)(ps[e] + si) * D + 512 + lane * 8) = z; } }
            const int nblk = ps[NE] / 256, nblk8 = (nblk + 7) & ~7;
            for (int mb = gt; mb < nblk8; mb += gn) { int e = 0; if (mb < nblk) { while (e < NE - 1 && mb * 256 >= ps[e + 1]) ++e; } BLKE[mb] = e; }
            if (gt == 0) ctl[CW_NBLK + l] = (unsigned)nblk8;
            __syncthreads();
        }
        SEAM(P + 7);
        if (IN(P + 8)) {
            WS_OPAQUE();
            const int nblk = __builtin_amdgcn_readfirstlane((int)ctl[CW_NBLK + l]);
            pg8::Gemm g{XS, W1 + (size_t)l * NE * 2 * DFF * D, nblk * 256, 2 * DFF, D}; pg8::MoeOrder<8> S; S.init(nblk, G, (int)blockIdx.x, BLKE);
            pg8::EpiSwigluG E{ACT, args.in[I_B1] + (size_t)l * NE * 2 * DFF}; pg8::gemm_phase(lds3, tid, g, S, E);
        }
        SEAM(P + 8);
        if (IN(P + 9)) {
            WS_OPAQUE();
            const int nblk = __builtin_amdgcn_readfirstlane((int)ctl[CW_NBLK + l]);
            pg8::Gemm g{ACT, W2 + (size_t)l * NE * D * DFF, nblk * 256, D, DFF}; pg8::MoeOrder<4> S; S.init(nblk, G, (int)blockIdx.x, BLKE);
            pg8::EpiYG E{Y, args.in[I_B2] + (size_t)l * NE * D}; pg8::gemm_phase(lds3, tid, g, S, E);
        }
        SEAM(P + 9);
        if (IN(P + 10)) {
            WS_OPAQUE();
            const bool last = (l == DEPTH - 1);
            const float* nw = last ? args.in[I_FNW] : args.in[I_NMW] + (size_t)(l + 1) * D;
            const float* modn = MOD + (size_t)(l + 1) * NB * NMOD;
            for (int tok = blockIdx.x * NWAVES + wave; tok < T; tok += G * NWAVES) {
                const int b = tok >> 11; f32x4 v[4], a[4];
#pragma unroll
                for (int i = 0; i < 4; ++i) { v[i] = *(const f32x4*)(X1 + (size_t)tok * D + (lane + 64 * i) * 4); a[i] = (f32x4){0.f, 0.f, 0.f, 0.f}; }
                for (int k = 0; k < 4; ++k) { const int slot = TOKS[tok * 4 + k]; const float g = TOKG[tok * 4 + k];
#pragma unroll
                    for (int i = 0; i < 4; ++i) { const unsigned* yp = (const unsigned*)(Y + (size_t)slot * D + (lane + 64 * i) * 4); const unsigned y0 = yp[0], y1 = yp[1];
                        f32x4 y; y[0] = __uint_as_float(y0 << 16); y[1] = __uint_as_float(y0 & 0xffff0000u); y[2] = __uint_as_float(y1 << 16); y[3] = __uint_as_float(y1 & 0xffff0000u); a[i] += g * y; } }
                float ss = 0.f;
#pragma unroll
                for (int i = 0; i < 4; ++i) { const int c = (lane + 64 * i) * 4; const f32x4 gf = *(const f32x4*)(mod + (size_t)b * NMOD + 5 * D + c); v[i] = v[i] + gf * a[i];
                    ss += v[i][0] * v[i][0] + v[i][1] * v[i][1] + v[i][2] * v[i][2] + v[i][3] * v[i][3]; }
                ss = wave_sum(ss); const float r = rsqrtf(ss * (1.0f / D) + EPS);
#pragma unroll
                for (int i = 0; i < 4; ++i) { const int c = (lane + 64 * i) * 4;
                    if (last) { f32x4 o;
#pragma unroll
                        for (int j = 0; j < 4; ++j) o[j] = v[i][j] * r * nw[c + j];
                        *(f32x4*)(args.out + (size_t)tok * D + c) = o;
                    } else {
                        *(f32x4*)(X2 + (size_t)tok * D + c) = v[i];
#pragma unroll
                        for (int j = 0; j < 4; ++j) H[(size_t)tok * D + c + j] = f2bf(v[i][j] * r * nw[c + j] * (1.0f + modn[(size_t)b * NMOD + D + c + j]) + modn[(size_t)b * NMOD + c + j]);
                    } }
            }
        }
        SEAM(P + 10);
    }
#undef IN
}

constexpr int N_PHASES = 1 + 11 * DEPTH;
typedef void (*kern_t)(Args);
template <int K> static kern_t kern_of() { return fwd<K>; }
static kern_t kern_for(int kind) {
    switch (kind) { case 0: return fwd<0>; case 1: return fwd<1>; case 2: return fwd<2>; case 3: return fwd<3>; case 4: return fwd<4>; case 5: return fwd<5>;
                    case 6: return fwd<6>; case 7: return fwd<7>; case 8: return fwd<8>; case 9: return fwd<9>; case 10: return fwd<10>; default: return fwd<100>; }
}

extern "C" void kernel_launch(void* const* d_in, const int* in_sizes, int n_in, void* d_out, int out_size, void* d_ws, size_t ws_size, hipStream_t stream) {
    static int grid = 0;
    if (grid == 0) {
        if (n_in != 20 || out_size != T * D || ws_size < WS_END) { fprintf(stderr, "kernel_launch: unexpected problem (n_in %d, out %d, ws %zu, need %zu)\n", n_in, out_size, ws_size, (size_t)WS_END); grid = -1; return; }
        int dev = 0, cus = 0;
        if (hipGetDevice(&dev) != hipSuccess || hipDeviceGetAttribute(&cus, hipDeviceAttributeMultiprocessorCount, dev) != hipSuccess) { grid = -1; return; }
        for (int k = 0; k <= 12; ++k) {
            if (hipFuncSetAttribute((const void*)(k == 12 ? (kern_t)fwd<-1> : kern_for(k)), hipFuncAttributeMaxDynamicSharedMemorySize, LDS_BYTES) != hipSuccess) { fprintf(stderr, "kernel_launch: hipFuncSetAttribute failed\n"); grid = -1; return; }
        }
        grid = cus > 0 ? cus : 256;
    }
    if (grid < 0) return;
    (void)hipMemsetAsync((char*)d_ws + WS_CTL, 0, CTL_BYTES, stream);
    Args a{};
    for (int i = 0; i < 20; ++i) a.in[i] = (const float*)d_in[i];
    a.out = (float*)d_out; a.ws = (unsigned char*)d_ws;
#if defined(MULTI_LAUNCH)
    for (int p = 0; p < N_PHASES; ++p) {
        if (p == 1 + 11) continue;
        a.ph_lo = p; a.ph_hi = p + 1;
        const int kind = p == 0 ? 11 : (p - 1) % 11;
        hipLaunchKernelGGL(kern_for(kind), dim3(grid), dim3(NTHREADS), LDS_BYTES, stream, a);
    }
#else
    a.ph_lo = 0; a.ph_hi = N_PHASES;
    hipLaunchKernelGGL(fwd<-1>, dim3(grid), dim3(NTHREADS), LDS_BYTES, stream, a);
#endif
}
```

```cpp
#include <hip/hip_runtime.h>
#include <stdint.h>
#include <stdio.h>

typedef unsigned short bf16_t;
typedef short bf16x8 __attribute__((ext_vector_type(8)));
typedef float f32x4 __attribute__((ext_vector_type(4)));
typedef float f32x16 __attribute__((ext_vector_type(16)));
typedef unsigned u32x4 __attribute__((ext_vector_type(4)));
#define LAS __attribute__((address_space(3)))

constexpr int T = 32768, D = 1024, NB = 16, SEQ = 2048, DEPTH = 2;
constexpr int ZC = 5320, ZLD = 5376;
constexpr int C_QA = 0, C_FA = 512, C_IA = 1024, C_GA = 1536, C_QB = 2048, C_KB = 2560, C_VB = 2624, C_IQ = 2688, C_IK = 3200, C_IW = 3264, C_GTA = 3272, C_GTB = 4296;
constexpr int NE = 32, DFF = 1024, NSLOT = 131072 + 32 * 256, NBLK_MAX = NSLOT / 256;
constexpr int NMOD = 6 * D;
constexpr float EPS = 1e-6f;
constexpr int NTHREADS = 512, NWAVES = 8;
#ifndef PROBE_GROUP
#define PROBE_GROUP 0
#endif
constexpr int probe_reps(int kind) { return (PROBE_GROUP == 1 && (kind == 1 || kind == 4 || kind == 5 || kind == 8 || kind == 9)) || (PROBE_GROUP == 2 && kind == 2) || (PROBE_GROUP == 3 && kind == 3) || (PROBE_GROUP == 4 && kind == 100) || (PROBE_GROUP == 5 && (kind == 6 || kind == 7 || kind == 10)) ? 2 : 1; }
constexpr int LDS_BYTES = 144 * 1024;

constexpr size_t al256(size_t x) { return (x + 255) & ~(size_t)255; }
constexpr size_t WS_CTL = 0;
constexpr size_t CTL_BYTES = 65536;
constexpr size_t WS_MOD = WS_CTL + CTL_BYTES;
constexpr size_t WS_LB = WS_MOD + al256((size_t)DEPTH * NB * NMOD * 4);
constexpr size_t WS_WIN = WS_LB + al256((size_t)DEPTH * 512 * 4);
constexpr size_t WS_WPA = WS_WIN + (size_t)DEPTH * ZLD * D * 2;
constexpr size_t WS_WPB = WS_WPA + (size_t)DEPTH * D * 512 * 2;
constexpr size_t WS_WOUT = WS_WPB + (size_t)DEPTH * D * 512 * 2;
constexpr size_t WS_W1 = WS_WOUT + (size_t)DEPTH * D * D * 2;
constexpr size_t WS_W2 = WS_W1 + (size_t)DEPTH * NE * 2 * DFF * D * 2;
constexpr size_t WS_H = WS_W2 + (size_t)DEPTH * NE * D * DFF * 2;
constexpr size_t WS_Z = WS_H + (size_t)T * D * 2;
constexpr size_t WS_Y = WS_Z;
constexpr size_t WS_ACT = WS_Z + (size_t)T * ZLD * 2;
constexpr size_t WS_ORAW = WS_ACT;
constexpr size_t WS_TMP = WS_ACT + (size_t)T * 512 * 4;
constexpr size_t WS_XS = WS_ACT + (size_t)NSLOT * DFF * 2;
constexpr size_t WS_HA = WS_XS + (size_t)NSLOT * D * 2;
constexpr size_t WS_ATT = WS_HA + (size_t)T * 512 * 2;
constexpr size_t WS_MASK = WS_ATT + (size_t)T * 512 * 2;
constexpr size_t WS_VBT = WS_MASK + (size_t)T * 64 * 4;
constexpr size_t WS_MERGED = WS_VBT + (size_t)T * 64 * 2;
constexpr size_t WS_X1 = WS_MERGED + (size_t)T * D * 2;
constexpr size_t WS_X2 = WS_X1 + (size_t)T * D * 4;
constexpr size_t WS_TOKE = WS_X2 + (size_t)T * D * 4;
constexpr size_t WS_TOKG = WS_TOKE + (size_t)T * 4 * 4;
constexpr size_t WS_TOKP = WS_TOKG + (size_t)T * 4 * 4;
constexpr size_t WS_TOKS = WS_TOKP + (size_t)T * 4 * 4;
constexpr size_t WS_BLKE = WS_TOKS + (size_t)T * 4 * 4;
constexpr size_t WS_BCNT = WS_BLKE + al256((size_t)(NBLK_MAX + 64) * 4);
constexpr size_t WS_END = WS_BCNT + (size_t)1024 * NE * 4;
static_assert((size_t)NSLOT * D * 2 <= (size_t)T * ZLD * 2, "Y must fit in Z");
static_assert((size_t)T * 512 * 4 + (size_t)T * D * 4 <= (size_t)NSLOT * DFF * 2, "ORAW+TMP must fit in ACT");
static_assert(WS_END <= ((size_t)1 << 31), "workspace layout exceeds 2 GiB");
constexpr int CW_CNT = 1024;
constexpr int CW_NBLK = 1200;

__device__ __forceinline__ bf16_t f2bf(float f) { unsigned u = __float_as_uint(f); u += 0x7fffu + ((u >> 16) & 1u); return (bf16_t)(u >> 16); }
__device__ __forceinline__ float bf2f(bf16_t b) { return __uint_as_float(((unsigned)b) << 16); }
__device__ __forceinline__ float sigmoidf_(float x) { return 1.0f / (1.0f + __expf(-x)); }
__device__ __forceinline__ float wave_sum(float v) {
#pragma unroll
    for (int o = 32; o >= 1; o >>= 1) v += __shfl_xor(v, o);
    return v;
}
__device__ __forceinline__ int wave_sum_i(int v) {
#pragma unroll
    for (int o = 32; o >= 1; o >>= 1) v += __shfl_xor(v, o);
    return v;
}
__device__ const unsigned char T5_BUCKET[128] = {
    0, 1, 2, 3, 4, 5, 6, 7, 8, 9, 10, 11, 12, 13, 14, 15, 16, 16, 16, 17, 17, 18, 18, 18, 19, 19, 19, 20, 20, 20, 20, 21, 21, 21, 21, 22, 22, 22, 22, 22, 23, 23, 23, 23, 23, 23, 24, 24, 24, 24, 24, 24, 25,
    25, 25, 25, 25, 25, 25, 26, 26, 26, 26, 26, 26, 26, 26, 27, 27, 27, 27, 27, 27, 27, 27, 27, 27, 28, 28, 28, 28, 28, 28, 28, 28, 28, 28, 29, 29, 29, 29, 29, 29, 29, 29, 29, 29, 29, 29, 30, 30, 30, 30, 30,
    30, 30, 30, 30, 30, 30, 30, 30, 30, 31, 31, 31, 31, 31, 31, 31, 31, 31, 31, 31, 31, 31, 31, 31};
__device__ __forceinline__ int t5_bucket(int rel) { return rel >= 128 ? 31 : (int)T5_BUCKET[rel]; }


#define XB_TMO      128
#define XB_XCNT(j)  (256  + 64 * (j))
#define XB_XSUB(j)  (1280 + 64 * (j))
#define XB_XGEN(j)  (2304 + 64 * (j))
#define XB_TOP      3328
#define XB_TOPGEN   3392
#define XCD_BAR_WORDS 3456
#define XB_SPIN_CAP (1u << 18)
__device__ __forceinline__ unsigned xb_ld(unsigned* p)              { return __hip_atomic_load(p, __ATOMIC_RELAXED, __HIP_MEMORY_SCOPE_AGENT); }
__device__ __forceinline__ unsigned xb_add(unsigned* p, unsigned v) { return __hip_atomic_fetch_add(p, v, __ATOMIC_RELAXED, __HIP_MEMORY_SCOPE_AGENT); }
__device__ __forceinline__ unsigned xb_xcc_id() { return (unsigned)__builtin_amdgcn_s_getreg((3 << 11) | 20) & 0xFu; }
#define XB_SPIN(cond, bar) do { unsigned _sp = 0; while (cond) { __builtin_amdgcn_s_sleep(1); \
    if ((++_sp & 255u) == 0u) { if (xb_ld(&(bar)[XB_TMO])) break; if (_sp > XB_SPIN_CAP) { atomicAdd(&(bar)[XB_TMO], 1u); break; } } } } while (0)
struct XcdBarrier { unsigned* bar; unsigned x; volatile LAS unsigned* st; };
__device__ __forceinline__ XcdBarrier xcd_barrier_post(unsigned* bar, volatile LAS unsigned* st) {
    XcdBarrier b; b.bar = bar; b.x = xb_xcc_id(); b.st = st;
    if (threadIdx.x == 0) (void)xb_add(&bar[XB_XCNT(b.x)], 1u);
    return b;
}
__device__ __forceinline__ void xcd_barrier_complete(unsigned* bar, unsigned x, unsigned& nloc, unsigned& nx) {
    const unsigned G = gridDim.x * gridDim.y * gridDim.z;
    unsigned sum, cnt, mine, sp = 0u;
    for (;;) {
        sum = 0u; cnt = 0u; mine = 0u;
#pragma unroll
        for (unsigned j = 0; j < 16; ++j) { const unsigned c = xb_ld(&bar[XB_XCNT(j)]); sum += c; cnt += (c > 0u) ? 1u : 0u; mine = (j == x) ? c : mine; }
        if (sum == G) break;
        __builtin_amdgcn_s_sleep(1);
        if ((++sp & 255u) == 0u) { if (xb_ld(&bar[XB_TMO])) break; if (sp > XB_SPIN_CAP) { atomicAdd(&bar[XB_TMO], 1u); break; } }
    }
    nloc = mine > 0u ? mine : 1u; nx = cnt > 0u ? cnt : 1u;
}
__device__ __forceinline__ void xcd_barrier(const XcdBarrier& b) {
    asm volatile("s_waitcnt vmcnt(0)" ::: "memory");
    __syncthreads();
    if (threadIdx.x == 0) {
        unsigned* bar = b.bar; asm volatile("" : "+s"(bar));
        __builtin_amdgcn_s_waitcnt(0);
        unsigned nloc = b.st[0], nx = b.st[1];
        if (nloc == 0u) { xcd_barrier_complete(bar, b.x, nloc, nx); b.st[0] = nloc; b.st[1] = nx; }
        const unsigned old = xb_add(&bar[XB_XSUB(b.x)], 1u);
        const unsigned gen = old / nloc;
        if (old + 1u == (gen + 1u) * nloc) {
            __builtin_amdgcn_fence(__ATOMIC_RELEASE, "agent");
            asm volatile("s_waitcnt vmcnt(0)" ::: "memory");
            const unsigned og = xb_add(&bar[XB_TOP], 1u);
            const unsigned tg = og / nx;
            if (og + 1u == (tg + 1u) * nx) xb_add(&bar[XB_TOPGEN], 1u);
            else XB_SPIN(xb_ld(&bar[XB_TOPGEN]) == tg, bar);
            __builtin_amdgcn_fence(__ATOMIC_ACQUIRE, "agent");
            xb_add(&bar[XB_XGEN(b.x)], 1u);
            asm volatile("s_waitcnt vmcnt(0)" ::: "memory");
        } else {
            XB_SPIN(xb_ld(&bar[XB_XGEN(b.x)]) == gen, bar);
            __builtin_amdgcn_fence(__ATOMIC_ACQUIRE, "agent");
            asm volatile("s_waitcnt vmcnt(0)" ::: "memory");
        }
    }
    __syncthreads();
}
constexpr int CW_BAR = 4096;

struct Args { const float* in[20]; float* out; unsigned char* ws; int ph_lo, ph_hi; };
enum { I_X = 0, I_C, I_WADA, I_BADA, I_NMW, I_WIN, I_LBL, I_HNW, I_RELB, I_WPA, I_WPB, I_WOUT, I_NFW, I_WR, I_BR, I_W1, I_B1, I_W2, I_B2, I_FNW };

namespace pg8 {
#define PG8_LAS __attribute__((address_space(3)))
constexpr int BM = 256, BK = 64, HALF = 128, HTB = HALF * BK * 2, STAGE_BYTES = 8 * HTB, NXCD = 8, WGM = 8;
__host__ __device__ __forceinline__ int lds_byte(int r, int c) { const int st = (r >> 4) * 2 + (c >> 5), rr = r & 15, cc = c & 31, ob = rr * 64 + cc * 2; return st * 1024 + (ob ^ (((ob >> 9) & 1) << 5)); }
__host__ __device__ __forceinline__ void stage_rc(int b, int& R, int& C) { const int st = b / 1024, sb = b % 1024, swz = sb ^ (((sb >> 9) & 1) << 5); R = (st >> 1) * 16 + swz / 64; C = (st & 1) * 32 + (swz % 64) / 2; }
__host__ __device__ __forceinline__ int perm32(int rho) { const int n = rho >> 4, i = rho & 15; return 8 * (i >> 2) + 4 * n + (i & 3); }
struct Unit { int pm, pn, brow, e; };
struct Gemm { const bf16_t* A; const bf16_t* Bt; int M, N, K; };
struct StaticOrder {
    int nM, nN, nwg, G, c;
    __device__ void init(int M, int N, int G_, int c_) { nM = M / BM; nN = N / BM; nwg = nM * nN; G = G_; c = c_; }
    __device__ bool next(int i, Unit& u) const {
        const long L = (long)i * G + c; if (L >= nwg) return false;
        int wgid = (int)L; { const int q = nwg / NXCD, r = nwg % NXCD, xcd = wgid % NXCD, off = wgid / NXCD; wgid = (xcd < r ? xcd * (q + 1) : r * (q + 1) + (xcd - r) * q) + off; }
        const int nig = WGM * nN, gid = wgid / nig, fm = gid * WGM, gsz = (nM - fm) < WGM ? (nM - fm) : WGM;
        u.pm = fm + ((wgid % nig) % gsz); u.pn = (wgid % nig) / gsz; u.brow = u.pn * BM; u.e = 0; return true;
    }
    __device__ __forceinline__ void a_ready(const Unit&) const {}
    __device__ __forceinline__ void done(const Unit&) const {}
};
template <int NN> struct MoeOrder {
    int nwg, G, c; const int* blke;
    __device__ void init(int nM, int G_, int c_, const int* blke_) { nwg = nM * NN; G = G_; c = c_; blke = blke_; }
    __device__ bool next(int i, Unit& u) const {
        const int L = i * G + c; if (L >= nwg) return false;
        const int wgid = (L & 7) * (nwg >> 3) + (L >> 3);
        const int gid = wgid / (8 * NN), rem = wgid % (8 * NN);
        u.pm = gid * 8 + (rem & 7); u.pn = rem >> 3; u.e = __builtin_amdgcn_readfirstlane(blke[u.pm]); u.brow = u.e * (NN * BM) + u.pn * BM; return true;
    }
    __device__ __forceinline__ void a_ready(const Unit&) const {}
    __device__ __forceinline__ void done(const Unit&) const {}
};
typedef __bf16 bf16x2v_t __attribute__((ext_vector_type(2)));
typedef float f32x2v_t __attribute__((ext_vector_type(2)));
__device__ __forceinline__ unsigned cvt_pk_bf16(float lo, float hi) { const f32x2v_t v = {lo, hi}; const bf16x2v_t r = __builtin_convertvector(v, bf16x2v_t); return __builtin_bit_cast(unsigned, r); }


struct EpiZ {
    static constexpr bool PERM = true, AFTER_DRAIN = false;
    bf16_t* C; int ldc;
    __device__ __forceinline__ void operator()(const f32x4 (&acc)[2][2][4][2], const Unit& u, int wr, int wc, int fr, int fq) const {
        const int row0 = u.pm * BM + wr * 64 + fr, col0 = u.pn * BM + wc * 32 + 8 * fq;
#pragma unroll
        for (int ai = 0; ai < 2; ++ai)
#pragma unroll
            for (int m = 0; m < 4; ++m) { bf16_t* rowp = C + (size_t)(row0 + ai * HALF + m * 16) * ldc + col0;
#pragma unroll
                for (int bj = 0; bj < 2; ++bj) { const f32x4 v0 = acc[ai][bj][m][0], v1 = acc[ai][bj][m][1];
                    u32x4 w; w.x = cvt_pk_bf16(v0[0], v0[1]); w.y = cvt_pk_bf16(v0[2], v0[3]); w.z = cvt_pk_bf16(v1[0], v1[1]); w.w = cvt_pk_bf16(v1[2], v1[3]);
                    *(u32x4*)(rowp + bj * HALF) = w; } }
    }
};
__device__ __forceinline__ void bf8_to_f32(const u32x4 w, f32x4& lo, f32x4& hi) {
    lo[0] = __uint_as_float(w.x << 16); lo[1] = __uint_as_float(w.x & 0xffff0000u); lo[2] = __uint_as_float(w.y << 16); lo[3] = __uint_as_float(w.y & 0xffff0000u);
    hi[0] = __uint_as_float(w.z << 16); hi[1] = __uint_as_float(w.z & 0xffff0000u); hi[2] = __uint_as_float(w.w << 16); hi[3] = __uint_as_float(w.w & 0xffff0000u);
}
__device__ __forceinline__ f32x4 sig4(f32x4 g) { f32x4 r; r[0] = sigmoidf_(g[0]); r[1] = sigmoidf_(g[1]); r[2] = sigmoidf_(g[2]); r[3] = sigmoidf_(g[3]); return r; }
template <bool SECOND> struct EpiMerge {
    static constexpr bool PERM = true, AFTER_DRAIN = false;
    float* tmp; bf16_t* merged; const bf16_t* Zg  ;
    __device__ __forceinline__ void operator()(const f32x4 (&acc)[2][2][4][2], const Unit& u, int wr, int wc, int fr, int fq) const {
        const int row0 = u.pm * BM + wr * 64 + fr, col0 = u.pn * BM + wc * 32 + 8 * fq;
#pragma unroll
        for (int ai = 0; ai < 2; ++ai)
#pragma unroll
            for (int m = 0; m < 4; ++m) { const size_t row = (size_t)(row0 + ai * HALF + m * 16);
#pragma unroll
                for (int bj = 0; bj < 2; ++bj) { const int col = col0 + bj * HALF;
                    f32x4 g0, g1; bf8_to_f32(*(const u32x4*)(Zg + row * ZLD + col), g0, g1); g0 = sig4(g0); g1 = sig4(g1);
                    f32x4 v0 = g0 * acc[ai][bj][m][0], v1 = g1 * acc[ai][bj][m][1];
                    if (!SECOND) { *(f32x4*)(tmp + row * D + col) = v0; *(f32x4*)(tmp + row * D + col + 4) = v1; }
                    else { v0 += *(const f32x4*)(tmp + row * D + col); v1 += *(const f32x4*)(tmp + row * D + col + 4);
                        u32x4 w; w.x = cvt_pk_bf16(v0[0], v0[1]); w.y = cvt_pk_bf16(v0[2], v0[3]); w.z = cvt_pk_bf16(v1[0], v1[1]); w.w = cvt_pk_bf16(v1[2], v1[3]);
                        *(u32x4*)(merged + row * D + col) = w; } } }
    }
};
struct EpiOutG {
    static constexpr bool PERM = false, AFTER_DRAIN = false;
    const float* xin; float* x1; const float* gate  ;
    __device__ __forceinline__ void operator()(const f32x4 (&acc)[2][2][4][2], const Unit& u, int wr, int wc, int fr, int fq) const {
        const int row0 = u.pm * BM + wr * 64 + fr, col0 = u.pn * BM + wc * 32 + 4 * fq; const int b = (u.pm * BM) >> 11;
        f32x4 gv[2][2];
#pragma unroll
        for (int bj = 0; bj < 2; ++bj)
#pragma unroll
            for (int n = 0; n < 2; ++n) gv[bj][n] = *(const f32x4*)(gate + (size_t)b * NMOD + col0 + bj * HALF + n * 16);
#pragma unroll
        for (int ai = 0; ai < 2; ++ai)
#pragma unroll
            for (int m = 0; m < 4; ++m) { const size_t off = (size_t)(row0 + ai * HALF + m * 16) * D + col0;
#pragma unroll
                for (int bj = 0; bj < 2; ++bj)
#pragma unroll
                    for (int n = 0; n < 2; ++n) *(f32x4*)(x1 + off + bj * HALF + n * 16) = *(const f32x4*)(xin + off + bj * HALF + n * 16) + gv[bj][n] * acc[ai][bj][m][n]; }
    }
};
struct EpiSwigluG {
    static constexpr bool PERM = true, AFTER_DRAIN = false;
    bf16_t* act; const float* b1  ;
    __device__ __forceinline__ void operator()(const f32x4 (&acc)[2][2][4][2], const Unit& u, int wr, int wc, int fr, int fq) const {
        const int row0 = u.pm * BM + wr * 64 + fr, col0 = u.pn * HALF + wc * 32 + 8 * fq;
        f32x4 bg[2], bl[2];
#pragma unroll
        for (int n = 0; n < 2; ++n) { bg[n] = *(const f32x4*)(b1 + (size_t)u.e * 2 * DFF + col0 + 4 * n); bl[n] = *(const f32x4*)(b1 + (size_t)u.e * 2 * DFF + DFF + col0 + 4 * n); }
#pragma unroll
        for (int ai = 0; ai < 2; ++ai)
#pragma unroll
            for (int m = 0; m < 4; ++m) { float o[8];
#pragma unroll
                for (int n = 0; n < 2; ++n) { const f32x4 gl = acc[ai][0][m][n] + bg[n], li = acc[ai][1][m][n] + bl[n];
#pragma unroll
                    for (int j = 0; j < 4; ++j) { const float g = fminf(gl[j], 7.0f), l = fminf(fmaxf(li[j], -7.0f), 7.0f); o[4 * n + j] = g * sigmoidf_(1.702f * g) * (l + 1.0f); } }
                u32x4 w; w.x = cvt_pk_bf16(o[0], o[1]); w.y = cvt_pk_bf16(o[2], o[3]); w.z = cvt_pk_bf16(o[4], o[5]); w.w = cvt_pk_bf16(o[6], o[7]);
                *(u32x4*)(act + (size_t)(row0 + ai * HALF + m * 16) * DFF + col0) = w; }
    }
};
struct EpiYG {
    static constexpr bool PERM = true, AFTER_DRAIN = false;
    bf16_t* Yb; const float* b2  ;
    __device__ __forceinline__ void operator()(const f32x4 (&acc)[2][2][4][2], const Unit& u, int wr, int wc, int fr, int fq) const {
        const int row0 = u.pm * BM + wr * 64 + fr, col0 = u.pn * BM + wc * 32 + 8 * fq;
        f32x4 bv[2][2];
#pragma unroll
        for (int bj = 0; bj < 2; ++bj)
#pragma unroll
            for (int n = 0; n < 2; ++n) bv[bj][n] = *(const f32x4*)(b2 + (size_t)u.e * D + col0 + bj * HALF + 4 * n);
#pragma unroll
        for (int ai = 0; ai < 2; ++ai)
#pragma unroll
            for (int m = 0; m < 4; ++m) { bf16_t* rowp = Yb + (size_t)(row0 + ai * HALF + m * 16) * D + col0;
#pragma unroll
                for (int bj = 0; bj < 2; ++bj) { const f32x4 v0 = acc[ai][bj][m][0] + bv[bj][0], v1 = acc[ai][bj][m][1] + bv[bj][1];
                    u32x4 w; w.x = cvt_pk_bf16(v0[0], v0[1]); w.y = cvt_pk_bf16(v0[2], v0[3]); w.z = cvt_pk_bf16(v1[0], v1[1]); w.w = cvt_pk_bf16(v1[2], v1[3]);
                    *(u32x4*)(rowp + bj * HALF) = w; } }
    }
};

template <class Epi, class Sched>
__device__ __forceinline__ void gemm_phase(PG8_LAS unsigned char* lds, const int tid, const Gemm g, const Sched& S, const Epi& E) {
    const int wid = __builtin_amdgcn_readfirstlane(tid >> 6), lane = tid & 63, wr = wid >> 2, wc = wid & 3, fr = lane & 15, fq = lane >> 4;
    const int K = g.K, nt = K / BK;
    unsigned voffA[2], voffB[2];
#pragma unroll
    for (int i = 0; i < 2; ++i) { int R, C; stage_rc(tid * 16 + i * 8192, R, C); const int Rb = Epi::PERM ? ((R & ~31) + perm32(R & 31)) : R;
        voffA[i] = (unsigned)(R * K + C) * 2u; voffB[i] = (unsigned)(Rb * K + C) * 2u; }
    const size_t kstep = (size_t)(BK * 2);
    const size_t hstep = (size_t)HALF * K * 2;
    const size_t tstep = 2 * hstep;
    const unsigned ldsw = (unsigned)wid * 1024u;
    const int aoff = lds_byte(wr * 64 + fr, fq * 8), boff = lds_byte(wc * 32 + fr, fq * 8);
#define PG8_SA(b, h) (((b) * 2 + (h)) * HTB)
#define PG8_SB(b, h) ((4 + (b) * 2 + (h)) * HTB)
#define PG8_STAGE(bufoff, gbase, voff) do { _Pragma("unroll") for (int _i = 0; _i < 2; ++_i) \
        __builtin_amdgcn_global_load_lds((const unsigned*)((const char*)(gbase) + (voff)[_i]), (PG8_LAS unsigned*)(lds + (bufoff) + ldsw + _i * 8192), 16, 0, 0); } while (0)
#define PG8_LDA(dst, b, h) do { _Pragma("unroll") for (int m = 0; m < 4; ++m) _Pragma("unroll") for (int k = 0; k < 2; ++k) dst[m][k] = *(const PG8_LAS bf16x8*)(lds + PG8_SA(b, h) + aoff + m * 2048 + k * 1024); } while (0)
#define PG8_LDB(dst, b, h) do { _Pragma("unroll") for (int n = 0; n < 2; ++n) _Pragma("unroll") for (int k = 0; k < 2; ++k) dst[n][k] = *(const PG8_LAS bf16x8*)(lds + PG8_SB(b, h) + boff + n * 2048 + k * 1024); } while (0)
#define PG8_MMA(ai, bj, At, Bt) do { __builtin_amdgcn_s_setprio(1); _Pragma("unroll") for (int m = 0; m < 4; ++m) _Pragma("unroll") for (int n = 0; n < 2; ++n) _Pragma("unroll") for (int k = 0; k < 2; ++k) \
        acc[ai][bj][m][n] = __builtin_amdgcn_mfma_f32_16x16x32_bf16(Bt[n][k], At[m][k], acc[ai][bj][m][n], 0, 0, 0); __builtin_amdgcn_s_setprio(0); } while (0)
#define PG8_WAIT_V(n) asm volatile("s_waitcnt vmcnt(" #n ")" ::: "memory")
#define PG8_WAIT_L(n) asm volatile("s_waitcnt lgkmcnt(" #n ")" ::: "memory")
#define PG8_BAR __builtin_amdgcn_s_barrier()
#define PG8_SCHED __builtin_amdgcn_sched_barrier(0)
    Unit cur, nxt; int ui = 0;
    if (!S.next(0, cur)) return;
    f32x4 acc[2][2][4][2];
#pragma unroll
    for (int a = 0; a < 2; ++a)
#pragma unroll
        for (int b = 0; b < 2; ++b)
#pragma unroll
            for (int m = 0; m < 4; ++m)
#pragma unroll
                for (int n = 0; n < 2; ++n) acc[a][b][m][n] = (f32x4){0.f, 0.f, 0.f, 0.f};
    bf16x8 At[4][2], B0[2][2], B1[2][2];
    const char* cA = (const char*)g.A + (size_t)cur.pm * tstep; const char* cB = (const char*)g.Bt + (size_t)cur.brow * K * 2;
    S.a_ready(cur);
    PG8_STAGE(PG8_SB(0, 0), cB, voffB); PG8_STAGE(PG8_SA(0, 0), cA, voffA); PG8_STAGE(PG8_SB(0, 1), cB + hstep, voffB); PG8_STAGE(PG8_SA(0, 1), cA + hstep, voffA);
    if (wr == 1) PG8_BAR;
    PG8_WAIT_V(4); PG8_BAR;
    PG8_STAGE(PG8_SB(1, 0), cB + kstep, voffB); PG8_STAGE(PG8_SA(1, 0), cA + kstep, voffA); PG8_STAGE(PG8_SB(1, 1), cB + hstep + kstep, voffB);
    PG8_WAIT_V(6); PG8_BAR;
    for (;;) {
        const bool has_next = S.next(ui + 1, nxt);
        const char* nA = has_next ? (const char*)g.A + (size_t)nxt.pm * tstep : cA; const char* nB = has_next ? (const char*)g.Bt + (size_t)nxt.brow * K * 2 : cB;
        for (int t = 0; t < nt; t += 2) {
            const bool last = (t == nt - 2);
            const char* a1 = cA + (size_t)(t + 1) * kstep;
            const char* a2 = last ? nA : cA + (size_t)(t + 2) * kstep; const char* b2 = last ? nB : cB + (size_t)(t + 2) * kstep;
            const char* a3 = a2 + kstep; const char* b3 = b2 + kstep;
            if (last && has_next) S.a_ready(nxt);
            PG8_LDB(B0, 0, 0); PG8_SCHED; PG8_LDA(At, 0, 0); PG8_STAGE(PG8_SA(1, 1), a1 + hstep, voffA);
            PG8_WAIT_L(8); PG8_BAR; PG8_WAIT_L(0); PG8_MMA(0, 0, At, B0); PG8_BAR; PG8_SCHED;
            PG8_LDB(B1, 0, 1); PG8_STAGE(PG8_SB(0, 0), b2, voffB);
            PG8_BAR; PG8_WAIT_L(0); PG8_MMA(0, 1, At, B1); PG8_BAR;
            PG8_LDA(At, 0, 1); PG8_STAGE(PG8_SA(0, 0), a2, voffA);
            PG8_BAR; PG8_WAIT_L(0); PG8_MMA(1, 0, At, B0); PG8_BAR; PG8_SCHED;
            PG8_STAGE(PG8_SB(0, 1), b2 + hstep, voffB);
            PG8_WAIT_V(6); PG8_BAR; PG8_MMA(1, 1, At, B1); PG8_BAR;
            PG8_LDB(B0, 1, 0); PG8_SCHED; PG8_LDA(At, 1, 0); PG8_STAGE(PG8_SA(0, 1), a2 + hstep, voffA);
            PG8_WAIT_L(8); PG8_BAR; PG8_WAIT_L(0); PG8_MMA(0, 0, At, B0); PG8_BAR; PG8_SCHED;
            PG8_LDB(B1, 1, 1); PG8_STAGE(PG8_SB(1, 0), b3, voffB);
            PG8_BAR; PG8_WAIT_L(0); PG8_MMA(0, 1, At, B1); PG8_BAR;
            PG8_LDA(At, 1, 1); PG8_STAGE(PG8_SA(1, 0), a3, voffA);
            PG8_BAR; PG8_WAIT_L(0); PG8_MMA(1, 0, At, B0); PG8_BAR; PG8_SCHED;
            PG8_STAGE(PG8_SB(1, 1), b3 + hstep, voffB);
            PG8_WAIT_V(6); PG8_BAR; PG8_MMA(1, 1, At, B1); PG8_BAR;
        }
        if constexpr (!Epi::AFTER_DRAIN) { E(acc, cur, wr, wc, fr, fq); S.done(cur); }
        if (!has_next) break;
#pragma unroll
        for (int a = 0; a < 2; ++a)
#pragma unroll
            for (int b = 0; b < 2; ++b)
#pragma unroll
                for (int m = 0; m < 4; ++m)
#pragma unroll
                    for (int n = 0; n < 2; ++n) acc[a][b][m][n] = (f32x4){0.f, 0.f, 0.f, 0.f};
        cur = nxt; cA = nA; cB = nB; ++ui;
    }
    PG8_WAIT_V(0);
    if (wr == 0) PG8_BAR;
    PG8_BAR;
    if constexpr (Epi::AFTER_DRAIN) { E.fused(acc, cur, wr, wc, fr, fq, lds, wid, lane); S.done(cur); }
#undef PG8_SA
#undef PG8_SB
#undef PG8_STAGE
#undef PG8_LDA
#undef PG8_LDB
#undef PG8_MMA
#undef PG8_WAIT_V
#undef PG8_WAIT_L
#undef PG8_BAR
#undef PG8_SCHED
}
}


struct CvtJob { const float* src; bf16_t* dst; int N  , K  , nvalid  , sc0, sc1  ; };
constexpr int CJ_WIN = DEPTH * 16 * 21, CJ_WPA = DEPTH * 8 * 4, CJ_WPB = CJ_WPA, CJ_WOUT = DEPTH * 16 * 4, CJ_W1 = DEPTH * NE * 16 * 8, CJ_W2 = DEPTH * NE * 16 * 4;
constexpr int CJ_TOTAL = CJ_WIN + CJ_WPA + CJ_WPB + CJ_WOUT + CJ_W1 + CJ_W2;
__device__ __forceinline__ CvtJob cvt_job(int J, const float* const* in, unsigned char* ws) {
    CvtJob j;
    if (J < CJ_WIN) { const int m = J / (16 * 21), r = J % (16 * 21), kt = r / 21, ns = r % 21;
        j.src = in[I_WIN] + (size_t)m * D * ZC + (size_t)kt * 64 * ZC; j.dst = (bf16_t*)(ws + WS_WIN) + (size_t)m * ZLD * D + (size_t)ns * 256 * D + kt * 64; j.N = ZC; j.K = D;
        j.nvalid = ZC - ns * 256 < 256 ? ZC - ns * 256 : 256; j.sc0 = ns * 256; j.sc1 = ns * 256 + 128; return j; }
    J -= CJ_WIN;
    if (J < CJ_WPA + CJ_WPB) { const int which = J / CJ_WPA, JJ = J % CJ_WPA; const int m = JJ / 32, r = JJ % 32, kt = r / 4, ns = r % 4;
        j.src = in[which ? I_WPB : I_WPA] + (size_t)m * 512 * D + (size_t)kt * 64 * D; j.dst = (bf16_t*)(ws + (which ? WS_WPB : WS_WPA)) + (size_t)m * D * 512 + (size_t)ns * 256 * 512 + kt * 64; j.N = D; j.K = 512;
        j.nvalid = 256; j.sc0 = ns * 256; j.sc1 = ns * 256 + 128; return j; }
    J -= CJ_WPA + CJ_WPB;
    if (J < CJ_WOUT) { const int m = J / 64, r = J % 64, kt = r / 4, ns = r % 4;
        j.src = in[I_WOUT] + (size_t)m * D * D + (size_t)kt * 64 * D; j.dst = (bf16_t*)(ws + WS_WOUT) + (size_t)m * D * D + (size_t)ns * 256 * D + kt * 64; j.N = D; j.K = D;
        j.nvalid = 256; j.sc0 = ns * 256; j.sc1 = ns * 256 + 128; return j; }
    J -= CJ_WOUT;
    if (J < CJ_W1) { const int m = J / 128, r = J % 128, kt = r / 8, ns = r % 8;
        j.src = in[I_W1] + (size_t)m * D * 2 * DFF + (size_t)kt * 64 * 2 * DFF; j.dst = (bf16_t*)(ws + WS_W1) + (size_t)m * 2 * DFF * D + (size_t)ns * 256 * D + kt * 64; j.N = 2 * DFF; j.K = D;
        j.nvalid = 256; j.sc0 = 128 * ns; j.sc1 = DFF + 128 * ns; return j; }
    J -= CJ_W1;
    { const int m = J / 64, r = J % 64, kt = r / 4, ns = r % 4;
        j.src = in[I_W2] + (size_t)m * DFF * D + (size_t)kt * 64 * D; j.dst = (bf16_t*)(ws + WS_W2) + (size_t)m * D * DFF + (size_t)ns * 256 * DFF + kt * 64; j.N = D; j.K = DFF;
        j.nvalid = 256; j.sc0 = ns * 256; j.sc1 = ns * 256 + 128; return j; }
}
__device__ __forceinline__ void cvt_load(const CvtJob& j, const int tid, f32x4 (&v)[8]) {
    const int i = tid >> 3, c0 = (tid & 7) * 32; const float* p = j.src + (size_t)i * j.N + (c0 < 128 ? j.sc0 + c0 : j.sc1 + c0 - 128);
#pragma unroll
    for (int q = 0; q < 8; ++q) v[q] = (c0 + 4 * q < j.nvalid) ? *(const f32x4*)(p + 4 * q) : (f32x4){0.f, 0.f, 0.f, 0.f};
}

__device__ __forceinline__ void hgrn_item(const bf16_t* __restrict__ zb, const float* __restrict__ lbv, float* __restrict__ oraw, unsigned char* ldsb, const int b, const int h, const int dvq, const int tid) {
    typedef unsigned long long u64;
    const int lane = tid & 63, wave = tid >> 6, r31 = lane & 31, hh = lane >> 5;
    bf16_t* QE = (bf16_t*)ldsb;
    bf16_t* KE = QE + 64 * 136;
    bf16_t* KET = KE + 64 * 136;
    bf16_t* VT = KET + 128 * 72;
    bf16_t* SBT = VT + 32 * 72;
    float* ex = (float*)(SBT + 32 * 136);
    float* er = ex + 512; float* el = er + 128; float* elr = el + 128;
    const int d = tid & 127, tg = tid >> 7;
    const float lb = lbv[h * 128 + d], oml = 1.0f - lb;
    const int vs = tid & 63, v0 = (tid >> 6) * 4;
    const bf16_t* fbase = zb + (size_t)(b * SEQ + 16 * tg) * ZLD + C_FA + h * 128 + d;
    const bf16_t* qbase = zb + (size_t)(b * SEQ + 16 * tg) * ZLD + C_QA + h * 128 + d;
    const bf16_t* vbase = zb + (size_t)(b * SEQ + vs) * ZLD + C_IA + h * 128 + dvq * 32 + v0;
    bf16_t nf[16], nq[16]; u64 nv;
#pragma unroll
    for (int j = 0; j < 16; ++j) { nf[j] = fbase[(size_t)j * ZLD]; nq[j] = qbase[(size_t)j * ZLD]; }
    nv = *(const u64*)vbase;
    f32x16 Sacc;
#pragma unroll
    for (int i = 0; i < 16; ++i) Sacc[i] = 0.f;
    for (int c = 0; c < SEQ / 64; ++c) {
        const int row0 = b * SEQ + c * 64;
        float g[16], kk[16], qv[16]; float run = 0.f;
#pragma unroll
        for (int j = 0; j < 16; ++j) {
            const float zf = fminf(fmaxf(bf2f(nf[j]), -60.f), 60.f), zq = bf2f(nq[j]);
            const float e = __expf(-zf), sg = 1.0f / (1.0f + e);
            run += __logf(lb + oml * sg); g[j] = run; kk[j] = oml * e * sg; qv[j] = zq * sigmoidf_(zq);
        }
        const u64 cv = nv;
        ex[tg * 128 + d] = run;
        __syncthreads();
        {
            const float e0 = ex[d], e1 = ex[128 + d], e2 = ex[256 + d], e3 = ex[384 + d];
            const float pre = tg == 0 ? 0.f : tg == 1 ? e0 : tg == 2 ? e0 + e1 : e0 + e1 + e2;
            const float r = e0 + e1, tot = (e0 + e1) + (e2 + e3);
            unsigned kt[8];
#pragma unroll
            for (int j = 0; j < 16; j += 2) {
                const float bt0 = pre + g[j], bt1 = pre + g[j + 1];
                const float qe0 = qv[j] * __expf(fminf(bt0 - r, 80.f)), qe1 = qv[j + 1] * __expf(fminf(bt1 - r, 80.f));
                const float ke0 = kk[j] * __expf(fminf(r - bt0, 80.f)), ke1 = kk[j + 1] * __expf(fminf(r - bt1, 80.f));
                const unsigned qp = pg8::cvt_pk_bf16(qe0, qe1), kp = pg8::cvt_pk_bf16(ke0, ke1);
                QE[(16 * tg + j) * 136 + d] = (bf16_t)(qp & 0xffffu); QE[(16 * tg + j + 1) * 136 + d] = (bf16_t)(qp >> 16);
                KE[(16 * tg + j) * 136 + d] = (bf16_t)(kp & 0xffffu); KE[(16 * tg + j + 1) * 136 + d] = (bf16_t)(kp >> 16);
                kt[j >> 1] = kp;
            }
            u32x4 w0, w1; w0.x = kt[0]; w0.y = kt[1]; w0.z = kt[2]; w0.w = kt[3]; w1.x = kt[4]; w1.y = kt[5]; w1.z = kt[6]; w1.w = kt[7];
            *(u32x4*)(KET + d * 72 + 16 * tg) = w0; *(u32x4*)(KET + d * 72 + 16 * tg + 8) = w1;
            if (tg == 0) { er[d] = __expf(r); el[d] = __expf(tot); elr[d] = __expf(tot - r); }
            VT[(v0 + 0) * 72 + vs] = (bf16_t)(cv & 0xffffu); VT[(v0 + 1) * 72 + vs] = (bf16_t)((cv >> 16) & 0xffffu); VT[(v0 + 2) * 72 + vs] = (bf16_t)((cv >> 32) & 0xffffu); VT[(v0 + 3) * 72 + vs] = (bf16_t)(cv >> 48);
        }
        __syncthreads();
        if (c + 1 < SEQ / 64) {
#pragma unroll
            for (int j = 0; j < 16; ++j) { nf[j] = fbase[(size_t)((c + 1) * 64 + j) * ZLD]; nq[j] = qbase[(size_t)((c + 1) * 64 + j) * ZLD]; }
            nv = *(const u64*)(vbase + (size_t)(c + 1) * 64 * ZLD);
        }
        if (wave >= 2 && wave < 6) {
            const int dq = wave - 2;
#pragma unroll
            for (int g4 = 0; g4 < 4; ++g4) {
                const int dd = 32 * dq + 8 * g4 + 4 * hh;
                const unsigned a0 = pg8::cvt_pk_bf16(er[dd] * Sacc[4 * g4], er[dd + 1] * Sacc[4 * g4 + 1]), a1 = pg8::cvt_pk_bf16(er[dd + 2] * Sacc[4 * g4 + 2], er[dd + 3] * Sacc[4 * g4 + 3]);
                *(u64*)(SBT + r31 * 136 + dd) = (u64)a0 | ((u64)a1 << 32);
            }
        }
        __syncthreads();
        if (wave < 2) {
            const int tt = wave;
            f32x16 Oacc;
#pragma unroll
            for (int i = 0; i < 16; ++i) Oacc[i] = 0.f;
            bf16x8 qf[8];
#pragma unroll
            for (int ks = 0; ks < 8; ++ks) qf[ks] = *(const bf16x8*)(QE + (32 * tt + r31) * 136 + 16 * ks + 8 * hh);
#pragma unroll
            for (int ks = 0; ks < 8; ++ks) { const bf16x8 sa = *(const bf16x8*)(SBT + r31 * 136 + 16 * ks + 8 * hh); Oacc = __builtin_amdgcn_mfma_f32_32x32x16_bf16(sa, qf[ks], Oacc, 0, 0, 0); }
            for (int st = 0; st <= tt; ++st) {
                f32x16 At;
#pragma unroll
                for (int i = 0; i < 16; ++i) At[i] = 0.f;
#pragma unroll
                for (int ks = 0; ks < 8; ++ks) { const bf16x8 ka = *(const bf16x8*)(KE + (32 * st + r31) * 136 + 16 * ks + 8 * hh); At = __builtin_amdgcn_mfma_f32_32x32x16_bf16(ka, qf[ks], At, 0, 0, 0); }
                if (st == tt) {
#pragma unroll
                    for (int i = 0; i < 16; ++i) { const int sl = (i & 3) + 8 * (i >> 2) + 4 * hh; if (sl > r31) At[i] = 0.f; }
                }
                union { unsigned u[4]; bf16x8 v; } pb0, pb1;
#pragma unroll
                for (int j = 0; j < 4; ++j) { pb0.u[j] = pg8::cvt_pk_bf16(At[2 * j], At[2 * j + 1]); pb1.u[j] = pg8::cvt_pk_bf16(At[8 + 2 * j], At[8 + 2 * j + 1]); }
                union { u64 q[2]; bf16x8 v; } a0, a1;
                a0.q[0] = *(const u64*)(VT + r31 * 72 + 32 * st + 4 * hh); a0.q[1] = *(const u64*)(VT + r31 * 72 + 32 * st + 8 + 4 * hh);
                a1.q[0] = *(const u64*)(VT + r31 * 72 + 32 * st + 16 + 4 * hh); a1.q[1] = *(const u64*)(VT + r31 * 72 + 32 * st + 24 + 4 * hh);
                Oacc = __builtin_amdgcn_mfma_f32_32x32x16_bf16(a0.v, pb0.v, Oacc, 0, 0, 0);
                Oacc = __builtin_amdgcn_mfma_f32_32x32x16_bf16(a1.v, pb1.v, Oacc, 0, 0, 0);
            }
            float* op = oraw + (size_t)(row0 + 32 * tt + r31) * 512 + h * 128 + dvq * 32 + 4 * hh;
#pragma unroll
            for (int g4 = 0; g4 < 4; ++g4) { f32x4 o; o[0] = Oacc[4 * g4]; o[1] = Oacc[4 * g4 + 1]; o[2] = Oacc[4 * g4 + 2]; o[3] = Oacc[4 * g4 + 3]; *(f32x4*)(op + 8 * g4) = o; }
        } else if (wave < 6) {
            const int dq = wave - 2;
            f32x16 dS;
#pragma unroll
            for (int i = 0; i < 16; ++i) dS[i] = 0.f;
#pragma unroll
            for (int ks = 0; ks < 4; ++ks) { const bf16x8 ka = *(const bf16x8*)(KET + (32 * dq + r31) * 72 + 16 * ks + 8 * hh), vb = *(const bf16x8*)(VT + r31 * 72 + 16 * ks + 8 * hh);
                dS = __builtin_amdgcn_mfma_f32_32x32x16_bf16(ka, vb, dS, 0, 0, 0); }
#pragma unroll
            for (int i = 0; i < 16; ++i) { const int dd = 32 * dq + (i & 3) + 8 * (i >> 2) + 4 * hh; Sacc[i] = el[dd] * Sacc[i] + elr[dd] * dS[i]; }
        }
        __syncthreads();
    }
}

__device__ __forceinline__ unsigned ordered_key(float f) { const unsigned u = __float_as_uint(f); return (u & 0x80000000u) ? ~u : (u | 0x80000000u); }
__device__ __forceinline__ void indexer_unit(const bf16_t* __restrict__ zb, unsigned* __restrict__ maskp, unsigned* sc  , unsigned* hist  ,
                                             const int b, const int t0, const int tid) {
    const int lane = tid & 63, wave = tid >> 6;
    const int r31 = lane & 31, hh = lane >> 5;
    {
        const int g = wave & 3, par = wave >> 2;
        const int head = (r31 & 3) + 4 * ((r31 >> 3) & 1), ql = 2 * ((r31 >> 4) & 1) + ((r31 >> 2) & 1);
        const bf16_t* ap = zb + (size_t)(b * SEQ + t0 + 4 * g + ql) * ZLD + C_IQ + head * 64 + 8 * hh;
        bf16x8 a[4];
#pragma unroll
        for (int s4 = 0; s4 < 4; ++s4) a[s4] = *(const bf16x8*)(ap + 16 * s4);
        float wq[16];
        {
            const int qa = t0 + 4 * g + hh, qb = qa + 2;
            f32x4 w0, w1, w2, w3; pg8::bf8_to_f32(*(const u32x4*)(zb + (size_t)(b * SEQ + qa) * ZLD + C_IW), w0, w1); pg8::bf8_to_f32(*(const u32x4*)(zb + (size_t)(b * SEQ + qb) * ZLD + C_IW), w2, w3);
#pragma unroll
            for (int i = 0; i < 4; ++i) { wq[i] = w0[i] * 0.04419417382415922f; wq[4 + i] = w1[i] * 0.04419417382415922f; wq[8 + i] = w2[i] * 0.04419417382415922f; wq[12 + i] = w3[i] * 0.04419417382415922f; }
        }
        const int ta = t0 + 4 * g + hh, tb_ = ta + 2;
        const int kt_max = (t0 + 15) >> 5;
        const bf16_t* kp = zb + (size_t)(b * SEQ + r31) * ZLD + C_IK + 8 * hh;
        bf16x8 nbk[4];
#pragma unroll
        for (int s4 = 0; s4 < 4; ++s4) nbk[s4] = *(const bf16x8*)(kp + (size_t)par * 32 * ZLD + 16 * s4);
        for (int kt = par; kt <= kt_max; kt += 2) {
            bf16x8 bk[4];
#pragma unroll
            for (int s4 = 0; s4 < 4; ++s4) bk[s4] = nbk[s4];
            { const int kn = kt + 2 <= kt_max ? kt + 2 : kt;
#pragma unroll
              for (int s4 = 0; s4 < 4; ++s4) nbk[s4] = *(const bf16x8*)(kp + (size_t)kn * 32 * ZLD + 16 * s4); }
            f32x16 acc;
#pragma unroll
            for (int q = 0; q < 16; ++q) acc[q] = 0.f;
#pragma unroll
            for (int s4 = 0; s4 < 4; ++s4) acc = __builtin_amdgcn_mfma_f32_32x32x16_bf16(a[s4], bk[s4], acc, 0, 0, 0);
            float sa = 0.f, sb = 0.f;
#pragma unroll
            for (int i = 0; i < 8; ++i) { sa += wq[i] * fmaxf(acc[i], 0.f); sb += wq[8 + i] * fmaxf(acc[8 + i], 0.f); }
            const int key = kt * 32 + r31;
            sc[(4 * g + hh) * 2048 + key] = key <= ta ? ordered_key(sa) : 0u;
            sc[(4 * g + 2 + hh) * 2048 + key] = key <= tb_ ? ordered_key(sb) : 0u;
        }
    }
    __syncthreads();
    for (int qq = 2 * wave; qq < 2 * wave + 2; ++qq) {
        const int t = t0 + qq;
        unsigned kreg[32];
#pragma unroll
        for (int i = 0; i < 32; ++i) { const int p = lane + 64 * i; kreg[i] = (p <= t) ? sc[qq * 2048 + p] : 0u; }
        unsigned prefix = 0u, mhi = 0u; int kk = 256;
#pragma unroll
        for (int pass = 3; pass >= 0; --pass) {
            const int shift = 8 * pass;
#pragma unroll
            for (int j = 0; j < 4; ++j) hist[lane * 4 + j] = 0u;
            asm volatile("s_waitcnt lgkmcnt(0)" ::: "memory");
#pragma unroll
            for (int i = 0; i < 32; ++i) { if ((kreg[i] & mhi) == prefix) atomicAdd(&hist[(kreg[i] >> shift) & 255u], 1u); }
            asm volatile("s_waitcnt lgkmcnt(0)" ::: "memory");
            const unsigned h0 = hist[lane * 4], h1 = hist[lane * 4 + 1], h2 = hist[lane * 4 + 2], h3 = hist[lane * 4 + 3];
            const int c4 = (int)(h0 + h1 + h2 + h3);
            int suf = c4;
#pragma unroll
            for (int o = 1; o < 64; o <<= 1) { const int v = __shfl_down(suf, o); if (lane + o < 64) suf += v; }
            const unsigned long long bal = __ballot(suf >= kk);
            const int L = 63 - __builtin_clzll(bal);
            int d = 0, kn = 0;
            {
                int cum = suf - c4;
                if (cum + (int)h3 >= kk) { d = 3; kn = kk - cum; } else { cum += (int)h3;
                if (cum + (int)h2 >= kk) { d = 2; kn = kk - cum; } else { cum += (int)h2;
                if (cum + (int)h1 >= kk) { d = 1; kn = kk - cum; } else { cum += (int)h1; d = 0; kn = kk - cum; } } }
            }
            d = __builtin_amdgcn_readlane(d, L); kn = __builtin_amdgcn_readlane(kn, L);
            prefix |= (unsigned)(4 * L + d) << shift; mhi |= 0xffu << shift; kk = kn;
        }
        unsigned myword = 0u; int eqbefore = 0;
#pragma unroll
        for (int i = 0; i < 32; ++i) {
            const bool eq = kreg[i] == prefix;
            const unsigned long long beq = __ballot(eq);
            const int rank = eqbefore + __popcll(beq & ((1ull << lane) - 1ull));
            const bool sel = kreg[i] > prefix || (eq && rank < kk);
            const unsigned long long bs = __ballot(sel);
            eqbefore += __popcll(beq);
            if (lane == 2 * i) myword = (unsigned)bs;
            if (lane == 2 * i + 1) myword = (unsigned)(bs >> 32);
        }
        maskp[(size_t)(b * SEQ + t) * 64 + lane] = myword;
    }
    __syncthreads();
}

__device__ __forceinline__ void attn_wave(const bf16_t* __restrict__ zb, const bf16_t* __restrict__ vbt, const unsigned* __restrict__ maskp, bf16_t* __restrict__ att, const float* tb  ,
                                          const int b, const int t0w, const int lane) {
    const int c = lane & 31, hh = lane >> 5, h = c & 7;
    const int tq = t0w + (c >> 3);
    const size_t rowq = (size_t)b * SEQ + tq;
    bf16x8 bq[4];
#pragma unroll
    for (int s4 = 0; s4 < 4; ++s4) bq[s4] = *(const bf16x8*)(zb + rowq * ZLD + C_QB + h * 64 + 16 * s4 + 8 * hh);
    const int kt_max = (t0w + 3) >> 5;
    const float bfar = tb[127 * 8 + h];
    const float LOG2E = 1.4426950408889634f;
    float m = -1e30f, lsum = 0.f;
    f32x16 O0, O1;
#pragma unroll
    for (int q = 0; q < 16; ++q) { O0[q] = 0.f; O1[q] = 0.f; }
    const bf16_t* kbase = zb + ((size_t)b * SEQ + c) * ZLD + C_KB + 8 * hh;
    const bf16_t* vbase = vbt + ((size_t)b * 64 + c) * SEQ + 4 * hh;
    const unsigned* mbase = maskp + rowq * 64;
    typedef unsigned long long u64;
    bf16x8 ak[4]; u64 av[2][2][2]; unsigned mw;
#pragma unroll
    for (int s4 = 0; s4 < 4; ++s4) ak[s4] = *(const bf16x8*)(kbase + 16 * s4);
#pragma unroll
    for (int mt = 0; mt < 2; ++mt)
#pragma unroll
        for (int s2 = 0; s2 < 2; ++s2) { av[mt][s2][0] = *(const u64*)(vbase + (size_t)mt * 32 * SEQ + 16 * s2); av[mt][s2][1] = *(const u64*)(vbase + (size_t)mt * 32 * SEQ + 16 * s2 + 8); }
    mw = mbase[0];
    for (int kt = 0; kt <= kt_max; ++kt) {
        const int key0 = kt * 32;
        bf16x8 cak[4]; u64 cav[2][2][2]; const unsigned cmw = mw >> (4 * hh);
#pragma unroll
        for (int s4 = 0; s4 < 4; ++s4) cak[s4] = ak[s4];
#pragma unroll
        for (int mt = 0; mt < 2; ++mt)
#pragma unroll
            for (int s2 = 0; s2 < 2; ++s2) { cav[mt][s2][0] = av[mt][s2][0]; cav[mt][s2][1] = av[mt][s2][1]; }
        {
            const int kn = kt < kt_max ? kt + 1 : kt;
#pragma unroll
            for (int s4 = 0; s4 < 4; ++s4) ak[s4] = *(const bf16x8*)(kbase + (size_t)kn * 32 * ZLD + 16 * s4);
#pragma unroll
            for (int mt = 0; mt < 2; ++mt)
#pragma unroll
                for (int s2 = 0; s2 < 2; ++s2) { av[mt][s2][0] = *(const u64*)(vbase + (size_t)mt * 32 * SEQ + kn * 32 + 16 * s2); av[mt][s2][1] = *(const u64*)(vbase + (size_t)mt * 32 * SEQ + kn * 32 + 16 * s2 + 8); }
            mw = mbase[kn];
        }
        f32x16 S;
#pragma unroll
        for (int q = 0; q < 16; ++q) S[q] = 0.f;
#pragma unroll
        for (int s4 = 0; s4 < 4; ++s4) S = __builtin_amdgcn_mfma_f32_32x32x16_bf16(cak[s4], bq[s4], S, 0, 0, 0);
        const bool nearb = (t0w - key0 - 31) < 113;
        float x[16]; float tmax = -1e30f;
        const int relb = tq - key0 - 4 * hh;
#pragma unroll
        for (int i = 0; i < 16; ++i) {
            const int ko = (i & 3) + 8 * (i >> 2);
            float bias = bfar;
            if (nearb) { int rel = relb - ko; rel = rel < 0 ? 0 : (rel > 127 ? 127 : rel); bias = tb[rel * 8 + h]; }
            x[i] = S[i] * 0.125f + bias;
            if ((cmw >> ko) & 1u) tmax = fmaxf(tmax, x[i]);
        }
        tmax = fmaxf(tmax, __shfl_xor(tmax, 32));
        const float mn = fmaxf(m, tmax);
        if (__ballot(mn > m) != 0ull) {
            const float scl = __builtin_amdgcn_exp2f((m - mn) * LOG2E);
            lsum *= scl;
#pragma unroll
            for (int q = 0; q < 16; ++q) { O0[q] *= scl; O1[q] *= scl; }
        }
        m = mn;
        float p[16];
#pragma unroll
        for (int i = 0; i < 16; ++i) { const int ko = (i & 3) + 8 * (i >> 2); p[i] = ((cmw >> ko) & 1u) ? __builtin_amdgcn_exp2f((x[i] - m) * LOG2E) : 0.f; lsum += p[i]; }
        union { unsigned u[4]; bf16x8 v; } pb0, pb1;
#pragma unroll
        for (int j = 0; j < 4; ++j) { pb0.u[j] = pg8::cvt_pk_bf16(p[2 * j], p[2 * j + 1]); pb1.u[j] = pg8::cvt_pk_bf16(p[8 + 2 * j], p[8 + 2 * j + 1]); }
        union { u64 q[2]; bf16x8 v; } a00, a01, a10, a11;
        a00.q[0] = cav[0][0][0]; a00.q[1] = cav[0][0][1]; a01.q[0] = cav[0][1][0]; a01.q[1] = cav[0][1][1];
        a10.q[0] = cav[1][0][0]; a10.q[1] = cav[1][0][1]; a11.q[0] = cav[1][1][0]; a11.q[1] = cav[1][1][1];
        O0 = __builtin_amdgcn_mfma_f32_32x32x16_bf16(a00.v, pb0.v, O0, 0, 0, 0);
        O0 = __builtin_amdgcn_mfma_f32_32x32x16_bf16(a01.v, pb1.v, O0, 0, 0, 0);
        O1 = __builtin_amdgcn_mfma_f32_32x32x16_bf16(a10.v, pb0.v, O1, 0, 0, 0);
        O1 = __builtin_amdgcn_mfma_f32_32x32x16_bf16(a11.v, pb1.v, O1, 0, 0, 0);
    }
    lsum += __shfl_xor(lsum, 32);
    const float inv = 1.0f / lsum;
    bf16_t* op = att + rowq * 512 + h * 64 + 4 * hh;
#pragma unroll
    for (int g4 = 0; g4 < 4; ++g4) {
        unsigned w0 = pg8::cvt_pk_bf16(O0[4 * g4] * inv, O0[4 * g4 + 1] * inv), w1 = pg8::cvt_pk_bf16(O0[4 * g4 + 2] * inv, O0[4 * g4 + 3] * inv);
        *(u64*)(op + 8 * g4) = (u64)w0 | ((u64)w1 << 32);
        w0 = pg8::cvt_pk_bf16(O1[4 * g4] * inv, O1[4 * g4 + 1] * inv); w1 = pg8::cvt_pk_bf16(O1[4 * g4 + 2] * inv, O1[4 * g4 + 3] * inv);
        *(u64*)(op + 32 + 8 * g4) = (u64)w0 | ((u64)w1 << 32);
    }
}

template <int KIND> __global__ void __launch_bounds__(NTHREADS, 2) fwd(Args args) {
    extern __shared__ __attribute__((aligned(16))) unsigned char lds[];
    const int tid = threadIdx.x, lane = tid & 63, wave = tid >> 6;
    const int G = gridDim.x;
    PG8_LAS unsigned char* const lds3 = (PG8_LAS unsigned char*)lds;
#define WS_OPAQUE() unsigned char* ws = args.ws; asm volatile("" : "+s"(ws)); int tid = threadIdx.x; asm volatile("" : "+v"(tid)); const int lane = tid & 63, wave = tid >> 6; (void)lane; (void)wave
#define ctl ((unsigned*)(ws + WS_CTL))
#define MOD ((float*)(ws + WS_MOD))
#define LB ((float*)(ws + WS_LB))
#define WIN ((bf16_t*)(ws + WS_WIN))
#define WPA ((bf16_t*)(ws + WS_WPA))
#define WPB ((bf16_t*)(ws + WS_WPB))
#define WOUT ((bf16_t*)(ws + WS_WOUT))
#define W1 ((bf16_t*)(ws + WS_W1))
#define W2 ((bf16_t*)(ws + WS_W2))
#define H ((bf16_t*)(ws + WS_H))
#define ZB ((bf16_t*)(ws + WS_Z))
#define VBT ((bf16_t*)(ws + WS_VBT))
#define Y ((bf16_t*)(ws + WS_Y))
#define XS ((bf16_t*)(ws + WS_XS))
#define ACT ((bf16_t*)(ws + WS_ACT))
#define ORAW ((float*)(ws + WS_ORAW))
#define TMP ((float*)(ws + WS_TMP))
#define HA ((bf16_t*)(ws + WS_HA))
#define ATT ((bf16_t*)(ws + WS_ATT))
#define MASK ((unsigned*)(ws + WS_MASK))
#define MERGED ((bf16_t*)(ws + WS_MERGED))
#define X1 ((float*)(ws + WS_X1))
#define X2 ((float*)(ws + WS_X2))
#define TOKE ((int*)(ws + WS_TOKE))
#define TOKG ((float*)(ws + WS_TOKG))
#define TOKP ((int*)(ws + WS_TOKP))
#define TOKS ((int*)(ws + WS_TOKS))
#define BLKE ((int*)(ws + WS_BLKE))
#define BCNT ((int*)(ws + WS_BCNT))
    const int lo = args.ph_lo, hi = args.ph_hi;
#define IN(k) ((KIND < 0 || ((k) == 0 ? KIND == 100 : KIND == ((k) - 1) % 11)) && lo <= (k) && (k) < hi)
#define SEAM(k) do { if (KIND < 0 && IN(k) && IN((k) + 1)) xcd_barrier(bar); } while (0)
    XcdBarrier bar; bar.bar = (unsigned*)(args.ws + WS_CTL) + CW_BAR; bar.x = 0; bar.st = nullptr;
    if (KIND < 0) {
        volatile LAS unsigned* xbw = (volatile LAS unsigned*)((LAS unsigned char*)lds + (LDS_BYTES - 16));
        if (tid == 0) { xbw[0] = 0u; xbw[1] = 0u; xbw[2] = 0u; xbw[3] = 0u; }
        __syncthreads();
        bar = xcd_barrier_post((unsigned*)(args.ws + WS_CTL) + CW_BAR, xbw);
    }

    if (IN(0)) for (int prep_ = 0; prep_ < probe_reps(100); ++prep_) {
        WS_OPAQUE();
        {
            bf16_t* lt = (bf16_t*)lds;
            f32x4 v[8];
            int J = blockIdx.x;
            CvtJob cur = cvt_job(J < CJ_TOTAL ? J : 0, args.in, ws);
            if (J < CJ_TOTAL) cvt_load(cur, tid, v);
            __syncthreads();
            for (; J < CJ_TOTAL; J += G) {
                {
                    const int i = tid >> 3, c0 = (tid & 7) * 32;
#pragma unroll
                    for (int q = 0; q < 8; q += 2) { u32x4 w; w.x = pg8::cvt_pk_bf16(v[q][0], v[q][1]); w.y = pg8::cvt_pk_bf16(v[q][2], v[q][3]); w.z = pg8::cvt_pk_bf16(v[q + 1][0], v[q + 1][1]); w.w = pg8::cvt_pk_bf16(v[q + 1][2], v[q + 1][3]);
                        *(u32x4*)(lt + i * 264 + c0 + 4 * q) = w; }
                }
                __syncthreads();
                const CvtJob me = cur;
                if (J + G < CJ_TOTAL) { cur = cvt_job(J + G, args.in, ws); cvt_load(cur, tid, v); }
                {
                    const int n = tid & 255, kh = tid >> 8;
                    unsigned w[16];
#pragma unroll
                    for (int q = 0; q < 16; ++q) w[q] = (unsigned)lt[(kh * 32 + 2 * q) * 264 + n] | ((unsigned)lt[(kh * 32 + 2 * q + 1) * 264 + n] << 16);
                    bf16_t* dp = me.dst + (size_t)n * me.K + kh * 32;
#pragma unroll
                    for (int q = 0; q < 4; ++q) { u32x4 o; o.x = w[4 * q]; o.y = w[4 * q + 1]; o.z = w[4 * q + 2]; o.w = w[4 * q + 3]; *(u32x4*)(dp + 8 * q) = o; }
                }
                __syncthreads();
            }
        }
        {
            float* ca = (float*)lds;
            float* red = ca + NB * D;
            __syncthreads();
            for (int i = tid; i < NB * D; i += NTHREADS) { const float c = args.in[I_C][i]; ca[i] = c * sigmoidf_(c); }
            __syncthreads();
            for (int u = blockIdx.x; u < DEPTH * NMOD / 48; u += G) {
                const int jc = tid % 48, kg = tid / 48;
                const int ln = u * 48 + jc, l = ln / NMOD, n = ln % NMOD;
                if (kg < 10) {
                    const float* w = args.in[I_WADA] + (size_t)l * D * NMOD + n;
                    float acc[NB];
#pragma unroll
                    for (int b = 0; b < NB; ++b) acc[b] = 0.f;
                    for (int k = kg; k < D; k += 10) { const float wv = w[(size_t)k * NMOD];
#pragma unroll
                        for (int b = 0; b < NB; ++b) acc[b] += ca[b * D + k] * wv; }
#pragma unroll
                    for (int b = 0; b < NB; ++b) red[(kg * NB + b) * 48 + jc] = acc[b];
                }
                __syncthreads();
                for (int o = tid; o < NB * 48; o += NTHREADS) { const int b = o / 48, jj = o % 48; float a = 0.f;
#pragma unroll
                    for (int q = 0; q < 10; ++q) a += red[(q * NB + b) * 48 + jj];
                    const int ln2 = u * 48 + jj, l2 = ln2 / NMOD, n2 = ln2 % NMOD;
                    MOD[((size_t)l2 * NB + b) * NMOD + n2] = a + args.in[I_BADA][(size_t)l2 * NMOD + n2]; }
                __syncthreads();
            }
        }
        if (blockIdx.x == G - 1) {
            for (int j = tid; j < 512; j += NTHREADS) { const float a0 = args.in[I_LBL][j], a1 = args.in[I_LBL][512 + j]; LB[j] = 0.f; LB[512 + j] = 1.0f / (1.0f + __expf(a0 - a1)); }
        }
    }

    SEAM(0);
#pragma unroll
    for (int l = 0; l < DEPTH; ++l) {
        const int P = 1 + 11 * l;
#define mod (MOD + (size_t)l * NB * NMOD)
#define xin ((l == 0) ? args.in[I_X] : (const float*)X2)
        if (IN(P + 0) && l == 0) {
            WS_OPAQUE();
            const float* nw = args.in[I_NMW] + (size_t)l * D;
            for (int row = blockIdx.x * NWAVES + wave; row < T; row += G * NWAVES) {
                const int b = row >> 11; f32x4 v[4]; float ss = 0.f;
#pragma unroll
                for (int i = 0; i < 4; ++i) { v[i] = *(const f32x4*)(xin + (size_t)row * D + (lane + 64 * i) * 4); ss += v[i][0] * v[i][0] + v[i][1] * v[i][1] + v[i][2] * v[i][2] + v[i][3] * v[i][3]; }
                ss = wave_sum(ss); const float r = rsqrtf(ss * (1.0f / D) + EPS);
#pragma unroll
                for (int i = 0; i < 4; ++i) { const int c = (lane + 64 * i) * 4;
                    const f32x4 w4 = *(const f32x4*)(nw + c), sc4 = *(const f32x4*)(mod + (size_t)b * NMOD + D + c), sh4 = *(const f32x4*)(mod + (size_t)b * NMOD + c);
                    const f32x4 hv = v[i] * r * w4 * (1.0f + sc4) + sh4;
                    *(unsigned long long*)(H + (size_t)row * D + c) = (unsigned long long)pg8::cvt_pk_bf16(hv[0], hv[1]) | ((unsigned long long)pg8::cvt_pk_bf16(hv[2], hv[3]) << 32); }
            }
        }
        if (l == 0) SEAM(P + 0);
        if (IN(P + 1)) for (int prep_ = 0; prep_ < probe_reps(1); ++prep_) {
            WS_OPAQUE();
            pg8::Gemm g{H, WIN + (size_t)l * ZLD * D, T, ZLD, D}; pg8::StaticOrder S; S.init(T, ZLD, G, (int)blockIdx.x);
            pg8::EpiZ E{ZB, ZLD};
            pg8::gemm_phase(lds3, tid, g, S, E);
        }
        SEAM(P + 1);
        if (IN(P + 2)) for (int prep_ = 0; prep_ < probe_reps(2); ++prep_) {
            WS_OPAQUE();
            for (int u = blockIdx.x; u < NB * 4 * 4; u += G) hgrn_item(ZB, LB + l * 512, ORAW, lds, u >> 4, (u >> 2) & 3, u & 3, tid);
            {
                for (int wt = blockIdx.x * NWAVES + wave; wt < (T / 64) * 8; wt += G * NWAVES) {
                    const int rg = wt >> 3, dg = wt & 7; const int row = rg * 64 + lane, bb = row >> 11, sidx = row & 2047;
                    const u32x4 w = *(const u32x4*)(ZB + (size_t)row * ZLD + C_VB + dg * 8);
                    bf16_t* vp = VBT + ((size_t)bb * 64 + dg * 8) * SEQ + sidx;
                    vp[0] = (bf16_t)(w.x & 0xffffu); vp[SEQ] = (bf16_t)(w.x >> 16); vp[2 * SEQ] = (bf16_t)(w.y & 0xffffu); vp[3 * SEQ] = (bf16_t)(w.y >> 16);
                    vp[4 * SEQ] = (bf16_t)(w.z & 0xffffu); vp[5 * SEQ] = (bf16_t)(w.z >> 16); vp[6 * SEQ] = (bf16_t)(w.w & 0xffffu); vp[7 * SEQ] = (bf16_t)(w.w >> 16);
                }
            }
            {
                unsigned* sc = (unsigned*)lds; unsigned* hist = sc + 16 * 2048 + wave * 256;
                __syncthreads();
                for (int u = blockIdx.x; u < T / 16; u += G) {
                    const int cc = u & 255, j = u >> 8; const int b = cc & 15, x = cc >> 4, pr = x + 16 * (j >> 1); const int q16 = (j & 1) ? 127 - pr : pr; const int t0 = q16 * 16;
                    if (t0 < 256) {
                        for (int i = tid; i < 16 * 64; i += NTHREADS) { const int qq = i >> 6, w = i & 63, n = t0 + qq + 1, lo_ = w * 32;
                            unsigned mm = 0u; if (n >= lo_ + 32) mm = 0xffffffffu; else if (n > lo_) mm = (1u << (n - lo_)) - 1u; MASK[(size_t)(b * SEQ + t0 + qq) * 64 + w] = mm; }
                    } else indexer_unit(ZB, MASK, sc, hist, b, t0, tid);
                }
                __syncthreads();
            }
        }
        SEAM(P + 2);
        if (IN(P + 3)) for (int prep_ = 0; prep_ < probe_reps(3); ++prep_) {
            WS_OPAQUE();
            const float* hnw = args.in[I_HNW] + (size_t)l * 512;
            for (int row = blockIdx.x * NWAVES + wave; row < T; row += G * NWAVES) {
                const int c0 = lane * 8; float o[8]; float ss = 0.f;
                { const f32x4 o0 = *(const f32x4*)(ORAW + (size_t)row * 512 + c0), o1 = *(const f32x4*)(ORAW + (size_t)row * 512 + c0 + 4);
#pragma unroll
                  for (int j = 0; j < 4; ++j) { o[j] = o0[j]; o[4 + j] = o1[j]; } }
#pragma unroll
                for (int j = 0; j < 8; ++j) ss += o[j] * o[j];
                ss += __shfl_xor(ss, 1); ss += __shfl_xor(ss, 2); ss += __shfl_xor(ss, 4); ss += __shfl_xor(ss, 8);
                const float r = rsqrtf(ss * (1.0f / 128.0f) + EPS);
                { f32x4 g0, g1; pg8::bf8_to_f32(*(const u32x4*)(ZB + (size_t)row * ZLD + C_GA + c0), g0, g1);
                  const f32x4 w0 = *(const f32x4*)(hnw + c0), w1 = *(const f32x4*)(hnw + c0 + 4); float hv[8];
#pragma unroll
                  for (int j = 0; j < 4; ++j) { hv[j] = o[j] * r * w0[j] * (g0[j] * sigmoidf_(g0[j])); hv[4 + j] = o[4 + j] * r * w1[j] * (g1[j] * sigmoidf_(g1[j])); }
                  u32x4 w; w.x = pg8::cvt_pk_bf16(hv[0], hv[1]); w.y = pg8::cvt_pk_bf16(hv[2], hv[3]); w.z = pg8::cvt_pk_bf16(hv[4], hv[5]); w.w = pg8::cvt_pk_bf16(hv[6], hv[7]);
                  *(u32x4*)(HA + (size_t)row * 512 + c0) = w; }
            }
            {
                float* tb = (float*)lds;
                __syncthreads();
                for (int i = tid; i < 1024; i += NTHREADS) tb[i] = args.in[I_RELB][(int)T5_BUCKET[i >> 3] * 8 + (i & 7)];
                __syncthreads();
                for (int u = blockIdx.x; u < T / 32; u += G) {
                    const int cc = u & 255, j = u >> 8; const int b = cc & 15, x = cc >> 4, pr = x + 16 * (j >> 1); const int qt = (j & 1) ? 63 - pr : pr;
                    attn_wave(ZB, VBT, MASK, ATT, tb, b, qt * 32 + 4 * wave, lane);
                }
                __syncthreads();
            }
        }
        SEAM(P + 3);
        if (IN(P + 4)) for (int prep_ = 0; prep_ < probe_reps(4); ++prep_) {
            WS_OPAQUE();
            pg8::StaticOrder S; S.init(T, D, G, (int)blockIdx.x);
            { pg8::Gemm g{HA, WPA + (size_t)l * D * 512, T, D, 512}; pg8::EpiMerge<false> E{TMP, MERGED, ZB + C_GTA}; pg8::gemm_phase(lds3, tid, g, S, E); }
            { pg8::Gemm g{ATT, WPB + (size_t)l * D * 512, T, D, 512}; pg8::EpiMerge<true> E{TMP, MERGED, ZB + C_GTB}; pg8::gemm_phase(lds3, tid, g, S, E); }
        }
        SEAM(P + 4);
        if (IN(P + 5)) for (int prep_ = 0; prep_ < probe_reps(5); ++prep_) {
            WS_OPAQUE();
            pg8::Gemm g{MERGED, WOUT + (size_t)l * D * D, T, D, D}; pg8::StaticOrder S; S.init(T, D, G, (int)blockIdx.x);
            pg8::EpiOutG E{xin, X1, mod + 2 * D}; pg8::gemm_phase(lds3, tid, g, S, E);
        }
        SEAM(P + 5);
        if (IN(P + 6)) for (int prep_ = 0; prep_ < probe_reps(6); ++prep_) {
            WS_OPAQUE();
            const float* nw = args.in[I_NFW] + (size_t)l * D; const float* wr = args.in[I_WR] + (size_t)l * D * NE; const float* br = args.in[I_BR] + (size_t)l * NE;
            float* wl = (float*)lds; unsigned* cntl = (unsigned*)(wl + D * NE);
            __syncthreads();
            for (int i = tid; i < D * 8; i += NTHREADS) { const int k = i >> 3, q = i & 7; *(f32x4*)(wl + k * NE + 4 * (q ^ ((k >> 1) & 7))) = *(const f32x4*)(wr + (size_t)k * NE + 4 * q); }
            if (tid < NE) cntl[tid] = 0u;
            __syncthreads();
            const int sw = (lane >> 1) & 7;
            const int ex = lane >> 1;
            const float brv = br[ex];
            for (int grp = blockIdx.x * NWAVES + wave; grp < T / 16; grp += G * NWAVES) {
                const int tok0 = grp * 16, b = tok0 >> 11;
                float ca[16], cb[16];
#pragma unroll
                for (int i = 0; i < 16; ++i) { const int k = lane + 64 * i; ca[i] = nw[k] * (1.0f + mod[(size_t)b * NMOD + 4 * D + k]); cb[i] = mod[(size_t)b * NMOD + 3 * D + k]; }
                for (int j = 0; j < 16; ++j) {
                    const int tok = tok0 + j;
                    float x[16]; float ss = 0.f;
#pragma unroll
                    for (int i = 0; i < 16; ++i) { x[i] = X1[(size_t)tok * D + lane + 64 * i]; ss += x[i] * x[i]; }
                    ss = wave_sum(ss); const float r = rsqrtf(ss * (1.0f / D) + EPS);
                    float acc[32];
#pragma unroll
                    for (int q = 0; q < 32; ++q) acc[q] = 0.f;
#pragma unroll
                    for (int i = 0; i < 16; ++i) {
                        const float hk = x[i] * r * ca[i] + cb[i];
                        H[(size_t)tok * D + lane + 64 * i] = f2bf(hk);
                        const float* wrow = wl + (lane + 64 * i) * NE;
#pragma unroll
                        for (int q = 0; q < 8; ++q) { const f32x4 w4 = *(const f32x4*)(wrow + 4 * (q ^ sw)); acc[4 * q] += hk * w4[0]; acc[4 * q + 1] += hk * w4[1]; acc[4 * q + 2] += hk * w4[2]; acc[4 * q + 3] += hk * w4[3]; }
                    }
                    float a16[16], a8[8], a4[4], a2[2], a1;
                    { const bool up = (lane & 32) != 0;
#pragma unroll
                      for (int q = 0; q < 16; ++q) { const float snd = up ? acc[q] : acc[16 + q], kp = up ? acc[16 + q] : acc[q]; a16[q] = kp + __shfl_xor(snd, 32); } }
                    { const bool up = (lane & 16) != 0;
#pragma unroll
                      for (int q = 0; q < 8; ++q) { const float snd = up ? a16[q] : a16[8 + q], kp = up ? a16[8 + q] : a16[q]; a8[q] = kp + __shfl_xor(snd, 16); } }
                    { const bool up = (lane & 8) != 0;
#pragma unroll
                      for (int q = 0; q < 4; ++q) { const float snd = up ? a8[q] : a8[4 + q], kp = up ? a8[4 + q] : a8[q]; a4[q] = kp + __shfl_xor(snd, 8); } }
                    { const bool up = (lane & 4) != 0;
#pragma unroll
                      for (int q = 0; q < 2; ++q) { const float snd = up ? a4[q] : a4[2 + q], kp = up ? a4[2 + q] : a4[q]; a2[q] = kp + __shfl_xor(snd, 4); } }
                    { const bool up = (lane & 2) != 0; const float snd = up ? a2[0] : a2[1], kp = up ? a2[1] : a2[0]; a1 = kp + __shfl_xor(snd, 2); }
                    a1 += __shfl_xor(a1, 1);
                    float logit = a1 + brv;
                    float tv[4]; int ti[4];
#pragma unroll
                    for (int k = 0; k < 4; ++k) {
                        float bv = logit; int bi = ex;
#pragma unroll
                        for (int o = 32; o >= 2; o >>= 1) { const float ov = __shfl_xor(bv, o); const int oi = __shfl_xor(bi, o); if (ov > bv || (ov == bv && oi < bi)) { bv = ov; bi = oi; } }
                        tv[k] = bv; ti[k] = bi; if (ex == bi) logit = -INFINITY;
                    }
                    const float e1 = __expf(tv[1] - tv[0]), e2 = __expf(tv[2] - tv[0]), e3 = __expf(tv[3] - tv[0]); const float inv = 1.0f / (1.0f + e1 + e2 + e3);
                    if (lane < 4) { const int ee = lane == 0 ? ti[0] : lane == 1 ? ti[1] : lane == 2 ? ti[2] : ti[3]; const float gg = (lane == 0 ? 1.0f : lane == 1 ? e1 : lane == 2 ? e2 : e3) * inv;
                        TOKE[tok * 4 + lane] = ee; TOKG[tok * 4 + lane] = gg; TOKP[tok * 4 + lane] = (int)atomicAdd(&cntl[ee], 1u); }
                }
            }
            __syncthreads();
            if (tid < NE) BCNT[blockIdx.x * NE + tid] = (int)cntl[tid];
        }
        SEAM(P + 6);
        if (IN(P + 7)) for (int prep_ = 0; prep_ < probe_reps(7); ++prep_) {
            WS_OPAQUE();
            int* ps = (int*)lds; int* tot = ps + 64; int* basel = tot + 32; int* pall = basel + 32; int* pbef = pall + 16 * NE;
            __syncthreads();
            {
                const int e = tid & 31, pt = tid >> 5, per = (G + 15) / 16; int sa = 0, sb = 0;
                for (int bb = pt * per; bb < (pt + 1) * per && bb < G; ++bb) { const int c = BCNT[bb * NE + e]; sa += c; sb += bb < (int)blockIdx.x ? c : 0; }
                pall[pt * NE + e] = sa; pbef[pt * NE + e] = sb;
            }
            __syncthreads();
            if (tid < NE) { int sa = 0, sb = 0; for (int pt = 0; pt < 16; ++pt) { sa += pall[pt * NE + tid]; sb += pbef[pt * NE + tid]; } tot[tid] = sa; basel[tid] = sb; }
            __syncthreads();
            if (tid == 0) { int a = 0; for (int e = 0; e < NE; ++e) { ps[e] = a; a += ((tot[e] + 255) / 256) * 256; } ps[NE] = a; }
            __syncthreads();
            const int gt = blockIdx.x * NTHREADS + tid, gn = G * NTHREADS;
            for (int grp = blockIdx.x * NWAVES + wave; grp < T / 16; grp += G * NWAVES) {
                const int tok0 = grp * 16;
                const int e_l = TOKE[tok0 * 4 + lane]; const int slot_l = ps[e_l] + basel[e_l] + TOKP[tok0 * 4 + lane];
                TOKS[tok0 * 4 + lane] = slot_l;
#pragma unroll 4
                for (int j = 0; j < 16; ++j) {
                    const u32x4 r0 = *(const u32x4*)(H + (size_t)(tok0 + j) * D + lane * 8), r1 = *(const u32x4*)(H + (size_t)(tok0 + j) * D + 512 + lane * 8);
#pragma unroll
                    for (int k = 0; k < 4; ++k) { const int slot = __shfl(slot_l, 4 * j + k);
                        *(u32x4*)(XS + (size_t)slot * D + lane * 8) = r0; *(u32x4*)(XS + (size_t)slot * D + 512 + lane * 8) = r1; }
                }
            }
            for (int i = blockIdx.x * NWAVES + wave; i < NE * 256; i += G * NWAVES) {
                const int e = i >> 8, j = i & 255; const int c = tot[e]; const int si = c + j;
                if (si < ps[e + 1] - ps[e]) { const u32x4 z = {0u, 0u, 0u, 0u}; *(u32x4*)(XS + (size_t)(ps[e] + si) * D + lane * 8) = z; *(u32x4*)(XS + (size_t)(ps[e] + si) * D + 512 + lane * 8) = z; } }
            const int nblk = ps[NE] / 256, nblk8 = (nblk + 7) & ~7;
            for (int mb = gt; mb < nblk8; mb += gn) { int e = 0; if (mb < nblk) { while (e < NE - 1 && mb * 256 >= ps[e + 1]) ++e; } BLKE[mb] = e; }
            if (gt == 0) ctl[CW_NBLK + l] = (unsigned)nblk8;
            __syncthreads();
        }
        SEAM(P + 7);
        if (IN(P + 8)) for (int prep_ = 0; prep_ < probe_reps(8); ++prep_) {
            WS_OPAQUE();
            const int nblk = __builtin_amdgcn_readfirstlane((int)ctl[CW_NBLK + l]);
            pg8::Gemm g{XS, W1 + (size_t)l * NE * 2 * DFF * D, nblk * 256, 2 * DFF, D}; pg8::MoeOrder<8> S; S.init(nblk, G, (int)blockIdx.x, BLKE);
            pg8::EpiSwigluG E{ACT, args.in[I_B1] + (size_t)l * NE * 2 * DFF}; pg8::gemm_phase(lds3, tid, g, S, E);
        }
        SEAM(P + 8);
        if (IN(P + 9)) for (int prep_ = 0; prep_ < probe_reps(9); ++prep_) {
            WS_OPAQUE();
            const int nblk = __builtin_amdgcn_readfirstlane((int)ctl[CW_NBLK + l]);
            pg8::Gemm g{ACT, W2 + (size_t)l * NE * D * DFF, nblk * 256, D, DFF}; pg8::MoeOrder<4> S; S.init(nblk, G, (int)blockIdx.x, BLKE);
            pg8::EpiYG E{Y, args.in[I_B2] + (size_t)l * NE * D}; pg8::gemm_phase(lds3, tid, g, S, E);
        }
        SEAM(P + 9);
        if (IN(P + 10)) for (int prep_ = 0; prep_ < probe_reps(10); ++prep_) {
            WS_OPAQUE();
            const bool last = (l == DEPTH - 1);
            const float* nw = last ? args.in[I_FNW] : args.in[I_NMW] + (size_t)(l + 1) * D;
            const float* modn = MOD + (size_t)(l + 1) * NB * NMOD;
            for (int grp = blockIdx.x * NWAVES + wave; grp < T / 16; grp += G * NWAVES) {
                const int tok0 = grp * 16, b = tok0 >> 11;
                const int slot_l = TOKS[tok0 * 4 + lane]; const float g_l = TOKG[tok0 * 4 + lane];
#pragma unroll 2
                for (int j = 0; j < 16; ++j) {
                    const int tok = tok0 + j; f32x4 v[4], a[4];
#pragma unroll
                    for (int i = 0; i < 4; ++i) { v[i] = *(const f32x4*)(X1 + (size_t)tok * D + (lane + 64 * i) * 4); a[i] = (f32x4){0.f, 0.f, 0.f, 0.f}; }
#pragma unroll
                    for (int k = 0; k < 4; ++k) { const int slot = __shfl(slot_l, 4 * j + k); const float g = __shfl(g_l, 4 * j + k);
#pragma unroll
                        for (int i = 0; i < 4; ++i) { const unsigned* yp = (const unsigned*)(Y + (size_t)slot * D + (lane + 64 * i) * 4); const unsigned y0 = yp[0], y1 = yp[1];
                            f32x4 y; y[0] = __uint_as_float(y0 << 16); y[1] = __uint_as_float(y0 & 0xffff0000u); y[2] = __uint_as_float(y1 << 16); y[3] = __uint_as_float(y1 & 0xffff0000u); a[i] += g * y; } }
                    float ss = 0.f;
#pragma unroll
                    for (int i = 0; i < 4; ++i) { const int c = (lane + 64 * i) * 4; const f32x4 gf = *(const f32x4*)(mod + (size_t)b * NMOD + 5 * D + c); v[i] = v[i] + gf * a[i];
                        ss += v[i][0] * v[i][0] + v[i][1] * v[i][1] + v[i][2] * v[i][2] + v[i][3] * v[i][3]; }
                    ss = wave_sum(ss); const float r = rsqrtf(ss * (1.0f / D) + EPS);
#pragma unroll
                    for (int i = 0; i < 4; ++i) { const int c = (lane + 64 * i) * 4;
                        if (last) { const f32x4 w4 = *(const f32x4*)(nw + c);
                            *(f32x4*)(args.out + (size_t)tok * D + c) = v[i] * r * w4;
                        } else {
                            *(f32x4*)(X2 + (size_t)tok * D + c) = v[i];
                            const f32x4 w4 = *(const f32x4*)(nw + c), sc4 = *(const f32x4*)(modn + (size_t)b * NMOD + D + c), sh4 = *(const f32x4*)(modn + (size_t)b * NMOD + c);
                            const f32x4 hv = v[i] * r * w4 * (1.0f + sc4) + sh4;
                            *(unsigned long long*)(H + (size_t)tok * D + c) = (unsigned long long)pg8::cvt_pk_bf16(hv[0], hv[1]) | ((unsigned long long)pg8::cvt_pk_bf16(hv[2], hv[3]) << 32);
                        } }
                }
            }
        }
        SEAM(P + 10);
    }
#undef IN
}

constexpr int N_PHASES = 1 + 11 * DEPTH;
typedef void (*kern_t)(Args);
template <int K> static kern_t kern_of() { return fwd<K>; }
static kern_t kern_for(int kind) {
    switch (kind) { case 0: return fwd<0>; case 1: return fwd<1>; case 2: return fwd<2>; case 3: return fwd<3>; case 4: return fwd<4>; case 5: return fwd<5>;
                    case 6: return fwd<6>; case 7: return fwd<7>; case 8: return fwd<8>; case 9: return fwd<9>; case 10: return fwd<10>; default: return fwd<100>; }
}

extern "C" void kernel_launch(void* const* d_in, const int* in_sizes, int n_in, void* d_out, int out_size, void* d_ws, size_t ws_size, hipStream_t stream) {
    static int grid = 0;
    if (grid == 0) {
        if (n_in != 20 || out_size != T * D || ws_size < WS_END) { fprintf(stderr, "kernel_launch: unexpected problem (n_in %d, out %d, ws %zu, need %zu)\n", n_in, out_size, ws_size, (size_t)WS_END); grid = -1; return; }
        int dev = 0, cus = 0;
        if (hipGetDevice(&dev) != hipSuccess || hipDeviceGetAttribute(&cus, hipDeviceAttributeMultiprocessorCount, dev) != hipSuccess) { grid = -1; return; }
        for (int k = 0; k <= 12; ++k) {
            if (hipFuncSetAttribute((const void*)(k == 12 ? (kern_t)fwd<-1> : kern_for(k)), hipFuncAttributeMaxDynamicSharedMemorySize, LDS_BYTES) != hipSuccess) { fprintf(stderr, "kernel_launch: hipFuncSetAttribute failed\n"); grid = -1; return; }
        }
        grid = cus > 0 ? cus : 256;
    }
    if (grid < 0) return;
    (void)hipMemsetAsync((char*)d_ws + WS_CTL, 0, CTL_BYTES, stream);
    Args a{};
    for (int i = 0; i < 20; ++i) a.in[i] = (const float*)d_in[i];
    a.out = (float*)d_out; a.ws = (unsigned char*)d_ws;
#if defined(MULTI_LAUNCH)
    for (int p = 0; p < N_PHASES; ++p) {
        if (p == 1 + 11) continue;
        a.ph_lo = p; a.ph_hi = p + 1;
        const int kind = p == 0 ? 11 : (p - 1) % 11;
        hipLaunchKernelGGL(kern_for(kind), dim3(grid), dim3(NTHREADS), LDS_BYTES, stream, a);
    }
#else
    a.ph_lo = 0; a.ph_hi = N_PHASES;
    hipLaunchKernelGGL(fwd<-1>, dim3(grid), dim3(NTHREADS), LDS_BYTES, stream, a);
#endif
}
```

```cpp
#include <hip/hip_runtime.h>
#include <stdint.h>
#include <stdio.h>

typedef unsigned short bf16_t;
typedef short bf16x8 __attribute__((ext_vector_type(8)));
typedef float f32x4 __attribute__((ext_vector_type(4)));
typedef float f32x16 __attribute__((ext_vector_type(16)));
typedef unsigned u32x4 __attribute__((ext_vector_type(4)));
#define LAS __attribute__((address_space(3)))
#define GAS __attribute__((address_space(1)))

constexpr int T = 32768, D = 1024, NB = 16, SEQ = 2048, DEPTH = 2;
constexpr int ZC = 5320, ZLD = 5376;
constexpr int C_QA = 0, C_FA = 512, C_IA = 1024, C_GA = 1536, C_QB = 2048, C_KB = 2560, C_VB = 2624, C_IQ = 2688, C_IK = 3200, C_IW = 3264, C_GTA = 3272, C_GTB = 4296;
constexpr int NE = 32, DFF = 1024, NSLOT = 131072 + 32 * 256, NBLK_MAX = NSLOT / 256;
constexpr int NMOD = 6 * D;
constexpr float EPS = 1e-6f;
constexpr int NTHREADS = 512, NWAVES = 8;
#ifndef PROBE_GROUP
#define PROBE_GROUP 0
#endif
constexpr int probe_reps(int kind) { return (PROBE_GROUP == 1 && (kind == 1 || kind == 4 || kind == 5 || kind == 8 || kind == 9)) || (PROBE_GROUP == 2 && kind == 2) || (PROBE_GROUP == 3 && kind == 3) || (PROBE_GROUP == 4 && kind == 100) || (PROBE_GROUP == 5 && (kind == 6 || kind == 7 || kind == 10)) || (PROBE_GROUP == 9 && kind == 8) || (PROBE_GROUP == 10 && kind == 1) || (PROBE_GROUP == 11 && kind == 9) || (PROBE_GROUP == 12 && (kind == 4 || kind == 5)) ? 2 : 1; }
constexpr int LDS_BYTES = 160 * 1024;

constexpr size_t al256(size_t x) { return (x + 255) & ~(size_t)255; }
constexpr size_t WS_CTL = 0;
constexpr size_t CTL_BYTES = 65536;
constexpr size_t WS_MOD = WS_CTL + CTL_BYTES;
constexpr size_t WS_LB = WS_MOD + al256((size_t)DEPTH * NB * NMOD * 4);
constexpr size_t WS_WIN = WS_LB + al256((size_t)DEPTH * 512 * 4);
constexpr size_t WS_WPA = WS_WIN + (size_t)DEPTH * ZLD * D * 2;
constexpr size_t WS_WPB = WS_WPA + (size_t)DEPTH * D * 512 * 2;
constexpr size_t WS_WOUT = WS_WPB + (size_t)DEPTH * D * 512 * 2;
constexpr size_t WS_W1 = WS_WOUT + (size_t)DEPTH * D * D * 2;
constexpr size_t WS_W2 = WS_W1 + (size_t)DEPTH * NE * 2 * DFF * D * 2;
constexpr size_t WS_H = WS_W2 + (size_t)DEPTH * NE * D * DFF * 2;
constexpr size_t WS_Z = WS_H + (size_t)T * D * 2;
constexpr size_t WS_Y = WS_Z;
constexpr size_t WS_ACT = WS_Z + (size_t)T * ZLD * 2;
constexpr size_t WS_ORAW = WS_ACT;
constexpr size_t WS_TMP = WS_ACT + (size_t)T * 512 * 4;
constexpr size_t WS_XS = WS_ACT + (size_t)NSLOT * DFF * 2;
constexpr size_t WS_HA = WS_XS + (size_t)NSLOT * D * 2;
constexpr size_t WS_ATT = WS_HA + (size_t)T * 512 * 2;
constexpr size_t WS_MASK = WS_ATT + (size_t)T * 512 * 2;
constexpr size_t WS_VBT = WS_MASK + (size_t)T * 64 * 4;
constexpr size_t WS_MERGED = WS_VBT + (size_t)T * 64 * 2;
constexpr size_t WS_X1 = WS_MERGED + (size_t)T * D * 2;
constexpr size_t WS_X2 = WS_X1 + (size_t)T * D * 4;
constexpr size_t WS_TOKE = WS_X2 + (size_t)T * D * 4;
constexpr size_t WS_TOKG = WS_TOKE + (size_t)T * 4 * 4;
constexpr size_t WS_TOKP = WS_TOKG + (size_t)T * 4 * 4;
constexpr size_t WS_TOKS = WS_TOKP + (size_t)T * 4 * 4;
constexpr size_t WS_BLKE = WS_TOKS + (size_t)T * 4 * 4;
constexpr size_t WS_BCNT = WS_BLKE + al256((size_t)(NBLK_MAX + 64) * 4);
constexpr size_t WS_END = WS_BCNT + (size_t)1024 * NE * 4;
static_assert((size_t)NSLOT * D * 2 <= (size_t)T * ZLD * 2, "Y must fit in Z");
static_assert((size_t)T * 512 * 4 + (size_t)T * D * 4 <= (size_t)NSLOT * DFF * 2, "ORAW+TMP must fit in ACT");
static_assert(WS_END <= ((size_t)1 << 31), "workspace layout exceeds 2 GiB");
constexpr int CW_CNT = 1024;
constexpr int CW_NBLK = 1200;

__device__ __forceinline__ bf16_t f2bf(float f) { unsigned u = __float_as_uint(f); u += 0x7fffu + ((u >> 16) & 1u); return (bf16_t)(u >> 16); }
__device__ __forceinline__ float bf2f(bf16_t b) { return __uint_as_float(((unsigned)b) << 16); }
__device__ __forceinline__ float sigmoidf_(float x) { return __builtin_amdgcn_rcpf(1.0f + __builtin_amdgcn_exp2f(-1.4426950408889634f * x)); }
__device__ __forceinline__ float wave_sum(float v) {
#pragma unroll
    for (int o = 32; o >= 1; o >>= 1) v += __shfl_xor(v, o);
    return v;
}
__device__ __forceinline__ int wave_sum_i(int v) {
#pragma unroll
    for (int o = 32; o >= 1; o >>= 1) v += __shfl_xor(v, o);
    return v;
}
__device__ const unsigned char T5_BUCKET[128] = {
    0, 1, 2, 3, 4, 5, 6, 7, 8, 9, 10, 11, 12, 13, 14, 15, 16, 16, 16, 17, 17, 18, 18, 18, 19, 19, 19, 20, 20, 20, 20, 21, 21, 21, 21, 22, 22, 22, 22, 22, 23, 23, 23, 23, 23, 23, 24, 24, 24, 24, 24, 24, 25,
    25, 25, 25, 25, 25, 25, 26, 26, 26, 26, 26, 26, 26, 26, 27, 27, 27, 27, 27, 27, 27, 27, 27, 27, 28, 28, 28, 28, 28, 28, 28, 28, 28, 28, 29, 29, 29, 29, 29, 29, 29, 29, 29, 29, 29, 29, 30, 30, 30, 30, 30,
    30, 30, 30, 30, 30, 30, 30, 30, 30, 31, 31, 31, 31, 31, 31, 31, 31, 31, 31, 31, 31, 31, 31, 31};
__device__ __forceinline__ int t5_bucket(int rel) { return rel >= 128 ? 31 : (int)T5_BUCKET[rel]; }


#define XB_TMO      128
#define XB_XCNT(j)  (256  + 64 * (j))
#define XB_XSUB(j)  (1280 + 64 * (j))
#define XB_XGEN(j)  (2304 + 64 * (j))
#define XB_TOP      3328
#define XB_TOPGEN   3392
#define XCD_BAR_WORDS 3456
#define XB_SPIN_CAP (1u << 18)
__device__ __forceinline__ unsigned xb_ld(unsigned* p)              { return __hip_atomic_load(p, __ATOMIC_RELAXED, __HIP_MEMORY_SCOPE_AGENT); }
__device__ __forceinline__ unsigned xb_add(unsigned* p, unsigned v) { return __hip_atomic_fetch_add(p, v, __ATOMIC_RELAXED, __HIP_MEMORY_SCOPE_AGENT); }
__device__ __forceinline__ unsigned xb_xcc_id() { return (unsigned)__builtin_amdgcn_s_getreg((3 << 11) | 20) & 0xFu; }
#define XB_SPIN(cond, bar) do { unsigned _sp = 0; while (cond) { __builtin_amdgcn_s_sleep(1); \
    if ((++_sp & 255u) == 0u) { if (xb_ld(&(bar)[XB_TMO])) break; if (_sp > XB_SPIN_CAP) { atomicAdd(&(bar)[XB_TMO], 1u); break; } } } } while (0)
struct XcdBarrier { unsigned* bar; unsigned x; volatile LAS unsigned* st; };
__device__ __forceinline__ XcdBarrier xcd_barrier_post(unsigned* bar, volatile LAS unsigned* st) {
    XcdBarrier b; b.bar = bar; b.x = xb_xcc_id(); b.st = st;
    if (threadIdx.x == 0) (void)xb_add(&bar[XB_XCNT(b.x)], 1u);
    return b;
}
__device__ __forceinline__ void xcd_barrier_complete(unsigned* bar, unsigned x, unsigned& nloc, unsigned& nx) {
    const unsigned G = gridDim.x * gridDim.y * gridDim.z;
    unsigned sum, cnt, mine, sp = 0u;
    for (;;) {
        sum = 0u; cnt = 0u; mine = 0u;
#pragma unroll
        for (unsigned j = 0; j < 16; ++j) { const unsigned c = xb_ld(&bar[XB_XCNT(j)]); sum += c; cnt += (c > 0u) ? 1u : 0u; mine = (j == x) ? c : mine; }
        if (sum == G) break;
        __builtin_amdgcn_s_sleep(1);
        if ((++sp & 255u) == 0u) { if (xb_ld(&bar[XB_TMO])) break; if (sp > XB_SPIN_CAP) { atomicAdd(&bar[XB_TMO], 1u); break; } }
    }
    nloc = mine > 0u ? mine : 1u; nx = cnt > 0u ? cnt : 1u;
}
__device__ __forceinline__ void xcd_barrier(const XcdBarrier& b) {
    asm volatile("s_waitcnt vmcnt(0)" ::: "memory");
    __syncthreads();
    if (threadIdx.x == 0) {
        unsigned* bar = b.bar; asm volatile("" : "+s"(bar));
        __builtin_amdgcn_s_waitcnt(0);
        unsigned nloc = b.st[0], nx = b.st[1];
        if (nloc == 0u) { xcd_barrier_complete(bar, b.x, nloc, nx); b.st[0] = nloc; b.st[1] = nx; }
        const unsigned old = xb_add(&bar[XB_XSUB(b.x)], 1u);
        const unsigned gen = old / nloc;
        if (old + 1u == (gen + 1u) * nloc) {
            __builtin_amdgcn_fence(__ATOMIC_RELEASE, "agent");
            asm volatile("s_waitcnt vmcnt(0)" ::: "memory");
            const unsigned og = xb_add(&bar[XB_TOP], 1u);
            const unsigned tg = og / nx;
            if (og + 1u == (tg + 1u) * nx) xb_add(&bar[XB_TOPGEN], 1u);
            else XB_SPIN(xb_ld(&bar[XB_TOPGEN]) == tg, bar);
            __builtin_amdgcn_fence(__ATOMIC_ACQUIRE, "agent");
            xb_add(&bar[XB_XGEN(b.x)], 1u);
            asm volatile("s_waitcnt vmcnt(0)" ::: "memory");
        } else {
            XB_SPIN(xb_ld(&bar[XB_XGEN(b.x)]) == gen, bar);
            __builtin_amdgcn_fence(__ATOMIC_ACQUIRE, "agent");
            asm volatile("s_waitcnt vmcnt(0)" ::: "memory");
        }
    }
    __syncthreads();
}
constexpr int CW_BAR = 4096;

struct Args { const float* in[20]; float* out; unsigned char* ws; int ph_lo, ph_hi; };
enum { I_X = 0, I_C, I_WADA, I_BADA, I_NMW, I_WIN, I_LBL, I_HNW, I_RELB, I_WPA, I_WPB, I_WOUT, I_NFW, I_WR, I_BR, I_W1, I_B1, I_W2, I_B2, I_FNW };

namespace pg8 {
#define PG8_LAS __attribute__((address_space(3)))
constexpr int BM = 256, BK = 64, HALF = 128, HTB = HALF * BK * 2, STAGE_BYTES = 8 * HTB, NXCD = 8, WGM = 8;
__host__ __device__ __forceinline__ int lds_byte(int r, int c) { const int st = (r >> 4) * 2 + (c >> 5), rr = r & 15, cc = c & 31, ob = rr * 64 + cc * 2; return st * 1024 + (ob ^ (((ob >> 9) & 1) << 5)); }
__host__ __device__ __forceinline__ void stage_rc(int b, int& R, int& C) { const int st = b / 1024, sb = b % 1024, swz = sb ^ (((sb >> 9) & 1) << 5); R = (st >> 1) * 16 + swz / 64; C = (st & 1) * 32 + (swz % 64) / 2; }
__host__ __device__ __forceinline__ int perm32(int rho) { const int n = rho >> 4, i = rho & 15; return 8 * (i >> 2) + 4 * n + (i & 3); }
struct Unit { int pm, pn, brow, e; };
struct Gemm { const bf16_t* A; const bf16_t* Bt; int M, N, K; };
struct StaticOrder {
    int nM, nN, nwg, G, c;
    __device__ void init(int M, int N, int G_, int c_) { nM = M / BM; nN = N / BM; nwg = nM * nN; G = G_; c = c_; }
    __device__ bool next(int i, Unit& u) const {
        const long L = (long)i * G + c; if (L >= nwg) return false;
        int wgid = (int)L; { const int q = nwg / NXCD, r = nwg % NXCD, xcd = wgid % NXCD, off = wgid / NXCD; wgid = (xcd < r ? xcd * (q + 1) : r * (q + 1) + (xcd - r) * q) + off; }
        const int nig = WGM * nN, gid = wgid / nig, fm = gid * WGM, gsz = (nM - fm) < WGM ? (nM - fm) : WGM;
        u.pm = fm + ((wgid % nig) % gsz); u.pn = (wgid % nig) / gsz; u.brow = u.pn * BM; u.e = 0; return true;
    }
    __device__ __forceinline__ void a_ready(const Unit&) const {}
    __device__ __forceinline__ void done(const Unit&) const {}
};
template <int NN> struct MoeOrder {
    int nwg, G, c; const int* blke;
    __device__ void init(int nM, int G_, int c_, const int* blke_) { nwg = nM * NN; G = G_; c = c_; blke = blke_; }
    __device__ bool next(int i, Unit& u) const {
        const int L = i * G + c; if (L >= nwg) return false;
        const int wgid = (L & 7) * (nwg >> 3) + (L >> 3);
        const int gid = wgid / (8 * NN), rem = wgid % (8 * NN);
        u.pm = gid * 8 + (rem & 7); u.pn = rem >> 3; u.e = __builtin_amdgcn_readfirstlane(blke[u.pm]); u.brow = u.e * (NN * BM) + u.pn * BM; return true;
    }
    __device__ __forceinline__ void a_ready(const Unit&) const {}
    __device__ __forceinline__ void done(const Unit&) const {}
};
typedef __bf16 bf16x2v_t __attribute__((ext_vector_type(2)));
typedef float f32x2v_t __attribute__((ext_vector_type(2)));
__device__ __forceinline__ unsigned cvt_pk_bf16(float lo, float hi) { const f32x2v_t v = {lo, hi}; const bf16x2v_t r = __builtin_convertvector(v, bf16x2v_t); return __builtin_bit_cast(unsigned, r); }


struct EpiZ {
    static constexpr bool PERM = true, AFTER_DRAIN = false;
    bf16_t* C; int ldc;
    __device__ __forceinline__ void operator()(const f32x4 (&acc)[2][2][4][2], const Unit& u, int wr, int wc, int fr, int fq) const {
        const int row0 = u.pm * BM + wr * 64 + fr, col0 = u.pn * BM + wc * 32 + 8 * fq;
#pragma unroll
        for (int ai = 0; ai < 2; ++ai)
#pragma unroll
            for (int m = 0; m < 4; ++m) { bf16_t* rowp = C + (size_t)(row0 + ai * HALF + m * 16) * ldc + col0;
#pragma unroll
                for (int bj = 0; bj < 2; ++bj) { const f32x4 v0 = acc[ai][bj][m][0], v1 = acc[ai][bj][m][1];
                    u32x4 w; w.x = cvt_pk_bf16(v0[0], v0[1]); w.y = cvt_pk_bf16(v0[2], v0[3]); w.z = cvt_pk_bf16(v1[0], v1[1]); w.w = cvt_pk_bf16(v1[2], v1[3]);
                    *(u32x4*)(rowp + bj * HALF) = w; } }
    }
};
__device__ __forceinline__ void bf8_to_f32(const u32x4 w, f32x4& lo, f32x4& hi) {
    lo[0] = __uint_as_float(w.x << 16); lo[1] = __uint_as_float(w.x & 0xffff0000u); lo[2] = __uint_as_float(w.y << 16); lo[3] = __uint_as_float(w.y & 0xffff0000u);
    hi[0] = __uint_as_float(w.z << 16); hi[1] = __uint_as_float(w.z & 0xffff0000u); hi[2] = __uint_as_float(w.w << 16); hi[3] = __uint_as_float(w.w & 0xffff0000u);
}
__device__ __forceinline__ f32x4 sig4(f32x4 g) { f32x4 r; r[0] = sigmoidf_(g[0]); r[1] = sigmoidf_(g[1]); r[2] = sigmoidf_(g[2]); r[3] = sigmoidf_(g[3]); return r; }
struct EpiMergeF {
    static constexpr bool PERM = true, AFTER_DRAIN = false, MIDK = true;
    bf16_t* merged; const bf16_t* Zga; const bf16_t* Zgb;
    __device__ __forceinline__ void mid(f32x4 (&acc)[2][2][4][2], const Unit& u, int wr, int wc, int fr, int fq) const {
        int row0 = u.pm * BM + wr * 64 + fr, col0 = u.pn * BM + wc * 32 + 8 * fq;
        asm volatile("" : "+v"(row0), "+v"(col0));
#pragma unroll
        for (int ai = 0; ai < 2; ++ai)
#pragma unroll
            for (int m = 0; m < 4; ++m) { const size_t row = (size_t)(row0 + ai * HALF + m * 16);
#pragma unroll
                for (int bj = 0; bj < 2; ++bj) { const int col = col0 + bj * HALF;
                    f32x4 a0, a1, b0, b1; bf8_to_f32(*(const u32x4*)(Zga + row * ZLD + col), a0, a1); bf8_to_f32(*(const u32x4*)(Zgb + row * ZLD + col), b0, b1);
#pragma unroll
                    for (int j = 0; j < 4; ++j) {
                        acc[ai][bj][m][0][j] *= (1.0f + __builtin_amdgcn_exp2f(-1.4426950408889634f * b0[j])) * __builtin_amdgcn_rcpf(1.0f + __builtin_amdgcn_exp2f(-1.4426950408889634f * a0[j]));
                        acc[ai][bj][m][1][j] *= (1.0f + __builtin_amdgcn_exp2f(-1.4426950408889634f * b1[j])) * __builtin_amdgcn_rcpf(1.0f + __builtin_amdgcn_exp2f(-1.4426950408889634f * a1[j])); }
                    asm volatile("" : "+v"(acc[ai][bj][m][0]), "+v"(acc[ai][bj][m][1]) :: "memory"); } }
    }
    __device__ __forceinline__ void operator()(const f32x4 (&acc)[2][2][4][2], const Unit& u, int wr, int wc, int fr, int fq) const {
        int row0 = u.pm * BM + wr * 64 + fr, col0 = u.pn * BM + wc * 32 + 8 * fq;
        asm volatile("" : "+v"(row0), "+v"(col0));
#pragma unroll
        for (int ai = 0; ai < 2; ++ai)
#pragma unroll
            for (int m = 0; m < 4; ++m) { const size_t row = (size_t)(row0 + ai * HALF + m * 16);
#pragma unroll
                for (int bj = 0; bj < 2; ++bj) { const int col = col0 + bj * HALF;
                    f32x4 g0, g1; bf8_to_f32(*(const u32x4*)(Zgb + row * ZLD + col), g0, g1); g0 = sig4(g0); g1 = sig4(g1);
                    const f32x4 v0 = g0 * acc[ai][bj][m][0], v1 = g1 * acc[ai][bj][m][1];
                    u32x4 w; w.x = cvt_pk_bf16(v0[0], v0[1]); w.y = cvt_pk_bf16(v0[2], v0[3]); w.z = cvt_pk_bf16(v1[0], v1[1]); w.w = cvt_pk_bf16(v1[2], v1[3]);
                    *(u32x4*)(merged + row * D + col) = w; } }
    }
};
struct EpiOutG {
    static constexpr bool PERM = false, AFTER_DRAIN = false;
    const float* xin; float* x1; const float* gate  ;
    __device__ __forceinline__ void operator()(const f32x4 (&acc)[2][2][4][2], const Unit& u, int wr, int wc, int fr, int fq) const {
        const int row0 = u.pm * BM + wr * 64 + fr, col0 = u.pn * BM + wc * 32 + 4 * fq; const int b = (u.pm * BM) >> 11;
        f32x4 gv[2][2];
#pragma unroll
        for (int bj = 0; bj < 2; ++bj)
#pragma unroll
            for (int n = 0; n < 2; ++n) gv[bj][n] = *(const f32x4*)(gate + (size_t)b * NMOD + col0 + bj * HALF + n * 16);
#pragma unroll
        for (int ai = 0; ai < 2; ++ai)
#pragma unroll
            for (int m = 0; m < 4; ++m) { const size_t off = (size_t)(row0 + ai * HALF + m * 16) * D + col0;
#pragma unroll
                for (int bj = 0; bj < 2; ++bj)
#pragma unroll
                    for (int n = 0; n < 2; ++n) *(f32x4*)(x1 + off + bj * HALF + n * 16) = *(const f32x4*)(xin + off + bj * HALF + n * 16) + gv[bj][n] * acc[ai][bj][m][n]; }
    }
};
struct EpiSwigluG {
    static constexpr bool PERM = true, AFTER_DRAIN = false;
    bf16_t* act; const float* b1  ;
    __device__ __forceinline__ void operator()(const f32x4 (&acc)[2][2][4][2], const Unit& u, int wr, int wc, int fr, int fq) const {
        const int row0 = u.pm * BM + wr * 64 + fr, col0 = u.pn * HALF + wc * 32 + 8 * fq;
        f32x4 bg[2], bl[2];
#pragma unroll
        for (int n = 0; n < 2; ++n) { bg[n] = *(const f32x4*)(b1 + (size_t)u.e * 2 * DFF + col0 + 4 * n); bl[n] = *(const f32x4*)(b1 + (size_t)u.e * 2 * DFF + DFF + col0 + 4 * n); }
#pragma unroll
        for (int ai = 0; ai < 2; ++ai)
#pragma unroll
            for (int m = 0; m < 4; ++m) { float o[8];
#pragma unroll
                for (int n = 0; n < 2; ++n) { const f32x4 gl = acc[ai][0][m][n] + bg[n], li = acc[ai][1][m][n] + bl[n];
#pragma unroll
                    for (int j = 0; j < 4; ++j) { const float g = fminf(gl[j], 7.0f), l = fminf(fmaxf(li[j], -7.0f), 7.0f); o[4 * n + j] = g * sigmoidf_(1.702f * g) * (l + 1.0f); } }
                u32x4 w; w.x = cvt_pk_bf16(o[0], o[1]); w.y = cvt_pk_bf16(o[2], o[3]); w.z = cvt_pk_bf16(o[4], o[5]); w.w = cvt_pk_bf16(o[6], o[7]);
                *(u32x4*)(act + (size_t)(row0 + ai * HALF + m * 16) * DFF + col0) = w; }
    }
};
struct EpiYG {
    static constexpr bool PERM = true, AFTER_DRAIN = false;
    bf16_t* Yb; const float* b2  ;
    __device__ __forceinline__ void operator()(const f32x4 (&acc)[2][2][4][2], const Unit& u, int wr, int wc, int fr, int fq) const {
        const int row0 = u.pm * BM + wr * 64 + fr, col0 = u.pn * BM + wc * 32 + 8 * fq;
        f32x4 bv[2][2];
#pragma unroll
        for (int bj = 0; bj < 2; ++bj)
#pragma unroll
            for (int n = 0; n < 2; ++n) bv[bj][n] = *(const f32x4*)(b2 + (size_t)u.e * D + col0 + bj * HALF + 4 * n);
#pragma unroll
        for (int ai = 0; ai < 2; ++ai)
#pragma unroll
            for (int m = 0; m < 4; ++m) { bf16_t* rowp = Yb + (size_t)(row0 + ai * HALF + m * 16) * D + col0;
#pragma unroll
                for (int bj = 0; bj < 2; ++bj) { const f32x4 v0 = acc[ai][bj][m][0] + bv[bj][0], v1 = acc[ai][bj][m][1] + bv[bj][1];
                    u32x4 w; w.x = cvt_pk_bf16(v0[0], v0[1]); w.y = cvt_pk_bf16(v0[2], v0[3]); w.z = cvt_pk_bf16(v1[0], v1[1]); w.w = cvt_pk_bf16(v1[2], v1[3]);
                    *(u32x4*)(rowp + bj * HALF) = w; } }
    }
};

template <class E, class = void> struct has_midk { static constexpr bool value = false; };
template <class E> struct has_midk<E, decltype((void)E::MIDK)> { static constexpr bool value = E::MIDK; };
template <class Epi, class Sched>
__device__ __forceinline__ void gemm_phase(PG8_LAS unsigned char* lds, const int tid, const Gemm g, const Sched& S, const Epi& E) {
    const int wid = __builtin_amdgcn_readfirstlane(tid >> 6), lane = tid & 63, wr = wid >> 2, wc = wid & 3, fr = lane & 15, fq = lane >> 4;
    const int K = g.K, nt = K / BK;
    unsigned voffA[2], voffB[2];
#pragma unroll
    for (int i = 0; i < 2; ++i) { int R, C; stage_rc(tid * 16 + i * 8192, R, C); const int Rb = Epi::PERM ? ((R & ~31) + perm32(R & 31)) : R;
        voffA[i] = (unsigned)(R * K + C) * 2u; voffB[i] = (unsigned)(Rb * K + C) * 2u; }
    const size_t kstep = (size_t)(BK * 2);
    const size_t hstep = (size_t)HALF * K * 2;
    const size_t tstep = 2 * hstep;
    const unsigned ldsw = (unsigned)wid * 1024u;
    const int aoff = lds_byte(wr * 64 + fr, fq * 8), boff = lds_byte(wc * 32 + fr, fq * 8);
#define PG8_SA(b, h) (((b) * 2 + (h)) * HTB)
#define PG8_SB(b, h) ((4 + (b) * 2 + (h)) * HTB)
#define PG8_STAGE(bufoff, gbase, voff) do { _Pragma("unroll") for (int _i = 0; _i < 2; ++_i) \
        __builtin_amdgcn_global_load_lds((const unsigned*)((const char*)(gbase) + (voff)[_i]), (PG8_LAS unsigned*)(lds + (bufoff) + ldsw + _i * 8192), 16, 0, 0); } while (0)
#define PG8_LDA(dst, b, h) do { _Pragma("unroll") for (int m = 0; m < 4; ++m) _Pragma("unroll") for (int k = 0; k < 2; ++k) dst[m][k] = *(const PG8_LAS bf16x8*)(lds + PG8_SA(b, h) + aoff + m * 2048 + k * 1024); } while (0)
#define PG8_LDB(dst, b, h) do { _Pragma("unroll") for (int n = 0; n < 2; ++n) _Pragma("unroll") for (int k = 0; k < 2; ++k) dst[n][k] = *(const PG8_LAS bf16x8*)(lds + PG8_SB(b, h) + boff + n * 2048 + k * 1024); } while (0)
#define PG8_MMA(ai, bj, At, Bt) do { __builtin_amdgcn_s_setprio(1); _Pragma("unroll") for (int m = 0; m < 4; ++m) _Pragma("unroll") for (int n = 0; n < 2; ++n) _Pragma("unroll") for (int k = 0; k < 2; ++k) \
        acc[ai][bj][m][n] = __builtin_amdgcn_mfma_f32_16x16x32_bf16(Bt[n][k], At[m][k], acc[ai][bj][m][n], 0, 0, 0); __builtin_amdgcn_s_setprio(0); } while (0)
#define PG8_WAIT_V(n) asm volatile("s_waitcnt vmcnt(" #n ")" ::: "memory")
#define PG8_WAIT_L(n) asm volatile("s_waitcnt lgkmcnt(" #n ")" ::: "memory")
#define PG8_BAR __builtin_amdgcn_s_barrier()
#define PG8_SCHED __builtin_amdgcn_sched_barrier(0)
    Unit cur, nxt; int ui = 0;
    if (!S.next(0, cur)) return;
    f32x4 acc[2][2][4][2];
#pragma unroll
    for (int a = 0; a < 2; ++a)
#pragma unroll
        for (int b = 0; b < 2; ++b)
#pragma unroll
            for (int m = 0; m < 4; ++m)
#pragma unroll
                for (int n = 0; n < 2; ++n) acc[a][b][m][n] = (f32x4){0.f, 0.f, 0.f, 0.f};
    bf16x8 At[4][2], B0[2][2], B1[2][2];
    const char* cA = (const char*)g.A + (size_t)cur.pm * tstep; const char* cB = (const char*)g.Bt + (size_t)cur.brow * K * 2;
    S.a_ready(cur);
    PG8_STAGE(PG8_SB(0, 0), cB, voffB); PG8_STAGE(PG8_SA(0, 0), cA, voffA); PG8_STAGE(PG8_SB(0, 1), cB + hstep, voffB); PG8_STAGE(PG8_SA(0, 1), cA + hstep, voffA);
    if (wr == 1) PG8_BAR;
    PG8_WAIT_V(4); PG8_BAR;
    PG8_STAGE(PG8_SB(1, 0), cB + kstep, voffB); PG8_STAGE(PG8_SA(1, 0), cA + kstep, voffA); PG8_STAGE(PG8_SB(1, 1), cB + hstep + kstep, voffB);
    PG8_WAIT_V(6); PG8_BAR;
    for (;;) {
        const bool has_next = S.next(ui + 1, nxt);
        const char* nA = has_next ? (const char*)g.A + (size_t)nxt.pm * tstep : cA; const char* nB = has_next ? (const char*)g.Bt + (size_t)nxt.brow * K * 2 : cB;
        for (int t = 0; t < nt; t += 2) {
            if constexpr (has_midk<Epi>::value) { if (t == nt / 2) E.mid(acc, cur, wr, wc, fr, fq); }
            const bool last = (t == nt - 2);
            const char* a1 = cA + (size_t)(t + 1) * kstep;
            const char* a2 = last ? nA : cA + (size_t)(t + 2) * kstep; const char* b2 = last ? nB : cB + (size_t)(t + 2) * kstep;
            const char* a3 = a2 + kstep; const char* b3 = b2 + kstep;
            if (last && has_next) S.a_ready(nxt);
            PG8_LDB(B0, 0, 0); PG8_SCHED; PG8_LDA(At, 0, 0); PG8_STAGE(PG8_SA(1, 1), a1 + hstep, voffA);
            PG8_WAIT_L(8); PG8_BAR; PG8_WAIT_L(0); PG8_MMA(0, 0, At, B0); PG8_BAR; PG8_SCHED;
            PG8_LDB(B1, 0, 1); PG8_STAGE(PG8_SB(0, 0), b2, voffB);
            PG8_BAR; PG8_WAIT_L(0); PG8_MMA(0, 1, At, B1); PG8_BAR;
            PG8_LDA(At, 0, 1); PG8_STAGE(PG8_SA(0, 0), a2, voffA);
            PG8_BAR; PG8_WAIT_L(0); PG8_MMA(1, 0, At, B0); PG8_BAR; PG8_SCHED;
            PG8_STAGE(PG8_SB(0, 1), b2 + hstep, voffB);
            PG8_WAIT_V(6); PG8_BAR; PG8_MMA(1, 1, At, B1); PG8_BAR;
            PG8_LDB(B0, 1, 0); PG8_SCHED; PG8_LDA(At, 1, 0); PG8_STAGE(PG8_SA(0, 1), a2 + hstep, voffA);
            PG8_WAIT_L(8); PG8_BAR; PG8_WAIT_L(0); PG8_MMA(0, 0, At, B0); PG8_BAR; PG8_SCHED;
            PG8_LDB(B1, 1, 1); PG8_STAGE(PG8_SB(1, 0), b3, voffB);
            PG8_BAR; PG8_WAIT_L(0); PG8_MMA(0, 1, At, B1); PG8_BAR;
            PG8_LDA(At, 1, 1); PG8_STAGE(PG8_SA(1, 0), a3, voffA);
            PG8_BAR; PG8_WAIT_L(0); PG8_MMA(1, 0, At, B0); PG8_BAR; PG8_SCHED;
            PG8_STAGE(PG8_SB(1, 1), b3 + hstep, voffB);
            PG8_WAIT_V(6); PG8_BAR; PG8_MMA(1, 1, At, B1); PG8_BAR;
        }
        if constexpr (!Epi::AFTER_DRAIN) { E(acc, cur, wr, wc, fr, fq); S.done(cur); }
        if (!has_next) break;
#pragma unroll
        for (int a = 0; a < 2; ++a)
#pragma unroll
            for (int b = 0; b < 2; ++b)
#pragma unroll
                for (int m = 0; m < 4; ++m)
#pragma unroll
                    for (int n = 0; n < 2; ++n) acc[a][b][m][n] = (f32x4){0.f, 0.f, 0.f, 0.f};
        cur = nxt; cA = nA; cB = nB; ++ui;
    }
    PG8_WAIT_V(0);
    if (wr == 0) PG8_BAR;
    PG8_BAR;
    if constexpr (Epi::AFTER_DRAIN) { E.fused(acc, cur, wr, wc, fr, fq, lds, wid, lane); S.done(cur); }
#undef PG8_SA
#undef PG8_SB
#undef PG8_STAGE
#undef PG8_LDA
#undef PG8_LDB
#undef PG8_MMA
#undef PG8_WAIT_V
#undef PG8_WAIT_L
#undef PG8_BAR
#undef PG8_SCHED
}
}


struct CvtJob { const float* src; bf16_t* dst; int N  , K  , nvalid  , sc0, sc1  ; };
constexpr int CJ_WIN = DEPTH * 16 * 21, CJ_WPA = DEPTH * 8 * 4, CJ_WPB = CJ_WPA, CJ_WOUT = DEPTH * 16 * 4, CJ_W1 = DEPTH * NE * 16 * 8, CJ_W2 = DEPTH * NE * 16 * 4;
constexpr int CJ_TOTAL = CJ_WIN + CJ_WPA + CJ_WPB + CJ_WOUT + CJ_W1 + CJ_W2;
__device__ __forceinline__ CvtJob cvt_job(int J, const float* const* in, unsigned char* ws) {
    CvtJob j;
    if (J < CJ_WIN) { const int m = J / (16 * 21), r = J % (16 * 21), kt = r / 21, ns = r % 21;
        j.src = in[I_WIN] + (size_t)m * D * ZC + (size_t)kt * 64 * ZC; j.dst = (bf16_t*)(ws + WS_WIN) + (size_t)m * ZLD * D + (size_t)ns * 256 * D + kt * 64; j.N = ZC; j.K = D;
        j.nvalid = ZC - ns * 256 < 256 ? ZC - ns * 256 : 256; j.sc0 = ns * 256; j.sc1 = ns * 256 + 128; return j; }
    J -= CJ_WIN;
    if (J < CJ_WPA + CJ_WPB) { const int which = J / CJ_WPA, JJ = J % CJ_WPA; const int m = JJ / 32, r = JJ % 32, kt = r / 4, ns = r % 4;
        j.src = in[which ? I_WPB : I_WPA] + (size_t)m * 512 * D + (size_t)kt * 64 * D; j.dst = (bf16_t*)(ws + WS_WPA) + (size_t)m * D * D + (size_t)ns * 256 * D + which * 512 + kt * 64; j.N = D; j.K = D;
        j.nvalid = 256; j.sc0 = ns * 256; j.sc1 = ns * 256 + 128; return j; }
    J -= CJ_WPA + CJ_WPB;
    if (J < CJ_WOUT) { const int m = J / 64, r = J % 64, kt = r / 4, ns = r % 4;
        j.src = in[I_WOUT] + (size_t)m * D * D + (size_t)kt * 64 * D; j.dst = (bf16_t*)(ws + WS_WOUT) + (size_t)m * D * D + (size_t)ns * 256 * D + kt * 64; j.N = D; j.K = D;
        j.nvalid = 256; j.sc0 = ns * 256; j.sc1 = ns * 256 + 128; return j; }
    J -= CJ_WOUT;
    if (J < CJ_W1) { const int m = J / 128, r = J % 128, kt = r / 8, ns = r % 8;
        j.src = in[I_W1] + (size_t)m * D * 2 * DFF + (size_t)kt * 64 * 2 * DFF; j.dst = (bf16_t*)(ws + WS_W1) + (size_t)m * 2 * DFF * D + (size_t)ns * 256 * D + kt * 64; j.N = 2 * DFF; j.K = D;
        j.nvalid = 256; j.sc0 = 128 * ns; j.sc1 = DFF + 128 * ns; return j; }
    J -= CJ_W1;
    { const int m = J / 64, r = J % 64, kt = r / 4, ns = r % 4;
        j.src = in[I_W2] + (size_t)m * DFF * D + (size_t)kt * 64 * D; j.dst = (bf16_t*)(ws + WS_W2) + (size_t)m * D * DFF + (size_t)ns * 256 * DFF + kt * 64; j.N = D; j.K = DFF;
        j.nvalid = 256; j.sc0 = ns * 256; j.sc1 = ns * 256 + 128; return j; }
}
__device__ __forceinline__ void cvt_load(const CvtJob& j, const int tid, f32x4 (&v)[8]) {
    const int i = tid >> 3, c0 = (tid & 7) * 32; const float* p = j.src + (size_t)i * j.N + (c0 < 128 ? j.sc0 + c0 : j.sc1 + c0 - 128);
#pragma unroll
    for (int q = 0; q < 8; ++q) v[q] = (c0 + 4 * q < j.nvalid) ? *(const f32x4*)(p + 4 * q) : (f32x4){0.f, 0.f, 0.f, 0.f};
}

__device__ __forceinline__ void hgrn_item(const bf16_t* __restrict__ zb, const float* __restrict__ lbv, float* __restrict__ oraw, unsigned char* ldsb, const int b, const int h, const int dvq, const int tid) {
    typedef unsigned long long u64;
    const int lane = tid & 63, wave = tid >> 6, r31 = lane & 31, hh = lane >> 5;
    bf16_t* QE = (bf16_t*)ldsb;
    bf16_t* KE = QE + 64 * 136;
    bf16_t* KET = KE + 64 * 136;
    bf16_t* VT = KET + 128 * 72;
    bf16_t* SBT = VT + 32 * 72;
    float* ex = (float*)(SBT + 32 * 136);
    float* er = ex + 512; float* el = er + 128; float* elr = el + 128;
    const int d = tid & 127, tg = tid >> 7;
    const float lb = lbv[h * 128 + d], oml = 1.0f - lb;
    const int vs = tid & 63, v0 = (tid >> 6) * 4;
    const bf16_t* fbase = zb + (size_t)(b * SEQ + 16 * tg) * ZLD + C_FA + h * 128 + d;
    const bf16_t* qbase = zb + (size_t)(b * SEQ + 16 * tg) * ZLD + C_QA + h * 128 + d;
    const bf16_t* vbase = zb + (size_t)(b * SEQ + vs) * ZLD + C_IA + h * 128 + dvq * 32 + v0;
    bf16_t nf[16], nq[16]; u64 nv;
#pragma unroll
    for (int j = 0; j < 16; ++j) { nf[j] = fbase[(size_t)j * ZLD]; nq[j] = qbase[(size_t)j * ZLD]; }
    nv = *(const u64*)vbase;
    f32x16 Sacc;
#pragma unroll
    for (int i = 0; i < 16; ++i) Sacc[i] = 0.f;
    for (int c = 0; c < SEQ / 64; ++c) {
        const int row0 = b * SEQ + c * 64;
        float g[16], kk[16], qv[16]; float run = 0.f;
#pragma unroll
        for (int j = 0; j < 16; ++j) {
            const float zf = fminf(fmaxf(bf2f(nf[j]), -60.f), 60.f), zq = bf2f(nq[j]);
            const float e = __builtin_amdgcn_exp2f(-1.4426950408889634f * zf), sg = __builtin_amdgcn_rcpf(1.0f + e);
            run += 0.6931471805599453f * __builtin_amdgcn_logf(lb + oml * sg); g[j] = run; kk[j] = oml * e * sg; qv[j] = zq * sigmoidf_(zq);
        }
        const u64 cv = nv;
        ex[tg * 128 + d] = run;
        __syncthreads();
        {
            const float e0 = ex[d], e1 = ex[128 + d], e2 = ex[256 + d], e3 = ex[384 + d];
            const float pre = tg == 0 ? 0.f : tg == 1 ? e0 : tg == 2 ? e0 + e1 : e0 + e1 + e2;
            const float r = e0 + e1, tot = (e0 + e1) + (e2 + e3);
            unsigned kt[8];
#pragma unroll
            for (int j = 0; j < 16; j += 2) {
                const float bt0 = pre + g[j], bt1 = pre + g[j + 1];
                const float L2E = 1.4426950408889634f;
                const float qe0 = qv[j] * __builtin_amdgcn_exp2f(L2E * fminf(bt0 - r, 80.f)), qe1 = qv[j + 1] * __builtin_amdgcn_exp2f(L2E * fminf(bt1 - r, 80.f));
                const float ke0 = kk[j] * __builtin_amdgcn_exp2f(L2E * fminf(r - bt0, 80.f)), ke1 = kk[j + 1] * __builtin_amdgcn_exp2f(L2E * fminf(r - bt1, 80.f));
                const unsigned qp = pg8::cvt_pk_bf16(qe0, qe1), kp = pg8::cvt_pk_bf16(ke0, ke1);
                QE[(16 * tg + j) * 136 + d] = (bf16_t)(qp & 0xffffu); QE[(16 * tg + j + 1) * 136 + d] = (bf16_t)(qp >> 16);
                KE[(16 * tg + j) * 136 + d] = (bf16_t)(kp & 0xffffu); KE[(16 * tg + j + 1) * 136 + d] = (bf16_t)(kp >> 16);
                kt[j >> 1] = kp;
            }
            u32x4 w0, w1; w0.x = kt[0]; w0.y = kt[1]; w0.z = kt[2]; w0.w = kt[3]; w1.x = kt[4]; w1.y = kt[5]; w1.z = kt[6]; w1.w = kt[7];
            *(u32x4*)(KET + d * 72 + 16 * tg) = w0; *(u32x4*)(KET + d * 72 + 16 * tg + 8) = w1;
            if (tg == 0) { er[d] = __expf(r); el[d] = __expf(tot); elr[d] = __expf(tot - r); }
            VT[(v0 + 0) * 72 + vs] = (bf16_t)(cv & 0xffffu); VT[(v0 + 1) * 72 + vs] = (bf16_t)((cv >> 16) & 0xffffu); VT[(v0 + 2) * 72 + vs] = (bf16_t)((cv >> 32) & 0xffffu); VT[(v0 + 3) * 72 + vs] = (bf16_t)(cv >> 48);
        }
        __syncthreads();
        if (c + 1 < SEQ / 64) {
#pragma unroll
            for (int j = 0; j < 16; ++j) { nf[j] = fbase[(size_t)((c + 1) * 64 + j) * ZLD]; nq[j] = qbase[(size_t)((c + 1) * 64 + j) * ZLD]; }
            nv = *(const u64*)(vbase + (size_t)(c + 1) * 64 * ZLD);
        }
        if (wave >= 2 && wave < 6) {
            const int dq = wave - 2;
#pragma unroll
            for (int g4 = 0; g4 < 4; ++g4) {
                const int dd = 32 * dq + 8 * g4 + 4 * hh;
                const unsigned a0 = pg8::cvt_pk_bf16(er[dd] * Sacc[4 * g4], er[dd + 1] * Sacc[4 * g4 + 1]), a1 = pg8::cvt_pk_bf16(er[dd + 2] * Sacc[4 * g4 + 2], er[dd + 3] * Sacc[4 * g4 + 3]);
                *(u64*)(SBT + r31 * 136 + dd) = (u64)a0 | ((u64)a1 << 32);
            }
        }
        __syncthreads();
        if (wave < 2) {
            const int tt = wave;
            f32x16 Oacc;
#pragma unroll
            for (int i = 0; i < 16; ++i) Oacc[i] = 0.f;
            bf16x8 qf[8];
#pragma unroll
            for (int ks = 0; ks < 8; ++ks) qf[ks] = *(const bf16x8*)(QE + (32 * tt + r31) * 136 + 16 * ks + 8 * hh);
#pragma unroll
            for (int ks = 0; ks < 8; ++ks) { const bf16x8 sa = *(const bf16x8*)(SBT + r31 * 136 + 16 * ks + 8 * hh); Oacc = __builtin_amdgcn_mfma_f32_32x32x16_bf16(sa, qf[ks], Oacc, 0, 0, 0); }
            for (int st = 0; st <= tt; ++st) {
                f32x16 At;
#pragma unroll
                for (int i = 0; i < 16; ++i) At[i] = 0.f;
#pragma unroll
                for (int ks = 0; ks < 8; ++ks) { const bf16x8 ka = *(const bf16x8*)(KE + (32 * st + r31) * 136 + 16 * ks + 8 * hh); At = __builtin_amdgcn_mfma_f32_32x32x16_bf16(ka, qf[ks], At, 0, 0, 0); }
                if (st == tt) {
#pragma unroll
                    for (int i = 0; i < 16; ++i) { const int sl = (i & 3) + 8 * (i >> 2) + 4 * hh; if (sl > r31) At[i] = 0.f; }
                }
                union { unsigned u[4]; bf16x8 v; } pb0, pb1;
#pragma unroll
                for (int j = 0; j < 4; ++j) { pb0.u[j] = pg8::cvt_pk_bf16(At[2 * j], At[2 * j + 1]); pb1.u[j] = pg8::cvt_pk_bf16(At[8 + 2 * j], At[8 + 2 * j + 1]); }
                union { u64 q[2]; bf16x8 v; } a0, a1;
                a0.q[0] = *(const u64*)(VT + r31 * 72 + 32 * st + 4 * hh); a0.q[1] = *(const u64*)(VT + r31 * 72 + 32 * st + 8 + 4 * hh);
                a1.q[0] = *(const u64*)(VT + r31 * 72 + 32 * st + 16 + 4 * hh); a1.q[1] = *(const u64*)(VT + r31 * 72 + 32 * st + 24 + 4 * hh);
                Oacc = __builtin_amdgcn_mfma_f32_32x32x16_bf16(a0.v, pb0.v, Oacc, 0, 0, 0);
                Oacc = __builtin_amdgcn_mfma_f32_32x32x16_bf16(a1.v, pb1.v, Oacc, 0, 0, 0);
            }
            float* op = oraw + (size_t)(row0 + 32 * tt + r31) * 512 + h * 128 + dvq * 32 + 4 * hh;
#pragma unroll
            for (int g4 = 0; g4 < 4; ++g4) { f32x4 o; o[0] = Oacc[4 * g4]; o[1] = Oacc[4 * g4 + 1]; o[2] = Oacc[4 * g4 + 2]; o[3] = Oacc[4 * g4 + 3]; *(f32x4*)(op + 8 * g4) = o; }
        } else if (wave < 6) {
            const int dq = wave - 2;
            f32x16 dS;
#pragma unroll
            for (int i = 0; i < 16; ++i) dS[i] = 0.f;
#pragma unroll
            for (int ks = 0; ks < 4; ++ks) { const bf16x8 ka = *(const bf16x8*)(KET + (32 * dq + r31) * 72 + 16 * ks + 8 * hh), vb = *(const bf16x8*)(VT + r31 * 72 + 16 * ks + 8 * hh);
                dS = __builtin_amdgcn_mfma_f32_32x32x16_bf16(ka, vb, dS, 0, 0, 0); }
#pragma unroll
            for (int i = 0; i < 16; ++i) { const int dd = 32 * dq + (i & 3) + 8 * (i >> 2) + 4 * hh; Sacc[i] = el[dd] * Sacc[i] + elr[dd] * dS[i]; }
        }
        __syncthreads();
    }
}


#define DPP_STEP(v, op, ctrl) v = v op __builtin_amdgcn_update_dpp(v, v, ctrl, 0xf, 0xf, false)
__device__ __forceinline__ int wave_sum_dpp(int v) { DPP_STEP(v, +, 0xB1); DPP_STEP(v, +, 0x4E); DPP_STEP(v, +, 0x141); DPP_STEP(v, +, 0x140);
    return __builtin_amdgcn_readlane(v, 0) + __builtin_amdgcn_readlane(v, 16) + __builtin_amdgcn_readlane(v, 32) + __builtin_amdgcn_readlane(v, 48); }
__device__ __forceinline__ int wave_and_u(int v) { DPP_STEP(v, &, 0xB1); DPP_STEP(v, &, 0x4E); DPP_STEP(v, &, 0x141); DPP_STEP(v, &, 0x140);
    return __builtin_amdgcn_readlane(v, 0) & __builtin_amdgcn_readlane(v, 16) & __builtin_amdgcn_readlane(v, 32) & __builtin_amdgcn_readlane(v, 48); }
__device__ __forceinline__ int wave_or_u(int v) { DPP_STEP(v, |, 0xB1); DPP_STEP(v, |, 0x4E); DPP_STEP(v, |, 0x141); DPP_STEP(v, |, 0x140);
    return __builtin_amdgcn_readlane(v, 0) | __builtin_amdgcn_readlane(v, 16) | __builtin_amdgcn_readlane(v, 32) | __builtin_amdgcn_readlane(v, 48); }

__device__ __forceinline__ unsigned ordered_key(float f) { const unsigned u = __float_as_uint(f); return (u & 0x80000000u) ? ~u : (u | 0x80000000u); }
__device__ __forceinline__ void indexer_unit(const bf16_t* __restrict__ zb, unsigned* __restrict__ maskp, unsigned* sc  , bf16_t* ring  ,
                                             const int b, const int t0, const int tid) {
    typedef unsigned long long u64;
    const int lane = tid & 63, wave = tid >> 6;
    const int r31 = lane & 31, hh = lane >> 5;
    constexpr int IDX_TILE = 32 * 72, IDX_SLOT = 2 * IDX_TILE;
    unsigned* hist = (unsigned*)ring + wave * 256;
    {
        const int g = wave & 3, par = wave >> 2;
        const int head = (r31 & 3) + 4 * ((r31 >> 3) & 1), ql = 2 * ((r31 >> 4) & 1) + ((r31 >> 2) & 1);
        const bf16_t* ap = zb + (size_t)(b * SEQ + t0 + 4 * g + ql) * ZLD + C_IQ + head * 64 + 8 * hh;
        bf16x8 a[4];
#pragma unroll
        for (int s4 = 0; s4 < 4; ++s4) a[s4] = *(const bf16x8*)(ap + 16 * s4);
        float wq[16];
        {
            const int qa = t0 + 4 * g + hh, qb = qa + 2;
            f32x4 w0, w1, w2, w3; pg8::bf8_to_f32(*(const u32x4*)(zb + (size_t)(b * SEQ + qa) * ZLD + C_IW), w0, w1); pg8::bf8_to_f32(*(const u32x4*)(zb + (size_t)(b * SEQ + qb) * ZLD + C_IW), w2, w3);
#pragma unroll
            for (int i = 0; i < 4; ++i) { wq[i] = w0[i] * 0.04419417382415922f; wq[4 + i] = w1[i] * 0.04419417382415922f; wq[8 + i] = w2[i] * 0.04419417382415922f; wq[12 + i] = w3[i] * 0.04419417382415922f; }
        }
        const int ta = t0 + 4 * g + hh, tb_ = ta + 2;
        const int kt_max = (t0 + 15) >> 5, nit = (kt_max >> 1) + 1;
        const int lsub = tid >> 8, lkey = (tid & 255) >> 3, lpc = tid & 7;
        const bf16_t* gsrc = zb + ((size_t)b * SEQ + lsub * 32 + lkey) * ZLD + C_IK + lpc * 8;
        const int loff = lsub * IDX_TILE + lkey * 72 + lpc * 8;
        u32x4 stg;
        __syncthreads();
        if (lsub <= kt_max) { stg = *(const u32x4*)gsrc; *(u32x4*)(ring + loff) = stg; }
        if (nit > 1 && 2 + lsub <= kt_max) { stg = *(const u32x4*)(gsrc + (size_t)64 * ZLD); *(u32x4*)(ring + IDX_SLOT + loff) = stg; }
        __syncthreads();
        for (int it = 0; it < nit; ++it) {
            const bool more = (it + 2 < nit) && (2 * (it + 2) + lsub <= kt_max);
            if (more) stg = *(const u32x4*)(gsrc + (size_t)(it + 2) * 64 * ZLD);
            const int kt = 2 * it + par;
            if (kt <= kt_max) {
                const bf16_t* tl = ring + (it % 3) * IDX_SLOT + par * IDX_TILE + r31 * 72 + 8 * hh;
                f32x16 acc;
#pragma unroll
                for (int q = 0; q < 16; ++q) acc[q] = 0.f;
#pragma unroll
                for (int s4 = 0; s4 < 4; ++s4) { const bf16x8 bk = *(const bf16x8*)(tl + 16 * s4); acc = __builtin_amdgcn_mfma_f32_32x32x16_bf16(a[s4], bk, acc, 0, 0, 0); }
                float sa = 0.f, sb = 0.f;
#pragma unroll
                for (int i = 0; i < 8; ++i) { sa += wq[i] * fmaxf(acc[i], 0.f); sb += wq[8 + i] * fmaxf(acc[8 + i], 0.f); }
                const int key = kt * 32 + r31;
                sc[(4 * g + hh) * 2048 + key] = key <= ta ? ordered_key(sa) : 0u;
                sc[(4 * g + 2 + hh) * 2048 + key] = key <= tb_ ? ordered_key(sb) : 0u;
            }
            if (more) *(u32x4*)(ring + ((it + 2) % 3) * IDX_SLOT + loff) = stg;
            __syncthreads();
        }
    }
    for (int srep_ = 0; srep_ < (PROBE_GROUP == 8 ? 2 : 1); ++srep_)
    for (int qq = 2 * wave; qq < 2 * wave + 2; ++qq) {
        const int t = t0 + qq;
        unsigned kreg[32];
#pragma unroll
        for (int i = 0; i < 32; ++i) { const int p = lane + 64 * i; kreg[i] = (p <= t) ? sc[qq * 2048 + p] : 0u; }
        unsigned kand = 0xffffffffu, kor = 0u;
#pragma unroll
        for (int i = 0; i < 32; ++i) { if (lane + 64 * i <= t) { kand &= kreg[i]; kor |= kreg[i]; } }
        kand = (unsigned)wave_and_u(kand); kor = (unsigned)wave_or_u(kor);
        const unsigned diff = kand ^ kor;
        unsigned prefix; int hb;
        if (diff == 0u) { prefix = kor; hb = -1; } else { hb = 31 - __builtin_clz(diff); prefix = (hb == 31) ? 0u : (kor & ~((2u << hb) - 1u)); }
        bool exact = false;
        for (int bit = hb; bit >= 0; --bit) {
            const unsigned cand = prefix | (1u << bit);
            int cl = 0;
#pragma unroll
            for (int i = 0; i < 32; ++i) cl += (kreg[i] >= cand) ? 1 : 0;
            const int cnt = wave_sum_dpp(cl);
            if (cnt >= 256) prefix = cand;
            if (cnt == 256) { exact = true; break; }
        }
        int kk = 0;
        if (!exact) { int cl = 0;
#pragma unroll
            for (int i = 0; i < 32; ++i) cl += (kreg[i] > prefix) ? 1 : 0;
            kk = 256 - wave_sum_dpp(cl); }
        const unsigned gtv = exact ? prefix - 1u : prefix;
        unsigned myword = 0u; int eqbefore = 0;
#pragma unroll
        for (int i = 0; i < 32; ++i) {
            const bool eq = kreg[i] == prefix;
            const unsigned long long beq = __ballot(eq);
            const int rank = eqbefore + __popcll(beq & ((1ull << lane) - 1ull));
            const bool sel = kreg[i] > gtv || (eq && rank < kk);
            const unsigned long long bs = __ballot(sel);
            eqbefore += __popcll(beq);
            if (lane == 2 * i) myword = (unsigned)bs;
            if (lane == 2 * i + 1) myword = (unsigned)(bs >> 32);
        }
        maskp[(size_t)(b * SEQ + t) * 64 + lane] = myword;
    }
    __syncthreads();
}

constexpr int ATT_KROW = 72, ATT_VROW = 36, ATT_SLOT = 32 * ATT_KROW + 64 * ATT_VROW;
__device__ __forceinline__ void attn_block(const bf16_t* __restrict__ zb, const bf16_t* __restrict__ vbt, const unsigned* __restrict__ maskp, bf16_t* __restrict__ att, const float* tb  ,
                                           bf16_t* ring  , const int b, const int qt, const int tid) {
    typedef unsigned long long u64;
    const int lane = tid & 63, wave = tid >> 6;
    const int c = lane & 31, hh = lane >> 5, h = c & 7;
    const int t0w = qt * 32 + 4 * wave;
    const int tq = t0w + (c >> 3);
    const size_t rowq = (size_t)b * SEQ + tq;
    bf16x8 bq[4];
#pragma unroll
    for (int s4 = 0; s4 < 4; ++s4) bq[s4] = *(const bf16x8*)(zb + rowq * ZLD + C_QB + h * 64 + 16 * s4 + 8 * hh);
    const int kt_max = qt;
    const float bfar = tb[127 * 8 + h];
    const float LOG2E = 1.4426950408889634f;
    float m = -1e30f, lsum = 0.f;
    f32x16 O0, O1;
#pragma unroll
    for (int q = 0; q < 16; ++q) { O0[q] = 0.f; O1[q] = 0.f; }
    const unsigned* mbase = maskp + rowq * 64;
    const bool ldk = tid < 256;
    const int lrow = ldk ? (tid >> 3) : ((tid - 256) >> 2), lpc = ldk ? (tid & 7) : (tid & 3);
    const bf16_t* gsrc = ldk ? zb + ((size_t)b * SEQ + lrow) * ZLD + C_KB + lpc * 8 : vbt + ((size_t)b * 64 + lrow) * SEQ + lpc * 8;
    const size_t gstep = ldk ? (size_t)32 * ZLD : (size_t)32;
    const int loff = ldk ? lrow * ATT_KROW + lpc * 8 : 32 * ATT_KROW + lrow * ATT_VROW + lpc * 8;
    u32x4 stg = *(const u32x4*)gsrc;
    { u64* d = (u64*)(ring + loff); d[0] = (u64)stg.x | ((u64)stg.y << 32); d[1] = (u64)stg.z | ((u64)stg.w << 32); }
    if (kt_max >= 1) { stg = *(const u32x4*)(gsrc + gstep); u64* d = (u64*)(ring + ATT_SLOT + loff); d[0] = (u64)stg.x | ((u64)stg.y << 32); d[1] = (u64)stg.z | ((u64)stg.w << 32); }
    unsigned mw = mbase[0];
    __syncthreads();
    for (int kt = 0; kt <= kt_max; ++kt) {
        const int key0 = kt * 32;
        const bf16_t* sl = ring + (kt % 3) * ATT_SLOT;
        const bool more = kt + 2 <= kt_max;
        if (more) stg = *(const u32x4*)(gsrc + (size_t)(kt + 2) * gstep);
        const unsigned cmw = mw >> (4 * hh);
        mw = mbase[kt < kt_max ? kt + 1 : kt];
        f32x16 S;
#pragma unroll
        for (int q = 0; q < 16; ++q) S[q] = 0.f;
#pragma unroll
        for (int s4 = 0; s4 < 4; ++s4) { const bf16x8 ak = *(const bf16x8*)(sl + c * ATT_KROW + 16 * s4 + 8 * hh); S = __builtin_amdgcn_mfma_f32_32x32x16_bf16(ak, bq[s4], S, 0, 0, 0); }
        const bool nearb = (t0w - key0 - 31) < 113;
        float x[16]; float tmax = -1e30f;
        const int relb = tq - key0 - 4 * hh;
#pragma unroll
        for (int i = 0; i < 16; ++i) {
            const int ko = (i & 3) + 8 * (i >> 2);
            float bias = bfar;
            if (nearb) { int rel = relb - ko; rel = rel < 0 ? 0 : (rel > 127 ? 127 : rel); bias = tb[rel * 8 + h]; }
            x[i] = S[i] * 0.125f + bias;
            if ((cmw >> ko) & 1u) tmax = fmaxf(tmax, x[i]);
        }
        tmax = fmaxf(tmax, __shfl_xor(tmax, 32));
        const float mn = fmaxf(m, tmax);
        if (__ballot(mn > m) != 0ull) {
            const float scl = __builtin_amdgcn_exp2f((m - mn) * LOG2E);
            lsum *= scl;
#pragma unroll
            for (int q = 0; q < 16; ++q) { O0[q] *= scl; O1[q] *= scl; }
        }
        m = mn;
        float p[16];
#pragma unroll
        for (int i = 0; i < 16; ++i) { const int ko = (i & 3) + 8 * (i >> 2); p[i] = ((cmw >> ko) & 1u) ? __builtin_amdgcn_exp2f((x[i] - m) * LOG2E) : 0.f; lsum += p[i]; }
        union { unsigned u[4]; bf16x8 v; } pb0, pb1;
#pragma unroll
        for (int j = 0; j < 4; ++j) { pb0.u[j] = pg8::cvt_pk_bf16(p[2 * j], p[2 * j + 1]); pb1.u[j] = pg8::cvt_pk_bf16(p[8 + 2 * j], p[8 + 2 * j + 1]); }
        const bf16_t* vt = sl + 32 * ATT_KROW + c * ATT_VROW + 4 * hh;
        union { u64 q[2]; bf16x8 v; } a00, a01, a10, a11;
        a00.q[0] = *(const u64*)(vt); a00.q[1] = *(const u64*)(vt + 8); a01.q[0] = *(const u64*)(vt + 16); a01.q[1] = *(const u64*)(vt + 24);
        a10.q[0] = *(const u64*)(vt + 32 * ATT_VROW); a10.q[1] = *(const u64*)(vt + 32 * ATT_VROW + 8); a11.q[0] = *(const u64*)(vt + 32 * ATT_VROW + 16); a11.q[1] = *(const u64*)(vt + 32 * ATT_VROW + 24);
        O0 = __builtin_amdgcn_mfma_f32_32x32x16_bf16(a00.v, pb0.v, O0, 0, 0, 0);
        O0 = __builtin_amdgcn_mfma_f32_32x32x16_bf16(a01.v, pb1.v, O0, 0, 0, 0);
        O1 = __builtin_amdgcn_mfma_f32_32x32x16_bf16(a10.v, pb0.v, O1, 0, 0, 0);
        O1 = __builtin_amdgcn_mfma_f32_32x32x16_bf16(a11.v, pb1.v, O1, 0, 0, 0);
        if (more) { u64* d = (u64*)(ring + ((kt + 2) % 3) * ATT_SLOT + loff); d[0] = (u64)stg.x | ((u64)stg.y << 32); d[1] = (u64)stg.z | ((u64)stg.w << 32); }
        __syncthreads();
    }
    lsum += __shfl_xor(lsum, 32);
    const float inv = __builtin_amdgcn_rcpf(lsum);
    bf16_t* op = att + rowq * D + 512 + h * 64 + 4 * hh;
#pragma unroll
    for (int g4 = 0; g4 < 4; ++g4) {
        unsigned w0 = pg8::cvt_pk_bf16(O0[4 * g4] * inv, O0[4 * g4 + 1] * inv), w1 = pg8::cvt_pk_bf16(O0[4 * g4 + 2] * inv, O0[4 * g4 + 3] * inv);
        *(u64*)(op + 8 * g4) = (u64)w0 | ((u64)w1 << 32);
        w0 = pg8::cvt_pk_bf16(O1[4 * g4] * inv, O1[4 * g4 + 1] * inv); w1 = pg8::cvt_pk_bf16(O1[4 * g4 + 2] * inv, O1[4 * g4 + 3] * inv);
        *(u64*)(op + 32 + 8 * g4) = (u64)w0 | ((u64)w1 << 32);
    }
}

template <int KIND> __global__ void __launch_bounds__(NTHREADS, 2) fwd(Args args) {
    extern __shared__ __attribute__((aligned(16))) unsigned char lds[];
    const int tid = threadIdx.x, lane = tid & 63, wave = tid >> 6;
    const int G = gridDim.x;
    PG8_LAS unsigned char* const lds3 = (PG8_LAS unsigned char*)lds;
#define WS_OPAQUE() unsigned long long ws_raw_ = (unsigned long long)args.ws; asm volatile("" : "+s"(ws_raw_)); GAS unsigned char* const wsg_ = (GAS unsigned char*)ws_raw_; unsigned char* const ws = (unsigned char*)wsg_; int tid = threadIdx.x; asm volatile("" : "+v"(tid)); const int lane = tid & 63, wave = tid >> 6; (void)lane; (void)wave
#define ctl ((unsigned*)(ws + WS_CTL))
#define MOD ((float*)(ws + WS_MOD))
#define LB ((float*)(ws + WS_LB))
#define WIN ((bf16_t*)(ws + WS_WIN))
#define WPA ((bf16_t*)(ws + WS_WPA))
#define WPB ((bf16_t*)(ws + WS_WPB))
#define WOUT ((bf16_t*)(ws + WS_WOUT))
#define W1 ((bf16_t*)(ws + WS_W1))
#define W2 ((bf16_t*)(ws + WS_W2))
#define H ((bf16_t*)(ws + WS_H))
#define ZB ((bf16_t*)(ws + WS_Z))
#define VBT ((bf16_t*)(ws + WS_VBT))
#define Y ((bf16_t*)(ws + WS_Y))
#define XS ((bf16_t*)(ws + WS_XS))
#define ACT ((bf16_t*)(ws + WS_ACT))
#define ORAW ((float*)(ws + WS_ORAW))
#define TMP ((float*)(ws + WS_TMP))
#define HA ((bf16_t*)(ws + WS_HA))
#define ATT ((bf16_t*)(ws + WS_ATT))
#define MASK ((unsigned*)(ws + WS_MASK))
#define MERGED ((bf16_t*)(ws + WS_MERGED))
#define X1 ((float*)(ws + WS_X1))
#define X2 ((float*)(ws + WS_X2))
#define TOKE ((int*)(ws + WS_TOKE))
#define TOKG ((float*)(ws + WS_TOKG))
#define TOKP ((int*)(ws + WS_TOKP))
#define TOKS ((int*)(ws + WS_TOKS))
#define BLKE ((int*)(ws + WS_BLKE))
#define BCNT ((int*)(ws + WS_BCNT))
    const int lo = args.ph_lo, hi = args.ph_hi;
#define IN(k) ((KIND < 0 || ((k) == 0 ? KIND == 100 : KIND == ((k) - 1) % 11)) && lo <= (k) && (k) < hi)
#define SEAM(k) do { if (KIND < 0 && IN(k) && IN((k) + 1)) xcd_barrier(bar); } while (0)
    XcdBarrier bar; bar.bar = (unsigned*)(args.ws + WS_CTL) + CW_BAR; bar.x = 0; bar.st = nullptr;
    if (KIND < 0) {
        volatile LAS unsigned* xbw = (volatile LAS unsigned*)((LAS unsigned char*)lds + (LDS_BYTES - 16));
        if (tid == 0) { xbw[0] = 0u; xbw[1] = 0u; xbw[2] = 0u; xbw[3] = 0u; }
        __syncthreads();
        bar = xcd_barrier_post((unsigned*)(args.ws + WS_CTL) + CW_BAR, xbw);
    }

    if (IN(0)) for (int prep_ = 0; prep_ < probe_reps(100); ++prep_) {
        WS_OPAQUE();
        {
            bf16_t* lt = (bf16_t*)lds;
            f32x4 v[8];
            int J = blockIdx.x;
            CvtJob cur = cvt_job(J < CJ_TOTAL ? J : 0, args.in, ws);
            if (J < CJ_TOTAL) cvt_load(cur, tid, v);
            __syncthreads();
            for (; J < CJ_TOTAL; J += G) {
                {
                    const int i = tid >> 3, c0 = (tid & 7) * 32;
#pragma unroll
                    for (int q = 0; q < 8; q += 2) { u32x4 w; w.x = pg8::cvt_pk_bf16(v[q][0], v[q][1]); w.y = pg8::cvt_pk_bf16(v[q][2], v[q][3]); w.z = pg8::cvt_pk_bf16(v[q + 1][0], v[q + 1][1]); w.w = pg8::cvt_pk_bf16(v[q + 1][2], v[q + 1][3]);
                        *(u32x4*)(lt + i * 264 + c0 + 4 * q) = w; }
                }
                __syncthreads();
                const CvtJob me = cur;
                if (J + G < CJ_TOTAL) { cur = cvt_job(J + G, args.in, ws); cvt_load(cur, tid, v); }
                {
                    const int n = tid & 255, kh = tid >> 8;
                    unsigned w[16];
#pragma unroll
                    for (int q = 0; q < 16; ++q) w[q] = (unsigned)lt[(kh * 32 + 2 * q) * 264 + n] | ((unsigned)lt[(kh * 32 + 2 * q + 1) * 264 + n] << 16);
                    bf16_t* dp = me.dst + (size_t)n * me.K + kh * 32;
#pragma unroll
                    for (int q = 0; q < 4; ++q) { u32x4 o; o.x = w[4 * q]; o.y = w[4 * q + 1]; o.z = w[4 * q + 2]; o.w = w[4 * q + 3]; *(u32x4*)(dp + 8 * q) = o; }
                }
                __syncthreads();
            }
        }
        {
            float* ca = (float*)lds;
            float* red = ca + NB * D;
            __syncthreads();
            for (int i = tid; i < NB * D; i += NTHREADS) { const float c = args.in[I_C][i]; ca[i] = c * sigmoidf_(c); }
            __syncthreads();
            for (int u = blockIdx.x; u < DEPTH * NMOD / 48; u += G) {
                const int jc = tid % 48, kg = tid / 48;
                const int ln = u * 48 + jc, l = ln / NMOD, n = ln % NMOD;
                if (kg < 10) {
                    const float* w = args.in[I_WADA] + (size_t)l * D * NMOD + n;
                    float acc[NB];
#pragma unroll
                    for (int b = 0; b < NB; ++b) acc[b] = 0.f;
                    for (int k = kg; k < D; k += 10) { const float wv = w[(size_t)k * NMOD];
#pragma unroll
                        for (int b = 0; b < NB; ++b) acc[b] += ca[b * D + k] * wv; }
#pragma unroll
                    for (int b = 0; b < NB; ++b) red[(kg * NB + b) * 48 + jc] = acc[b];
                }
                __syncthreads();
                for (int o = tid; o < NB * 48; o += NTHREADS) { const int b = o / 48, jj = o % 48; float a = 0.f;
#pragma unroll
                    for (int q = 0; q < 10; ++q) a += red[(q * NB + b) * 48 + jj];
                    const int ln2 = u * 48 + jj, l2 = ln2 / NMOD, n2 = ln2 % NMOD;
                    MOD[((size_t)l2 * NB + b) * NMOD + n2] = a + args.in[I_BADA][(size_t)l2 * NMOD + n2]; }
                __syncthreads();
            }
        }
        if (blockIdx.x == G - 1) {
            for (int j = tid; j < 512; j += NTHREADS) { const float a0 = args.in[I_LBL][j], a1 = args.in[I_LBL][512 + j]; LB[j] = 0.f; LB[512 + j] = 1.0f / (1.0f + __expf(a0 - a1)); }
        }
    }

    SEAM(0);
#pragma unroll
    for (int l = 0; l < DEPTH; ++l) {
        const int P = 1 + 11 * l;
#define mod (MOD + (size_t)l * NB * NMOD)
#define xin ((l == 0) ? args.in[I_X] : (const float*)X2)
        if (IN(P + 0) && l == 0) {
            WS_OPAQUE();
            const float* nw = args.in[I_NMW] + (size_t)l * D;
            for (int row = blockIdx.x * NWAVES + wave; row < T; row += G * NWAVES) {
                const int b = row >> 11; f32x4 v[4]; float ss = 0.f;
#pragma unroll
                for (int i = 0; i < 4; ++i) { v[i] = *(const f32x4*)(xin + (size_t)row * D + (lane + 64 * i) * 4); ss += v[i][0] * v[i][0] + v[i][1] * v[i][1] + v[i][2] * v[i][2] + v[i][3] * v[i][3]; }
                ss = wave_sum(ss); const float r = rsqrtf(ss * (1.0f / D) + EPS);
#pragma unroll
                for (int i = 0; i < 4; ++i) { const int c = (lane + 64 * i) * 4;
                    const f32x4 w4 = *(const f32x4*)(nw + c), sc4 = *(const f32x4*)(mod + (size_t)b * NMOD + D + c), sh4 = *(const f32x4*)(mod + (size_t)b * NMOD + c);
                    const f32x4 hv = v[i] * r * w4 * (1.0f + sc4) + sh4;
                    *(unsigned long long*)(H + (size_t)row * D + c) = (unsigned long long)pg8::cvt_pk_bf16(hv[0], hv[1]) | ((unsigned long long)pg8::cvt_pk_bf16(hv[2], hv[3]) << 32); }
            }
        }
        if (l == 0) SEAM(P + 0);
        if (IN(P + 1)) for (int prep_ = 0; prep_ < probe_reps(1); ++prep_) {
            WS_OPAQUE();
            pg8::Gemm g{H, WIN + (size_t)l * ZLD * D, T, ZLD, D}; pg8::StaticOrder S; S.init(T, ZLD, G, (int)blockIdx.x);
            pg8::EpiZ E{ZB, ZLD};
            pg8::gemm_phase(lds3, tid, g, S, E);
        }
        SEAM(P + 1);
        if (IN(P + 2)) for (int prep_ = 0; prep_ < probe_reps(2); ++prep_) {
            WS_OPAQUE();
            for (int hrep_ = 0; hrep_ < (PROBE_GROUP == 6 ? 2 : 1); ++hrep_)
            for (int u = blockIdx.x; u < NB * 4 * 4; u += G) hgrn_item(ZB, LB + l * 512, ORAW, lds, u >> 4, (u >> 2) & 3, u & 3, tid);
            {
                for (int wt = blockIdx.x * NWAVES + wave; wt < (T / 64) * 8; wt += G * NWAVES) {
                    const int rg = wt >> 3, dg = wt & 7; const int row = rg * 64 + lane, bb = row >> 11, sidx = row & 2047;
                    const u32x4 w = *(const u32x4*)(ZB + (size_t)row * ZLD + C_VB + dg * 8);
                    bf16_t* vp = VBT + ((size_t)bb * 64 + dg * 8) * SEQ + sidx;
                    vp[0] = (bf16_t)(w.x & 0xffffu); vp[SEQ] = (bf16_t)(w.x >> 16); vp[2 * SEQ] = (bf16_t)(w.y & 0xffffu); vp[3 * SEQ] = (bf16_t)(w.y >> 16);
                    vp[4 * SEQ] = (bf16_t)(w.z & 0xffffu); vp[5 * SEQ] = (bf16_t)(w.z >> 16); vp[6 * SEQ] = (bf16_t)(w.w & 0xffffu); vp[7 * SEQ] = (bf16_t)(w.w >> 16);
                }
            }
            {
                unsigned* sc = (unsigned*)lds; bf16_t* iring = (bf16_t*)(sc + 16 * 2048);
                __syncthreads();
                for (int irep_ = 0; irep_ < (PROBE_GROUP == 7 ? 2 : 1); ++irep_)
                for (int u = blockIdx.x; u < T / 16; u += G) {
                    const int cc = u & 255, j = u >> 8; const int b = cc & 15, x = cc >> 4, pr = x + 16 * (j >> 1); const int q16 = (j & 1) ? 127 - pr : pr; const int t0 = q16 * 16;
                    if (t0 < 256) {
                        for (int i = tid; i < 16 * 64; i += NTHREADS) { const int qq = i >> 6, w = i & 63, n = t0 + qq + 1, lo_ = w * 32;
                            unsigned mm = 0u; if (n >= lo_ + 32) mm = 0xffffffffu; else if (n > lo_) mm = (1u << (n - lo_)) - 1u; MASK[(size_t)(b * SEQ + t0 + qq) * 64 + w] = mm; }
                    } else indexer_unit(ZB, MASK, sc, iring, b, t0, tid);
                }
                __syncthreads();
            }
        }
        SEAM(P + 2);
        if (IN(P + 3)) for (int prep_ = 0; prep_ < probe_reps(3); ++prep_) {
            WS_OPAQUE();
            const float* hnw = args.in[I_HNW] + (size_t)l * 512;
            for (int row = blockIdx.x * NWAVES + wave; row < T; row += G * NWAVES) {
                const int c0 = lane * 8; float o[8]; float ss = 0.f;
                { const f32x4 o0 = *(const f32x4*)(ORAW + (size_t)row * 512 + c0), o1 = *(const f32x4*)(ORAW + (size_t)row * 512 + c0 + 4);
#pragma unroll
                  for (int j = 0; j < 4; ++j) { o[j] = o0[j]; o[4 + j] = o1[j]; } }
#pragma unroll
                for (int j = 0; j < 8; ++j) ss += o[j] * o[j];
                ss += __shfl_xor(ss, 1); ss += __shfl_xor(ss, 2); ss += __shfl_xor(ss, 4); ss += __shfl_xor(ss, 8);
                const float r = rsqrtf(ss * (1.0f / 128.0f) + EPS);
                { f32x4 g0, g1; pg8::bf8_to_f32(*(const u32x4*)(ZB + (size_t)row * ZLD + C_GA + c0), g0, g1);
                  const f32x4 w0 = *(const f32x4*)(hnw + c0), w1 = *(const f32x4*)(hnw + c0 + 4); float hv[8];
#pragma unroll
                  for (int j = 0; j < 4; ++j) { hv[j] = o[j] * r * w0[j] * (g0[j] * sigmoidf_(g0[j])); hv[4 + j] = o[4 + j] * r * w1[j] * (g1[j] * sigmoidf_(g1[j])); }
                  u32x4 w; w.x = pg8::cvt_pk_bf16(hv[0], hv[1]); w.y = pg8::cvt_pk_bf16(hv[2], hv[3]); w.z = pg8::cvt_pk_bf16(hv[4], hv[5]); w.w = pg8::cvt_pk_bf16(hv[6], hv[7]);
                  *(u32x4*)(HA + (size_t)row * D + c0) = w; }
            }
            {
                float* tb = (float*)lds;
                __syncthreads();
                for (int i = tid; i < 1024; i += NTHREADS) tb[i] = args.in[I_RELB][(int)T5_BUCKET[i >> 3] * 8 + (i & 7)];
                __syncthreads();
                for (int u = blockIdx.x; u < T / 32; u += G) {
                    const int cc = u & 255, j = u >> 8; const int b = cc & 15, x = cc >> 4, pr = x + 16 * (j >> 1); const int qt = (j & 1) ? 63 - pr : pr;
                    attn_block(ZB, VBT, MASK, HA, tb, (bf16_t*)(tb + 1024), b, qt, tid);
                }
                __syncthreads();
            }
        }
        SEAM(P + 3);
        if (IN(P + 4)) for (int prep_ = 0; prep_ < probe_reps(4); ++prep_) {
            WS_OPAQUE();
            pg8::StaticOrder S; S.init(T, D, G, (int)blockIdx.x);
            pg8::Gemm g{HA, WPA + (size_t)l * D * D, T, D, D}; pg8::EpiMergeF E{MERGED, ZB + C_GTA, ZB + C_GTB}; pg8::gemm_phase(lds3, tid, g, S, E);
        }
        SEAM(P + 4);
        if (IN(P + 5)) for (int prep_ = 0; prep_ < probe_reps(5); ++prep_) {
            WS_OPAQUE();
            pg8::Gemm g{MERGED, WOUT + (size_t)l * D * D, T, D, D}; pg8::StaticOrder S; S.init(T, D, G, (int)blockIdx.x);
            pg8::EpiOutG E{xin, X1, mod + 2 * D}; pg8::gemm_phase(lds3, tid, g, S, E);
        }
        SEAM(P + 5);
        if (IN(P + 6)) for (int prep_ = 0; prep_ < probe_reps(6); ++prep_) {
            WS_OPAQUE();
            const float* nw = args.in[I_NFW] + (size_t)l * D; const float* wr = args.in[I_WR] + (size_t)l * D * NE; const float* br = args.in[I_BR] + (size_t)l * NE;
            float* wl = (float*)lds; unsigned* cntl = (unsigned*)(wl + D * NE);
            __syncthreads();
            for (int i = tid; i < D * 8; i += NTHREADS) { const int k = i >> 3, q = i & 7; *(f32x4*)(wl + k * NE + 4 * (q ^ ((k >> 1) & 7))) = *(const f32x4*)(wr + (size_t)k * NE + 4 * q); }
            if (tid < NE) cntl[tid] = 0u;
            __syncthreads();
            const int sw = (lane >> 1) & 7;
            const int ex = lane >> 1;
            const float brv = br[ex];
            for (int grp = blockIdx.x * NWAVES + wave; grp < T / 16; grp += G * NWAVES) {
                const int tok0 = grp * 16, b = tok0 >> 11;
                float ca[16], cb[16];
#pragma unroll
                for (int i = 0; i < 16; ++i) { const int k = lane + 64 * i; ca[i] = nw[k] * (1.0f + mod[(size_t)b * NMOD + 4 * D + k]); cb[i] = mod[(size_t)b * NMOD + 3 * D + k]; }
                for (int j = 0; j < 16; ++j) {
                    const int tok = tok0 + j;
                    float x[16]; float ss = 0.f;
#pragma unroll
                    for (int i = 0; i < 16; ++i) { x[i] = X1[(size_t)tok * D + lane + 64 * i]; ss += x[i] * x[i]; }
                    ss = wave_sum(ss); const float r = rsqrtf(ss * (1.0f / D) + EPS);
                    float acc[32];
#pragma unroll
                    for (int q = 0; q < 32; ++q) acc[q] = 0.f;
#pragma unroll
                    for (int i = 0; i < 16; ++i) {
                        const float hk = x[i] * r * ca[i] + cb[i];
                        H[(size_t)tok * D + lane + 64 * i] = f2bf(hk);
                        const float* wrow = wl + (lane + 64 * i) * NE;
#pragma unroll
                        for (int q = 0; q < 8; ++q) { const f32x4 w4 = *(const f32x4*)(wrow + 4 * (q ^ sw)); acc[4 * q] += hk * w4[0]; acc[4 * q + 1] += hk * w4[1]; acc[4 * q + 2] += hk * w4[2]; acc[4 * q + 3] += hk * w4[3]; }
                    }
                    float a16[16], a8[8], a4[4], a2[2], a1;
                    { const bool up = (lane & 32) != 0;
#pragma unroll
                      for (int q = 0; q < 16; ++q) { const float snd = up ? acc[q] : acc[16 + q], kp = up ? acc[16 + q] : acc[q]; a16[q] = kp + __shfl_xor(snd, 32); } }
                    { const bool up = (lane & 16) != 0;
#pragma unroll
                      for (int q = 0; q < 8; ++q) { const float snd = up ? a16[q] : a16[8 + q], kp = up ? a16[8 + q] : a16[q]; a8[q] = kp + __shfl_xor(snd, 16); } }
                    { const bool up = (lane & 8) != 0;
#pragma unroll
                      for (int q = 0; q < 4; ++q) { const float snd = up ? a8[q] : a8[4 + q], kp = up ? a8[4 + q] : a8[q]; a4[q] = kp + __shfl_xor(snd, 8); } }
                    { const bool up = (lane & 4) != 0;
#pragma unroll
                      for (int q = 0; q < 2; ++q) { const float snd = up ? a4[q] : a4[2 + q], kp = up ? a4[2 + q] : a4[q]; a2[q] = kp + __shfl_xor(snd, 4); } }
                    { const bool up = (lane & 2) != 0; const float snd = up ? a2[0] : a2[1], kp = up ? a2[1] : a2[0]; a1 = kp + __shfl_xor(snd, 2); }
                    a1 += __shfl_xor(a1, 1);
                    float logit = a1 + brv;
                    float tv[4]; int ti[4];
#pragma unroll
                    for (int k = 0; k < 4; ++k) {
                        float bv = logit; int bi = ex;
#pragma unroll
                        for (int o = 32; o >= 2; o >>= 1) { const float ov = __shfl_xor(bv, o); const int oi = __shfl_xor(bi, o); if (ov > bv || (ov == bv && oi < bi)) { bv = ov; bi = oi; } }
                        tv[k] = bv; ti[k] = bi; if (ex == bi) logit = -INFINITY;
                    }
                    const float e1 = __expf(tv[1] - tv[0]), e2 = __expf(tv[2] - tv[0]), e3 = __expf(tv[3] - tv[0]); const float inv = 1.0f / (1.0f + e1 + e2 + e3);
                    if (lane < 4) { const int ee = lane == 0 ? ti[0] : lane == 1 ? ti[1] : lane == 2 ? ti[2] : ti[3]; const float gg = (lane == 0 ? 1.0f : lane == 1 ? e1 : lane == 2 ? e2 : e3) * inv;
                        TOKE[tok * 4 + lane] = ee; TOKG[tok * 4 + lane] = gg; TOKP[tok * 4 + lane] = (int)atomicAdd(&cntl[ee], 1u); }
                }
            }
            __syncthreads();
            if (tid < NE) BCNT[blockIdx.x * NE + tid] = (int)cntl[tid];
        }
        SEAM(P + 6);
        if (IN(P + 7)) for (int prep_ = 0; prep_ < probe_reps(7); ++prep_) {
            WS_OPAQUE();
            int* ps = (int*)lds; int* tot = ps + 64; int* basel = tot + 32; int* pall = basel + 32; int* pbef = pall + 16 * NE;
            __syncthreads();
            {
                const int e = tid & 31, pt = tid >> 5, per = (G + 15) / 16; int sa = 0, sb = 0;
                for (int bb = pt * per; bb < (pt + 1) * per && bb < G; ++bb) { const int c = BCNT[bb * NE + e]; sa += c; sb += bb < (int)blockIdx.x ? c : 0; }
                pall[pt * NE + e] = sa; pbef[pt * NE + e] = sb;
            }
            __syncthreads();
            if (tid < NE) { int sa = 0, sb = 0; for (int pt = 0; pt < 16; ++pt) { sa += pall[pt * NE + tid]; sb += pbef[pt * NE + tid]; } tot[tid] = sa; basel[tid] = sb; }
            __syncthreads();
            if (tid == 0) { int a = 0; for (int e = 0; e < NE; ++e) { ps[e] = a; a += ((tot[e] + 255) / 256) * 256; } ps[NE] = a; }
            __syncthreads();
            const int gt = blockIdx.x * NTHREADS + tid, gn = G * NTHREADS;
            for (int grp = blockIdx.x * NWAVES + wave; grp < T / 16; grp += G * NWAVES) {
                const int tok0 = grp * 16;
                const int e_l = TOKE[tok0 * 4 + lane]; const int slot_l = ps[e_l] + basel[e_l] + TOKP[tok0 * 4 + lane];
                TOKS[tok0 * 4 + lane] = slot_l;
#pragma unroll 4
                for (int j = 0; j < 16; ++j) {
                    const u32x4 r0 = *(const u32x4*)(H + (size_t)(tok0 + j) * D + lane * 8), r1 = *(const u32x4*)(H + (size_t)(tok0 + j) * D + 512 + lane * 8);
#pragma unroll
                    for (int k = 0; k < 4; ++k) { const int slot = __shfl(slot_l, 4 * j + k);
                        *(u32x4*)(XS + (size_t)slot * D + lane * 8) = r0; *(u32x4*)(XS + (size_t)slot * D + 512 + lane * 8) = r1; }
                }
            }
            for (int i = blockIdx.x * NWAVES + wave; i < NE * 256; i += G * NWAVES) {
                const int e = i >> 8, j = i & 255; const int c = tot[e]; const int si = c + j;
                if (si < ps[e + 1] - ps[e]) { const u32x4 z = {0u, 0u, 0u, 0u}; *(u32x4*)(XS + (size_t)(ps[e] + si) * D + lane * 8) = z; *(u32x4*)(XS + (size_t)(ps[e] + si) * D + 512 + lane * 8) = z; } }
            const int nblk = ps[NE] / 256, nblk8 = (nblk + 7) & ~7;
            for (int mb = gt; mb < nblk8; mb += gn) { int e = 0; if (mb < nblk) { while (e < NE - 1 && mb * 256 >= ps[e + 1]) ++e; } BLKE[mb] = e; }
            if (gt == 0) ctl[CW_NBLK + l] = (unsigned)nblk8;
            __syncthreads();
        }
        SEAM(P + 7);
        if (IN(P + 8)) for (int prep_ = 0; prep_ < probe_reps(8); ++prep_) {
            WS_OPAQUE();
            const int nblk = __builtin_amdgcn_readfirstlane((int)ctl[CW_NBLK + l]);
            pg8::Gemm g{XS, W1 + (size_t)l * NE * 2 * DFF * D, nblk * 256, 2 * DFF, D}; pg8::MoeOrder<8> S; S.init(nblk, G, (int)blockIdx.x, BLKE);
            pg8::EpiSwigluG E{ACT, args.in[I_B1] + (size_t)l * NE * 2 * DFF}; pg8::gemm_phase(lds3, tid, g, S, E);
        }
        SEAM(P + 8);
        if (IN(P + 9)) for (int prep_ = 0; prep_ < probe_reps(9); ++prep_) {
            WS_OPAQUE();
            const int nblk = __builtin_amdgcn_readfirstlane((int)ctl[CW_NBLK + l]);
            pg8::Gemm g{ACT, W2 + (size_t)l * NE * D * DFF, nblk * 256, D, DFF}; pg8::MoeOrder<4> S; S.init(nblk, G, (int)blockIdx.x, BLKE);
            pg8::EpiYG E{Y, args.in[I_B2] + (size_t)l * NE * D}; pg8::gemm_phase(lds3, tid, g, S, E);
        }
        SEAM(P + 9);
        if (IN(P + 10)) for (int prep_ = 0; prep_ < probe_reps(10); ++prep_) {
            WS_OPAQUE();
            const bool last = (l == DEPTH - 1);
            const float* nw = last ? args.in[I_FNW] : args.in[I_NMW] + (size_t)(l + 1) * D;
            const float* modn = MOD + (size_t)(l + 1) * NB * NMOD;
            for (int grp = blockIdx.x * NWAVES + wave; grp < T / 16; grp += G * NWAVES) {
                const int tok0 = grp * 16, b = tok0 >> 11;
                const int slot_l = TOKS[tok0 * 4 + lane]; const float g_l = TOKG[tok0 * 4 + lane];
#pragma unroll 2
                for (int j = 0; j < 16; ++j) {
                    const int tok = tok0 + j; f32x4 v[4], a[4];
#pragma unroll
                    for (int i = 0; i < 4; ++i) { v[i] = *(const f32x4*)(X1 + (size_t)tok * D + (lane + 64 * i) * 4); a[i] = (f32x4){0.f, 0.f, 0.f, 0.f}; }
#pragma unroll
                    for (int k = 0; k < 4; ++k) { const int slot = __shfl(slot_l, 4 * j + k); const float g = __shfl(g_l, 4 * j + k);
#pragma unroll
                        for (int i = 0; i < 4; ++i) { const unsigned* yp = (const unsigned*)(Y + (size_t)slot * D + (lane + 64 * i) * 4); const unsigned y0 = yp[0], y1 = yp[1];
                            f32x4 y; y[0] = __uint_as_float(y0 << 16); y[1] = __uint_as_float(y0 & 0xffff0000u); y[2] = __uint_as_float(y1 << 16); y[3] = __uint_as_float(y1 & 0xffff0000u); a[i] += g * y; } }
                    float ss = 0.f;
#pragma unroll
                    for (int i = 0; i < 4; ++i) { const int c = (lane + 64 * i) * 4; const f32x4 gf = *(const f32x4*)(mod + (size_t)b * NMOD + 5 * D + c); v[i] = v[i] + gf * a[i];
                        ss += v[i][0] * v[i][0] + v[i][1] * v[i][1] + v[i][2] * v[i][2] + v[i][3] * v[i][3]; }
                    ss = wave_sum(ss); const float r = rsqrtf(ss * (1.0f / D) + EPS);
#pragma unroll
                    for (int i = 0; i < 4; ++i) { const int c = (lane + 64 * i) * 4;
                        if (last) { const f32x4 w4 = *(const f32x4*)(nw + c);
                            *(f32x4*)(args.out + (size_t)tok * D + c) = v[i] * r * w4;
                        } else {
                            *(f32x4*)(X2 + (size_t)tok * D + c) = v[i];
                            const f32x4 w4 = *(const f32x4*)(nw + c), sc4 = *(const f32x4*)(modn + (size_t)b * NMOD + D + c), sh4 = *(const f32x4*)(modn + (size_t)b * NMOD + c);
                            const f32x4 hv = v[i] * r * w4 * (1.0f + sc4) + sh4;
                            *(unsigned long long*)(H + (size_t)tok * D + c) = (unsigned long long)pg8::cvt_pk_bf16(hv[0], hv[1]) | ((unsigned long long)pg8::cvt_pk_bf16(hv[2], hv[3]) << 32);
                        } }
                }
            }
        }
        SEAM(P + 10);
    }
#undef IN
}

constexpr int N_PHASES = 1 + 11 * DEPTH;
typedef void (*kern_t)(Args);
template <int K> static kern_t kern_of() { return fwd<K>; }
static kern_t kern_for(int kind) {
    switch (kind) { case 0: return fwd<0>; case 1: return fwd<1>; case 2: return fwd<2>; case 3: return fwd<3>; case 4: return fwd<4>; case 5: return fwd<5>;
                    case 6: return fwd<6>; case 7: return fwd<7>; case 8: return fwd<8>; case 9: return fwd<9>; case 10: return fwd<10>; default: return fwd<100>; }
}

extern "C" void kernel_launch(void* const* d_in, const int* in_sizes, int n_in, void* d_out, int out_size, void* d_ws, size_t ws_size, hipStream_t stream) {
    static int grid = 0;
    if (grid == 0) {
        if (n_in != 20 || out_size != T * D || ws_size < WS_END) { fprintf(stderr, "kernel_launch: unexpected problem (n_in %d, out %d, ws %zu, need %zu)\n", n_in, out_size, ws_size, (size_t)WS_END); grid = -1; return; }
        int dev = 0, cus = 0;
        if (hipGetDevice(&dev) != hipSuccess || hipDeviceGetAttribute(&cus, hipDeviceAttributeMultiprocessorCount, dev) != hipSuccess) { grid = -1; return; }
        for (int k = 0; k <= 12; ++k) {
            if (hipFuncSetAttribute((const void*)(k == 12 ? (kern_t)fwd<-1> : kern_for(k)), hipFuncAttributeMaxDynamicSharedMemorySize, LDS_BYTES) != hipSuccess) { fprintf(stderr, "kernel_launch: hipFuncSetAttribute failed\n"); grid = -1; return; }
        }
        grid = cus > 0 ? cus : 256;
    }
    if (grid < 0) return;
    (void)hipMemsetAsync((char*)d_ws + WS_CTL, 0, CTL_BYTES, stream);
    Args a{};
    for (int i = 0; i < 20; ++i) a.in[i] = (const float*)d_in[i];
    a.out = (float*)d_out; a.ws = (unsigned char*)d_ws;
#if defined(MULTI_LAUNCH)
    for (int p = 0; p < N_PHASES; ++p) {
        if (p == 1 + 11) continue;
        a.ph_lo = p; a.ph_hi = p + 1;
        const int kind = p == 0 ? 11 : (p - 1) % 11;
        hipLaunchKernelGGL(kern_for(kind), dim3(grid), dim3(NTHREADS), LDS_BYTES, stream, a);
    }
#else
    a.ph_lo = 0; a.ph_hi = N_PHASES;
    hipLaunchKernelGGL(fwd<-1>, dim3(grid), dim3(NTHREADS), LDS_BYTES, stream, a);
#endif
}
```

```cpp
#include <hip/hip_runtime.h>
#include <stdint.h>
#include <stdio.h>

typedef unsigned short bf16_t;
typedef short bf16x8 __attribute__((ext_vector_type(8)));
typedef float f32x4 __attribute__((ext_vector_type(4)));
typedef float f32x16 __attribute__((ext_vector_type(16)));
typedef unsigned u32x4 __attribute__((ext_vector_type(4)));
#define LAS __attribute__((address_space(3)))
#define GAS __attribute__((address_space(1)))

constexpr int T = 32768, D = 1024, NB = 16, SEQ = 2048, DEPTH = 2;
constexpr int ZC = 5320, ZLD = 5376;
constexpr int C_QA = 0, C_FA = 512, C_IA = 1024, C_GA = 1536, C_QB = 2048, C_KB = 2560, C_VB = 2624, C_IQ = 2688, C_IK = 3200, C_IW = 3264, C_GTA = 3272, C_GTB = 4296;
constexpr int NE = 32, DFF = 1024, NSLOT = 131072 + 32 * 256, NBLK_MAX = NSLOT / 256;
constexpr int NMOD = 6 * D;
constexpr float EPS = 1e-6f;
constexpr int NTHREADS = 512, NWAVES = 8;
#ifndef PROBE_GROUP
#define PROBE_GROUP 0
#endif
constexpr int probe_reps(int kind) { return (PROBE_GROUP == 1 && (kind == 1 || kind == 4 || kind == 5 || kind == 8 || kind == 9)) || (PROBE_GROUP == 2 && kind == 2) || (PROBE_GROUP == 3 && kind == 3) || (PROBE_GROUP == 4 && kind == 100) || (PROBE_GROUP == 5 && (kind == 6 || kind == 7 || kind == 10)) || (PROBE_GROUP == 9 && kind == 8) || (PROBE_GROUP == 10 && kind == 1) || (PROBE_GROUP == 11 && kind == 9) || (PROBE_GROUP == 12 && (kind == 4 || kind == 5)) ? 2 : 1; }
constexpr int LDS_BYTES = 160 * 1024;

constexpr size_t al256(size_t x) { return (x + 255) & ~(size_t)255; }
constexpr size_t WS_CTL = 0;
constexpr size_t CTL_BYTES = 65536;
constexpr size_t WS_MOD = WS_CTL + CTL_BYTES;
constexpr size_t WS_LB = WS_MOD + al256((size_t)DEPTH * NB * NMOD * 4);
constexpr size_t WS_WIN = WS_LB + al256((size_t)DEPTH * 512 * 4);
constexpr size_t WS_WPA = WS_WIN + (size_t)DEPTH * ZLD * D * 2;
constexpr size_t WS_WPB = WS_WPA + (size_t)DEPTH * D * 512 * 2;
constexpr size_t WS_WOUT = WS_WPB + (size_t)DEPTH * D * 512 * 2;
constexpr size_t WS_W1 = WS_WOUT + (size_t)DEPTH * D * D * 2;
constexpr size_t WS_W2 = WS_W1 + (size_t)DEPTH * NE * 2 * DFF * D * 2;
constexpr size_t WS_H = WS_W2 + (size_t)DEPTH * NE * D * DFF * 2;
constexpr size_t WS_Z = WS_H + (size_t)T * D * 2;
constexpr size_t WS_Y = WS_Z;
constexpr size_t WS_ACT = WS_Z + (size_t)T * ZLD * 2;
constexpr size_t WS_ORAW = WS_ACT;
constexpr size_t WS_TMP = WS_ACT + (size_t)T * 512 * 4;
constexpr size_t WS_XS = WS_ACT + (size_t)NSLOT * DFF * 2;
constexpr size_t WS_HA = WS_XS + (size_t)NSLOT * D * 2;
constexpr size_t WS_ATT = WS_HA + (size_t)T * 512 * 2;
constexpr size_t WS_MASK = WS_ATT + (size_t)T * 512 * 2;
constexpr size_t WS_VBT = WS_MASK + (size_t)T * 64 * 4;
constexpr size_t WS_MERGED = WS_VBT + (size_t)T * 64 * 2;
constexpr size_t WS_X1 = WS_MERGED + (size_t)T * D * 2;
constexpr size_t WS_X2 = WS_X1 + (size_t)T * D * 4;
constexpr size_t WS_TOKE = WS_X2 + (size_t)T * D * 4;
constexpr size_t WS_TOKG = WS_TOKE + (size_t)T * 4 * 4;
constexpr size_t WS_TOKP = WS_TOKG + (size_t)T * 4 * 4;
constexpr size_t WS_TOKS = WS_TOKP + (size_t)T * 4 * 4;
constexpr size_t WS_BLKE = WS_TOKS + (size_t)T * 4 * 4;
constexpr size_t WS_BCNT = WS_BLKE + al256((size_t)(NBLK_MAX + 64) * 4);
constexpr size_t WS_END = WS_BCNT + (size_t)1024 * NE * 4;
static_assert((size_t)NSLOT * D * 2 <= (size_t)T * ZLD * 2, "Y must fit in Z");
static_assert((size_t)T * 512 * 4 + (size_t)T * D * 4 <= (size_t)NSLOT * DFF * 2, "ORAW+TMP must fit in ACT");
static_assert(WS_END <= ((size_t)1 << 31), "workspace layout exceeds 2 GiB");
constexpr int CW_CNT = 1024;
constexpr int CW_NBLK = 1200;
constexpr int CW_Q = 1216;

__device__ __forceinline__ bf16_t f2bf(float f) { unsigned u = __float_as_uint(f); u += 0x7fffu + ((u >> 16) & 1u); return (bf16_t)(u >> 16); }
__device__ __forceinline__ float bf2f(bf16_t b) { return __uint_as_float(((unsigned)b) << 16); }
__device__ __forceinline__ float sigmoidf_(float x) { return __builtin_amdgcn_rcpf(1.0f + __builtin_amdgcn_exp2f(-1.4426950408889634f * x)); }
__device__ __forceinline__ float wave_sum(float v) {
#pragma unroll
    for (int o = 32; o >= 1; o >>= 1) v += __shfl_xor(v, o);
    return v;
}
__device__ __forceinline__ int wave_sum_i(int v) {
#pragma unroll
    for (int o = 32; o >= 1; o >>= 1) v += __shfl_xor(v, o);
    return v;
}
__device__ const unsigned char T5_BUCKET[128] = {
    0, 1, 2, 3, 4, 5, 6, 7, 8, 9, 10, 11, 12, 13, 14, 15, 16, 16, 16, 17, 17, 18, 18, 18, 19, 19, 19, 20, 20, 20, 20, 21, 21, 21, 21, 22, 22, 22, 22, 22, 23, 23, 23, 23, 23, 23, 24, 24, 24, 24, 24, 24, 25,
    25, 25, 25, 25, 25, 25, 26, 26, 26, 26, 26, 26, 26, 26, 27, 27, 27, 27, 27, 27, 27, 27, 27, 27, 28, 28, 28, 28, 28, 28, 28, 28, 28, 28, 29, 29, 29, 29, 29, 29, 29, 29, 29, 29, 29, 29, 30, 30, 30, 30, 30,
    30, 30, 30, 30, 30, 30, 30, 30, 30, 31, 31, 31, 31, 31, 31, 31, 31, 31, 31, 31, 31, 31, 31, 31};
__device__ __forceinline__ int t5_bucket(int rel) { return rel >= 128 ? 31 : (int)T5_BUCKET[rel]; }


#define XB_TMO      128
#define XB_XCNT(j)  (256  + 64 * (j))
#define XB_XSUB(j)  (1280 + 64 * (j))
#define XB_XGEN(j)  (2304 + 64 * (j))
#define XB_TOP      3328
#define XB_TOPGEN   3392
#define XCD_BAR_WORDS 3456
#define XB_SPIN_CAP (1u << 18)
__device__ __forceinline__ unsigned xb_ld(unsigned* p)              { return __hip_atomic_load(p, __ATOMIC_RELAXED, __HIP_MEMORY_SCOPE_AGENT); }
__device__ __forceinline__ unsigned xb_add(unsigned* p, unsigned v) { return __hip_atomic_fetch_add(p, v, __ATOMIC_RELAXED, __HIP_MEMORY_SCOPE_AGENT); }
__device__ __forceinline__ unsigned xb_xcc_id() { return (unsigned)__builtin_amdgcn_s_getreg((3 << 11) | 20) & 0xFu; }
#define XB_SPIN(cond, bar) do { unsigned _sp = 0; while (cond) { __builtin_amdgcn_s_sleep(1); \
    if ((++_sp & 255u) == 0u) { if (xb_ld(&(bar)[XB_TMO])) break; if (_sp > XB_SPIN_CAP) { atomicAdd(&(bar)[XB_TMO], 1u); break; } } } } while (0)
struct XcdBarrier { unsigned* bar; unsigned x; volatile LAS unsigned* st; };
__device__ __forceinline__ XcdBarrier xcd_barrier_post(unsigned* bar, volatile LAS unsigned* st) {
    XcdBarrier b; b.bar = bar; b.x = xb_xcc_id(); b.st = st;
    if (threadIdx.x == 0) (void)xb_add(&bar[XB_XCNT(b.x)], 1u);
    return b;
}
__device__ __forceinline__ void xcd_barrier_complete(unsigned* bar, unsigned x, unsigned& nloc, unsigned& nx) {
    const unsigned G = gridDim.x * gridDim.y * gridDim.z;
    unsigned sum, cnt, mine, sp = 0u;
    for (;;) {
        sum = 0u; cnt = 0u; mine = 0u;
#pragma unroll
        for (unsigned j = 0; j < 16; ++j) { const unsigned c = xb_ld(&bar[XB_XCNT(j)]); sum += c; cnt += (c > 0u) ? 1u : 0u; mine = (j == x) ? c : mine; }
        if (sum == G) break;
        __builtin_amdgcn_s_sleep(1);
        if ((++sp & 255u) == 0u) { if (xb_ld(&bar[XB_TMO])) break; if (sp > XB_SPIN_CAP) { atomicAdd(&bar[XB_TMO], 1u); break; } }
    }
    nloc = mine > 0u ? mine : 1u; nx = cnt > 0u ? cnt : 1u;
}
__device__ __forceinline__ void xcd_barrier(const XcdBarrier& b) {
    asm volatile("s_waitcnt vmcnt(0)" ::: "memory");
    __syncthreads();
    if (threadIdx.x == 0) {
        unsigned* bar = b.bar; asm volatile("" : "+s"(bar));
        __builtin_amdgcn_s_waitcnt(0);
        unsigned nloc = b.st[0], nx = b.st[1];
        if (nloc == 0u) { xcd_barrier_complete(bar, b.x, nloc, nx); b.st[0] = nloc; b.st[1] = nx; }
        const unsigned old = xb_add(&bar[XB_XSUB(b.x)], 1u);
        const unsigned gen = old / nloc;
        if (old + 1u == (gen + 1u) * nloc) {
            __builtin_amdgcn_fence(__ATOMIC_RELEASE, "agent");
            asm volatile("s_waitcnt vmcnt(0)" ::: "memory");
            const unsigned og = xb_add(&bar[XB_TOP], 1u);
            const unsigned tg = og / nx;
            if (og + 1u == (tg + 1u) * nx) xb_add(&bar[XB_TOPGEN], 1u);
            else XB_SPIN(xb_ld(&bar[XB_TOPGEN]) == tg, bar);
            __builtin_amdgcn_fence(__ATOMIC_ACQUIRE, "agent");
            xb_add(&bar[XB_XGEN(b.x)], 1u);
            asm volatile("s_waitcnt vmcnt(0)" ::: "memory");
        } else {
            XB_SPIN(xb_ld(&bar[XB_XGEN(b.x)]) == gen, bar);
            __builtin_amdgcn_fence(__ATOMIC_ACQUIRE, "agent");
            asm volatile("s_waitcnt vmcnt(0)" ::: "memory");
        }
    }
    __syncthreads();
}
constexpr int CW_BAR = 4096;

struct Args { const float* in[20]; float* out; unsigned char* ws; int ph_lo, ph_hi; };
enum { I_X = 0, I_C, I_WADA, I_BADA, I_NMW, I_WIN, I_LBL, I_HNW, I_RELB, I_WPA, I_WPB, I_WOUT, I_NFW, I_WR, I_BR, I_W1, I_B1, I_W2, I_B2, I_FNW };

namespace pg8 {
#define PG8_LAS __attribute__((address_space(3)))
constexpr int BM = 256, BK = 64, HALF = 128, HTB = HALF * BK * 2, STAGE_BYTES = 8 * HTB, NXCD = 8, WGM = 8;
__host__ __device__ __forceinline__ int lds_byte(int r, int c) { const int st = (r >> 4) * 2 + (c >> 5), rr = r & 15, cc = c & 31, ob = rr * 64 + cc * 2; return st * 1024 + (ob ^ (((ob >> 9) & 1) << 5)); }
__host__ __device__ __forceinline__ void stage_rc(int b, int& R, int& C) { const int st = b / 1024, sb = b % 1024, swz = sb ^ (((sb >> 9) & 1) << 5); R = (st >> 1) * 16 + swz / 64; C = (st & 1) * 32 + (swz % 64) / 2; }
__host__ __device__ __forceinline__ int perm32(int rho) { const int n = rho >> 4, i = rho & 15; return 8 * (i >> 2) + 4 * n + (i & 3); }
struct Unit { int pm, pn, brow, e; };
struct Gemm { const bf16_t* A; const bf16_t* Bt; int M, N, K; };
struct StaticOrder {
    int nM, nN, nwg, G, c;
    __device__ void init(int M, int N, int G_, int c_) { nM = M / BM; nN = N / BM; nwg = nM * nN; G = G_; c = c_; }
    __device__ bool next(int i, Unit& u) const {
        const long L = (long)i * G + c; if (L >= nwg) return false;
        int wgid = (int)L; { const int q = nwg / NXCD, r = nwg % NXCD, xcd = wgid % NXCD, off = wgid / NXCD; wgid = (xcd < r ? xcd * (q + 1) : r * (q + 1) + (xcd - r) * q) + off; }
        const int nig = WGM * nN, gid = wgid / nig, fm = gid * WGM, gsz = (nM - fm) < WGM ? (nM - fm) : WGM;
        u.pm = fm + ((wgid % nig) % gsz); u.pn = (wgid % nig) / gsz; u.brow = u.pn * BM; u.e = 0; return true;
    }
    __device__ __forceinline__ void a_ready(const Unit&) const {}
    __device__ __forceinline__ void done(const Unit&) const {}
};
template <int NN> struct MoeOrder {
    int nwg, G, c; const int* blke;
    __device__ void init(int nM, int G_, int c_, const int* blke_) { nwg = nM * NN; G = G_; c = c_; blke = blke_; }
    __device__ bool next(int i, Unit& u) const {
        const int L = i * G + c; if (L >= nwg) return false;
        const int wgid = (L & 7) * (nwg >> 3) + (L >> 3);
        const int gid = wgid / (8 * NN), rem = wgid % (8 * NN);
        u.pm = gid * 8 + (rem & 7); u.pn = rem >> 3; u.e = __builtin_amdgcn_readfirstlane(blke[u.pm]); u.brow = u.e * (NN * BM) + u.pn * BM; return true;
    }
    __device__ __forceinline__ void a_ready(const Unit&) const {}
    __device__ __forceinline__ void done(const Unit&) const {}
};
typedef __bf16 bf16x2v_t __attribute__((ext_vector_type(2)));
typedef float f32x2v_t __attribute__((ext_vector_type(2)));
__device__ __forceinline__ unsigned cvt_pk_bf16(float lo, float hi) { const f32x2v_t v = {lo, hi}; const bf16x2v_t r = __builtin_convertvector(v, bf16x2v_t); return __builtin_bit_cast(unsigned, r); }


struct EpiZ {
    static constexpr bool PERM = true, AFTER_DRAIN = false;
    bf16_t* C; int ldc;
    __device__ __forceinline__ void operator()(const f32x4 (&acc)[2][2][4][2], const Unit& u, int wr, int wc, int fr, int fq) const {
        const int row0 = u.pm * BM + wr * 64 + fr, col0 = u.pn * BM + wc * 32 + 8 * fq;
#pragma unroll
        for (int ai = 0; ai < 2; ++ai)
#pragma unroll
            for (int m = 0; m < 4; ++m) { bf16_t* rowp = C + (size_t)(row0 + ai * HALF + m * 16) * ldc + col0;
#pragma unroll
                for (int bj = 0; bj < 2; ++bj) { const f32x4 v0 = acc[ai][bj][m][0], v1 = acc[ai][bj][m][1];
                    u32x4 w; w.x = cvt_pk_bf16(v0[0], v0[1]); w.y = cvt_pk_bf16(v0[2], v0[3]); w.z = cvt_pk_bf16(v1[0], v1[1]); w.w = cvt_pk_bf16(v1[2], v1[3]);
                    *(u32x4*)(rowp + bj * HALF) = w; } }
    }
};
__device__ __forceinline__ void bf8_to_f32(const u32x4 w, f32x4& lo, f32x4& hi) {
    lo[0] = __uint_as_float(w.x << 16); lo[1] = __uint_as_float(w.x & 0xffff0000u); lo[2] = __uint_as_float(w.y << 16); lo[3] = __uint_as_float(w.y & 0xffff0000u);
    hi[0] = __uint_as_float(w.z << 16); hi[1] = __uint_as_float(w.z & 0xffff0000u); hi[2] = __uint_as_float(w.w << 16); hi[3] = __uint_as_float(w.w & 0xffff0000u);
}
__device__ __forceinline__ f32x4 sig4(f32x4 g) { f32x4 r; r[0] = sigmoidf_(g[0]); r[1] = sigmoidf_(g[1]); r[2] = sigmoidf_(g[2]); r[3] = sigmoidf_(g[3]); return r; }
struct EpiMergeF {
    static constexpr bool PERM = true, AFTER_DRAIN = false, MIDK = true;
    bf16_t* merged; const bf16_t* Zga; const bf16_t* Zgb;
    __device__ __forceinline__ void mid(f32x4 (&acc)[2][2][4][2], const Unit& u, int wr, int wc, int fr, int fq) const {
        int row0 = u.pm * BM + wr * 64 + fr, col0 = u.pn * BM + wc * 32 + 8 * fq;
        asm volatile("" : "+v"(row0), "+v"(col0));
#pragma unroll
        for (int ai = 0; ai < 2; ++ai)
#pragma unroll
            for (int m = 0; m < 4; ++m) { const size_t row = (size_t)(row0 + ai * HALF + m * 16);
#pragma unroll
                for (int bj = 0; bj < 2; ++bj) { const int col = col0 + bj * HALF;
                    f32x4 a0, a1, b0, b1; bf8_to_f32(*(const u32x4*)(Zga + row * ZLD + col), a0, a1); bf8_to_f32(*(const u32x4*)(Zgb + row * ZLD + col), b0, b1);
#pragma unroll
                    for (int j = 0; j < 4; ++j) {
                        acc[ai][bj][m][0][j] *= (1.0f + __builtin_amdgcn_exp2f(-1.4426950408889634f * b0[j])) * __builtin_amdgcn_rcpf(1.0f + __builtin_amdgcn_exp2f(-1.4426950408889634f * a0[j]));
                        acc[ai][bj][m][1][j] *= (1.0f + __builtin_amdgcn_exp2f(-1.4426950408889634f * b1[j])) * __builtin_amdgcn_rcpf(1.0f + __builtin_amdgcn_exp2f(-1.4426950408889634f * a1[j])); }
                    asm volatile("" : "+v"(acc[ai][bj][m][0]), "+v"(acc[ai][bj][m][1]) :: "memory"); } }
    }
    __device__ __forceinline__ void operator()(const f32x4 (&acc)[2][2][4][2], const Unit& u, int wr, int wc, int fr, int fq) const {
        int row0 = u.pm * BM + wr * 64 + fr, col0 = u.pn * BM + wc * 32 + 8 * fq;
        asm volatile("" : "+v"(row0), "+v"(col0));
#pragma unroll
        for (int ai = 0; ai < 2; ++ai)
#pragma unroll
            for (int m = 0; m < 4; ++m) { const size_t row = (size_t)(row0 + ai * HALF + m * 16);
#pragma unroll
                for (int bj = 0; bj < 2; ++bj) { const int col = col0 + bj * HALF;
                    f32x4 g0, g1; bf8_to_f32(*(const u32x4*)(Zgb + row * ZLD + col), g0, g1); g0 = sig4(g0); g1 = sig4(g1);
                    const f32x4 v0 = g0 * acc[ai][bj][m][0], v1 = g1 * acc[ai][bj][m][1];
                    u32x4 w; w.x = cvt_pk_bf16(v0[0], v0[1]); w.y = cvt_pk_bf16(v0[2], v0[3]); w.z = cvt_pk_bf16(v1[0], v1[1]); w.w = cvt_pk_bf16(v1[2], v1[3]);
                    *(u32x4*)(merged + row * D + col) = w; } }
    }
};
struct EpiOutG {
    static constexpr bool PERM = false, AFTER_DRAIN = false;
    const float* xin; float* x1; const float* gate  ;
    __device__ __forceinline__ void operator()(const f32x4 (&acc)[2][2][4][2], const Unit& u, int wr, int wc, int fr, int fq) const {
        const int row0 = u.pm * BM + wr * 64 + fr, col0 = u.pn * BM + wc * 32 + 4 * fq; const int b = (u.pm * BM) >> 11;
        f32x4 gv[2][2];
#pragma unroll
        for (int bj = 0; bj < 2; ++bj)
#pragma unroll
            for (int n = 0; n < 2; ++n) gv[bj][n] = *(const f32x4*)(gate + (size_t)b * NMOD + col0 + bj * HALF + n * 16);
#pragma unroll
        for (int ai = 0; ai < 2; ++ai)
#pragma unroll
            for (int m = 0; m < 4; ++m) { const size_t off = (size_t)(row0 + ai * HALF + m * 16) * D + col0;
#pragma unroll
                for (int bj = 0; bj < 2; ++bj)
#pragma unroll
                    for (int n = 0; n < 2; ++n) *(f32x4*)(x1 + off + bj * HALF + n * 16) = *(const f32x4*)(xin + off + bj * HALF + n * 16) + gv[bj][n] * acc[ai][bj][m][n]; }
    }
};
struct EpiSwigluG {
    static constexpr bool PERM = true, AFTER_DRAIN = false;
    bf16_t* act; const float* b1  ;
    __device__ __forceinline__ void operator()(const f32x4 (&acc)[2][2][4][2], const Unit& u, int wr, int wc, int fr, int fq) const {
        const int row0 = u.pm * BM + wr * 64 + fr, col0 = u.pn * HALF + wc * 32 + 8 * fq;
        f32x4 bg[2], bl[2];
#pragma unroll
        for (int n = 0; n < 2; ++n) { bg[n] = *(const f32x4*)(b1 + (size_t)u.e * 2 * DFF + col0 + 4 * n); bl[n] = *(const f32x4*)(b1 + (size_t)u.e * 2 * DFF + DFF + col0 + 4 * n); }
#pragma unroll
        for (int ai = 0; ai < 2; ++ai)
#pragma unroll
            for (int m = 0; m < 4; ++m) { float o[8];
#pragma unroll
                for (int n = 0; n < 2; ++n) { const f32x4 gl = acc[ai][0][m][n] + bg[n], li = acc[ai][1][m][n] + bl[n];
#pragma unroll
                    for (int j = 0; j < 4; ++j) { const float g = fminf(gl[j], 7.0f), l = fminf(fmaxf(li[j], -7.0f), 7.0f); o[4 * n + j] = g * sigmoidf_(1.702f * g) * (l + 1.0f); } }
                u32x4 w; w.x = cvt_pk_bf16(o[0], o[1]); w.y = cvt_pk_bf16(o[2], o[3]); w.z = cvt_pk_bf16(o[4], o[5]); w.w = cvt_pk_bf16(o[6], o[7]);
                *(u32x4*)(act + (size_t)(row0 + ai * HALF + m * 16) * DFF + col0) = w; }
    }
};
struct EpiYG {
    static constexpr bool PERM = true, AFTER_DRAIN = false;
    bf16_t* Yb; const float* b2  ;
    __device__ __forceinline__ void operator()(const f32x4 (&acc)[2][2][4][2], const Unit& u, int wr, int wc, int fr, int fq) const {
        const int row0 = u.pm * BM + wr * 64 + fr, col0 = u.pn * BM + wc * 32 + 8 * fq;
        f32x4 bv[2][2];
#pragma unroll
        for (int bj = 0; bj < 2; ++bj)
#pragma unroll
            for (int n = 0; n < 2; ++n) bv[bj][n] = *(const f32x4*)(b2 + (size_t)u.e * D + col0 + bj * HALF + 4 * n);
#pragma unroll
        for (int ai = 0; ai < 2; ++ai)
#pragma unroll
            for (int m = 0; m < 4; ++m) { bf16_t* rowp = Yb + (size_t)(row0 + ai * HALF + m * 16) * D + col0;
#pragma unroll
                for (int bj = 0; bj < 2; ++bj) { const f32x4 v0 = acc[ai][bj][m][0] + bv[bj][0], v1 = acc[ai][bj][m][1] + bv[bj][1];
                    u32x4 w; w.x = cvt_pk_bf16(v0[0], v0[1]); w.y = cvt_pk_bf16(v0[2], v0[3]); w.z = cvt_pk_bf16(v1[0], v1[1]); w.w = cvt_pk_bf16(v1[2], v1[3]);
                    *(u32x4*)(rowp + bj * HALF) = w; } }
    }
};

template <class E, class = void> struct has_midk { static constexpr bool value = false; };
template <class E> struct has_midk<E, decltype((void)E::MIDK)> { static constexpr bool value = E::MIDK; };
template <class Epi, class Sched>
__device__ __forceinline__ void gemm_phase(PG8_LAS unsigned char* lds, const int tid, const Gemm g, const Sched& S, const Epi& E) {
    const int wid = __builtin_amdgcn_readfirstlane(tid >> 6), lane = tid & 63, wr = wid >> 2, wc = wid & 3, fr = lane & 15, fq = lane >> 4;
    const int K = g.K, nt = K / BK;
    unsigned voffA[2], voffB[2];
#pragma unroll
    for (int i = 0; i < 2; ++i) { int R, C; stage_rc(tid * 16 + i * 8192, R, C); const int Rb = Epi::PERM ? ((R & ~31) + perm32(R & 31)) : R;
        voffA[i] = (unsigned)(R * K + C) * 2u; voffB[i] = (unsigned)(Rb * K + C) * 2u; }
    const size_t kstep = (size_t)(BK * 2);
    const size_t hstep = (size_t)HALF * K * 2;
    const size_t tstep = 2 * hstep;
    const unsigned ldsw = (unsigned)wid * 1024u;
    const int aoff = lds_byte(wr * 64 + fr, fq * 8), boff = lds_byte(wc * 32 + fr, fq * 8);
#define PG8_SA(b, h) (((b) * 2 + (h)) * HTB)
#define PG8_SB(b, h) ((4 + (b) * 2 + (h)) * HTB)
#define PG8_STAGE(bufoff, gbase, voff) do { _Pragma("unroll") for (int _i = 0; _i < 2; ++_i) \
        __builtin_amdgcn_global_load_lds((const unsigned*)((const char*)(gbase) + (voff)[_i]), (PG8_LAS unsigned*)(lds + (bufoff) + ldsw + _i * 8192), 16, 0, 0); } while (0)
#define PG8_LDA(dst, b, h) do { _Pragma("unroll") for (int m = 0; m < 4; ++m) _Pragma("unroll") for (int k = 0; k < 2; ++k) dst[m][k] = *(const PG8_LAS bf16x8*)(lds + PG8_SA(b, h) + aoff + m * 2048 + k * 1024); } while (0)
#define PG8_LDB(dst, b, h) do { _Pragma("unroll") for (int n = 0; n < 2; ++n) _Pragma("unroll") for (int k = 0; k < 2; ++k) dst[n][k] = *(const PG8_LAS bf16x8*)(lds + PG8_SB(b, h) + boff + n * 2048 + k * 1024); } while (0)
#define PG8_MMA(ai, bj, At, Bt) do { __builtin_amdgcn_s_setprio(1); _Pragma("unroll") for (int m = 0; m < 4; ++m) _Pragma("unroll") for (int n = 0; n < 2; ++n) _Pragma("unroll") for (int k = 0; k < 2; ++k) \
        acc[ai][bj][m][n] = __builtin_amdgcn_mfma_f32_16x16x32_bf16(Bt[n][k], At[m][k], acc[ai][bj][m][n], 0, 0, 0); __builtin_amdgcn_s_setprio(0); } while (0)
#define PG8_WAIT_V(n) asm volatile("s_waitcnt vmcnt(" #n ")" ::: "memory")
#define PG8_WAIT_L(n) asm volatile("s_waitcnt lgkmcnt(" #n ")" ::: "memory")
#define PG8_BAR __builtin_amdgcn_s_barrier()
#define PG8_SCHED __builtin_amdgcn_sched_barrier(0)
    Unit cur, nxt; int ui = 0;
    if (!S.next(0, cur)) return;
    f32x4 acc[2][2][4][2];
#pragma unroll
    for (int a = 0; a < 2; ++a)
#pragma unroll
        for (int b = 0; b < 2; ++b)
#pragma unroll
            for (int m = 0; m < 4; ++m)
#pragma unroll
                for (int n = 0; n < 2; ++n) acc[a][b][m][n] = (f32x4){0.f, 0.f, 0.f, 0.f};
    bf16x8 At[4][2], B0[2][2], B1[2][2];
    const char* cA = (const char*)g.A + (size_t)cur.pm * tstep; const char* cB = (const char*)g.Bt + (size_t)cur.brow * K * 2;
    S.a_ready(cur);
    PG8_STAGE(PG8_SB(0, 0), cB, voffB); PG8_STAGE(PG8_SA(0, 0), cA, voffA); PG8_STAGE(PG8_SB(0, 1), cB + hstep, voffB); PG8_STAGE(PG8_SA(0, 1), cA + hstep, voffA);
    if (wr == 1) PG8_BAR;
    PG8_WAIT_V(4); PG8_BAR;
    PG8_STAGE(PG8_SB(1, 0), cB + kstep, voffB); PG8_STAGE(PG8_SA(1, 0), cA + kstep, voffA); PG8_STAGE(PG8_SB(1, 1), cB + hstep + kstep, voffB);
    PG8_WAIT_V(6); PG8_BAR;
    for (;;) {
        const bool has_next = S.next(ui + 1, nxt);
        const char* nA = has_next ? (const char*)g.A + (size_t)nxt.pm * tstep : cA; const char* nB = has_next ? (const char*)g.Bt + (size_t)nxt.brow * K * 2 : cB;
        for (int t = 0; t < nt; t += 2) {
            if constexpr (has_midk<Epi>::value) { if (t == nt / 2) E.mid(acc, cur, wr, wc, fr, fq); }
            const bool last = (t == nt - 2);
            const char* a1 = cA + (size_t)(t + 1) * kstep;
            const char* a2 = last ? nA : cA + (size_t)(t + 2) * kstep; const char* b2 = last ? nB : cB + (size_t)(t + 2) * kstep;
            const char* a3 = a2 + kstep; const char* b3 = b2 + kstep;
            if (last && has_next) S.a_ready(nxt);
            PG8_LDB(B0, 0, 0); PG8_SCHED; PG8_LDA(At, 0, 0); PG8_STAGE(PG8_SA(1, 1), a1 + hstep, voffA);
            PG8_WAIT_L(8); PG8_BAR; PG8_WAIT_L(0); PG8_MMA(0, 0, At, B0); PG8_BAR; PG8_SCHED;
            PG8_LDB(B1, 0, 1); PG8_STAGE(PG8_SB(0, 0), b2, voffB);
            PG8_BAR; PG8_WAIT_L(0); PG8_MMA(0, 1, At, B1); PG8_BAR;
            PG8_LDA(At, 0, 1); PG8_STAGE(PG8_SA(0, 0), a2, voffA);
            PG8_BAR; PG8_WAIT_L(0); PG8_MMA(1, 0, At, B0); PG8_BAR; PG8_SCHED;
            PG8_STAGE(PG8_SB(0, 1), b2 + hstep, voffB);
            PG8_WAIT_V(6); PG8_BAR; PG8_MMA(1, 1, At, B1); PG8_BAR;
            PG8_LDB(B0, 1, 0); PG8_SCHED; PG8_LDA(At, 1, 0); PG8_STAGE(PG8_SA(0, 1), a2 + hstep, voffA);
            PG8_WAIT_L(8); PG8_BAR; PG8_WAIT_L(0); PG8_MMA(0, 0, At, B0); PG8_BAR; PG8_SCHED;
            PG8_LDB(B1, 1, 1); PG8_STAGE(PG8_SB(1, 0), b3, voffB);
            PG8_BAR; PG8_WAIT_L(0); PG8_MMA(0, 1, At, B1); PG8_BAR;
            PG8_LDA(At, 1, 1); PG8_STAGE(PG8_SA(1, 0), a3, voffA);
            PG8_BAR; PG8_WAIT_L(0); PG8_MMA(1, 0, At, B0); PG8_BAR; PG8_SCHED;
            PG8_STAGE(PG8_SB(1, 1), b3 + hstep, voffB);
            PG8_WAIT_V(6); PG8_BAR; PG8_MMA(1, 1, At, B1); PG8_BAR;
        }
        if constexpr (!Epi::AFTER_DRAIN) { E(acc, cur, wr, wc, fr, fq); S.done(cur); }
        if (!has_next) break;
#pragma unroll
        for (int a = 0; a < 2; ++a)
#pragma unroll
            for (int b = 0; b < 2; ++b)
#pragma unroll
                for (int m = 0; m < 4; ++m)
#pragma unroll
                    for (int n = 0; n < 2; ++n) acc[a][b][m][n] = (f32x4){0.f, 0.f, 0.f, 0.f};
        cur = nxt; cA = nA; cB = nB; ++ui;
    }
    PG8_WAIT_V(0);
    if (wr == 0) PG8_BAR;
    PG8_BAR;
    if constexpr (Epi::AFTER_DRAIN) { E.fused(acc, cur, wr, wc, fr, fq, lds, wid, lane); S.done(cur); }
#undef PG8_SA
#undef PG8_SB
#undef PG8_STAGE
#undef PG8_LDA
#undef PG8_LDB
#undef PG8_MMA
#undef PG8_WAIT_V
#undef PG8_WAIT_L
#undef PG8_BAR
#undef PG8_SCHED
}
}


struct CvtJob { const float* src; bf16_t* dst; int N  , K  , nvalid  , sc0, sc1  ; };
constexpr int CJ_WIN = DEPTH * 16 * 21, CJ_WPA = DEPTH * 8 * 4, CJ_WPB = CJ_WPA, CJ_WOUT = DEPTH * 16 * 4, CJ_W1 = DEPTH * NE * 16 * 8, CJ_W2 = DEPTH * NE * 16 * 4;
constexpr int CJ_TOTAL = CJ_WIN + CJ_WPA + CJ_WPB + CJ_WOUT + CJ_W1 + CJ_W2;
__device__ __forceinline__ CvtJob cvt_job(int J, const float* const* in, unsigned char* ws) {
    CvtJob j;
    if (J < CJ_WIN) { const int m = J / (16 * 21), r = J % (16 * 21), kt = r / 21, ns = r % 21;
        j.src = in[I_WIN] + (size_t)m * D * ZC + (size_t)kt * 64 * ZC; j.dst = (bf16_t*)(ws + WS_WIN) + (size_t)m * ZLD * D + (size_t)ns * 256 * D + kt * 64; j.N = ZC; j.K = D;
        j.nvalid = ZC - ns * 256 < 256 ? ZC - ns * 256 : 256; j.sc0 = ns * 256; j.sc1 = ns * 256 + 128; return j; }
    J -= CJ_WIN;
    if (J < CJ_WPA + CJ_WPB) { const int which = J / CJ_WPA, JJ = J % CJ_WPA; const int m = JJ / 32, r = JJ % 32, kt = r / 4, ns = r % 4;
        j.src = in[which ? I_WPB : I_WPA] + (size_t)m * 512 * D + (size_t)kt * 64 * D; j.dst = (bf16_t*)(ws + WS_WPA) + (size_t)m * D * D + (size_t)ns * 256 * D + which * 512 + kt * 64; j.N = D; j.K = D;
        j.nvalid = 256; j.sc0 = ns * 256; j.sc1 = ns * 256 + 128; return j; }
    J -= CJ_WPA + CJ_WPB;
    if (J < CJ_WOUT) { const int m = J / 64, r = J % 64, kt = r / 4, ns = r % 4;
        j.src = in[I_WOUT] + (size_t)m * D * D + (size_t)kt * 64 * D; j.dst = (bf16_t*)(ws + WS_WOUT) + (size_t)m * D * D + (size_t)ns * 256 * D + kt * 64; j.N = D; j.K = D;
        j.nvalid = 256; j.sc0 = ns * 256; j.sc1 = ns * 256 + 128; return j; }
    J -= CJ_WOUT;
    if (J < CJ_W1) { const int m = J / 128, r = J % 128, kt = r / 8, ns = r % 8;
        j.src = in[I_W1] + (size_t)m * D * 2 * DFF + (size_t)kt * 64 * 2 * DFF; j.dst = (bf16_t*)(ws + WS_W1) + (size_t)m * 2 * DFF * D + (size_t)ns * 256 * D + kt * 64; j.N = 2 * DFF; j.K = D;
        j.nvalid = 256; j.sc0 = 128 * ns; j.sc1 = DFF + 128 * ns; return j; }
    J -= CJ_W1;
    { const int m = J / 64, r = J % 64, kt = r / 4, ns = r % 4;
        j.src = in[I_W2] + (size_t)m * DFF * D + (size_t)kt * 64 * D; j.dst = (bf16_t*)(ws + WS_W2) + (size_t)m * D * DFF + (size_t)ns * 256 * DFF + kt * 64; j.N = D; j.K = DFF;
        j.nvalid = 256; j.sc0 = ns * 256; j.sc1 = ns * 256 + 128; return j; }
}
__device__ __forceinline__ void cvt_load(const CvtJob& j, const int tid, f32x4 (&v)[8]) {
    const int i = tid >> 3, c0 = (tid & 7) * 32; const float* p = j.src + (size_t)i * j.N + (c0 < 128 ? j.sc0 + c0 : j.sc1 + c0 - 128);
#pragma unroll
    for (int q = 0; q < 8; ++q) v[q] = (c0 + 4 * q < j.nvalid) ? *(const f32x4*)(p + 4 * q) : (f32x4){0.f, 0.f, 0.f, 0.f};
}

__device__ __forceinline__ void hgrn_item(const bf16_t* __restrict__ zb, const float* __restrict__ lbv, const float* __restrict__ hnw, bf16_t* __restrict__ ha, unsigned char* ldsb, const int b, const int h, const int tid) {
    typedef unsigned long long u64;
    const int lane = tid & 63, wave = __builtin_amdgcn_readfirstlane(tid >> 6), r31 = lane & 31, hh = lane >> 5;
    bf16_t* QE = (bf16_t*)ldsb;
    bf16_t* KE = QE + 64 * 136;
    bf16_t* KET = KE + 64 * 136;
    bf16_t* VT = KET + 128 * 72;
    bf16_t* SBT = VT + 128 * 72;
    float* ex = (float*)(SBT + 128 * 136);
    float* er = ex + 512; float* el = er + 128; float* elr = el + 128;
    float* ssq = elr + 128;
    const int tg = wave >> 1, d = (wave & 1) * 64 + lane;
    const float lb = lbv[h * 128 + d], oml = 1.0f - lb;
    const int vs = lane, v0 = wave * 16;
    const bf16_t* fbase = zb + (size_t)(b * SEQ + 16 * tg) * ZLD + C_FA + h * 128;
    const bf16_t* qbase = zb + (size_t)(b * SEQ + 16 * tg) * ZLD + C_QA + h * 128;
    const bf16_t* vbase = zb + (size_t)(b * SEQ) * ZLD + C_IA + h * 128 + v0;
    const unsigned voff = (unsigned)vs * ZLD;
    unsigned nfq[16]; u32x4 nv0, nv1;
#pragma unroll
    for (int j = 0; j < 16; ++j) nfq[j] = (unsigned)(fbase + (size_t)j * ZLD)[d] | ((unsigned)(qbase + (size_t)j * ZLD)[d] << 16);
    nv0 = *(const u32x4*)(vbase + voff); nv1 = *(const u32x4*)(vbase + voff + 8);
    const int tt = wave & 1, oq = wave >> 1, dq = wave & 3, sv = wave >> 2;
    f32x16 S0, S1;
#pragma unroll
    for (int i = 0; i < 16; ++i) { S0[i] = 0.f; S1[i] = 0.f; }
    for (int c = 0; c < SEQ / 64; ++c) {
        const int row0 = b * SEQ + c * 64;
        float g[16], kk[16], qv[16]; float run = 0.f;
#pragma unroll
        for (int j = 0; j < 16; ++j) {
            const float zf = fminf(fmaxf(__uint_as_float(nfq[j] << 16), -60.f), 60.f), zq = __uint_as_float(nfq[j] & 0xffff0000u);
            const float e = __builtin_amdgcn_exp2f(-1.4426950408889634f * zf), sg = __builtin_amdgcn_rcpf(1.0f + e);
            run += 0.6931471805599453f * __builtin_amdgcn_logf(lb + oml * sg); g[j] = run; kk[j] = oml * e * sg; qv[j] = zq * sigmoidf_(zq);
        }
        const u32x4 cv0 = nv0, cv1 = nv1;
        ex[tg * 128 + d] = run;
        __syncthreads();
        {
            const float e0 = ex[d], e1 = ex[128 + d], e2 = ex[256 + d], e3 = ex[384 + d];
            const float pre = tg == 0 ? 0.f : tg == 1 ? e0 : tg == 2 ? e0 + e1 : e0 + e1 + e2;
            const float r = e0 + e1, tot = (e0 + e1) + (e2 + e3);
            unsigned kt[8];
#pragma unroll
            for (int j = 0; j < 16; j += 2) {
                const float bt0 = pre + g[j], bt1 = pre + g[j + 1];
                const float L2E = 1.4426950408889634f;
                const float qe0 = qv[j] * __builtin_amdgcn_exp2f(L2E * fminf(bt0 - r, 80.f)), qe1 = qv[j + 1] * __builtin_amdgcn_exp2f(L2E * fminf(bt1 - r, 80.f));
                const float ke0 = kk[j] * __builtin_amdgcn_exp2f(L2E * fminf(r - bt0, 80.f)), ke1 = kk[j + 1] * __builtin_amdgcn_exp2f(L2E * fminf(r - bt1, 80.f));
                const unsigned qp = pg8::cvt_pk_bf16(qe0, qe1), kp = pg8::cvt_pk_bf16(ke0, ke1);
                QE[(16 * tg + j) * 136 + d] = (bf16_t)(qp & 0xffffu); QE[(16 * tg + j + 1) * 136 + d] = (bf16_t)(qp >> 16);
                KE[(16 * tg + j) * 136 + d] = (bf16_t)(kp & 0xffffu); KE[(16 * tg + j + 1) * 136 + d] = (bf16_t)(kp >> 16);
                kt[j >> 1] = kp;
            }
            u32x4 w0, w1; w0.x = kt[0]; w0.y = kt[1]; w0.z = kt[2]; w0.w = kt[3]; w1.x = kt[4]; w1.y = kt[5]; w1.z = kt[6]; w1.w = kt[7];
            *(u32x4*)(KET + d * 72 + 16 * tg) = w0; *(u32x4*)(KET + d * 72 + 16 * tg + 8) = w1;
            if (tg == 0) { er[d] = __expf(r); el[d] = __expf(tot); elr[d] = __expf(tot - r); }
            const unsigned vw[8] = {cv0.x, cv0.y, cv0.z, cv0.w, cv1.x, cv1.y, cv1.z, cv1.w};
#pragma unroll
            for (int q = 0; q < 8; ++q) { VT[(v0 + 2 * q) * 72 + vs] = (bf16_t)(vw[q] & 0xffffu); VT[(v0 + 2 * q + 1) * 72 + vs] = (bf16_t)(vw[q] >> 16); }
        }
        __syncthreads();
        if (c + 1 < SEQ / 64) {
#pragma unroll
            for (int j = 0; j < 16; ++j) nfq[j] = (unsigned)(fbase + (size_t)((c + 1) * 64 + j) * ZLD)[d] | ((unsigned)(qbase + (size_t)((c + 1) * 64 + j) * ZLD)[d] << 16);
            nv0 = *(const u32x4*)(vbase + (size_t)(c + 1) * 64 * ZLD + voff); nv1 = *(const u32x4*)(vbase + (size_t)(c + 1) * 64 * ZLD + voff + 8);
        }
#pragma unroll
        for (int ti = 0; ti < 2; ++ti) {
            const int vq = 2 * sv + ti;
#pragma unroll
            for (int g4 = 0; g4 < 4; ++g4) {
                const int dd = 32 * dq + 8 * g4 + 4 * hh;
                const float s0 = ti ? S1[4 * g4] : S0[4 * g4], s1 = ti ? S1[4 * g4 + 1] : S0[4 * g4 + 1], s2 = ti ? S1[4 * g4 + 2] : S0[4 * g4 + 2], s3 = ti ? S1[4 * g4 + 3] : S0[4 * g4 + 3];
                const unsigned a0 = pg8::cvt_pk_bf16(er[dd] * s0, er[dd + 1] * s1), a1 = pg8::cvt_pk_bf16(er[dd + 2] * s2, er[dd + 3] * s3);
                *(u64*)(SBT + (32 * vq + r31) * 136 + dd) = (u64)a0 | ((u64)a1 << 32);
            }
        }
        __syncthreads();
        f32x16 Oacc;
#pragma unroll
        for (int i = 0; i < 16; ++i) Oacc[i] = 0.f;
        {
            bf16x8 qf[8];
#pragma unroll
            for (int ks = 0; ks < 8; ++ks) qf[ks] = *(const bf16x8*)(QE + (32 * tt + r31) * 136 + 16 * ks + 8 * hh);
#pragma unroll
            for (int ks = 0; ks < 8; ++ks) { const bf16x8 sa = *(const bf16x8*)(SBT + (32 * oq + r31) * 136 + 16 * ks + 8 * hh); Oacc = __builtin_amdgcn_mfma_f32_32x32x16_bf16(sa, qf[ks], Oacc, 0, 0, 0); }
            for (int st = 0; st <= tt; ++st) {
                f32x16 At;
#pragma unroll
                for (int i = 0; i < 16; ++i) At[i] = 0.f;
#pragma unroll
                for (int ks = 0; ks < 8; ++ks) { const bf16x8 ka = *(const bf16x8*)(KE + (32 * st + r31) * 136 + 16 * ks + 8 * hh); At = __builtin_amdgcn_mfma_f32_32x32x16_bf16(ka, qf[ks], At, 0, 0, 0); }
                if (st == tt) {
#pragma unroll
                    for (int i = 0; i < 16; ++i) { const int sl = (i & 3) + 8 * (i >> 2) + 4 * hh; if (sl > r31) At[i] = 0.f; }
                }
                union { unsigned u[4]; bf16x8 v; } pb0, pb1;
#pragma unroll
                for (int j = 0; j < 4; ++j) { pb0.u[j] = pg8::cvt_pk_bf16(At[2 * j], At[2 * j + 1]); pb1.u[j] = pg8::cvt_pk_bf16(At[8 + 2 * j], At[8 + 2 * j + 1]); }
                union { u64 q[2]; bf16x8 v; } a0, a1;
                const bf16_t* vr = VT + (32 * oq + r31) * 72 + 32 * st + 4 * hh;
                a0.q[0] = *(const u64*)(vr); a0.q[1] = *(const u64*)(vr + 8); a1.q[0] = *(const u64*)(vr + 16); a1.q[1] = *(const u64*)(vr + 24);
                Oacc = __builtin_amdgcn_mfma_f32_32x32x16_bf16(a0.v, pb0.v, Oacc, 0, 0, 0);
                Oacc = __builtin_amdgcn_mfma_f32_32x32x16_bf16(a1.v, pb1.v, Oacc, 0, 0, 0);
            }
        }
        {
            float q2 = 0.f;
#pragma unroll
            for (int i = 0; i < 16; ++i) q2 += Oacc[i] * Oacc[i];
            q2 += __shfl_xor(q2, 32);
            if (hh == 0) ssq[(32 * tt + r31) * 4 + oq] = q2;
        }
        {
            f32x16 d0, d1;
#pragma unroll
            for (int i = 0; i < 16; ++i) { d0[i] = 0.f; d1[i] = 0.f; }
#pragma unroll
            for (int ks = 0; ks < 4; ++ks) {
                const bf16x8 ka = *(const bf16x8*)(KET + (32 * dq + r31) * 72 + 16 * ks + 8 * hh);
                const bf16x8 vb0 = *(const bf16x8*)(VT + (64 * sv + r31) * 72 + 16 * ks + 8 * hh), vb1 = *(const bf16x8*)(VT + (64 * sv + 32 + r31) * 72 + 16 * ks + 8 * hh);
                d0 = __builtin_amdgcn_mfma_f32_32x32x16_bf16(ka, vb0, d0, 0, 0, 0); d1 = __builtin_amdgcn_mfma_f32_32x32x16_bf16(ka, vb1, d1, 0, 0, 0);
            }
#pragma unroll
            for (int i = 0; i < 16; ++i) { const int dd = 32 * dq + (i & 3) + 8 * (i >> 2) + 4 * hh; const float a = el[dd], bb = elr[dd]; S0[i] = a * S0[i] + bb * d0[i]; S1[i] = a * S1[i] + bb * d1[i]; }
        }
        __syncthreads();
        {
            const int t = 32 * tt + r31;
            const f32x4 sq = *(const f32x4*)(ssq + t * 4);
            const float rn = rsqrtf(((sq[0] + sq[1]) + (sq[2] + sq[3])) * (1.0f / 128.0f) + EPS);
            const int vcol = h * 128 + 32 * oq + 4 * hh;
            const bf16_t* gp = zb + (size_t)(row0 + t) * ZLD + C_GA + vcol;
            bf16_t* op = ha + (size_t)(row0 + t) * D + vcol;
#pragma unroll
            for (int g4 = 0; g4 < 4; ++g4) {
                const u64 gw = *(const u64*)(gp + 8 * g4); const f32x4 w4 = *(const f32x4*)(hnw + vcol + 8 * g4);
                float o[4];
#pragma unroll
                for (int j = 0; j < 4; ++j) { const float gg = bf2f((bf16_t)((gw >> (16 * j)) & 0xffffu)); o[j] = Oacc[4 * g4 + j] * rn * w4[j] * (gg * sigmoidf_(gg)); }
                *(u64*)(op + 8 * g4) = (u64)pg8::cvt_pk_bf16(o[0], o[1]) | ((u64)pg8::cvt_pk_bf16(o[2], o[3]) << 32);
            }
        }
    }
    __syncthreads();
}

#define DPP_STEP(v, op, ctrl) v = v op __builtin_amdgcn_update_dpp(v, v, ctrl, 0xf, 0xf, false)
__device__ __forceinline__ int wave_sum_dpp(int v) { DPP_STEP(v, +, 0xB1); DPP_STEP(v, +, 0x4E); DPP_STEP(v, +, 0x141); DPP_STEP(v, +, 0x140);
    return __builtin_amdgcn_readlane(v, 0) + __builtin_amdgcn_readlane(v, 16) + __builtin_amdgcn_readlane(v, 32) + __builtin_amdgcn_readlane(v, 48); }
__device__ __forceinline__ int wave_and_u(int v) { DPP_STEP(v, &, 0xB1); DPP_STEP(v, &, 0x4E); DPP_STEP(v, &, 0x141); DPP_STEP(v, &, 0x140);
    return __builtin_amdgcn_readlane(v, 0) & __builtin_amdgcn_readlane(v, 16) & __builtin_amdgcn_readlane(v, 32) & __builtin_amdgcn_readlane(v, 48); }
__device__ __forceinline__ int wave_or_u(int v) { DPP_STEP(v, |, 0xB1); DPP_STEP(v, |, 0x4E); DPP_STEP(v, |, 0x141); DPP_STEP(v, |, 0x140);
    return __builtin_amdgcn_readlane(v, 0) | __builtin_amdgcn_readlane(v, 16) | __builtin_amdgcn_readlane(v, 32) | __builtin_amdgcn_readlane(v, 48); }

__device__ __forceinline__ unsigned ordered_key(float f) { const unsigned u = __float_as_uint(f); return (u & 0x80000000u) ? ~u : (u | 0x80000000u); }
__device__ __forceinline__ void indexer_unit(const bf16_t* __restrict__ zb, unsigned* __restrict__ maskp, unsigned* sc  , bf16_t* ring  ,
                                             const int b, const int t0, const int tid) {
    typedef unsigned long long u64;
    const int lane = tid & 63, wave = tid >> 6;
    const int r31 = lane & 31, hh = lane >> 5;
    constexpr int IDX_TILE = 32 * 72, IDX_SLOT = 2 * IDX_TILE;
    unsigned* hist = (unsigned*)ring + wave * 256;
    {
        const int g = wave & 3, par = wave >> 2;
        const int head = (r31 & 3) + 4 * ((r31 >> 3) & 1), ql = 2 * ((r31 >> 4) & 1) + ((r31 >> 2) & 1);
        const bf16_t* ap = zb + (size_t)(b * SEQ + t0 + 4 * g + ql) * ZLD + C_IQ + head * 64 + 8 * hh;
        bf16x8 a[4];
#pragma unroll
        for (int s4 = 0; s4 < 4; ++s4) a[s4] = *(const bf16x8*)(ap + 16 * s4);
        float wq[16];
        {
            const int qa = t0 + 4 * g + hh, qb = qa + 2;
            f32x4 w0, w1, w2, w3; pg8::bf8_to_f32(*(const u32x4*)(zb + (size_t)(b * SEQ + qa) * ZLD + C_IW), w0, w1); pg8::bf8_to_f32(*(const u32x4*)(zb + (size_t)(b * SEQ + qb) * ZLD + C_IW), w2, w3);
#pragma unroll
            for (int i = 0; i < 4; ++i) { wq[i] = w0[i] * 0.04419417382415922f; wq[4 + i] = w1[i] * 0.04419417382415922f; wq[8 + i] = w2[i] * 0.04419417382415922f; wq[12 + i] = w3[i] * 0.04419417382415922f; }
        }
        const int ta = t0 + 4 * g + hh, tb_ = ta + 2;
        const int kt_max = (t0 + 15) >> 5, nit = (kt_max >> 1) + 1;
        const int lsub = tid >> 8, lkey = (tid & 255) >> 3, lpc = tid & 7;
        const bf16_t* gsrc = zb + ((size_t)b * SEQ + lsub * 32 + lkey) * ZLD + C_IK + lpc * 8;
        const int loff = lsub * IDX_TILE + lkey * 72 + lpc * 8;
        u32x4 stg;
        __syncthreads();
        if (lsub <= kt_max) { stg = *(const u32x4*)gsrc; *(u32x4*)(ring + loff) = stg; }
        if (nit > 1 && 2 + lsub <= kt_max) { stg = *(const u32x4*)(gsrc + (size_t)64 * ZLD); *(u32x4*)(ring + IDX_SLOT + loff) = stg; }
        __syncthreads();
        for (int it = 0; it < nit; ++it) {
            const bool more = (it + 2 < nit) && (2 * (it + 2) + lsub <= kt_max);
            if (more) stg = *(const u32x4*)(gsrc + (size_t)(it + 2) * 64 * ZLD);
            const int kt = 2 * it + par;
            if (kt <= kt_max) {
                const bf16_t* tl = ring + (it % 3) * IDX_SLOT + par * IDX_TILE + r31 * 72 + 8 * hh;
                f32x16 acc;
#pragma unroll
                for (int q = 0; q < 16; ++q) acc[q] = 0.f;
#pragma unroll
                for (int s4 = 0; s4 < 4; ++s4) { const bf16x8 bk = *(const bf16x8*)(tl + 16 * s4); acc = __builtin_amdgcn_mfma_f32_32x32x16_bf16(a[s4], bk, acc, 0, 0, 0); }
                float sa = 0.f, sb = 0.f;
#pragma unroll
                for (int i = 0; i < 8; ++i) { sa += wq[i] * fmaxf(acc[i], 0.f); sb += wq[8 + i] * fmaxf(acc[8 + i], 0.f); }
                const int key = kt * 32 + r31;
                sc[(4 * g + hh) * 2048 + key] = key <= ta ? ordered_key(sa) : 0u;
                sc[(4 * g + 2 + hh) * 2048 + key] = key <= tb_ ? ordered_key(sb) : 0u;
            }
            if (more) *(u32x4*)(ring + ((it + 2) % 3) * IDX_SLOT + loff) = stg;
            __syncthreads();
        }
    }
    for (int srep_ = 0; srep_ < (PROBE_GROUP == 8 ? 2 : 1); ++srep_)
    for (int qq = 2 * wave; qq < 2 * wave + 2; ++qq) {
        const int t = t0 + qq;
        unsigned kreg[32];
#pragma unroll
        for (int i = 0; i < 32; ++i) { const int p = lane + 64 * i; kreg[i] = (p <= t) ? sc[qq * 2048 + p] : 0u; }
        unsigned kand = 0xffffffffu, kor = 0u;
#pragma unroll
        for (int i = 0; i < 32; ++i) { if (lane + 64 * i <= t) { kand &= kreg[i]; kor |= kreg[i]; } }
        kand = (unsigned)wave_and_u(kand); kor = (unsigned)wave_or_u(kor);
        const unsigned diff = kand ^ kor;
        unsigned prefix; int hb;
        if (diff == 0u) { prefix = kor; hb = -1; } else { hb = 31 - __builtin_clz(diff); prefix = (hb == 31) ? 0u : (kor & ~((2u << hb) - 1u)); }
        bool exact = false;
        for (int bit = hb; bit >= 0; --bit) {
            const unsigned cand = prefix | (1u << bit);
            int cl = 0;
#pragma unroll
            for (int i = 0; i < 32; ++i) cl += (kreg[i] >= cand) ? 1 : 0;
            const int cnt = wave_sum_dpp(cl);
            if (cnt >= 256) prefix = cand;
            if (cnt == 256) { exact = true; break; }
        }
        int kk = 0;
        if (!exact) { int cl = 0;
#pragma unroll
            for (int i = 0; i < 32; ++i) cl += (kreg[i] > prefix) ? 1 : 0;
            kk = 256 - wave_sum_dpp(cl); }
        const unsigned gtv = exact ? prefix - 1u : prefix;
        unsigned myword = 0u; int eqbefore = 0;
#pragma unroll
        for (int i = 0; i < 32; ++i) {
            const bool eq = kreg[i] == prefix;
            const unsigned long long beq = __ballot(eq);
            const int rank = eqbefore + __popcll(beq & ((1ull << lane) - 1ull));
            const bool sel = kreg[i] > gtv || (eq && rank < kk);
            const unsigned long long bs = __ballot(sel);
            eqbefore += __popcll(beq);
            if (lane == 2 * i) myword = (unsigned)bs;
            if (lane == 2 * i + 1) myword = (unsigned)(bs >> 32);
        }
        maskp[(size_t)(b * SEQ + t) * 64 + lane] = myword;
    }
    __syncthreads();
}

constexpr int ATT_KROW = 72, ATT_VROW = 68, ATT_SLOT = 64 * ATT_KROW + 64 * ATT_VROW;
__device__ __forceinline__ void attn_block(const bf16_t* __restrict__ zb, const bf16_t* __restrict__ vbt, const unsigned* __restrict__ maskp, bf16_t* __restrict__ att, const float* tb  ,
                                           bf16_t* ring  , const int b, const int qt, const int tid) {
    typedef unsigned long long u64;
    const int lane = tid & 63, wave = tid >> 6;
    const int c = lane & 31, hh = lane >> 5, h = c & 7;
    const int t0w = qt * 32 + 4 * wave;
    const int tq = t0w + (c >> 3);
    const size_t rowq = (size_t)b * SEQ + tq;
    bf16x8 bq[4];
#pragma unroll
    for (int s4 = 0; s4 < 4; ++s4) bq[s4] = *(const bf16x8*)(zb + rowq * ZLD + C_QB + h * 64 + 16 * s4 + 8 * hh);
    const int nstep = (qt >> 1) + 1;
    const float bfar = tb[127 * 8 + h];
    const float QS = 0.125f * 1.4426950408889634f;
    float m = -1e30f, lsum = 0.f;
    f32x16 O0, O1;
#pragma unroll
    for (int q = 0; q < 16; ++q) { O0[q] = 0.f; O1[q] = 0.f; }
    const u64* mbase = (const u64*)(maskp + rowq * 64);
    const int lrow = tid >> 3, lpc = tid & 7;
    const bf16_t* gk = zb + ((size_t)b * SEQ + lrow) * ZLD + C_KB + lpc * 8;
    const bf16_t* gv = vbt + ((size_t)b * 64 + lrow) * SEQ + lpc * 8;
    const int lk = lrow * ATT_KROW + lpc * 8, lv = 64 * ATT_KROW + lrow * ATT_VROW + lpc * 8;
    u32x4 sk = *(const u32x4*)gk, sv = *(const u32x4*)gv;
    { *(u32x4*)(ring + lk) = sk; u64* d = (u64*)(ring + lv); d[0] = (u64)sv.x | ((u64)sv.y << 32); d[1] = (u64)sv.z | ((u64)sv.w << 32); }
    if (nstep > 1) { sk = *(const u32x4*)(gk + (size_t)64 * ZLD); sv = *(const u32x4*)(gv + 64);
        *(u32x4*)(ring + ATT_SLOT + lk) = sk; u64* d = (u64*)(ring + ATT_SLOT + lv); d[0] = (u64)sv.x | ((u64)sv.y << 32); d[1] = (u64)sv.z | ((u64)sv.w << 32); }
    u64 mw2 = mbase[0];
    __syncthreads();
    for (int st = 0; st < nstep; ++st) {
        const int key0 = st * 64;
        const bf16_t* sl = ring + (st % 3) * ATT_SLOT;
        const bool more = st + 2 < nstep;
        if (more) { sk = *(const u32x4*)(gk + (size_t)(st + 2) * 64 * ZLD); sv = *(const u32x4*)(gv + (st + 2) * 64); }
        const unsigned cm0 = (unsigned)mw2 >> (4 * hh), cm1 = (unsigned)(mw2 >> 32) >> (4 * hh);
        mw2 = mbase[st + 1 < nstep ? st + 1 : st];
        f32x16 S0, S1;
#pragma unroll
        for (int q = 0; q < 16; ++q) { S0[q] = 0.f; S1[q] = 0.f; }
#pragma unroll
        for (int s4 = 0; s4 < 4; ++s4) {
            const bf16x8 k0 = *(const bf16x8*)(sl + c * ATT_KROW + 16 * s4 + 8 * hh), k1 = *(const bf16x8*)(sl + (32 + c) * ATT_KROW + 16 * s4 + 8 * hh);
            S0 = __builtin_amdgcn_mfma_f32_32x32x16_bf16(k0, bq[s4], S0, 0, 0, 0);
            S1 = __builtin_amdgcn_mfma_f32_32x32x16_bf16(k1, bq[s4], S1, 0, 0, 0);
        }
        float x0[16], x1[16]; float tmax = -1e30f;
        {
            const bool nearb = (t0w - key0 - 31) < 113;
            const int relb = tq - key0 - 4 * hh;
#pragma unroll
            for (int i = 0; i < 16; ++i) { const int ko = (i & 3) + 8 * (i >> 2); float bias = bfar;
                if (nearb) { int rel = relb - ko; rel = rel < 0 ? 0 : (rel > 127 ? 127 : rel); bias = tb[rel * 8 + h]; }
                x0[i] = S0[i] * QS + bias; if ((cm0 >> ko) & 1u) tmax = fmaxf(tmax, x0[i]); }
        }
        {
            const bool nearb = (t0w - key0 - 63) < 113;
            const int relb = tq - key0 - 32 - 4 * hh;
#pragma unroll
            for (int i = 0; i < 16; ++i) { const int ko = (i & 3) + 8 * (i >> 2); float bias = bfar;
                if (nearb) { int rel = relb - ko; rel = rel < 0 ? 0 : (rel > 127 ? 127 : rel); bias = tb[rel * 8 + h]; }
                x1[i] = S1[i] * QS + bias; if ((cm1 >> ko) & 1u) tmax = fmaxf(tmax, x1[i]); }
        }
        tmax = fmaxf(tmax, __shfl_xor(tmax, 32));
        const float mn = fmaxf(m, tmax);
        if (__ballot(mn > m) != 0ull) {
            const float scl = __builtin_amdgcn_exp2f(m - mn);
            lsum *= scl;
#pragma unroll
            for (int q = 0; q < 16; ++q) { O0[q] *= scl; O1[q] *= scl; }
        }
        m = mn;
        float p0[16], p1[16];
#pragma unroll
        for (int i = 0; i < 16; ++i) { const int ko = (i & 3) + 8 * (i >> 2);
            p0[i] = ((cm0 >> ko) & 1u) ? __builtin_amdgcn_exp2f(x0[i] - m) : 0.f; p1[i] = ((cm1 >> ko) & 1u) ? __builtin_amdgcn_exp2f(x1[i] - m) : 0.f; lsum += p0[i] + p1[i]; }
        union { unsigned u[4]; bf16x8 v; } pb00, pb01, pb10, pb11;
#pragma unroll
        for (int j = 0; j < 4; ++j) { pb00.u[j] = pg8::cvt_pk_bf16(p0[2 * j], p0[2 * j + 1]); pb01.u[j] = pg8::cvt_pk_bf16(p0[8 + 2 * j], p0[8 + 2 * j + 1]);
                                      pb10.u[j] = pg8::cvt_pk_bf16(p1[2 * j], p1[2 * j + 1]); pb11.u[j] = pg8::cvt_pk_bf16(p1[8 + 2 * j], p1[8 + 2 * j + 1]); }
        const bf16_t* vt = sl + 64 * ATT_KROW + c * ATT_VROW + 4 * hh;
#pragma unroll
        for (int sub = 0; sub < 2; ++sub) {
            union { u64 q[2]; bf16x8 v; } a00, a01, a10, a11;
            const bf16_t* vs = vt + 32 * sub;
            a00.q[0] = *(const u64*)(vs); a00.q[1] = *(const u64*)(vs + 8); a01.q[0] = *(const u64*)(vs + 16); a01.q[1] = *(const u64*)(vs + 24);
            a10.q[0] = *(const u64*)(vs + 32 * ATT_VROW); a10.q[1] = *(const u64*)(vs + 32 * ATT_VROW + 8); a11.q[0] = *(const u64*)(vs + 32 * ATT_VROW + 16); a11.q[1] = *(const u64*)(vs + 32 * ATT_VROW + 24);
            O0 = __builtin_amdgcn_mfma_f32_32x32x16_bf16(a00.v, sub ? pb10.v : pb00.v, O0, 0, 0, 0);
            O1 = __builtin_amdgcn_mfma_f32_32x32x16_bf16(a10.v, sub ? pb10.v : pb00.v, O1, 0, 0, 0);
            O0 = __builtin_amdgcn_mfma_f32_32x32x16_bf16(a01.v, sub ? pb11.v : pb01.v, O0, 0, 0, 0);
            O1 = __builtin_amdgcn_mfma_f32_32x32x16_bf16(a11.v, sub ? pb11.v : pb01.v, O1, 0, 0, 0);
        }
        if (more) { bf16_t* ds = ring + ((st + 2) % 3) * ATT_SLOT; *(u32x4*)(ds + lk) = sk; u64* d = (u64*)(ds + lv); d[0] = (u64)sv.x | ((u64)sv.y << 32); d[1] = (u64)sv.z | ((u64)sv.w << 32); }
        __syncthreads();
    }
    lsum += __shfl_xor(lsum, 32);
    const float inv = __builtin_amdgcn_rcpf(lsum);
    bf16_t* op = att + rowq * D + 512 + h * 64 + 4 * hh;
#pragma unroll
    for (int g4 = 0; g4 < 4; ++g4) {
        unsigned w0 = pg8::cvt_pk_bf16(O0[4 * g4] * inv, O0[4 * g4 + 1] * inv), w1 = pg8::cvt_pk_bf16(O0[4 * g4 + 2] * inv, O0[4 * g4 + 3] * inv);
        *(u64*)(op + 8 * g4) = (u64)w0 | ((u64)w1 << 32);
        w0 = pg8::cvt_pk_bf16(O1[4 * g4] * inv, O1[4 * g4 + 1] * inv); w1 = pg8::cvt_pk_bf16(O1[4 * g4 + 2] * inv, O1[4 * g4 + 3] * inv);
        *(u64*)(op + 32 + 8 * g4) = (u64)w0 | ((u64)w1 << 32);
    }
}

template <int KIND> __global__ void __launch_bounds__(NTHREADS, 2) fwd(Args args) {
    extern __shared__ __attribute__((aligned(16))) unsigned char lds[];
    const int tid = threadIdx.x, lane = tid & 63, wave = tid >> 6;
    const int G = gridDim.x;
    PG8_LAS unsigned char* const lds3 = (PG8_LAS unsigned char*)lds;
#define WS_OPAQUE() unsigned long long ws_raw_ = (unsigned long long)args.ws; asm volatile("" : "+s"(ws_raw_)); GAS unsigned char* const wsg_ = (GAS unsigned char*)ws_raw_; unsigned char* const ws = (unsigned char*)wsg_; int tid = threadIdx.x; asm volatile("" : "+v"(tid)); const int lane = tid & 63, wave = tid >> 6; (void)lane; (void)wave
#define ctl ((unsigned*)(ws + WS_CTL))
#define MOD ((float*)(ws + WS_MOD))
#define LB ((float*)(ws + WS_LB))
#define WIN ((bf16_t*)(ws + WS_WIN))
#define WPA ((bf16_t*)(ws + WS_WPA))
#define WPB ((bf16_t*)(ws + WS_WPB))
#define WOUT ((bf16_t*)(ws + WS_WOUT))
#define W1 ((bf16_t*)(ws + WS_W1))
#define W2 ((bf16_t*)(ws + WS_W2))
#define H ((bf16_t*)(ws + WS_H))
#define ZB ((bf16_t*)(ws + WS_Z))
#define VBT ((bf16_t*)(ws + WS_VBT))
#define Y ((bf16_t*)(ws + WS_Y))
#define XS ((bf16_t*)(ws + WS_XS))
#define ACT ((bf16_t*)(ws + WS_ACT))
#define ORAW ((float*)(ws + WS_ORAW))
#define TMP ((float*)(ws + WS_TMP))
#define HA ((bf16_t*)(ws + WS_HA))
#define ATT ((bf16_t*)(ws + WS_ATT))
#define MASK ((unsigned*)(ws + WS_MASK))
#define MERGED ((bf16_t*)(ws + WS_MERGED))
#define X1 ((float*)(ws + WS_X1))
#define X2 ((float*)(ws + WS_X2))
#define TOKE ((int*)(ws + WS_TOKE))
#define TOKG ((float*)(ws + WS_TOKG))
#define TOKP ((int*)(ws + WS_TOKP))
#define TOKS ((int*)(ws + WS_TOKS))
#define BLKE ((int*)(ws + WS_BLKE))
#define BCNT ((int*)(ws + WS_BCNT))
    const int lo = args.ph_lo, hi = args.ph_hi;
#define IN(k) ((KIND < 0 || ((k) == 0 ? KIND == 100 : KIND == ((k) - 1) % 11)) && lo <= (k) && (k) < hi)
#define SEAM(k) do { if (KIND < 0 && IN(k) && IN((k) + 1)) xcd_barrier(bar); } while (0)
    XcdBarrier bar; bar.bar = (unsigned*)(args.ws + WS_CTL) + CW_BAR; bar.x = 0; bar.st = nullptr;
    if (KIND < 0) {
        volatile LAS unsigned* xbw = (volatile LAS unsigned*)((LAS unsigned char*)lds + (LDS_BYTES - 16));
        if (tid == 0) { xbw[0] = 0u; xbw[1] = 0u; xbw[2] = 0u; xbw[3] = 0u; }
        __syncthreads();
        bar = xcd_barrier_post((unsigned*)(args.ws + WS_CTL) + CW_BAR, xbw);
    }

    if (IN(0)) for (int prep_ = 0; prep_ < probe_reps(100); ++prep_) {
        WS_OPAQUE();
        {
            bf16_t* lt = (bf16_t*)lds;
            f32x4 v[8];
            int J = blockIdx.x;
            CvtJob cur = cvt_job(J < CJ_TOTAL ? J : 0, args.in, ws);
            if (J < CJ_TOTAL) cvt_load(cur, tid, v);
            __syncthreads();
            for (; J < CJ_TOTAL; J += G) {
                {
                    const int i = tid >> 3, c0 = (tid & 7) * 32;
#pragma unroll
                    for (int q = 0; q < 8; q += 2) { u32x4 w; w.x = pg8::cvt_pk_bf16(v[q][0], v[q][1]); w.y = pg8::cvt_pk_bf16(v[q][2], v[q][3]); w.z = pg8::cvt_pk_bf16(v[q + 1][0], v[q + 1][1]); w.w = pg8::cvt_pk_bf16(v[q + 1][2], v[q + 1][3]);
                        *(u32x4*)(lt + i * 264 + c0 + 4 * q) = w; }
                }
                __syncthreads();
                const CvtJob me = cur;
                if (J + G < CJ_TOTAL) { cur = cvt_job(J + G, args.in, ws); cvt_load(cur, tid, v); }
                {
                    const int n = tid & 255, kh = tid >> 8;
                    unsigned w[16];
#pragma unroll
                    for (int q = 0; q < 16; ++q) w[q] = (unsigned)lt[(kh * 32 + 2 * q) * 264 + n] | ((unsigned)lt[(kh * 32 + 2 * q + 1) * 264 + n] << 16);
                    bf16_t* dp = me.dst + (size_t)n * me.K + kh * 32;
#pragma unroll
                    for (int q = 0; q < 4; ++q) { u32x4 o; o.x = w[4 * q]; o.y = w[4 * q + 1]; o.z = w[4 * q + 2]; o.w = w[4 * q + 3]; *(u32x4*)(dp + 8 * q) = o; }
                }
                __syncthreads();
            }
        }
        {
            float* ca = (float*)lds;
            float* red = ca + NB * D;
            __syncthreads();
            for (int i = tid; i < NB * D; i += NTHREADS) { const float c = args.in[I_C][i]; ca[i] = c * sigmoidf_(c); }
            __syncthreads();
            for (int u = blockIdx.x; u < DEPTH * NMOD / 48; u += G) {
                const int jc = tid % 48, kg = tid / 48;
                const int ln = u * 48 + jc, l = ln / NMOD, n = ln % NMOD;
                if (kg < 10) {
                    const float* w = args.in[I_WADA] + (size_t)l * D * NMOD + n;
                    float acc[NB];
#pragma unroll
                    for (int b = 0; b < NB; ++b) acc[b] = 0.f;
                    for (int k = kg; k < D; k += 10) { const float wv = w[(size_t)k * NMOD];
#pragma unroll
                        for (int b = 0; b < NB; ++b) acc[b] += ca[b * D + k] * wv; }
#pragma unroll
                    for (int b = 0; b < NB; ++b) red[(kg * NB + b) * 48 + jc] = acc[b];
                }
                __syncthreads();
                for (int o = tid; o < NB * 48; o += NTHREADS) { const int b = o / 48, jj = o % 48; float a = 0.f;
#pragma unroll
                    for (int q = 0; q < 10; ++q) a += red[(q * NB + b) * 48 + jj];
                    const int ln2 = u * 48 + jj, l2 = ln2 / NMOD, n2 = ln2 % NMOD;
                    MOD[((size_t)l2 * NB + b) * NMOD + n2] = a + args.in[I_BADA][(size_t)l2 * NMOD + n2]; }
                __syncthreads();
            }
        }
        if (blockIdx.x == G - 1) {
            for (int j = tid; j < 512; j += NTHREADS) { const float a0 = args.in[I_LBL][j], a1 = args.in[I_LBL][512 + j]; LB[j] = 0.f; LB[512 + j] = 1.0f / (1.0f + __expf(a0 - a1)); }
        }
    }

    SEAM(0);
#pragma unroll
    for (int l = 0; l < DEPTH; ++l) {
        const int P = 1 + 11 * l;
#define mod (MOD + (size_t)l * NB * NMOD)
#define xin ((l == 0) ? args.in[I_X] : (const float*)X2)
        if (IN(P + 0) && l == 0) {
            WS_OPAQUE();
            const float* nw = args.in[I_NMW] + (size_t)l * D;
            for (int row = blockIdx.x * NWAVES + wave; row < T; row += G * NWAVES) {
                const int b = row >> 11; f32x4 v[4]; float ss = 0.f;
#pragma unroll
                for (int i = 0; i < 4; ++i) { v[i] = *(const f32x4*)(xin + (size_t)row * D + (lane + 64 * i) * 4); ss += v[i][0] * v[i][0] + v[i][1] * v[i][1] + v[i][2] * v[i][2] + v[i][3] * v[i][3]; }
                ss = wave_sum(ss); const float r = rsqrtf(ss * (1.0f / D) + EPS);
#pragma unroll
                for (int i = 0; i < 4; ++i) { const int c = (lane + 64 * i) * 4;
                    const f32x4 w4 = *(const f32x4*)(nw + c), sc4 = *(const f32x4*)(mod + (size_t)b * NMOD + D + c), sh4 = *(const f32x4*)(mod + (size_t)b * NMOD + c);
                    const f32x4 hv = v[i] * r * w4 * (1.0f + sc4) + sh4;
                    *(unsigned long long*)(H + (size_t)row * D + c) = (unsigned long long)pg8::cvt_pk_bf16(hv[0], hv[1]) | ((unsigned long long)pg8::cvt_pk_bf16(hv[2], hv[3]) << 32); }
            }
        }
        if (l == 0) SEAM(P + 0);
        if (IN(P + 1)) for (int prep_ = 0; prep_ < probe_reps(1); ++prep_) {
            WS_OPAQUE();
            pg8::Gemm g{H, WIN + (size_t)l * ZLD * D, T, ZLD, D}; pg8::StaticOrder S; S.init(T, ZLD, G, (int)blockIdx.x);
            pg8::EpiZ E{ZB, ZLD};
            pg8::gemm_phase(lds3, tid, g, S, E);
        }
        SEAM(P + 1);
        if (IN(P + 2)) for (int prep_ = 0; prep_ < probe_reps(2); ++prep_) {
            WS_OPAQUE();
            {
                for (int wt = blockIdx.x * NWAVES + wave; wt < (T / 64) * 8; wt += G * NWAVES) {
                    const int rg = wt >> 3, dg = wt & 7; const int row = rg * 64 + lane, bb = row >> 11, sidx = row & 2047;
                    const u32x4 w = *(const u32x4*)(ZB + (size_t)row * ZLD + C_VB + dg * 8);
                    bf16_t* vp = VBT + ((size_t)bb * 64 + dg * 8) * SEQ + sidx;
                    vp[0] = (bf16_t)(w.x & 0xffffu); vp[SEQ] = (bf16_t)(w.x >> 16); vp[2 * SEQ] = (bf16_t)(w.y & 0xffffu); vp[3 * SEQ] = (bf16_t)(w.y >> 16);
                    vp[4 * SEQ] = (bf16_t)(w.z & 0xffffu); vp[5 * SEQ] = (bf16_t)(w.z >> 16); vp[6 * SEQ] = (bf16_t)(w.w & 0xffffu); vp[7 * SEQ] = (bf16_t)(w.w >> 16);
                }
            }
            {
                unsigned* sc = (unsigned*)lds; bf16_t* iring = (bf16_t*)(sc + 16 * 2048);
                int* tk = (int*)(lds + LDS_BYTES - 64);
                const float* hnw = args.in[I_HNW] + (size_t)l * 512;
                for (;;) {
                    __syncthreads();
                    if (tid == 0) *tk = (int)atomicAdd(&ctl[CW_Q + l], 1u);
                    __syncthreads();
                    const int ticket = *tk;
                    if (ticket >= NB * 4 + T / 16) break;
                    int tid_q = threadIdx.x; asm volatile("" : "+v"(tid_q));
                    if (ticket < NB * 4) { hgrn_item(ZB, LB + l * 512, hnw, HA, lds, ticket >> 2, ticket & 3, tid_q); continue; }
                    const int u = ticket - NB * 4; const int b = u & 15, q16 = 127 - (u >> 4), t0 = q16 * 16;
                    if (t0 < 256) {
                        for (int i = tid_q; i < 16 * 64; i += NTHREADS) { const int qq = i >> 6, w = i & 63, n = t0 + qq + 1, lo_ = w * 32;
                            unsigned mm = 0u; if (n >= lo_ + 32) mm = 0xffffffffu; else if (n > lo_) mm = (1u << (n - lo_)) - 1u; MASK[(size_t)(b * SEQ + t0 + qq) * 64 + w] = mm; }
                    } else indexer_unit(ZB, MASK, sc, iring, b, t0, tid_q);
                }
                __syncthreads();
            }
        }
        SEAM(P + 2);
        if (IN(P + 3)) for (int prep_ = 0; prep_ < probe_reps(3); ++prep_) {
            WS_OPAQUE();
            {
                float* tb = (float*)lds;
                __syncthreads();
                for (int i = tid; i < 1024; i += NTHREADS) tb[i] = 1.4426950408889634f * args.in[I_RELB][(int)T5_BUCKET[i >> 3] * 8 + (i & 7)];
                __syncthreads();
                for (int u = blockIdx.x; u < T / 32; u += G) {
                    const int cc = u & 255, j = u >> 8; const int b = cc & 15, x = cc >> 4, pr = x + 16 * (j >> 1); const int qt = (j & 1) ? 63 - pr : pr;
                    attn_block(ZB, VBT, MASK, HA, tb, (bf16_t*)(tb + 1024), b, qt, tid);
                }
                __syncthreads();
            }
        }
        SEAM(P + 3);
        if (IN(P + 4)) for (int prep_ = 0; prep_ < probe_reps(4); ++prep_) {
            WS_OPAQUE();
            pg8::StaticOrder S; S.init(T, D, G, (int)blockIdx.x);
            pg8::Gemm g{HA, WPA + (size_t)l * D * D, T, D, D}; pg8::EpiMergeF E{MERGED, ZB + C_GTA, ZB + C_GTB}; pg8::gemm_phase(lds3, tid, g, S, E);
        }
        SEAM(P + 4);
        if (IN(P + 5)) for (int prep_ = 0; prep_ < probe_reps(5); ++prep_) {
            WS_OPAQUE();
            pg8::Gemm g{MERGED, WOUT + (size_t)l * D * D, T, D, D}; pg8::StaticOrder S; S.init(T, D, G, (int)blockIdx.x);
            pg8::EpiOutG E{xin, X1, mod + 2 * D}; pg8::gemm_phase(lds3, tid, g, S, E);
        }
        SEAM(P + 5);
        if (IN(P + 6)) for (int prep_ = 0; prep_ < probe_reps(6); ++prep_) {
            WS_OPAQUE();
            const float* nw = args.in[I_NFW] + (size_t)l * D; const float* wr = args.in[I_WR] + (size_t)l * D * NE; const float* br = args.in[I_BR] + (size_t)l * NE;
            float* wl = (float*)lds; unsigned* cntl = (unsigned*)(wl + D * NE);
            __syncthreads();
            for (int i = tid; i < D * 8; i += NTHREADS) { const int k = i >> 3, q = i & 7; *(f32x4*)(wl + k * NE + 4 * (q ^ ((k >> 1) & 7))) = *(const f32x4*)(wr + (size_t)k * NE + 4 * q); }
            if (tid < NE) cntl[tid] = 0u;
            __syncthreads();
            const int sw = (lane >> 1) & 7;
            const int ex = lane >> 1;
            const float brv = br[ex];
            for (int grp = blockIdx.x * NWAVES + wave; grp < T / 16; grp += G * NWAVES) {
                const int tok0 = grp * 16, b = tok0 >> 11;
                float ca[16], cb[16];
#pragma unroll
                for (int i = 0; i < 16; ++i) { const int k = lane + 64 * i; ca[i] = nw[k] * (1.0f + mod[(size_t)b * NMOD + 4 * D + k]); cb[i] = mod[(size_t)b * NMOD + 3 * D + k]; }
                for (int j = 0; j < 16; ++j) {
                    const int tok = tok0 + j;
                    float x[16]; float ss = 0.f;
#pragma unroll
                    for (int i = 0; i < 16; ++i) { x[i] = X1[(size_t)tok * D + lane + 64 * i]; ss += x[i] * x[i]; }
                    ss = wave_sum(ss); const float r = rsqrtf(ss * (1.0f / D) + EPS);
                    float acc[32];
#pragma unroll
                    for (int q = 0; q < 32; ++q) acc[q] = 0.f;
#pragma unroll
                    for (int i = 0; i < 16; ++i) {
                        const float hk = x[i] * r * ca[i] + cb[i];
                        H[(size_t)tok * D + lane + 64 * i] = f2bf(hk);
                        const float* wrow = wl + (lane + 64 * i) * NE;
#pragma unroll
                        for (int q = 0; q < 8; ++q) { const f32x4 w4 = *(const f32x4*)(wrow + 4 * (q ^ sw)); acc[4 * q] += hk * w4[0]; acc[4 * q + 1] += hk * w4[1]; acc[4 * q + 2] += hk * w4[2]; acc[4 * q + 3] += hk * w4[3]; }
                    }
                    float a16[16], a8[8], a4[4], a2[2], a1;
                    { const bool up = (lane & 32) != 0;
#pragma unroll
                      for (int q = 0; q < 16; ++q) { const float snd = up ? acc[q] : acc[16 + q], kp = up ? acc[16 + q] : acc[q]; a16[q] = kp + __shfl_xor(snd, 32); } }
                    { const bool up = (lane & 16) != 0;
#pragma unroll
                      for (int q = 0; q < 8; ++q) { const float snd = up ? a16[q] : a16[8 + q], kp = up ? a16[8 + q] : a16[q]; a8[q] = kp + __shfl_xor(snd, 16); } }
                    { const bool up = (lane & 8) != 0;
#pragma unroll
                      for (int q = 0; q < 4; ++q) { const float snd = up ? a8[q] : a8[4 + q], kp = up ? a8[4 + q] : a8[q]; a4[q] = kp + __shfl_xor(snd, 8); } }
                    { const bool up = (lane & 4) != 0;
#pragma unroll
                      for (int q = 0; q < 2; ++q) { const float snd = up ? a4[q] : a4[2 + q], kp = up ? a4[2 + q] : a4[q]; a2[q] = kp + __shfl_xor(snd, 4); } }
                    { const bool up = (lane & 2) != 0; const float snd = up ? a2[0] : a2[1], kp = up ? a2[1] : a2[0]; a1 = kp + __shfl_xor(snd, 2); }
                    a1 += __shfl_xor(a1, 1);
                    float logit = a1 + brv;
                    float tv[4]; int ti[4];
#pragma unroll
                    for (int k = 0; k < 4; ++k) {
                        float bv = logit; int bi = ex;
#pragma unroll
                        for (int o = 32; o >= 2; o >>= 1) { const float ov = __shfl_xor(bv, o); const int oi = __shfl_xor(bi, o); if (ov > bv || (ov == bv && oi < bi)) { bv = ov; bi = oi; } }
                        tv[k] = bv; ti[k] = bi; if (ex == bi) logit = -INFINITY;
                    }
                    const float e1 = __expf(tv[1] - tv[0]), e2 = __expf(tv[2] - tv[0]), e3 = __expf(tv[3] - tv[0]); const float inv = 1.0f / (1.0f + e1 + e2 + e3);
                    if (lane < 4) { const int ee = lane == 0 ? ti[0] : lane == 1 ? ti[1] : lane == 2 ? ti[2] : ti[3]; const float gg = (lane == 0 ? 1.0f : lane == 1 ? e1 : lane == 2 ? e2 : e3) * inv;
                        TOKE[tok * 4 + lane] = ee; TOKG[tok * 4 + lane] = gg; TOKP[tok * 4 + lane] = (int)atomicAdd(&cntl[ee], 1u); }
                }
            }
            __syncthreads();
            if (tid < NE) BCNT[blockIdx.x * NE + tid] = (int)cntl[tid];
        }
        SEAM(P + 6);
        if (IN(P + 7)) for (int prep_ = 0; prep_ < probe_reps(7); ++prep_) {
            WS_OPAQUE();
            int* ps = (int*)lds; int* tot = ps + 64; int* basel = tot + 32; int* pall = basel + 32; int* pbef = pall + 16 * NE;
            __syncthreads();
            {
                const int e = tid & 31, pt = tid >> 5, per = (G + 15) / 16; int sa = 0, sb = 0;
                for (int bb = pt * per; bb < (pt + 1) * per && bb < G; ++bb) { const int c = BCNT[bb * NE + e]; sa += c; sb += bb < (int)blockIdx.x ? c : 0; }
                pall[pt * NE + e] = sa; pbef[pt * NE + e] = sb;
            }
            __syncthreads();
            if (tid < NE) { int sa = 0, sb = 0; for (int pt = 0; pt < 16; ++pt) { sa += pall[pt * NE + tid]; sb += pbef[pt * NE + tid]; } tot[tid] = sa; basel[tid] = sb; }
            __syncthreads();
            if (tid == 0) { int a = 0; for (int e = 0; e < NE; ++e) { ps[e] = a; a += ((tot[e] + 255) / 256) * 256; } ps[NE] = a; }
            __syncthreads();
            const int gt = blockIdx.x * NTHREADS + tid, gn = G * NTHREADS;
            for (int grp = blockIdx.x * NWAVES + wave; grp < T / 16; grp += G * NWAVES) {
                const int tok0 = grp * 16;
                const int e_l = TOKE[tok0 * 4 + lane]; const int slot_l = ps[e_l] + basel[e_l] + TOKP[tok0 * 4 + lane];
                TOKS[tok0 * 4 + lane] = slot_l;
#pragma unroll 4
                for (int j = 0; j < 16; ++j) {
                    const u32x4 r0 = *(const u32x4*)(H + (size_t)(tok0 + j) * D + lane * 8), r1 = *(const u32x4*)(H + (size_t)(tok0 + j) * D + 512 + lane * 8);
#pragma unroll
                    for (int k = 0; k < 4; ++k) { const int slot = __shfl(slot_l, 4 * j + k);
                        *(u32x4*)(XS + (size_t)slot * D + lane * 8) = r0; *(u32x4*)(XS + (size_t)slot * D + 512 + lane * 8) = r1; }
                }
            }
            for (int i = blockIdx.x * NWAVES + wave; i < NE * 256; i += G * NWAVES) {
                const int e = i >> 8, j = i & 255; const int c = tot[e]; const int si = c + j;
                if (si < ps[e + 1] - ps[e]) { const u32x4 z = {0u, 0u, 0u, 0u}; *(u32x4*)(XS + (size_t)(ps[e] + si) * D + lane * 8) = z; *(u32x4*)(XS + (size_t)(ps[e] + si) * D + 512 + lane * 8) = z; } }
            const int nblk = ps[NE] / 256, nblk8 = (nblk + 7) & ~7;
            for (int mb = gt; mb < nblk8; mb += gn) { int e = 0; if (mb < nblk) { while (e < NE - 1 && mb * 256 >= ps[e + 1]) ++e; } BLKE[mb] = e; }
            if (gt == 0) ctl[CW_NBLK + l] = (unsigned)nblk8;
            __syncthreads();
        }
        SEAM(P + 7);
        if (IN(P + 8)) for (int prep_ = 0; prep_ < probe_reps(8); ++prep_) {
            WS_OPAQUE();
            const int nblk = __builtin_amdgcn_readfirstlane((int)ctl[CW_NBLK + l]);
            pg8::Gemm g{XS, W1 + (size_t)l * NE * 2 * DFF * D, nblk * 256, 2 * DFF, D}; pg8::MoeOrder<8> S; S.init(nblk, G, (int)blockIdx.x, BLKE);
            pg8::EpiSwigluG E{ACT, args.in[I_B1] + (size_t)l * NE * 2 * DFF}; pg8::gemm_phase(lds3, tid, g, S, E);
        }
        SEAM(P + 8);
        if (IN(P + 9)) for (int prep_ = 0; prep_ < probe_reps(9); ++prep_) {
            WS_OPAQUE();
            const int nblk = __builtin_amdgcn_readfirstlane((int)ctl[CW_NBLK + l]);
            pg8::Gemm g{ACT, W2 + (size_t)l * NE * D * DFF, nblk * 256, D, DFF}; pg8::MoeOrder<4> S; S.init(nblk, G, (int)blockIdx.x, BLKE);
            pg8::EpiYG E{Y, args.in[I_B2] + (size_t)l * NE * D}; pg8::gemm_phase(lds3, tid, g, S, E);
        }
        SEAM(P + 9);
        if (IN(P + 10)) for (int prep_ = 0; prep_ < probe_reps(10); ++prep_) {
            WS_OPAQUE();
            const bool last = (l == DEPTH - 1);
            const float* nw = last ? args.in[I_FNW] : args.in[I_NMW] + (size_t)(l + 1) * D;
            const float* modn = MOD + (size_t)(l + 1) * NB * NMOD;
            for (int grp = blockIdx.x * NWAVES + wave; grp < T / 16; grp += G * NWAVES) {
                const int tok0 = grp * 16, b = tok0 >> 11;
                const int slot_l = TOKS[tok0 * 4 + lane]; const float g_l = TOKG[tok0 * 4 + lane];
#pragma unroll 2
                for (int j = 0; j < 16; ++j) {
                    const int tok = tok0 + j; f32x4 v[4], a[4];
#pragma unroll
                    for (int i = 0; i < 4; ++i) { v[i] = *(const f32x4*)(X1 + (size_t)tok * D + (lane + 64 * i) * 4); a[i] = (f32x4){0.f, 0.f, 0.f, 0.f}; }
#pragma unroll
                    for (int k = 0; k < 4; ++k) { const int slot = __shfl(slot_l, 4 * j + k); const float g = __shfl(g_l, 4 * j + k);
#pragma unroll
                        for (int i = 0; i < 4; ++i) { const unsigned* yp = (const unsigned*)(Y + (size_t)slot * D + (lane + 64 * i) * 4); const unsigned y0 = yp[0], y1 = yp[1];
                            f32x4 y; y[0] = __uint_as_float(y0 << 16); y[1] = __uint_as_float(y0 & 0xffff0000u); y[2] = __uint_as_float(y1 << 16); y[3] = __uint_as_float(y1 & 0xffff0000u); a[i] += g * y; } }
                    float ss = 0.f;
#pragma unroll
                    for (int i = 0; i < 4; ++i) { const int c = (lane + 64 * i) * 4; const f32x4 gf = *(const f32x4*)(mod + (size_t)b * NMOD + 5 * D + c); v[i] = v[i] + gf * a[i];
                        ss += v[i][0] * v[i][0] + v[i][1] * v[i][1] + v[i][2] * v[i][2] + v[i][3] * v[i][3]; }
                    ss = wave_sum(ss); const float r = rsqrtf(ss * (1.0f / D) + EPS);
#pragma unroll
                    for (int i = 0; i < 4; ++i) { const int c = (lane + 64 * i) * 4;
                        if (last) { const f32x4 w4 = *(const f32x4*)(nw + c);
                            *(f32x4*)(args.out + (size_t)tok * D + c) = v[i] * r * w4;
                        } else {
                            *(f32x4*)(X2 + (size_t)tok * D + c) = v[i];
                            const f32x4 w4 = *(const f32x4*)(nw + c), sc4 = *(const f32x4*)(modn + (size_t)b * NMOD + D + c), sh4 = *(const f32x4*)(modn + (size_t)b * NMOD + c);
                            const f32x4 hv = v[i] * r * w4 * (1.0f + sc4) + sh4;
                            *(unsigned long long*)(H + (size_t)tok * D + c) = (unsigned long long)pg8::cvt_pk_bf16(hv[0], hv[1]) | ((unsigned long long)pg8::cvt_pk_bf16(hv[2], hv[3]) << 32);
                        } }
                }
            }
        }
        SEAM(P + 10);
    }
#undef IN
}

constexpr int N_PHASES = 1 + 11 * DEPTH;
typedef void (*kern_t)(Args);
template <int K> static kern_t kern_of() { return fwd<K>; }
static kern_t kern_for(int kind) {
    switch (kind) { case 0: return fwd<0>; case 1: return fwd<1>; case 2: return fwd<2>; case 3: return fwd<3>; case 4: return fwd<4>; case 5: return fwd<5>;
                    case 6: return fwd<6>; case 7: return fwd<7>; case 8: return fwd<8>; case 9: return fwd<9>; case 10: return fwd<10>; default: return fwd<100>; }
}

extern "C" void kernel_launch(void* const* d_in, const int* in_sizes, int n_in, void* d_out, int out_size, void* d_ws, size_t ws_size, hipStream_t stream) {
    static int grid = 0;
    if (grid == 0) {
        if (n_in != 20 || out_size != T * D || ws_size < WS_END) { fprintf(stderr, "kernel_launch: unexpected problem (n_in %d, out %d, ws %zu, need %zu)\n", n_in, out_size, ws_size, (size_t)WS_END); grid = -1; return; }
        int dev = 0, cus = 0;
        if (hipGetDevice(&dev) != hipSuccess || hipDeviceGetAttribute(&cus, hipDeviceAttributeMultiprocessorCount, dev) != hipSuccess) { grid = -1; return; }
        for (int k = 0; k <= 12; ++k) {
            if (hipFuncSetAttribute((const void*)(k == 12 ? (kern_t)fwd<-1> : kern_for(k)), hipFuncAttributeMaxDynamicSharedMemorySize, LDS_BYTES) != hipSuccess) { fprintf(stderr, "kernel_launch: hipFuncSetAttribute failed\n"); grid = -1; return; }
        }
        grid = cus > 0 ? cus : 256;
    }
    if (grid < 0) return;
    (void)hipMemsetAsync((char*)d_ws + WS_CTL, 0, CTL_BYTES, stream);
    Args a{};
    for (int i = 0; i < 20; ++i) a.in[i] = (const float*)d_in[i];
    a.out = (float*)d_out; a.ws = (unsigned char*)d_ws;
#if defined(MULTI_LAUNCH)
    for (int p = 0; p < N_PHASES; ++p) {
        if (p == 1 + 11) continue;
        a.ph_lo = p; a.ph_hi = p + 1;
        const int kind = p == 0 ? 11 : (p - 1) % 11;
        hipLaunchKernelGGL(kern_for(kind), dim3(grid), dim3(NTHREADS), LDS_BYTES, stream, a);
    }
#else
    a.ph_lo = 0; a.ph_hi = N_PHASES;
    hipLaunchKernelGGL(fwd<-1>, dim3(grid), dim3(NTHREADS), LDS_BYTES, stream, a);
#endif
}
```

```cpp
#include <hip/hip_runtime.h>
#include <stdint.h>
#include <stdio.h>

typedef unsigned short bf16_t;
typedef short bf16x8 __attribute__((ext_vector_type(8)));
typedef float f32x4 __attribute__((ext_vector_type(4)));
typedef float f32x16 __attribute__((ext_vector_type(16)));
typedef unsigned u32x4 __attribute__((ext_vector_type(4)));
#define LAS __attribute__((address_space(3)))
#define GAS __attribute__((address_space(1)))

constexpr int T = 32768, D = 1024, NB = 16, SEQ = 2048, DEPTH = 2;
constexpr int ZC = 5320, ZLD = 5376;
constexpr int C_QA = 0, C_FA = 512, C_IA = 1024, C_GA = 1536, C_QB = 2048, C_KB = 2560, C_VB = 2624, C_IQ = 2688, C_IK = 3200, C_IW = 3264, C_GTA = 3272, C_GTB = 4296;
constexpr int NE = 32, DFF = 1024, NSLOT = 131072 + 32 * 256, NBLK_MAX = NSLOT / 256;
constexpr int NMOD = 6 * D;
constexpr float EPS = 1e-6f;
constexpr int NTHREADS = 512, NWAVES = 8;
#ifndef PROBE_GROUP
#define PROBE_GROUP 0
#endif
constexpr int probe_reps(int kind) { return (PROBE_GROUP == 1 && (kind == 1 || kind == 4 || kind == 5 || kind == 8 || kind == 9)) || (PROBE_GROUP == 2 && kind == 2) || (PROBE_GROUP == 3 && kind == 3) || (PROBE_GROUP == 4 && kind == 100) || (PROBE_GROUP == 5 && (kind == 6 || kind == 7 || kind == 10)) || (PROBE_GROUP == 9 && kind == 8) || (PROBE_GROUP == 10 && kind == 1) || (PROBE_GROUP == 11 && kind == 9) || (PROBE_GROUP == 12 && (kind == 4 || kind == 5)) || (PROBE_GROUP == 14 && kind == 4) || (PROBE_GROUP == 15 && kind == 5) ? 2 : 1; }
constexpr int LDS_BYTES = 160 * 1024;

constexpr size_t al256(size_t x) { return (x + 255) & ~(size_t)255; }
constexpr size_t WS_CTL = 0;
constexpr size_t CTL_BYTES = 65536;
constexpr size_t WS_MOD = WS_CTL + CTL_BYTES;
constexpr size_t WS_LB = WS_MOD + al256((size_t)DEPTH * NB * NMOD * 4);
constexpr size_t WS_WIN = WS_LB + al256((size_t)DEPTH * 512 * 4);
constexpr size_t WS_WPA = WS_WIN + (size_t)DEPTH * ZLD * D * 2;
constexpr size_t WS_WPB = WS_WPA + (size_t)DEPTH * D * 512 * 2;
constexpr size_t WS_WOUT = WS_WPB + (size_t)DEPTH * D * 512 * 2;
constexpr size_t WS_W1 = WS_WOUT + (size_t)DEPTH * D * D * 2;
constexpr size_t WS_W2 = WS_W1 + (size_t)DEPTH * NE * 2 * DFF * D * 2;
constexpr size_t WS_H = WS_W2 + (size_t)DEPTH * NE * D * DFF * 2;
constexpr size_t WS_Z = WS_H + (size_t)T * D * 2;
constexpr size_t WS_Y = WS_Z;
constexpr size_t WS_ACT = WS_Z + (size_t)T * ZLD * 2;
constexpr size_t WS_QEG = WS_ACT;
constexpr size_t WS_KEG = WS_QEG + (size_t)T * 512 * 2;
constexpr size_t WS_KETG = WS_KEG + (size_t)T * 512 * 2;
constexpr size_t WS_HVEC = WS_KETG + (size_t)T * 512 * 2;
constexpr size_t WS_XS = WS_ACT + (size_t)NSLOT * DFF * 2;
constexpr size_t WS_HA = WS_XS + (size_t)NSLOT * D * 2;
constexpr size_t WS_ATT = WS_HA + (size_t)T * 512 * 2;
constexpr size_t WS_MASK = WS_ATT + (size_t)T * 512 * 2;
constexpr size_t WS_VBT = WS_MASK + (size_t)T * 64 * 4;
constexpr size_t WS_MERGED = WS_VBT + (size_t)T * 64 * 2;
constexpr size_t WS_X1 = WS_MERGED + (size_t)T * D * 2;
constexpr size_t WS_X2 = WS_X1 + (size_t)T * D * 4;
constexpr size_t WS_TOKE = WS_X2 + (size_t)T * D * 4;
constexpr size_t WS_TOKG = WS_TOKE + (size_t)T * 4 * 4;
constexpr size_t WS_TOKP = WS_TOKG + (size_t)T * 4 * 4;
constexpr size_t WS_TOKS = WS_TOKP + (size_t)T * 4 * 4;
constexpr size_t WS_BLKE = WS_TOKS + (size_t)T * 4 * 4;
constexpr size_t WS_BCNT = WS_BLKE + al256((size_t)(NBLK_MAX + 64) * 4);
constexpr size_t WS_END = WS_BCNT + (size_t)1024 * NE * 4;
static_assert((size_t)NSLOT * D * 2 <= (size_t)T * ZLD * 2, "Y must fit in Z");
static_assert((size_t)T * 512 * 2 * 3 + (size_t)NB * 4 * 32 * 384 * 4 <= (size_t)NSLOT * DFF * 2, "HGRN2 gate tensors must fit in ACT");
static_assert(WS_END <= ((size_t)1 << 31), "workspace layout exceeds 2 GiB");
constexpr int CW_CNT = 1024;
constexpr int CW_NBLK = 1200;
constexpr int CW_Q = 1216;

__device__ __forceinline__ bf16_t f2bf(float f) { unsigned u = __float_as_uint(f); u += 0x7fffu + ((u >> 16) & 1u); return (bf16_t)(u >> 16); }
__device__ __forceinline__ float bf2f(bf16_t b) { return __uint_as_float(((unsigned)b) << 16); }
__device__ __forceinline__ float sigmoidf_(float x) { return __builtin_amdgcn_rcpf(1.0f + __builtin_amdgcn_exp2f(-1.4426950408889634f * x)); }
__device__ __forceinline__ float wave_sum(float v) {
#pragma unroll
    for (int o = 32; o >= 1; o >>= 1) v += __shfl_xor(v, o);
    return v;
}
__device__ __forceinline__ int wave_sum_i(int v) {
#pragma unroll
    for (int o = 32; o >= 1; o >>= 1) v += __shfl_xor(v, o);
    return v;
}
__device__ const unsigned char T5_BUCKET[128] = {
    0, 1, 2, 3, 4, 5, 6, 7, 8, 9, 10, 11, 12, 13, 14, 15, 16, 16, 16, 17, 17, 18, 18, 18, 19, 19, 19, 20, 20, 20, 20, 21, 21, 21, 21, 22, 22, 22, 22, 22, 23, 23, 23, 23, 23, 23, 24, 24, 24, 24, 24, 24, 25,
    25, 25, 25, 25, 25, 25, 26, 26, 26, 26, 26, 26, 26, 26, 27, 27, 27, 27, 27, 27, 27, 27, 27, 27, 28, 28, 28, 28, 28, 28, 28, 28, 28, 28, 29, 29, 29, 29, 29, 29, 29, 29, 29, 29, 29, 29, 30, 30, 30, 30, 30,
    30, 30, 30, 30, 30, 30, 30, 30, 30, 31, 31, 31, 31, 31, 31, 31, 31, 31, 31, 31, 31, 31, 31, 31};
__device__ __forceinline__ int t5_bucket(int rel) { return rel >= 128 ? 31 : (int)T5_BUCKET[rel]; }


#define XB_TMO      128
#define XB_XCNT(j)  (256  + 64 * (j))
#define XB_XSUB(j)  (1280 + 64 * (j))
#define XB_XGEN(j)  (2304 + 64 * (j))
#define XB_TOP      3328
#define XB_TOPGEN   3392
#define XCD_BAR_WORDS 3456
#define XB_SPIN_CAP (1u << 18)
__device__ __forceinline__ unsigned xb_ld(unsigned* p)              { return __hip_atomic_load(p, __ATOMIC_RELAXED, __HIP_MEMORY_SCOPE_AGENT); }
__device__ __forceinline__ unsigned xb_add(unsigned* p, unsigned v) { return __hip_atomic_fetch_add(p, v, __ATOMIC_RELAXED, __HIP_MEMORY_SCOPE_AGENT); }
__device__ __forceinline__ unsigned xb_xcc_id() { return (unsigned)__builtin_amdgcn_s_getreg((3 << 11) | 20) & 0xFu; }
#define XB_SPIN(cond, bar) do { unsigned _sp = 0; while (cond) { __builtin_amdgcn_s_sleep(1); \
    if ((++_sp & 255u) == 0u) { if (xb_ld(&(bar)[XB_TMO])) break; if (_sp > XB_SPIN_CAP) { atomicAdd(&(bar)[XB_TMO], 1u); break; } } } } while (0)
struct XcdBarrier { unsigned* bar; unsigned x; volatile LAS unsigned* st; };
__device__ __forceinline__ XcdBarrier xcd_barrier_post(unsigned* bar, volatile LAS unsigned* st) {
    XcdBarrier b; b.bar = bar; b.x = xb_xcc_id(); b.st = st;
    if (threadIdx.x == 0) (void)xb_add(&bar[XB_XCNT(b.x)], 1u);
    return b;
}
__device__ __forceinline__ void xcd_barrier_complete(unsigned* bar, unsigned x, unsigned& nloc, unsigned& nx) {
    const unsigned G = gridDim.x * gridDim.y * gridDim.z;
    unsigned sum, cnt, mine, sp = 0u;
    for (;;) {
        sum = 0u; cnt = 0u; mine = 0u;
#pragma unroll
        for (unsigned j = 0; j < 16; ++j) { const unsigned c = xb_ld(&bar[XB_XCNT(j)]); sum += c; cnt += (c > 0u) ? 1u : 0u; mine = (j == x) ? c : mine; }
        if (sum == G) break;
        __builtin_amdgcn_s_sleep(1);
        if ((++sp & 255u) == 0u) { if (xb_ld(&bar[XB_TMO])) break; if (sp > XB_SPIN_CAP) { atomicAdd(&bar[XB_TMO], 1u); break; } }
    }
    nloc = mine > 0u ? mine : 1u; nx = cnt > 0u ? cnt : 1u;
}
__device__ __forceinline__ void xcd_barrier(const XcdBarrier& b) {
    asm volatile("s_waitcnt vmcnt(0)" ::: "memory");
    __syncthreads();
    if (threadIdx.x == 0) {
        unsigned* bar = b.bar; asm volatile("" : "+s"(bar));
        __builtin_amdgcn_s_waitcnt(0);
        unsigned nloc = b.st[0], nx = b.st[1];
        if (nloc == 0u) { xcd_barrier_complete(bar, b.x, nloc, nx); b.st[0] = nloc; b.st[1] = nx; }
        const unsigned old = xb_add(&bar[XB_XSUB(b.x)], 1u);
        const unsigned gen = old / nloc;
        if (old + 1u == (gen + 1u) * nloc) {
            __builtin_amdgcn_fence(__ATOMIC_RELEASE, "agent");
            asm volatile("s_waitcnt vmcnt(0)" ::: "memory");
            const unsigned og = xb_add(&bar[XB_TOP], 1u);
            const unsigned tg = og / nx;
            if (og + 1u == (tg + 1u) * nx) xb_add(&bar[XB_TOPGEN], 1u);
            else XB_SPIN(xb_ld(&bar[XB_TOPGEN]) == tg, bar);
            __builtin_amdgcn_fence(__ATOMIC_ACQUIRE, "agent");
            xb_add(&bar[XB_XGEN(b.x)], 1u);
            asm volatile("s_waitcnt vmcnt(0)" ::: "memory");
        } else {
            XB_SPIN(xb_ld(&bar[XB_XGEN(b.x)]) == gen, bar);
            __builtin_amdgcn_fence(__ATOMIC_ACQUIRE, "agent");
            asm volatile("s_waitcnt vmcnt(0)" ::: "memory");
        }
    }
    __syncthreads();
}
constexpr int CW_BAR = 4096;

struct Args { const float* in[20]; float* out; unsigned char* ws; int ph_lo, ph_hi; };
enum { I_X = 0, I_C, I_WADA, I_BADA, I_NMW, I_WIN, I_LBL, I_HNW, I_RELB, I_WPA, I_WPB, I_WOUT, I_NFW, I_WR, I_BR, I_W1, I_B1, I_W2, I_B2, I_FNW };

namespace pg8 {
#define PG8_LAS __attribute__((address_space(3)))
constexpr int BM = 256, BK = 64, HALF = 128, HTB = HALF * BK * 2, STAGE_BYTES = 8 * HTB, NXCD = 8, WGM = 8;
__host__ __device__ __forceinline__ int lds_byte(int r, int c) { const int st = (r >> 4) * 2 + (c >> 5), rr = r & 15, cc = c & 31, ob = rr * 64 + cc * 2; return st * 1024 + (ob ^ (((ob >> 9) & 1) << 5)); }
__host__ __device__ __forceinline__ void stage_rc(int b, int& R, int& C) { const int st = b / 1024, sb = b % 1024, swz = sb ^ (((sb >> 9) & 1) << 5); R = (st >> 1) * 16 + swz / 64; C = (st & 1) * 32 + (swz % 64) / 2; }
__host__ __device__ __forceinline__ int perm32(int rho) { const int n = rho >> 4, i = rho & 15; return 8 * (i >> 2) + 4 * n + (i & 3); }
struct Unit { int pm, pn, brow, e; };
struct Gemm { const bf16_t* A; const bf16_t* Bt; int M, N, K; };
struct StaticOrder {
    int nM, nN, nwg, G, c;
    __device__ void init(int M, int N, int G_, int c_) { nM = M / BM; nN = N / BM; nwg = nM * nN; G = G_; c = c_; }
    __device__ bool next(int i, Unit& u) const {
        const long L = (long)i * G + c; if (L >= nwg) return false;
        int wgid = (int)L; { const int q = nwg / NXCD, r = nwg % NXCD, xcd = wgid % NXCD, off = wgid / NXCD; wgid = (xcd < r ? xcd * (q + 1) : r * (q + 1) + (xcd - r) * q) + off; }
        const int nig = WGM * nN, gid = wgid / nig, fm = gid * WGM, gsz = (nM - fm) < WGM ? (nM - fm) : WGM;
        u.pm = fm + ((wgid % nig) % gsz); u.pn = (wgid % nig) / gsz; u.brow = u.pn * BM; u.e = 0; return true;
    }
    __device__ __forceinline__ void a_ready(const Unit&) const {}
    __device__ __forceinline__ void done(const Unit&) const {}
};
template <int NN, bool GATH = false> struct MoeOrder {
    static constexpr bool GATHER = GATH;
    int nwg, G, c; const PG8_LAS int* blke; const int* rowtok;
    __device__ void init(int nM, int G_, int c_, const PG8_LAS int* blke_, const int* rowtok_ = nullptr) { nwg = nM * NN; G = G_; c = c_; blke = blke_; rowtok = rowtok_; }
    __device__ bool next(int i, Unit& u) const {
        const int L = i * G + c; if (L >= nwg) return false;
        const int wgid = (L & 7) * (nwg >> 3) + (L >> 3);
        const int gid = wgid / (8 * NN), rem = wgid % (8 * NN);
        u.pm = gid * 8 + (rem & 7); u.pn = rem >> 3; u.e = __builtin_amdgcn_readfirstlane(blke[u.pm]); u.brow = u.e * (NN * BM) + u.pn * BM; return true;
    }
    __device__ __forceinline__ void a_ready(const Unit&) const {}
    __device__ __forceinline__ void done(const Unit&) const {}
};
typedef __bf16 bf16x2v_t __attribute__((ext_vector_type(2)));
typedef float f32x2v_t __attribute__((ext_vector_type(2)));
__device__ __forceinline__ unsigned cvt_pk_bf16(float lo, float hi) { const f32x2v_t v = {lo, hi}; const bf16x2v_t r = __builtin_convertvector(v, bf16x2v_t); return __builtin_bit_cast(unsigned, r); }


struct EpiZ {
    static constexpr bool PERM = true, AFTER_DRAIN = false;
    bf16_t* C; int ldc;
    __device__ __forceinline__ void operator()(const f32x4 (&acc)[2][2][4][2], const Unit& u, int wr, int wc, int fr, int fq) const {
        const int row0 = u.pm * BM + wr * 64 + fr, col0 = u.pn * BM + wc * 32 + 8 * fq;
#pragma unroll
        for (int ai = 0; ai < 2; ++ai)
#pragma unroll
            for (int m = 0; m < 4; ++m) { bf16_t* rowp = C + (size_t)(row0 + ai * HALF + m * 16) * ldc + col0;
#pragma unroll
                for (int bj = 0; bj < 2; ++bj) { const f32x4 v0 = acc[ai][bj][m][0], v1 = acc[ai][bj][m][1];
                    u32x4 w; w.x = cvt_pk_bf16(v0[0], v0[1]); w.y = cvt_pk_bf16(v0[2], v0[3]); w.z = cvt_pk_bf16(v1[0], v1[1]); w.w = cvt_pk_bf16(v1[2], v1[3]);
                    *(u32x4*)(rowp + bj * HALF) = w; } }
    }
};
__device__ __forceinline__ void bf8_to_f32(const u32x4 w, f32x4& lo, f32x4& hi) {
    lo[0] = __uint_as_float(w.x << 16); lo[1] = __uint_as_float(w.x & 0xffff0000u); lo[2] = __uint_as_float(w.y << 16); lo[3] = __uint_as_float(w.y & 0xffff0000u);
    hi[0] = __uint_as_float(w.z << 16); hi[1] = __uint_as_float(w.z & 0xffff0000u); hi[2] = __uint_as_float(w.w << 16); hi[3] = __uint_as_float(w.w & 0xffff0000u);
}
__device__ __forceinline__ f32x4 sig4(f32x4 g) { f32x4 r; r[0] = sigmoidf_(g[0]); r[1] = sigmoidf_(g[1]); r[2] = sigmoidf_(g[2]); r[3] = sigmoidf_(g[3]); return r; }
struct EpiMergeF {
    static constexpr bool PERM = true, AFTER_DRAIN = false, MIDK = true;
    bf16_t* merged; const bf16_t* Zga; const bf16_t* Zgb;
    __device__ __forceinline__ void mid(f32x4 (&acc)[2][2][4][2], const Unit& u, int wr, int wc, int fr, int fq) const {
        int row0 = u.pm * BM + wr * 64 + fr, col0 = u.pn * BM + wc * 32 + 8 * fq;
        asm volatile("" : "+v"(row0), "+v"(col0));
#pragma unroll
        for (int ai = 0; ai < 2; ++ai)
#pragma unroll
            for (int mp = 0; mp < 2; ++mp) {
                u32x4 ga[2][2], gb[2][2];
#pragma unroll
                for (int mi = 0; mi < 2; ++mi)
#pragma unroll
                    for (int bj = 0; bj < 2; ++bj) { const size_t row = (size_t)(row0 + ai * HALF + (2 * mp + mi) * 16); const int col = col0 + bj * HALF;
                        ga[mi][bj] = *(const u32x4*)(Zga + row * ZLD + col); gb[mi][bj] = *(const u32x4*)(Zgb + row * ZLD + col); }
#pragma unroll
                for (int mi = 0; mi < 2; ++mi)
#pragma unroll
                    for (int bj = 0; bj < 2; ++bj) { const int m = 2 * mp + mi;
                        f32x4 a0, a1, b0, b1; bf8_to_f32(ga[mi][bj], a0, a1); bf8_to_f32(gb[mi][bj], b0, b1);
#pragma unroll
                        for (int j = 0; j < 4; ++j) {
                            acc[ai][bj][m][0][j] *= (1.0f + __builtin_amdgcn_exp2f(-1.4426950408889634f * b0[j])) * __builtin_amdgcn_rcpf(1.0f + __builtin_amdgcn_exp2f(-1.4426950408889634f * a0[j]));
                            acc[ai][bj][m][1][j] *= (1.0f + __builtin_amdgcn_exp2f(-1.4426950408889634f * b1[j])) * __builtin_amdgcn_rcpf(1.0f + __builtin_amdgcn_exp2f(-1.4426950408889634f * a1[j])); } }
                asm volatile("" : "+v"(acc[ai][0][2 * mp][0]), "+v"(acc[ai][0][2 * mp][1]), "+v"(acc[ai][1][2 * mp][0]), "+v"(acc[ai][1][2 * mp][1]),
                                  "+v"(acc[ai][0][2 * mp + 1][0]), "+v"(acc[ai][0][2 * mp + 1][1]), "+v"(acc[ai][1][2 * mp + 1][0]), "+v"(acc[ai][1][2 * mp + 1][1]) :: "memory");
            }
    }
    __device__ __forceinline__ void operator()(const f32x4 (&acc)[2][2][4][2], const Unit& u, int wr, int wc, int fr, int fq) const {
        int row0 = u.pm * BM + wr * 64 + fr, col0 = u.pn * BM + wc * 32 + 8 * fq;
        asm volatile("" : "+v"(row0), "+v"(col0));
#pragma unroll
        for (int ai = 0; ai < 2; ++ai) {
            u32x4 gb[4][2];
#pragma unroll
            for (int m = 0; m < 4; ++m)
#pragma unroll
                for (int bj = 0; bj < 2; ++bj) gb[m][bj] = *(const u32x4*)(Zgb + (size_t)(row0 + ai * HALF + m * 16) * ZLD + col0 + bj * HALF);
#pragma unroll
            for (int m = 0; m < 4; ++m)
#pragma unroll
                for (int bj = 0; bj < 2; ++bj) {
                    f32x4 g0, g1; bf8_to_f32(gb[m][bj], g0, g1); g0 = sig4(g0); g1 = sig4(g1);
                    const f32x4 v0 = g0 * acc[ai][bj][m][0], v1 = g1 * acc[ai][bj][m][1];
                    u32x4 w; w.x = cvt_pk_bf16(v0[0], v0[1]); w.y = cvt_pk_bf16(v0[2], v0[3]); w.z = cvt_pk_bf16(v1[0], v1[1]); w.w = cvt_pk_bf16(v1[2], v1[3]);
                    *(u32x4*)(merged + (size_t)(row0 + ai * HALF + m * 16) * D + col0 + bj * HALF) = w; }
        }
    }
};
struct EpiOutG {
    static constexpr bool PERM = true, AFTER_DRAIN = false;
    const bf16_t* xin; bf16_t* x1; const float* gate  ;
    __device__ __forceinline__ void operator()(const f32x4 (&acc)[2][2][4][2], const Unit& u, int wr, int wc, int fr, int fq) const {
        const int row0 = u.pm * BM + wr * 64 + fr, col0 = u.pn * BM + wc * 32 + 8 * fq; const int b = (u.pm * BM) >> 11;
        f32x4 gv[2][2];
#pragma unroll
        for (int bj = 0; bj < 2; ++bj)
#pragma unroll
            for (int n = 0; n < 2; ++n) gv[bj][n] = *(const f32x4*)(gate + (size_t)b * NMOD + col0 + bj * HALF + 4 * n);
#pragma unroll
        for (int ai = 0; ai < 2; ++ai) {
            u32x4 xv[4][2];
#pragma unroll
            for (int m = 0; m < 4; ++m)
#pragma unroll
                for (int bj = 0; bj < 2; ++bj) xv[m][bj] = *(const u32x4*)(xin + (size_t)(row0 + ai * HALF + m * 16) * D + col0 + bj * HALF);
#pragma unroll
            for (int m = 0; m < 4; ++m)
#pragma unroll
                for (int bj = 0; bj < 2; ++bj) {
                    f32x4 x0, x1f; bf8_to_f32(xv[m][bj], x0, x1f);
                    const f32x4 v0 = x0 + gv[bj][0] * acc[ai][bj][m][0], v1 = x1f + gv[bj][1] * acc[ai][bj][m][1];
                    u32x4 w; w.x = cvt_pk_bf16(v0[0], v0[1]); w.y = cvt_pk_bf16(v0[2], v0[3]); w.z = cvt_pk_bf16(v1[0], v1[1]); w.w = cvt_pk_bf16(v1[2], v1[3]);
                    *(u32x4*)(x1 + (size_t)(row0 + ai * HALF + m * 16) * D + col0 + bj * HALF) = w; }
        }
    }
};
struct EpiSwigluG {
    static constexpr bool PERM = true, AFTER_DRAIN = false;
    bf16_t* act; const float* b1  ;
    __device__ __forceinline__ void operator()(const f32x4 (&acc)[2][2][4][2], const Unit& u, int wr, int wc, int fr, int fq) const {
        typedef float f32x2 __attribute__((ext_vector_type(2)));
        const int row0 = u.pm * BM + wr * 64 + fr, col0 = u.pn * HALF + wc * 32 + 8 * fq;
        f32x2 bg[2][2], bl[2][2];
#pragma unroll
        for (int n = 0; n < 2; ++n) { const f32x4 g4 = *(const f32x4*)(b1 + (size_t)u.e * 2 * DFF + col0 + 4 * n), l4 = *(const f32x4*)(b1 + (size_t)u.e * 2 * DFF + DFF + col0 + 4 * n);
            bg[n][0] = (f32x2){g4[0], g4[1]}; bg[n][1] = (f32x2){g4[2], g4[3]}; bl[n][0] = (f32x2){l4[0] + 1.0f, l4[1] + 1.0f}; bl[n][1] = (f32x2){l4[2] + 1.0f, l4[3] + 1.0f}; }
#pragma unroll
        for (int ai = 0; ai < 2; ++ai)
#pragma unroll
            for (int m = 0; m < 4; ++m) { unsigned o[4];
#pragma unroll
                for (int n = 0; n < 2; ++n)
#pragma unroll
                    for (int h = 0; h < 2; ++h) {
                        f32x2 g = (f32x2){acc[ai][0][m][n][2 * h], acc[ai][0][m][n][2 * h + 1]} + bg[n][h];
                        f32x2 l = (f32x2){acc[ai][1][m][n][2 * h], acc[ai][1][m][n][2 * h + 1]} + bl[n][h];
                        g = (f32x2){fminf(g[0], 7.0f), fminf(g[1], 7.0f)};
                        l = (f32x2){__builtin_amdgcn_fmed3f(l[0], -6.0f, 8.0f), __builtin_amdgcn_fmed3f(l[1], -6.0f, 8.0f)};
                        const f32x2 t = g * (-1.702f * 1.4426950408889634f);
                        const f32x2 d = (f32x2){__builtin_amdgcn_exp2f(t[0]), __builtin_amdgcn_exp2f(t[1])} + 1.0f;
                        const f32x2 r = (f32x2){__builtin_amdgcn_rcpf(d[0]), __builtin_amdgcn_rcpf(d[1])};
                        const f32x2 ov = g * r * l;
                        o[2 * n + h] = cvt_pk_bf16(ov[0], ov[1]); }
                u32x4 w; w.x = o[0]; w.y = o[1]; w.z = o[2]; w.w = o[3];
                *(u32x4*)(act + (size_t)(row0 + ai * HALF + m * 16) * DFF + col0) = w; }
    }
};
struct EpiYG {
    static constexpr bool PERM = true, AFTER_DRAIN = false;
    bf16_t* Yb; const float* b2  ;
    __device__ __forceinline__ void operator()(const f32x4 (&acc)[2][2][4][2], const Unit& u, int wr, int wc, int fr, int fq) const {
        const int row0 = u.pm * BM + wr * 64 + fr, col0 = u.pn * BM + wc * 32 + 8 * fq;
        f32x4 bv[2][2];
#pragma unroll
        for (int bj = 0; bj < 2; ++bj)
#pragma unroll
            for (int n = 0; n < 2; ++n) bv[bj][n] = *(const f32x4*)(b2 + (size_t)u.e * D + col0 + bj * HALF + 4 * n);
#pragma unroll
        for (int ai = 0; ai < 2; ++ai)
#pragma unroll
            for (int m = 0; m < 4; ++m) { bf16_t* rowp = Yb + (size_t)(row0 + ai * HALF + m * 16) * D + col0;
#pragma unroll
                for (int bj = 0; bj < 2; ++bj) { const f32x4 v0 = acc[ai][bj][m][0] + bv[bj][0], v1 = acc[ai][bj][m][1] + bv[bj][1];
                    u32x4 w; w.x = cvt_pk_bf16(v0[0], v0[1]); w.y = cvt_pk_bf16(v0[2], v0[3]); w.z = cvt_pk_bf16(v1[0], v1[1]); w.w = cvt_pk_bf16(v1[2], v1[3]);
                    *(u32x4*)(rowp + bj * HALF) = w; } }
    }
};

template <class E, class = void> struct has_midk { static constexpr bool value = false; };
template <class E> struct has_midk<E, decltype((void)E::MIDK)> { static constexpr bool value = E::MIDK; };
template <class S_, class = void> struct sched_gather { static constexpr bool value = false; };
template <class S_> struct sched_gather<S_, decltype((void)S_::GATHER)> { static constexpr bool value = S_::GATHER; };
template <class Epi, class Sched>
__device__ __forceinline__ void gemm_phase(PG8_LAS unsigned char* lds, const int tid, const Gemm g, const Sched& S, const Epi& E) {
    const int wid = __builtin_amdgcn_readfirstlane(tid >> 6), lane = tid & 63, wr = wid >> 2, wc = wid & 3, fr = lane & 15, fq = lane >> 4;
    const int K = g.K, nt = K / BK;
    unsigned voffA[2], voffB[2]; int gR[2], gC[2];
#pragma unroll
    for (int i = 0; i < 2; ++i) { int R, C; stage_rc(tid * 16 + i * 8192, R, C); const int Rb = Epi::PERM ? ((R & ~31) + perm32(R & 31)) : R;
        voffA[i] = (unsigned)(R * K + C) * 2u; voffB[i] = (unsigned)(Rb * K + C) * 2u; gR[i] = R; gC[i] = C; }
    const size_t kstep = (size_t)(BK * 2);
    const size_t hstep = (size_t)HALF * K * 2;
    const size_t tstep = 2 * hstep;
    const unsigned ldsw = (unsigned)wid * 1024u;
    const int aoff = lds_byte(wr * 64 + fr, fq * 8), boff = lds_byte(wc * 32 + fr, fq * 8);
#define PG8_SA(b, h) (((b) * 2 + (h)) * HTB)
#define PG8_SB(b, h) ((4 + (b) * 2 + (h)) * HTB)
#define PG8_STAGE(bufoff, gbase, voff) do { _Pragma("unroll") for (int _i = 0; _i < 2; ++_i) \
        __builtin_amdgcn_global_load_lds((const unsigned*)((const char*)(gbase) + (voff)[_i]), (PG8_LAS unsigned*)(lds + (bufoff) + ldsw + _i * 8192), 16, 0, 0); } while (0)
#define PG8_LDA(dst, b, h) do { _Pragma("unroll") for (int m = 0; m < 4; ++m) _Pragma("unroll") for (int k = 0; k < 2; ++k) dst[m][k] = *(const PG8_LAS bf16x8*)(lds + PG8_SA(b, h) + aoff + m * 2048 + k * 1024); } while (0)
#define PG8_LDB(dst, b, h) do { _Pragma("unroll") for (int n = 0; n < 2; ++n) _Pragma("unroll") for (int k = 0; k < 2; ++k) dst[n][k] = *(const PG8_LAS bf16x8*)(lds + PG8_SB(b, h) + boff + n * 2048 + k * 1024); } while (0)
#define PG8_MMA(ai, bj, At, Bt) do { __builtin_amdgcn_s_setprio(1); _Pragma("unroll") for (int m = 0; m < 4; ++m) _Pragma("unroll") for (int n = 0; n < 2; ++n) _Pragma("unroll") for (int k = 0; k < 2; ++k) \
        acc[ai][bj][m][n] = __builtin_amdgcn_mfma_f32_16x16x32_bf16(Bt[n][k], At[m][k], acc[ai][bj][m][n], 0, 0, 0); __builtin_amdgcn_s_setprio(0); } while (0)
#define PG8_WAIT_V(n) asm volatile("s_waitcnt vmcnt(" #n ")" ::: "memory")
#define PG8_WAIT_L(n) asm volatile("s_waitcnt lgkmcnt(" #n ")" ::: "memory")
#define PG8_BAR __builtin_amdgcn_s_barrier()
#define PG8_SCHED __builtin_amdgcn_sched_barrier(0)
    Unit cur, nxt; int ui = 0;
    if (!S.next(0, cur)) return;
    f32x4 acc[2][2][4][2];
#pragma unroll
    for (int a = 0; a < 2; ++a)
#pragma unroll
        for (int b = 0; b < 2; ++b)
#pragma unroll
            for (int m = 0; m < 4; ++m)
#pragma unroll
                for (int n = 0; n < 2; ++n) acc[a][b][m][n] = (f32x4){0.f, 0.f, 0.f, 0.f};
    bf16x8 At[4][2], B0[2][2], B1[2][2];
    unsigned vC0[2], vC1[2], vN0[2], vN1[2];
    if constexpr (sched_gather<Sched>::value) {
#pragma unroll
        for (int i = 0; i < 2; ++i) { vC0[i] = ((unsigned)S.rowtok[cur.pm * BM + gR[i]] * (unsigned)K + (unsigned)gC[i]) * 2u; vC1[i] = ((unsigned)S.rowtok[cur.pm * BM + HALF + gR[i]] * (unsigned)K + (unsigned)gC[i]) * 2u; vN0[i] = vC0[i]; vN1[i] = vC1[i]; }
    } else {
#pragma unroll
        for (int i = 0; i < 2; ++i) { vC0[i] = voffA[i]; vC1[i] = voffA[i] + (unsigned)hstep; vN0[i] = vC0[i]; vN1[i] = vC1[i]; }
    }
    const char* cA = sched_gather<Sched>::value ? (const char*)g.A : (const char*)g.A + (size_t)cur.pm * tstep; const char* cB = (const char*)g.Bt + (size_t)cur.brow * K * 2;
    S.a_ready(cur);
    PG8_STAGE(PG8_SB(0, 0), cB, voffB); PG8_STAGE(PG8_SA(0, 0), cA, vC0); PG8_STAGE(PG8_SB(0, 1), cB + hstep, voffB); PG8_STAGE(PG8_SA(0, 1), cA, vC1);
    if (wr == 1) PG8_BAR;
    PG8_WAIT_V(4); PG8_BAR;
    PG8_STAGE(PG8_SB(1, 0), cB + kstep, voffB); PG8_STAGE(PG8_SA(1, 0), cA + kstep, vC0); PG8_STAGE(PG8_SB(1, 1), cB + hstep + kstep, voffB);
    PG8_WAIT_V(6); PG8_BAR;
    for (;;) {
        const bool has_next = S.next(ui + 1, nxt);
        const char* nA = sched_gather<Sched>::value ? cA : (has_next ? (const char*)g.A + (size_t)nxt.pm * tstep : cA); const char* nB = has_next ? (const char*)g.Bt + (size_t)nxt.brow * K * 2 : cB;
        PG8_LAS int* const tokb = (PG8_LAS int*)(lds + STAGE_BYTES + 4096) + ((ui + 1) & 1) * BM;
        if constexpr (sched_gather<Sched>::value) { if (has_next && wid == 0)
            __builtin_amdgcn_global_load_lds((const unsigned*)(S.rowtok + nxt.pm * BM + lane * 4), (PG8_LAS unsigned*)tokb, 16, 0, 0); }
        for (int t = 0; t < nt; t += 2) {
            if constexpr (has_midk<Epi>::value) { if (t == nt / 2) E.mid(acc, cur, wr, wc, fr, fq); }
            const bool last = (t == nt - 2);
            const char* a1 = cA + (size_t)(t + 1) * kstep;
            const char* a2 = last ? nA : cA + (size_t)(t + 2) * kstep; const char* b2 = last ? nB : cB + (size_t)(t + 2) * kstep;
            const char* a3 = a2 + kstep; const char* b3 = b2 + kstep;
            unsigned w0[2], w1[2];
#pragma unroll
            for (int i = 0; i < 2; ++i) { w0[i] = vC0[i]; w1[i] = vC1[i]; }
            if constexpr (sched_gather<Sched>::value) { if (last && has_next) {
#pragma unroll
                for (int i = 0; i < 2; ++i) { vN0[i] = ((unsigned)tokb[gR[i]] * (unsigned)K + (unsigned)gC[i]) * 2u; vN1[i] = ((unsigned)tokb[HALF + gR[i]] * (unsigned)K + (unsigned)gC[i]) * 2u; w0[i] = vN0[i]; w1[i] = vN1[i]; } } }
            if (last && has_next) S.a_ready(nxt);
            PG8_LDB(B0, 0, 0); PG8_SCHED; PG8_LDA(At, 0, 0); PG8_STAGE(PG8_SA(1, 1), a1, vC1);
            PG8_WAIT_L(8); PG8_BAR; PG8_WAIT_L(0); PG8_MMA(0, 0, At, B0); PG8_BAR; PG8_SCHED;
            PG8_LDB(B1, 0, 1); PG8_STAGE(PG8_SB(0, 0), b2, voffB);
            PG8_BAR; PG8_WAIT_L(0); PG8_MMA(0, 1, At, B1); PG8_BAR;
            PG8_LDA(At, 0, 1); PG8_STAGE(PG8_SA(0, 0), a2, w0);
            PG8_BAR; PG8_WAIT_L(0); PG8_MMA(1, 0, At, B0); PG8_BAR; PG8_SCHED;
            PG8_STAGE(PG8_SB(0, 1), b2 + hstep, voffB);
            PG8_WAIT_V(6); PG8_BAR; PG8_MMA(1, 1, At, B1); PG8_BAR;
            PG8_LDB(B0, 1, 0); PG8_SCHED; PG8_LDA(At, 1, 0); PG8_STAGE(PG8_SA(0, 1), a2, w1);
            PG8_WAIT_L(8); PG8_BAR; PG8_WAIT_L(0); PG8_MMA(0, 0, At, B0); PG8_BAR; PG8_SCHED;
            PG8_LDB(B1, 1, 1); PG8_STAGE(PG8_SB(1, 0), b3, voffB);
            PG8_BAR; PG8_WAIT_L(0); PG8_MMA(0, 1, At, B1); PG8_BAR;
            PG8_LDA(At, 1, 1); PG8_STAGE(PG8_SA(1, 0), a3, w0);
            PG8_BAR; PG8_WAIT_L(0); PG8_MMA(1, 0, At, B0); PG8_BAR; PG8_SCHED;
            PG8_STAGE(PG8_SB(1, 1), b3 + hstep, voffB);
            PG8_WAIT_V(6); PG8_BAR; PG8_MMA(1, 1, At, B1); PG8_BAR;
        }
        if constexpr (!Epi::AFTER_DRAIN) { E(acc, cur, wr, wc, fr, fq); S.done(cur); }
        if (!has_next) break;
#pragma unroll
        for (int a = 0; a < 2; ++a)
#pragma unroll
            for (int b = 0; b < 2; ++b)
#pragma unroll
                for (int m = 0; m < 4; ++m)
#pragma unroll
                    for (int n = 0; n < 2; ++n) acc[a][b][m][n] = (f32x4){0.f, 0.f, 0.f, 0.f};
        cur = nxt; cA = nA; cB = nB; ++ui;
#pragma unroll
        for (int i = 0; i < 2; ++i) { vC0[i] = vN0[i]; vC1[i] = vN1[i]; }
    }
    PG8_WAIT_V(0);
    if (wr == 0) PG8_BAR;
    PG8_BAR;
    if constexpr (Epi::AFTER_DRAIN) { E.fused(acc, cur, wr, wc, fr, fq, lds, wid, lane); S.done(cur); }
#undef PG8_SA
#undef PG8_SB
#undef PG8_STAGE
#undef PG8_LDA
#undef PG8_LDB
#undef PG8_MMA
#undef PG8_WAIT_V
#undef PG8_WAIT_L
#undef PG8_BAR
#undef PG8_SCHED
}
}


struct CvtJob { const float* src; bf16_t* dst; int N  , K  , nvalid  , sc0, sc1  ; };
constexpr int CJ_WIN = DEPTH * 16 * 21, CJ_WPA = DEPTH * 8 * 4, CJ_WPB = CJ_WPA, CJ_WOUT = DEPTH * 16 * 4, CJ_W1 = DEPTH * NE * 16 * 8, CJ_W2 = DEPTH * NE * 16 * 4;
constexpr int CJ_TOTAL = CJ_WIN + CJ_WPA + CJ_WPB + CJ_WOUT + CJ_W1 + CJ_W2;
__device__ __forceinline__ CvtJob cvt_job(int J, const float* const* in, unsigned char* ws) {
    CvtJob j;
    if (J < CJ_WIN) { const int m = J / (16 * 21), r = J % (16 * 21), kt = r / 21, ns = r % 21;
        j.src = in[I_WIN] + (size_t)m * D * ZC + (size_t)kt * 64 * ZC; j.dst = (bf16_t*)(ws + WS_WIN) + (size_t)m * ZLD * D + (size_t)ns * 256 * D + kt * 64; j.N = ZC; j.K = D;
        j.nvalid = ZC - ns * 256 < 256 ? ZC - ns * 256 : 256; j.sc0 = ns * 256; j.sc1 = ns * 256 + 128; return j; }
    J -= CJ_WIN;
    if (J < CJ_WPA + CJ_WPB) { const int which = J / CJ_WPA, JJ = J % CJ_WPA; const int m = JJ / 32, r = JJ % 32, kt = r / 4, ns = r % 4;
        j.src = in[which ? I_WPB : I_WPA] + (size_t)m * 512 * D + (size_t)kt * 64 * D; j.dst = (bf16_t*)(ws + WS_WPA) + (size_t)m * D * D + (size_t)ns * 256 * D + which * 512 + kt * 64; j.N = D; j.K = D;
        j.nvalid = 256; j.sc0 = ns * 256; j.sc1 = ns * 256 + 128; return j; }
    J -= CJ_WPA + CJ_WPB;
    if (J < CJ_WOUT) { const int m = J / 64, r = J % 64, kt = r / 4, ns = r % 4;
        j.src = in[I_WOUT] + (size_t)m * D * D + (size_t)kt * 64 * D; j.dst = (bf16_t*)(ws + WS_WOUT) + (size_t)m * D * D + (size_t)ns * 256 * D + kt * 64; j.N = D; j.K = D;
        j.nvalid = 256; j.sc0 = ns * 256; j.sc1 = ns * 256 + 128; return j; }
    J -= CJ_WOUT;
    if (J < CJ_W1) { const int m = J / 128, r = J % 128, kt = r / 8, ns = r % 8;
        j.src = in[I_W1] + (size_t)m * D * 2 * DFF + (size_t)kt * 64 * 2 * DFF; j.dst = (bf16_t*)(ws + WS_W1) + (size_t)m * 2 * DFF * D + (size_t)ns * 256 * D + kt * 64; j.N = 2 * DFF; j.K = D;
        j.nvalid = 256; j.sc0 = 128 * ns; j.sc1 = DFF + 128 * ns; return j; }
    J -= CJ_W1;
    { const int m = J / 64, r = J % 64, kt = r / 4, ns = r % 4;
        j.src = in[I_W2] + (size_t)m * DFF * D + (size_t)kt * 64 * D; j.dst = (bf16_t*)(ws + WS_W2) + (size_t)m * D * DFF + (size_t)ns * 256 * DFF + kt * 64; j.N = D; j.K = DFF;
        j.nvalid = 256; j.sc0 = ns * 256; j.sc1 = ns * 256 + 128; return j; }
}
__device__ __forceinline__ void cvt_load(const CvtJob& j, const int tid, f32x4 (&v)[8]) {
    const int i = tid >> 3, c0 = (tid & 7) * 32; const float* p = j.src + (size_t)i * j.N + (c0 < 128 ? j.sc0 + c0 : j.sc1 + c0 - 128);
#pragma unroll
    for (int q = 0; q < 8; ++q) v[q] = (c0 + 4 * q < j.nvalid) ? *(const f32x4*)(p + 4 * q) : (f32x4){0.f, 0.f, 0.f, 0.f};
}

constexpr int CJ_LAYER = CJ_TOTAL / DEPTH;
constexpr int CW_BGQ = 1300;
__device__ __forceinline__ int layer_job(const int layer, int j) {
    constexpr int H_WIN = CJ_WIN / DEPTH, H_WPA = CJ_WPA / DEPTH, H_WOUT = CJ_WOUT / DEPTH, H_W1 = CJ_W1 / DEPTH, H_W2 = CJ_W2 / DEPTH;
    if (j < H_WIN) return layer * H_WIN + j; j -= H_WIN;
    if (j < H_WPA) return CJ_WIN + layer * H_WPA + j; j -= H_WPA;
    if (j < H_WPA) return CJ_WIN + CJ_WPA + layer * H_WPA + j; j -= H_WPA;
    if (j < H_WOUT) return CJ_WIN + CJ_WPA + CJ_WPB + layer * H_WOUT + j; j -= H_WOUT;
    if (j < H_W1) return CJ_WIN + CJ_WPA + CJ_WPB + CJ_WOUT + layer * H_W1 + j; j -= H_W1;
    return CJ_WIN + CJ_WPA + CJ_WPB + CJ_WOUT + CJ_W1 + layer * H_W2 + j;
}
__device__ __forceinline__ void bg_convert(unsigned char* ldsb, const int tid_in, const bool use_stop, unsigned stop_off, const unsigned stop_val, const int layer) {
    int tid = tid_in; asm volatile("" : "+v"(tid));
    typedef __attribute__((address_space(4))) const unsigned long long* kaptr_t;
    kaptr_t ka = (kaptr_t)__builtin_amdgcn_kernarg_segment_ptr(); asm volatile("" : "+s"(ka));
    const float* const* in = (const float* const*)ka;
    unsigned char* ws = (unsigned char*)ka[21];
    unsigned* q = (unsigned*)(ws + WS_CTL) + CW_BGQ; unsigned* stop = use_stop ? (unsigned*)(ws + WS_CTL) + stop_off : nullptr;
    bf16_t* lt = (bf16_t*)ldsb;
    volatile int* tk = (volatile int*)(ldsb + LDS_BYTES - 64);
    f32x4 v[8];
    __syncthreads();
    if (tid == 0) { int t = -1; if (!stop || __hip_atomic_load(stop, __ATOMIC_RELAXED, __HIP_MEMORY_SCOPE_AGENT) == stop_val) { t = (int)atomicAdd(q, 1u); if (t >= CJ_LAYER) t = -1; } *tk = t; }
    __syncthreads();
    int J = __builtin_amdgcn_readfirstlane(*tk);
    CvtJob cur = cvt_job(layer_job(layer, J < 0 ? 0 : J), in, ws);
    if (J >= 0) cvt_load(cur, tid, v);
    while (J >= 0) {
        {
            const int i = tid >> 3, c0 = (tid & 7) * 32;
#pragma unroll
            for (int qq = 0; qq < 8; qq += 2) { u32x4 w; w.x = pg8::cvt_pk_bf16(v[qq][0], v[qq][1]); w.y = pg8::cvt_pk_bf16(v[qq][2], v[qq][3]); w.z = pg8::cvt_pk_bf16(v[qq + 1][0], v[qq + 1][1]); w.w = pg8::cvt_pk_bf16(v[qq + 1][2], v[qq + 1][3]);
                *(u32x4*)(lt + i * 264 + c0 + 4 * qq) = w; }
        }
        if (tid == 0) { int t = -1; if (!stop || __hip_atomic_load(stop, __ATOMIC_RELAXED, __HIP_MEMORY_SCOPE_AGENT) == stop_val) { t = (int)atomicAdd(q, 1u); if (t >= CJ_LAYER) t = -1; } *tk = t; }
        __syncthreads();
        const CvtJob me = cur; const int Jn = __builtin_amdgcn_readfirstlane(*tk);
        if (Jn >= 0) { cur = cvt_job(layer_job(layer, Jn), in, ws); cvt_load(cur, tid, v); }
        {
            const int n = tid & 255, kh = tid >> 8;
            unsigned w[16];
#pragma unroll
            for (int qq = 0; qq < 16; ++qq) w[qq] = (unsigned)lt[(kh * 32 + 2 * qq) * 264 + n] | ((unsigned)lt[(kh * 32 + 2 * qq + 1) * 264 + n] << 16);
            bf16_t* dp = me.dst + (size_t)n * me.K + kh * 32;
#pragma unroll
            for (int qq = 0; qq < 4; ++qq) { u32x4 o; o.x = w[4 * qq]; o.y = w[4 * qq + 1]; o.z = w[4 * qq + 2]; o.w = w[4 * qq + 3]; *(u32x4*)(dp + 8 * qq) = o; }
        }
        __syncthreads();
        J = Jn;
    }
}

__device__ __forceinline__ void hgrn_prep_item(const bf16_t* __restrict__ zb, const float* __restrict__ lbv, bf16_t* __restrict__ qeg, bf16_t* __restrict__ keg, bf16_t* __restrict__ ketg, float* __restrict__ hvec,
                                               float* ex  , const int b, const int h, const int c, const int tid) {
    const int lane = tid & 63, wave = __builtin_amdgcn_readfirstlane(tid >> 6);
    const int tg = wave >> 1, d = (wave & 1) * 64 + lane;
    const float lb = lbv[h * 128 + d], oml = 1.0f - lb;
    const int row0 = b * SEQ + c * 64 + 16 * tg;
    const bf16_t* fbase = zb + (size_t)row0 * ZLD + C_FA + h * 128;
    const bf16_t* qbase = zb + (size_t)row0 * ZLD + C_QA + h * 128;
    float g[16], kk[16], qv[16]; float run = 0.f;
#pragma unroll
    for (int j = 0; j < 16; ++j) {
        const float zf = fminf(fmaxf(bf2f((fbase + (size_t)j * ZLD)[d]), -60.f), 60.f), zq = bf2f((qbase + (size_t)j * ZLD)[d]);
        const float e = __builtin_amdgcn_exp2f(-1.4426950408889634f * zf), sg = __builtin_amdgcn_rcpf(1.0f + e);
        run += 0.6931471805599453f * __builtin_amdgcn_logf(lb + oml * sg); g[j] = run; kk[j] = oml * e * sg; qv[j] = zq * sigmoidf_(zq);
    }
    __syncthreads();
    ex[tg * 128 + d] = run;
    __syncthreads();
    const float e0 = ex[d], e1 = ex[128 + d], e2 = ex[256 + d], e3 = ex[384 + d];
    const float pre = tg == 0 ? 0.f : tg == 1 ? e0 : tg == 2 ? e0 + e1 : e0 + e1 + e2;
    const float r = e0 + e1, tot = (e0 + e1) + (e2 + e3);
    unsigned kt[8];
    bf16_t* qo = qeg + (size_t)row0 * 512 + h * 128 + d; bf16_t* ko = keg + (size_t)row0 * 512 + h * 128 + d;
#pragma unroll
    for (int j = 0; j < 16; j += 2) {
        const float bt0 = pre + g[j], bt1 = pre + g[j + 1];
        const float L2E = 1.4426950408889634f;
        const float qe0 = qv[j] * __builtin_amdgcn_exp2f(L2E * fminf(bt0 - r, 80.f)), qe1 = qv[j + 1] * __builtin_amdgcn_exp2f(L2E * fminf(bt1 - r, 80.f));
        const float ke0 = kk[j] * __builtin_amdgcn_exp2f(L2E * fminf(r - bt0, 80.f)), ke1 = kk[j + 1] * __builtin_amdgcn_exp2f(L2E * fminf(r - bt1, 80.f));
        const unsigned qp = pg8::cvt_pk_bf16(qe0, qe1), kp = pg8::cvt_pk_bf16(ke0, ke1);
        qo[(size_t)j * 512] = (bf16_t)(qp & 0xffffu); qo[(size_t)(j + 1) * 512] = (bf16_t)(qp >> 16);
        ko[(size_t)j * 512] = (bf16_t)(kp & 0xffffu); ko[(size_t)(j + 1) * 512] = (bf16_t)(kp >> 16);
        kt[j >> 1] = kp;
    }
    const size_t item = ((size_t)(b * 4 + h) * 32 + c);
    u32x4 w0, w1; w0.x = kt[0]; w0.y = kt[1]; w0.z = kt[2]; w0.w = kt[3]; w1.x = kt[4]; w1.y = kt[5]; w1.z = kt[6]; w1.w = kt[7];
    bf16_t* kto = ketg + item * (128 * 64) + d * 64 + 16 * tg;
    *(u32x4*)kto = w0; *(u32x4*)(kto + 8) = w1;
    if (tg == 0) { float* hv = hvec + item * 384; hv[d] = __expf(r); hv[128 + d] = __expf(tot); hv[256 + d] = __expf(tot - r); }
}

__device__ __forceinline__ void hgrn_item(const bf16_t* __restrict__ zb, const bf16_t* __restrict__ qeg, const bf16_t* __restrict__ keg, const bf16_t* __restrict__ ketg, const float* __restrict__ hvec,
                                          const float* __restrict__ hnw, bf16_t* __restrict__ ha, unsigned char* ldsb, const int b, const int h, const int tid) {
    typedef unsigned long long u64;
    const int lane = tid & 63, wave = __builtin_amdgcn_readfirstlane(tid >> 6), r31 = lane & 31, hh = lane >> 5;
    bf16_t* QE = (bf16_t*)ldsb;
    bf16_t* KE = QE + 64 * 136;
    bf16_t* KET = KE + 64 * 136;
    bf16_t* VT = KET + 128 * 72;
    bf16_t* SBT = VT + 128 * 72;
    float* er = (float*)(SBT + 128 * 136); float* el = er + 128; float* elr = el + 128;
    float* ssq = elr + 128;
    const int lt = tid >> 3, lp = tid & 7, kd = tid >> 2, kp = tid & 3;
    const bf16_t* gq = qeg + (size_t)(b * SEQ + lt) * 512 + h * 128 + lp * 8;
    const bf16_t* gk = keg + (size_t)(b * SEQ + lt) * 512 + h * 128 + lp * 8;
    const bf16_t* gt = ketg + (size_t)(b * 4 + h) * 32 * (128 * 64) + kd * 64 + kp * 8;
    const float* gv = hvec + (size_t)(b * 4 + h) * 32 * 384;
    const int v0 = wave * 16;
    const bf16_t* vbase = zb + (size_t)(b * SEQ) * ZLD + C_IA + h * 128 + v0;
    const unsigned voff = (unsigned)lane * ZLD;
    u32x4 nq0, nq1, nk0, nk1, nt0, nt1, nv0, nv1; f32x4 nvec = {0.f, 0.f, 0.f, 0.f};
    nq0 = *(const u32x4*)gq; nq1 = *(const u32x4*)(gq + 64); nk0 = *(const u32x4*)gk; nk1 = *(const u32x4*)(gk + 64); nt0 = *(const u32x4*)gt; nt1 = *(const u32x4*)(gt + 32);
    nv0 = *(const u32x4*)(vbase + voff); nv1 = *(const u32x4*)(vbase + voff + 8);
    if (tid < 96) nvec = *(const f32x4*)(gv + tid * 4);
    const int tt = wave & 1, oq = wave >> 1, dq = wave & 3, sv = wave >> 2;
    f32x4 hw4[4];
#pragma unroll
    for (int g4 = 0; g4 < 4; ++g4) hw4[g4] = *(const f32x4*)(hnw + h * 128 + 32 * oq + 4 * hh + 8 * g4);
    f32x16 S0, S1;
#pragma unroll
    for (int i = 0; i < 16; ++i) { S0[i] = 0.f; S1[i] = 0.f; }
    for (int c = 0; c < SEQ / 64; ++c) {
        const int row0 = b * SEQ + c * 64;
        *(u32x4*)(QE + lt * 136 + lp * 8) = nq0; *(u32x4*)(QE + lt * 136 + 64 + lp * 8) = nq1;
        *(u32x4*)(KE + lt * 136 + lp * 8) = nk0; *(u32x4*)(KE + lt * 136 + 64 + lp * 8) = nk1;
        *(u32x4*)(KET + kd * 72 + kp * 8) = nt0; *(u32x4*)(KET + kd * 72 + 32 + kp * 8) = nt1;
        if (tid < 96) *(f32x4*)(er + tid * 4) = nvec;
        { const unsigned vw[8] = {nv0.x, nv0.y, nv0.z, nv0.w, nv1.x, nv1.y, nv1.z, nv1.w};
#pragma unroll
          for (int q = 0; q < 8; ++q) { VT[(v0 + 2 * q) * 72 + lane] = (bf16_t)(vw[q] & 0xffffu); VT[(v0 + 2 * q + 1) * 72 + lane] = (bf16_t)(vw[q] >> 16); } }
        __syncthreads();
        u64 gw[4];
        {
            const bf16_t* gp = zb + (size_t)(row0 + 32 * tt + r31) * ZLD + C_GA + h * 128 + 32 * oq + 4 * hh;
#pragma unroll
            for (int g4 = 0; g4 < 4; ++g4) gw[g4] = *(const u64*)(gp + 8 * g4);
        }
        if (c + 1 < SEQ / 64) {
            const size_t ro = (size_t)(c + 1) * 64 * 512;
            nq0 = *(const u32x4*)(gq + ro); nq1 = *(const u32x4*)(gq + ro + 64); nk0 = *(const u32x4*)(gk + ro); nk1 = *(const u32x4*)(gk + ro + 64);
            nt0 = *(const u32x4*)(gt + (size_t)(c + 1) * (128 * 64)); nt1 = *(const u32x4*)(gt + (size_t)(c + 1) * (128 * 64) + 32);
            nv0 = *(const u32x4*)(vbase + (size_t)(c + 1) * 64 * ZLD + voff); nv1 = *(const u32x4*)(vbase + (size_t)(c + 1) * 64 * ZLD + voff + 8);
            if (tid < 96) nvec = *(const f32x4*)(gv + (size_t)(c + 1) * 384 + tid * 4);
        }
#pragma unroll
        for (int ti = 0; ti < 2; ++ti) {
            const int vq = 2 * sv + ti;
#pragma unroll
            for (int g4 = 0; g4 < 4; ++g4) {
                const int dd = 32 * dq + 8 * g4 + 4 * hh;
                const float s0 = ti ? S1[4 * g4] : S0[4 * g4], s1 = ti ? S1[4 * g4 + 1] : S0[4 * g4 + 1], s2 = ti ? S1[4 * g4 + 2] : S0[4 * g4 + 2], s3 = ti ? S1[4 * g4 + 3] : S0[4 * g4 + 3];
                const unsigned a0 = pg8::cvt_pk_bf16(er[dd] * s0, er[dd + 1] * s1), a1 = pg8::cvt_pk_bf16(er[dd + 2] * s2, er[dd + 3] * s3);
                *(u64*)(SBT + (32 * vq + r31) * 136 + dd) = (u64)a0 | ((u64)a1 << 32);
            }
        }
        __syncthreads();
        f32x16 Oacc;
#pragma unroll
        for (int i = 0; i < 16; ++i) Oacc[i] = 0.f;
        {
            bf16x8 qf[8];
#pragma unroll
            for (int ks = 0; ks < 8; ++ks) qf[ks] = *(const bf16x8*)(QE + (32 * tt + r31) * 136 + 16 * ks + 8 * hh);
#pragma unroll
            for (int ks = 0; ks < 8; ++ks) { const bf16x8 sa = *(const bf16x8*)(SBT + (32 * oq + r31) * 136 + 16 * ks + 8 * hh); Oacc = __builtin_amdgcn_mfma_f32_32x32x16_bf16(sa, qf[ks], Oacc, 0, 0, 0); }
            for (int st = 0; st <= tt; ++st) {
                f32x16 At;
#pragma unroll
                for (int i = 0; i < 16; ++i) At[i] = 0.f;
#pragma unroll
                for (int ks = 0; ks < 8; ++ks) { const bf16x8 ka = *(const bf16x8*)(KE + (32 * st + r31) * 136 + 16 * ks + 8 * hh); At = __builtin_amdgcn_mfma_f32_32x32x16_bf16(ka, qf[ks], At, 0, 0, 0); }
                if (st == tt) {
#pragma unroll
                    for (int i = 0; i < 16; ++i) { const int sl = (i & 3) + 8 * (i >> 2) + 4 * hh; if (sl > r31) At[i] = 0.f; }
                }
                union { unsigned u[4]; bf16x8 v; } pb0, pb1;
#pragma unroll
                for (int j = 0; j < 4; ++j) { pb0.u[j] = pg8::cvt_pk_bf16(At[2 * j], At[2 * j + 1]); pb1.u[j] = pg8::cvt_pk_bf16(At[8 + 2 * j], At[8 + 2 * j + 1]); }
                union { u64 q[2]; bf16x8 v; } a0, a1;
                const bf16_t* vr = VT + (32 * oq + r31) * 72 + 32 * st + 4 * hh;
                a0.q[0] = *(const u64*)(vr); a0.q[1] = *(const u64*)(vr + 8); a1.q[0] = *(const u64*)(vr + 16); a1.q[1] = *(const u64*)(vr + 24);
                Oacc = __builtin_amdgcn_mfma_f32_32x32x16_bf16(a0.v, pb0.v, Oacc, 0, 0, 0);
                Oacc = __builtin_amdgcn_mfma_f32_32x32x16_bf16(a1.v, pb1.v, Oacc, 0, 0, 0);
            }
        }
        {
            float q2 = 0.f;
#pragma unroll
            for (int i = 0; i < 16; ++i) q2 += Oacc[i] * Oacc[i];
            q2 += __shfl_xor(q2, 32);
            if (hh == 0) ssq[(32 * tt + r31) * 4 + oq] = q2;
        }
        {
            f32x16 d0, d1;
#pragma unroll
            for (int i = 0; i < 16; ++i) { d0[i] = 0.f; d1[i] = 0.f; }
#pragma unroll
            for (int ks = 0; ks < 4; ++ks) {
                const bf16x8 ka = *(const bf16x8*)(KET + (32 * dq + r31) * 72 + 16 * ks + 8 * hh);
                const bf16x8 vb0 = *(const bf16x8*)(VT + (64 * sv + r31) * 72 + 16 * ks + 8 * hh), vb1 = *(const bf16x8*)(VT + (64 * sv + 32 + r31) * 72 + 16 * ks + 8 * hh);
                d0 = __builtin_amdgcn_mfma_f32_32x32x16_bf16(ka, vb0, d0, 0, 0, 0); d1 = __builtin_amdgcn_mfma_f32_32x32x16_bf16(ka, vb1, d1, 0, 0, 0);
            }
#pragma unroll
            for (int i = 0; i < 16; ++i) { const int dd = 32 * dq + (i & 3) + 8 * (i >> 2) + 4 * hh; const float a = el[dd], bb = elr[dd]; S0[i] = a * S0[i] + bb * d0[i]; S1[i] = a * S1[i] + bb * d1[i]; }
        }
        __syncthreads();
        {
            const int t = 32 * tt + r31;
            const f32x4 sq = *(const f32x4*)(ssq + t * 4);
            const float rn = rsqrtf(((sq[0] + sq[1]) + (sq[2] + sq[3])) * (1.0f / 128.0f) + EPS);
            const int vcol = h * 128 + 32 * oq + 4 * hh;
            bf16_t* op = ha + (size_t)(row0 + t) * D + vcol;
#pragma unroll
            for (int g4 = 0; g4 < 4; ++g4) {
                const f32x4 w4 = hw4[g4];
                float o[4];
#pragma unroll
                for (int j = 0; j < 4; ++j) { const float gg = bf2f((bf16_t)((gw[g4] >> (16 * j)) & 0xffffu)); o[j] = Oacc[4 * g4 + j] * rn * w4[j] * (gg * sigmoidf_(gg)); }
                *(u64*)(op + 8 * g4) = (u64)pg8::cvt_pk_bf16(o[0], o[1]) | ((u64)pg8::cvt_pk_bf16(o[2], o[3]) << 32);
            }
        }
    }
    __syncthreads();
}

#define DPP_STEP(v, op, ctrl) v = v op __builtin_amdgcn_update_dpp(v, v, ctrl, 0xf, 0xf, false)
__device__ __forceinline__ int wave_sum_dpp(int v) { DPP_STEP(v, +, 0xB1); DPP_STEP(v, +, 0x4E); DPP_STEP(v, +, 0x141); DPP_STEP(v, +, 0x140);
    return __builtin_amdgcn_readlane(v, 0) + __builtin_amdgcn_readlane(v, 16) + __builtin_amdgcn_readlane(v, 32) + __builtin_amdgcn_readlane(v, 48); }
__device__ __forceinline__ int wave_and_u(int v) { DPP_STEP(v, &, 0xB1); DPP_STEP(v, &, 0x4E); DPP_STEP(v, &, 0x141); DPP_STEP(v, &, 0x140);
    return __builtin_amdgcn_readlane(v, 0) & __builtin_amdgcn_readlane(v, 16) & __builtin_amdgcn_readlane(v, 32) & __builtin_amdgcn_readlane(v, 48); }
__device__ __forceinline__ int wave_or_u(int v) { DPP_STEP(v, |, 0xB1); DPP_STEP(v, |, 0x4E); DPP_STEP(v, |, 0x141); DPP_STEP(v, |, 0x140);
    return __builtin_amdgcn_readlane(v, 0) | __builtin_amdgcn_readlane(v, 16) | __builtin_amdgcn_readlane(v, 32) | __builtin_amdgcn_readlane(v, 48); }


#define CNT8(OP, cl, cand, k) do { unsigned long long m0_, m1_, m2_, m3_, m4_, m5_, m6_, m7_, dd_; \
    asm volatile("v_cmp_" OP "_u32_e64 %[m0], %[k0], %[c]\n\tv_cmp_" OP "_u32_e64 %[m1], %[k1], %[c]\n\tv_cmp_" OP "_u32_e64 %[m2], %[k2], %[c]\n\tv_cmp_" OP "_u32_e64 %[m3], %[k3], %[c]\n\t" \
                 "v_cmp_" OP "_u32_e64 %[m4], %[k4], %[c]\n\tv_cmp_" OP "_u32_e64 %[m5], %[k5], %[c]\n\tv_cmp_" OP "_u32_e64 %[m6], %[k6], %[c]\n\tv_cmp_" OP "_u32_e64 %[m7], %[k7], %[c]\n\t" \
                 "v_addc_co_u32_e64 %[a], %[dd], %[a], 0, %[m0]\n\tv_addc_co_u32_e64 %[a], %[dd], %[a], 0, %[m1]\n\tv_addc_co_u32_e64 %[a], %[dd], %[a], 0, %[m2]\n\tv_addc_co_u32_e64 %[a], %[dd], %[a], 0, %[m3]\n\t" \
                 "v_addc_co_u32_e64 %[a], %[dd], %[a], 0, %[m4]\n\tv_addc_co_u32_e64 %[a], %[dd], %[a], 0, %[m5]\n\tv_addc_co_u32_e64 %[a], %[dd], %[a], 0, %[m6]\n\tv_addc_co_u32_e64 %[a], %[dd], %[a], 0, %[m7]\n\t" \
                 : [a] "+v"(cl), [m0] "=&s"(m0_), [m1] "=&s"(m1_), [m2] "=&s"(m2_), [m3] "=&s"(m3_), [m4] "=&s"(m4_), [m5] "=&s"(m5_), [m6] "=&s"(m6_), [m7] "=&s"(m7_), [dd] "=&s"(dd_) \
                 : [k0] "v"((k)[0]), [k1] "v"((k)[1]), [k2] "v"((k)[2]), [k3] "v"((k)[3]), [k4] "v"((k)[4]), [k5] "v"((k)[5]), [k6] "v"((k)[6]), [k7] "v"((k)[7]), [c] "s"(cand)); } while (0)

#define SCNT8(OP, cnt, cand, k) do { unsigned long long m0_, m1_, m2_, m3_, m4_, m5_, m6_, m7_; int c0_, c1_, c2_, c3_, c4_, c5_, c6_, c7_; \
    asm volatile("v_cmp_" OP "_u32_e64 %[m0], %[k0], %[c]\n\tv_cmp_" OP "_u32_e64 %[m1], %[k1], %[c]\n\tv_cmp_" OP "_u32_e64 %[m2], %[k2], %[c]\n\tv_cmp_" OP "_u32_e64 %[m3], %[k3], %[c]\n\t" \
                 "v_cmp_" OP "_u32_e64 %[m4], %[k4], %[c]\n\tv_cmp_" OP "_u32_e64 %[m5], %[k5], %[c]\n\tv_cmp_" OP "_u32_e64 %[m6], %[k6], %[c]\n\tv_cmp_" OP "_u32_e64 %[m7], %[k7], %[c]\n\t" \
                 "s_bcnt1_i32_b64 %[c0], %[m0]\n\ts_bcnt1_i32_b64 %[c1], %[m1]\n\ts_bcnt1_i32_b64 %[c2], %[m2]\n\ts_bcnt1_i32_b64 %[c3], %[m3]\n\t" \
                 "s_bcnt1_i32_b64 %[c4], %[m4]\n\ts_bcnt1_i32_b64 %[c5], %[m5]\n\ts_bcnt1_i32_b64 %[c6], %[m6]\n\ts_bcnt1_i32_b64 %[c7], %[m7]\n\t" \
                 : [m0] "=&s"(m0_), [m1] "=&s"(m1_), [m2] "=&s"(m2_), [m3] "=&s"(m3_), [m4] "=&s"(m4_), [m5] "=&s"(m5_), [m6] "=&s"(m6_), [m7] "=&s"(m7_), \
                   [c0] "=&s"(c0_), [c1] "=&s"(c1_), [c2] "=&s"(c2_), [c3] "=&s"(c3_), [c4] "=&s"(c4_), [c5] "=&s"(c5_), [c6] "=&s"(c6_), [c7] "=&s"(c7_) \
                 : [k0] "v"((k)[0]), [k1] "v"((k)[1]), [k2] "v"((k)[2]), [k3] "v"((k)[3]), [k4] "v"((k)[4]), [k5] "v"((k)[5]), [k6] "v"((k)[6]), [k7] "v"((k)[7]), [c] "s"(cand) : "scc"); \
    cnt += ((c0_ + c1_) + (c2_ + c3_)) + ((c4_ + c5_) + (c6_ + c7_)); } while (0)

__device__ __forceinline__ unsigned ordered_key(float f) { const unsigned u = __float_as_uint(f); return (u & 0x80000000u) ? ~u : (u | 0x80000000u); }
__device__ __forceinline__ void indexer_unit(const bf16_t* __restrict__ zb, unsigned* __restrict__ maskp, unsigned* sc  , bf16_t* ring  ,
                                             const int b, const int t0, const int tid) {
    typedef unsigned long long u64;
    const int lane = tid & 63, wave = tid >> 6;
    const int r31 = lane & 31, hh = lane >> 5;
    constexpr int IDX_TILE = 32 * 72, IDX_SLOT = 2 * IDX_TILE;
    unsigned* hist = (unsigned*)ring + wave * 256;
    {
        const int g = wave & 3, par = wave >> 2;
        const int head = (r31 & 3) + 4 * ((r31 >> 3) & 1), ql = 2 * ((r31 >> 4) & 1) + ((r31 >> 2) & 1);
        const bf16_t* ap = zb + (size_t)(b * SEQ + t0 + 4 * g + ql) * ZLD + C_IQ + head * 64 + 8 * hh;
        bf16x8 a[4];
#pragma unroll
        for (int s4 = 0; s4 < 4; ++s4) a[s4] = *(const bf16x8*)(ap + 16 * s4);
        float wq[16];
        {
            const int qa = t0 + 4 * g + hh, qb = qa + 2;
            f32x4 w0, w1, w2, w3; pg8::bf8_to_f32(*(const u32x4*)(zb + (size_t)(b * SEQ + qa) * ZLD + C_IW), w0, w1); pg8::bf8_to_f32(*(const u32x4*)(zb + (size_t)(b * SEQ + qb) * ZLD + C_IW), w2, w3);
#pragma unroll
            for (int i = 0; i < 4; ++i) { wq[i] = w0[i] * 0.04419417382415922f; wq[4 + i] = w1[i] * 0.04419417382415922f; wq[8 + i] = w2[i] * 0.04419417382415922f; wq[12 + i] = w3[i] * 0.04419417382415922f; }
        }
        const int ta = t0 + 4 * g + hh, tb_ = ta + 2;
        const int kt_max = (t0 + 15) >> 5, nit = (kt_max >> 1) + 1;
        const int lsub = tid >> 8, lkey = (tid & 255) >> 3, lpc = tid & 7;
        const bf16_t* gsrc = zb + ((size_t)b * SEQ + lsub * 32 + lkey) * ZLD + C_IK + lpc * 8;
        const int loff = lsub * IDX_TILE + lkey * 72 + lpc * 8;
        u32x4 stg;
        __syncthreads();
        if (lsub <= kt_max) { stg = *(const u32x4*)gsrc; *(u32x4*)(ring + loff) = stg; }
        if (nit > 1 && 2 + lsub <= kt_max) { stg = *(const u32x4*)(gsrc + (size_t)64 * ZLD); *(u32x4*)(ring + IDX_SLOT + loff) = stg; }
        __syncthreads();
        for (int it = 0; it < nit; ++it) {
            const bool more = (it + 2 < nit) && (2 * (it + 2) + lsub <= kt_max);
            if (more) stg = *(const u32x4*)(gsrc + (size_t)(it + 2) * 64 * ZLD);
            const int kt = 2 * it + par;
            if (kt <= kt_max) {
                const bf16_t* tl = ring + (it % 3) * IDX_SLOT + par * IDX_TILE + r31 * 72 + 8 * hh;
                f32x16 acc;
#pragma unroll
                for (int q = 0; q < 16; ++q) acc[q] = 0.f;
#pragma unroll
                for (int s4 = 0; s4 < 4; ++s4) { const bf16x8 bk = *(const bf16x8*)(tl + 16 * s4); acc = __builtin_amdgcn_mfma_f32_32x32x16_bf16(a[s4], bk, acc, 0, 0, 0); }
                float sa = 0.f, sb = 0.f;
#pragma unroll
                for (int i = 0; i < 8; ++i) { sa += wq[i] * fmaxf(acc[i], 0.f); sb += wq[8 + i] * fmaxf(acc[8 + i], 0.f); }
                const int key = kt * 32 + r31;
                sc[(4 * g + hh) * 2048 + key] = key <= ta ? ordered_key(sa) : 0u;
                sc[(4 * g + 2 + hh) * 2048 + key] = key <= tb_ ? ordered_key(sb) : 0u;
            }
            if (more) *(u32x4*)(ring + ((it + 2) % 3) * IDX_SLOT + loff) = stg;
            __syncthreads();
        }
    }
    for (int srep_ = 0; srep_ < (PROBE_GROUP == 8 ? 2 : 1); ++srep_)
    for (int qq = 2 * wave; qq < 2 * wave + 2; ++qq) {
        const int t = t0 + qq;
        unsigned kreg[32];
#pragma unroll
        for (int i = 0; i < 32; ++i) kreg[i] = sc[qq * 2048 + lane + 64 * i];
        asm volatile("" ::: "memory");
#pragma unroll
        for (int i = 0; i < 32; ++i) kreg[i] = (lane + 64 * i <= t) ? kreg[i] : 0u;
        const int ngrp = __builtin_amdgcn_readfirstlane((t >> 9) + 1);
        unsigned kand = 0xffffffffu, kor = 0u;
#pragma unroll
        for (int i = 0; i < 32; ++i) { if (lane + 64 * i <= t) { kand &= kreg[i]; kor |= kreg[i]; } }
        kand = (unsigned)wave_and_u(kand); kor = (unsigned)wave_or_u(kor);
        const unsigned diff = kand ^ kor;
        unsigned prefix; int hb;
        if (diff == 0u) { prefix = kor; hb = -1; } else { hb = 31 - __builtin_clz(diff); prefix = (hb == 31) ? 0u : (kor & ~((2u << hb) - 1u)); }
        bool exact = false;
        for (int bit = hb; bit >= 0; --bit) {
            const unsigned cand = prefix | (1u << bit);
            int cnt = 0;
            SCNT8("ge", cnt, cand, kreg); if (ngrp > 1) SCNT8("ge", cnt, cand, kreg + 8); if (ngrp > 2) SCNT8("ge", cnt, cand, kreg + 16); if (ngrp > 3) SCNT8("ge", cnt, cand, kreg + 24);
            if (cnt >= 256) prefix = cand;
            if (cnt == 256) { exact = true; break; }
        }
        int kk = 0;
        if (!exact) { int cg = 0;
            SCNT8("gt", cg, prefix, kreg); if (ngrp > 1) SCNT8("gt", cg, prefix, kreg + 8); if (ngrp > 2) SCNT8("gt", cg, prefix, kreg + 16); if (ngrp > 3) SCNT8("gt", cg, prefix, kreg + 24);
            kk = 256 - cg; }
        const unsigned gtv = exact ? prefix - 1u : prefix;
        unsigned myword = 0u; int eqbefore = 0;
#pragma unroll
        for (int gi = 0; gi < 4; ++gi) {
            if (gi < ngrp) {
                if (exact) {
#pragma unroll
                    for (int i = 8 * gi; i < 8 * gi + 8; ++i) { const unsigned long long bs = __ballot(kreg[i] > gtv); if (lane == 2 * i) myword = (unsigned)bs; if (lane == 2 * i + 1) myword = (unsigned)(bs >> 32); }
                } else {
#pragma unroll
                    for (int i = 8 * gi; i < 8 * gi + 8; ++i) {
                        const bool eq = kreg[i] == prefix;
                        const unsigned long long beq = __ballot(eq);
                        const int rank = eqbefore + __popcll(beq & ((1ull << lane) - 1ull));
                        const bool sel = kreg[i] > gtv || (eq && rank < kk);
                        const unsigned long long bs = __ballot(sel);
                        eqbefore += __popcll(beq);
                        if (lane == 2 * i) myword = (unsigned)bs;
                        if (lane == 2 * i + 1) myword = (unsigned)(bs >> 32);
                    }
                }
            }
        }
        maskp[(size_t)(b * SEQ + t) * 64 + lane] = myword;
    }
    __syncthreads();
}

constexpr int ATT_KROW = 72, ATT_VROW = 68, ATT_SLOT = 64 * ATT_KROW + 64 * ATT_VROW;
__device__ __forceinline__ void attn_block(const bf16_t* __restrict__ zb, const bf16_t* __restrict__ vbt, const unsigned* __restrict__ maskp, bf16_t* __restrict__ att, const float* tb  ,
                                           bf16_t* ring  , const int b, const int qt, const int tid) {
    typedef unsigned long long u64;
    const int lane = tid & 63, wave = tid >> 6;
    const int c = lane & 31, hh = lane >> 5, h = c & 7;
    const int t0w = qt * 32 + 4 * wave;
    const int tq = t0w + (c >> 3);
    const size_t rowq = (size_t)b * SEQ + tq;
    bf16x8 bq[4];
#pragma unroll
    for (int s4 = 0; s4 < 4; ++s4) bq[s4] = *(const bf16x8*)(zb + rowq * ZLD + C_QB + h * 64 + 16 * s4 + 8 * hh);
    const int nstep = (qt >> 1) + 1;
    const float bfar = tb[127 * 8 + h];
    const float QS = 0.125f * 1.4426950408889634f;
    float m = -1e30f, lsum = 0.f;
    f32x16 O0, O1;
#pragma unroll
    for (int q = 0; q < 16; ++q) { O0[q] = 0.f; O1[q] = 0.f; }
    const u64* mbase = (const u64*)(maskp + rowq * 64);
    const int lrow = tid >> 3, lpc = tid & 7;
    const bf16_t* gk = zb + ((size_t)b * SEQ + lrow) * ZLD + C_KB + lpc * 8;
    const bf16_t* gv = vbt + ((size_t)b * 64 + lrow) * SEQ + lpc * 8;
    const int lk = lrow * ATT_KROW + lpc * 8, lv = 64 * ATT_KROW + lrow * ATT_VROW + lpc * 8;
    u32x4 sk = *(const u32x4*)gk, sv = *(const u32x4*)gv;
    { *(u32x4*)(ring + lk) = sk; u64* d = (u64*)(ring + lv); d[0] = (u64)sv.x | ((u64)sv.y << 32); d[1] = (u64)sv.z | ((u64)sv.w << 32); }
    if (nstep > 1) { sk = *(const u32x4*)(gk + (size_t)64 * ZLD); sv = *(const u32x4*)(gv + 64);
        *(u32x4*)(ring + ATT_SLOT + lk) = sk; u64* d = (u64*)(ring + ATT_SLOT + lv); d[0] = (u64)sv.x | ((u64)sv.y << 32); d[1] = (u64)sv.z | ((u64)sv.w << 32); }
    u64 mw2 = mbase[0];
    __syncthreads();
    for (int st = 0; st < nstep; ++st) {
        const int key0 = st * 64;
        const bf16_t* sl = ring + (st % 3) * ATT_SLOT;
        const bool more = st + 2 < nstep;
        if (more) { sk = *(const u32x4*)(gk + (size_t)(st + 2) * 64 * ZLD); sv = *(const u32x4*)(gv + (st + 2) * 64); }
        const unsigned cm0 = (unsigned)mw2 >> (4 * hh), cm1 = (unsigned)(mw2 >> 32) >> (4 * hh);
        mw2 = mbase[st + 1 < nstep ? st + 1 : st];
        f32x16 S0, S1;
#pragma unroll
        for (int q = 0; q < 16; ++q) { S0[q] = 0.f; S1[q] = 0.f; }
#pragma unroll
        for (int s4 = 0; s4 < 4; ++s4) {
            const bf16x8 k0 = *(const bf16x8*)(sl + c * ATT_KROW + 16 * s4 + 8 * hh), k1 = *(const bf16x8*)(sl + (32 + c) * ATT_KROW + 16 * s4 + 8 * hh);
            S0 = __builtin_amdgcn_mfma_f32_32x32x16_bf16(k0, bq[s4], S0, 0, 0, 0);
            S1 = __builtin_amdgcn_mfma_f32_32x32x16_bf16(k1, bq[s4], S1, 0, 0, 0);
        }
        float x0[16], x1[16]; float tmax = -1e30f;
        {
            float bs[16];
            if ((t0w - key0 - 31) < 113) {
                const int relb = tq - key0 - 4 * hh;
#pragma unroll
                for (int i = 0; i < 16; ++i) { int rel = relb - ((i & 3) + 8 * (i >> 2)); rel = rel < 0 ? 0 : (rel > 127 ? 127 : rel); bs[i] = tb[rel * 8 + h]; }
            } else {
#pragma unroll
                for (int i = 0; i < 16; ++i) bs[i] = bfar;
            }
#pragma unroll
            for (int i = 0; i < 16; ++i) { const int ko = (i & 3) + 8 * (i >> 2); const float xv = __builtin_fmaf(S0[i], QS, bs[i]); x0[i] = (cm0 & (1u << ko)) ? xv : -2e30f; tmax = fmaxf(tmax, x0[i]); }
        }
        {
            float bs[16];
            if ((t0w - key0 - 63) < 113) {
                const int relb = tq - key0 - 32 - 4 * hh;
#pragma unroll
                for (int i = 0; i < 16; ++i) { int rel = relb - ((i & 3) + 8 * (i >> 2)); rel = rel < 0 ? 0 : (rel > 127 ? 127 : rel); bs[i] = tb[rel * 8 + h]; }
            } else {
#pragma unroll
                for (int i = 0; i < 16; ++i) bs[i] = bfar;
            }
#pragma unroll
            for (int i = 0; i < 16; ++i) { const int ko = (i & 3) + 8 * (i >> 2); const float xv = __builtin_fmaf(S1[i], QS, bs[i]); x1[i] = (cm1 & (1u << ko)) ? xv : -2e30f; tmax = fmaxf(tmax, x1[i]); }
        }
        tmax = fmaxf(tmax, __shfl_xor(tmax, 32));
        const float mn = fmaxf(m, tmax);
        if (__ballot(mn > m) != 0ull) {
            const float scl = __builtin_amdgcn_exp2f(m - mn);
            lsum *= scl;
#pragma unroll
            for (int q = 0; q < 16; ++q) { O0[q] *= scl; O1[q] *= scl; }
        }
        m = mn;
        float p0[16], p1[16];
#pragma unroll
        for (int i = 0; i < 16; ++i) { const int ko = (i & 3) + 8 * (i >> 2);
            (void)ko; p0[i] = __builtin_amdgcn_exp2f(x0[i] - m); p1[i] = __builtin_amdgcn_exp2f(x1[i] - m); lsum += p0[i] + p1[i]; }
        union { unsigned u[4]; bf16x8 v; } pb00, pb01, pb10, pb11;
#pragma unroll
        for (int j = 0; j < 4; ++j) { pb00.u[j] = pg8::cvt_pk_bf16(p0[2 * j], p0[2 * j + 1]); pb01.u[j] = pg8::cvt_pk_bf16(p0[8 + 2 * j], p0[8 + 2 * j + 1]);
                                      pb10.u[j] = pg8::cvt_pk_bf16(p1[2 * j], p1[2 * j + 1]); pb11.u[j] = pg8::cvt_pk_bf16(p1[8 + 2 * j], p1[8 + 2 * j + 1]); }
        const bf16_t* vt = sl + 64 * ATT_KROW + c * ATT_VROW + 4 * hh;
#pragma unroll
        for (int sub = 0; sub < 2; ++sub) {
            union { u64 q[2]; bf16x8 v; } a00, a01, a10, a11;
            const bf16_t* vs = vt + 32 * sub;
            a00.q[0] = *(const u64*)(vs); a00.q[1] = *(const u64*)(vs + 8); a01.q[0] = *(const u64*)(vs + 16); a01.q[1] = *(const u64*)(vs + 24);
            a10.q[0] = *(const u64*)(vs + 32 * ATT_VROW); a10.q[1] = *(const u64*)(vs + 32 * ATT_VROW + 8); a11.q[0] = *(const u64*)(vs + 32 * ATT_VROW + 16); a11.q[1] = *(const u64*)(vs + 32 * ATT_VROW + 24);
            O0 = __builtin_amdgcn_mfma_f32_32x32x16_bf16(a00.v, sub ? pb10.v : pb00.v, O0, 0, 0, 0);
            O1 = __builtin_amdgcn_mfma_f32_32x32x16_bf16(a10.v, sub ? pb10.v : pb00.v, O1, 0, 0, 0);
            O0 = __builtin_amdgcn_mfma_f32_32x32x16_bf16(a01.v, sub ? pb11.v : pb01.v, O0, 0, 0, 0);
            O1 = __builtin_amdgcn_mfma_f32_32x32x16_bf16(a11.v, sub ? pb11.v : pb01.v, O1, 0, 0, 0);
        }
        if (more) { bf16_t* ds = ring + ((st + 2) % 3) * ATT_SLOT; *(u32x4*)(ds + lk) = sk; u64* d = (u64*)(ds + lv); d[0] = (u64)sv.x | ((u64)sv.y << 32); d[1] = (u64)sv.z | ((u64)sv.w << 32); }
        __syncthreads();
    }
    lsum += __shfl_xor(lsum, 32);
    const float inv = __builtin_amdgcn_rcpf(lsum);
    bf16_t* op = att + rowq * D + 512 + h * 64 + 4 * hh;
#pragma unroll
    for (int g4 = 0; g4 < 4; ++g4) {
        unsigned w0 = pg8::cvt_pk_bf16(O0[4 * g4] * inv, O0[4 * g4 + 1] * inv), w1 = pg8::cvt_pk_bf16(O0[4 * g4 + 2] * inv, O0[4 * g4 + 3] * inv);
        *(u64*)(op + 8 * g4) = (u64)w0 | ((u64)w1 << 32);
        w0 = pg8::cvt_pk_bf16(O1[4 * g4] * inv, O1[4 * g4 + 1] * inv); w1 = pg8::cvt_pk_bf16(O1[4 * g4 + 2] * inv, O1[4 * g4 + 3] * inv);
        *(u64*)(op + 32 + 8 * g4) = (u64)w0 | ((u64)w1 << 32);
    }
}

__device__ __forceinline__ void xcd_barrier_bg(const XcdBarrier& b, unsigned char* ldsb) {
    asm volatile("s_waitcnt vmcnt(0)" ::: "memory");
    __syncthreads();
    if (threadIdx.x == 0) {
        unsigned* bar = b.bar; asm volatile("" : "+s"(bar));
        __builtin_amdgcn_s_waitcnt(0);
        unsigned nloc = b.st[0], nx = b.st[1];
        if (nloc == 0u) { xcd_barrier_complete(bar, b.x, nloc, nx); b.st[0] = nloc; b.st[1] = nx; }
        const unsigned old = xb_add(&bar[XB_XSUB(b.x)], 1u);
        const unsigned gen = old / nloc;
        if (old + 1u == (gen + 1u) * nloc) {
            __builtin_amdgcn_fence(__ATOMIC_RELEASE, "agent");
            asm volatile("s_waitcnt vmcnt(0)" ::: "memory");
            const unsigned og = xb_add(&bar[XB_TOP], 1u);
            const unsigned tg = og / nx;
            if (og + 1u == (tg + 1u) * nx) xb_add(&bar[XB_TOPGEN], 1u);
            else XB_SPIN(xb_ld(&bar[XB_TOPGEN]) == tg, bar);
            __builtin_amdgcn_fence(__ATOMIC_ACQUIRE, "agent");
            xb_add(&bar[XB_XGEN(b.x)], 1u);
            asm volatile("s_waitcnt vmcnt(0)" ::: "memory");
            b.st[2] = 0u;
        } else { b.st[2] = 1u; b.st[3] = gen; }
    }
    __syncthreads();
    if (b.st[2] != 0u) {
        const unsigned gen = __builtin_amdgcn_readfirstlane(b.st[3]);
        bg_convert(ldsb, (int)threadIdx.x, true, CW_BAR + XB_XGEN(b.x), gen, 1);
        asm volatile("s_waitcnt vmcnt(0)" ::: "memory");
        __syncthreads();
        if (threadIdx.x == 0) {
            unsigned* bar = b.bar; asm volatile("" : "+s"(bar));
            XB_SPIN(xb_ld(&bar[XB_XGEN(b.x)]) == gen, bar);
            __builtin_amdgcn_fence(__ATOMIC_ACQUIRE, "agent");
            asm volatile("s_waitcnt vmcnt(0)" ::: "memory");
        }
    }
    __syncthreads();
}

template <int KIND> __global__ void __launch_bounds__(NTHREADS, 2) fwd(Args args) {
    extern __shared__ __attribute__((aligned(16))) unsigned char lds[];
    const int tid = threadIdx.x, lane = tid & 63, wave = tid >> 6;
    const int G = gridDim.x;
    PG8_LAS unsigned char* const lds3 = (PG8_LAS unsigned char*)lds;
#define WS_OPAQUE() unsigned long long ws_raw_ = (unsigned long long)args.ws; asm volatile("" : "+s"(ws_raw_)); GAS unsigned char* const wsg_ = (GAS unsigned char*)ws_raw_; unsigned char* const ws = (unsigned char*)wsg_; int tid = threadIdx.x; asm volatile("" : "+v"(tid)); const int lane = tid & 63, wave = tid >> 6; (void)lane; (void)wave
#define ctl ((unsigned*)(ws + WS_CTL))
#define MOD ((float*)(ws + WS_MOD))
#define LB ((float*)(ws + WS_LB))
#define WIN ((bf16_t*)(ws + WS_WIN))
#define WPA ((bf16_t*)(ws + WS_WPA))
#define WPB ((bf16_t*)(ws + WS_WPB))
#define WOUT ((bf16_t*)(ws + WS_WOUT))
#define W1 ((bf16_t*)(ws + WS_W1))
#define W2 ((bf16_t*)(ws + WS_W2))
#define H ((bf16_t*)(ws + WS_H))
#define ZB ((bf16_t*)(ws + WS_Z))
#define VBT ((bf16_t*)(ws + WS_VBT))
#define Y ((bf16_t*)(ws + WS_Y))
#define XS ((bf16_t*)(ws + WS_XS))
#define ACT ((bf16_t*)(ws + WS_ACT))
#define QEG ((bf16_t*)(ws + WS_QEG))
#define KEG ((bf16_t*)(ws + WS_KEG))
#define KETG ((bf16_t*)(ws + WS_KETG))
#define HVEC ((float*)(ws + WS_HVEC))
#define HA ((bf16_t*)(ws + WS_HA))
#define ATT ((bf16_t*)(ws + WS_ATT))
#define MASK ((unsigned*)(ws + WS_MASK))
#define MERGED ((bf16_t*)(ws + WS_MERGED))
#define X1 ((bf16_t*)(ws + WS_X1))
#define X2 ((bf16_t*)(ws + WS_X2))
#define TOKE ((int*)(ws + WS_TOKE))
#define TOKG ((float*)(ws + WS_TOKG))
#define TOKP ((int*)(ws + WS_TOKP))
#define TOKS ((int*)(ws + WS_TOKS))
#define BLKE ((int*)(ws + WS_BLKE))
#define SLOTTOK ((int*)(ws + WS_XS))
#define BCNT ((int*)(ws + WS_BCNT))
    const int lo = args.ph_lo, hi = args.ph_hi;
#define IN(k) ((KIND < 0 || ((k) == 0 ? KIND == 100 : KIND == ((k) - 1) % 11)) && lo <= (k) && (k) < hi)
#define SEAM(k) do { if (KIND < 0 && IN(k) && IN((k) + 1)) { if (DEPTH == 2 && (k) <= 10) xcd_barrier_bg(bar, lds); else xcd_barrier(bar); } } while (0)
    XcdBarrier bar; bar.bar = (unsigned*)(args.ws + WS_CTL) + CW_BAR; bar.x = 0; bar.st = nullptr;
    if (KIND < 0) {
        volatile LAS unsigned* xbw = (volatile LAS unsigned*)((LAS unsigned char*)lds + (LDS_BYTES - 16));
        if (tid == 0) { xbw[0] = 0u; xbw[1] = 0u; xbw[2] = 0u; xbw[3] = 0u; }
        __syncthreads();
        bar = xcd_barrier_post((unsigned*)(args.ws + WS_CTL) + CW_BAR, xbw);
    }

    if (IN(0)) for (int prep_ = 0; prep_ < probe_reps(100); ++prep_) {
        WS_OPAQUE();
        {
            bf16_t* lt = (bf16_t*)lds;
            f32x4 v[8];
            constexpr bool BGL1 = (DEPTH == 2 && KIND < 0); constexpr int CJ_P0 = BGL1 ? CJ_LAYER : CJ_TOTAL;
            int J = blockIdx.x;
            CvtJob cur = cvt_job(J < CJ_P0 ? (BGL1 ? layer_job(0, J) : J) : 0, args.in, ws);
            if (J < CJ_P0) cvt_load(cur, tid, v);
            __syncthreads();
            for (; J < CJ_P0; J += G) {
                {
                    const int i = tid >> 3, c0 = (tid & 7) * 32;
#pragma unroll
                    for (int q = 0; q < 8; q += 2) { u32x4 w; w.x = pg8::cvt_pk_bf16(v[q][0], v[q][1]); w.y = pg8::cvt_pk_bf16(v[q][2], v[q][3]); w.z = pg8::cvt_pk_bf16(v[q + 1][0], v[q + 1][1]); w.w = pg8::cvt_pk_bf16(v[q + 1][2], v[q + 1][3]);
                        *(u32x4*)(lt + i * 264 + c0 + 4 * q) = w; }
                }
                __syncthreads();
                const CvtJob me = cur;
                if (J + G < CJ_P0) { cur = cvt_job(BGL1 ? layer_job(0, J + G) : J + G, args.in, ws); cvt_load(cur, tid, v); }
                {
                    const int n = tid & 255, kh = tid >> 8;
                    unsigned w[16];
#pragma unroll
                    for (int q = 0; q < 16; ++q) w[q] = (unsigned)lt[(kh * 32 + 2 * q) * 264 + n] | ((unsigned)lt[(kh * 32 + 2 * q + 1) * 264 + n] << 16);
                    bf16_t* dp = me.dst + (size_t)n * me.K + kh * 32;
#pragma unroll
                    for (int q = 0; q < 4; ++q) { u32x4 o; o.x = w[4 * q]; o.y = w[4 * q + 1]; o.z = w[4 * q + 2]; o.w = w[4 * q + 3]; *(u32x4*)(dp + 8 * q) = o; }
                }
                __syncthreads();
            }
        }
        {
            float* ca = (float*)lds;
            float* red = ca + NB * D;
            __syncthreads();
            for (int i = tid; i < NB * D; i += NTHREADS) { const float c = args.in[I_C][i]; ca[i] = c * sigmoidf_(c); }
            __syncthreads();
            for (int u = blockIdx.x; u < DEPTH * NMOD / 48; u += G) {
                const int jc = tid % 48, kg = tid / 48;
                const int ln = u * 48 + jc, l = ln / NMOD, n = ln % NMOD;
                if (kg < 10) {
                    const float* w = args.in[I_WADA] + (size_t)l * D * NMOD + n;
                    float acc[NB];
#pragma unroll
                    for (int b = 0; b < NB; ++b) acc[b] = 0.f;
                    for (int k = kg; k < D; k += 10) { const float wv = w[(size_t)k * NMOD];
#pragma unroll
                        for (int b = 0; b < NB; ++b) acc[b] += ca[b * D + k] * wv; }
#pragma unroll
                    for (int b = 0; b < NB; ++b) red[(kg * NB + b) * 48 + jc] = acc[b];
                }
                __syncthreads();
                for (int o = tid; o < NB * 48; o += NTHREADS) { const int b = o / 48, jj = o % 48; float a = 0.f;
#pragma unroll
                    for (int q = 0; q < 10; ++q) a += red[(q * NB + b) * 48 + jj];
                    const int ln2 = u * 48 + jj, l2 = ln2 / NMOD, n2 = ln2 % NMOD;
                    MOD[((size_t)l2 * NB + b) * NMOD + n2] = a + args.in[I_BADA][(size_t)l2 * NMOD + n2]; }
                __syncthreads();
            }
        }
        if (blockIdx.x == G - 1) {
            for (int j = tid; j < 512; j += NTHREADS) { const float a0 = args.in[I_LBL][j], a1 = args.in[I_LBL][512 + j]; LB[j] = 0.f; LB[512 + j] = 1.0f / (1.0f + __expf(a0 - a1)); }
        }
    }

    SEAM(0);
    if (PROBE_GROUP == 13 && KIND < 0) { for (int i = 0; i < 20; ++i) xcd_barrier(bar); }
#pragma unroll
    for (int l = 0; l < DEPTH; ++l) {
        const int P = 1 + 11 * l;
#define mod (MOD + (size_t)l * NB * NMOD)
        if (IN(P + 0) && l == 0) {
            WS_OPAQUE();
            const float* nw = args.in[I_NMW] + (size_t)l * D;
            for (int row = blockIdx.x * NWAVES + wave; row < T; row += G * NWAVES) {
                const int b = row >> 11; f32x4 v[4]; float ss = 0.f;
#pragma unroll
                for (int i = 0; i < 4; ++i) { v[i] = *(const f32x4*)(args.in[I_X] + (size_t)row * D + (lane + 64 * i) * 4); ss += v[i][0] * v[i][0] + v[i][1] * v[i][1] + v[i][2] * v[i][2] + v[i][3] * v[i][3]; }
                ss = wave_sum(ss); const float r = rsqrtf(ss * (1.0f / D) + EPS);
#pragma unroll
                for (int i = 0; i < 4; ++i) { const int c = (lane + 64 * i) * 4;
                    const f32x4 w4 = *(const f32x4*)(nw + c), sc4 = *(const f32x4*)(mod + (size_t)b * NMOD + D + c), sh4 = *(const f32x4*)(mod + (size_t)b * NMOD + c);
                    const f32x4 hv = v[i] * r * w4 * (1.0f + sc4) + sh4;
                    *(unsigned long long*)(H + (size_t)row * D + c) = (unsigned long long)pg8::cvt_pk_bf16(hv[0], hv[1]) | ((unsigned long long)pg8::cvt_pk_bf16(hv[2], hv[3]) << 32);
                    *(unsigned long long*)(X2 + (size_t)row * D + c) = (unsigned long long)pg8::cvt_pk_bf16(v[i][0], v[i][1]) | ((unsigned long long)pg8::cvt_pk_bf16(v[i][2], v[i][3]) << 32); }
            }
        }
        if (l == 0) SEAM(P + 0);
        if (IN(P + 1)) for (int prep_ = 0; prep_ < probe_reps(1); ++prep_) {
            WS_OPAQUE();
            pg8::Gemm g{H, WIN + (size_t)l * ZLD * D, T, ZLD, D}; pg8::StaticOrder S; S.init(T, ZLD, G, (int)blockIdx.x);
            pg8::EpiZ E{ZB, ZLD};
            pg8::gemm_phase(lds3, tid, g, S, E);
        }
        SEAM(P + 1);
        if (IN(P + 2)) for (int prep_ = 0; prep_ < probe_reps(2); ++prep_) {
            WS_OPAQUE();
            {
                for (int wt = blockIdx.x * NWAVES + wave; wt < (T / 64) * 8; wt += G * NWAVES) {
                    const int rg = wt >> 3, dg = wt & 7; const int row = rg * 64 + lane, bb = row >> 11, sidx = row & 2047;
                    const u32x4 w = *(const u32x4*)(ZB + (size_t)row * ZLD + C_VB + dg * 8);
                    bf16_t* vp = VBT + ((size_t)bb * 64 + dg * 8) * SEQ + sidx;
                    vp[0] = (bf16_t)(w.x & 0xffffu); vp[SEQ] = (bf16_t)(w.x >> 16); vp[2 * SEQ] = (bf16_t)(w.y & 0xffffu); vp[3 * SEQ] = (bf16_t)(w.y >> 16);
                    vp[4 * SEQ] = (bf16_t)(w.z & 0xffffu); vp[5 * SEQ] = (bf16_t)(w.z >> 16); vp[6 * SEQ] = (bf16_t)(w.w & 0xffffu); vp[7 * SEQ] = (bf16_t)(w.w >> 16);
                }
            }
            for (int it = blockIdx.x; it < NB * 4 * 32; it += G) {
                int tid_p = threadIdx.x; asm volatile("" : "+v"(tid_p));
                hgrn_prep_item(ZB, LB + l * 512, QEG, KEG, KETG, HVEC, (float*)lds, it >> 7, (it >> 5) & 3, it & 31, tid_p);
            }
            {
                unsigned* sc = (unsigned*)lds; bf16_t* iring = (bf16_t*)(sc + 16 * 2048);
                int* tk = (int*)(lds + LDS_BYTES - 64);
                for (;;) {
                    __syncthreads();
                    if (tid == 0) *tk = (int)atomicAdd(&ctl[CW_Q + l + 8 * prep_], 1u);
                    __syncthreads();
                    const int ticket = *tk;
                    if (ticket >= T / 16) break;
                    int tid_q = threadIdx.x; asm volatile("" : "+v"(tid_q));
                    const int u = ticket; const int b = u & 15, q16 = 127 - (u >> 4), t0 = q16 * 16;
                    if (t0 < 256) {
                        for (int i = tid_q; i < 16 * 64; i += NTHREADS) { const int qq = i >> 6, w = i & 63, n = t0 + qq + 1, lo_ = w * 32;
                            unsigned mm = 0u; if (n >= lo_ + 32) mm = 0xffffffffu; else if (n > lo_) mm = (1u << (n - lo_)) - 1u; MASK[(size_t)(b * SEQ + t0 + qq) * 64 + w] = mm; }
                    } else indexer_unit(ZB, MASK, sc, iring, b, t0, tid_q);
                }
                __syncthreads();
            }
        }
        SEAM(P + 2);
        if (IN(P + 3)) for (int prep_ = 0; prep_ < probe_reps(3); ++prep_) {
            WS_OPAQUE();
            {
                float* tb = (float*)lds;
                int* tk = (int*)(lds + LDS_BYTES - 64);
                const float* hnw = args.in[I_HNW] + (size_t)l * 512;
                bool tb_ok = false;
                for (;;) {
                    __syncthreads();
                    if (tid == 0) *tk = (int)atomicAdd(&ctl[CW_Q + 2 + l + 8 * prep_], 1u);
                    __syncthreads();
                    const int ticket = *tk;
                    if (ticket >= NB * 4 + T / 32) break;
                    int tid_q = threadIdx.x; asm volatile("" : "+v"(tid_q));
                    if (ticket < NB * 4) { hgrn_item(ZB, QEG, KEG, KETG, HVEC, hnw, HA, lds, ticket >> 2, ticket & 3, tid_q); tb_ok = false; continue; }
                    if (!tb_ok) { for (int i = tid_q; i < 1024; i += NTHREADS) tb[i] = 1.4426950408889634f * args.in[I_RELB][(int)T5_BUCKET[i >> 3] * 8 + (i & 7)]; __syncthreads(); tb_ok = true; }
                    const int u = ticket - NB * 4; const int b = u & 15, qt = 63 - (u >> 4);
                    attn_block(ZB, VBT, MASK, HA, tb, (bf16_t*)(tb + 1024), b, qt, tid_q);
                }
                __syncthreads();
            }
        }
        SEAM(P + 3);
        if (IN(P + 4)) for (int prep_ = 0; prep_ < probe_reps(4); ++prep_) {
            WS_OPAQUE();
            pg8::StaticOrder S; S.init(T, D, G, (int)blockIdx.x);
            pg8::Gemm g{HA, WPA + (size_t)l * D * D, T, D, D}; pg8::EpiMergeF E{MERGED, ZB + C_GTA, ZB + C_GTB}; pg8::gemm_phase(lds3, tid, g, S, E);
        }
        SEAM(P + 4);
        if (IN(P + 5)) for (int prep_ = 0; prep_ < probe_reps(5); ++prep_) {
            WS_OPAQUE();
            pg8::Gemm g{MERGED, WOUT + (size_t)l * D * D, T, D, D}; pg8::StaticOrder S; S.init(T, D, G, (int)blockIdx.x);
            pg8::EpiOutG E{X2, X1, mod + 2 * D}; pg8::gemm_phase(lds3, tid, g, S, E);
        }
        SEAM(P + 5);
        if (IN(P + 6)) for (int prep_ = 0; prep_ < probe_reps(6); ++prep_) {
            WS_OPAQUE();
            const float* nw = args.in[I_NFW] + (size_t)l * D; const float* wr = args.in[I_WR] + (size_t)l * D * NE; const float* br = args.in[I_BR] + (size_t)l * NE;
            constexpr int WTLD = 260;
            float* WT = (float*)lds; float* CAl = WT + 128 * WTLD; float* CBl = CAl + D; float* C0 = CBl + D; unsigned* cntl = (unsigned*)(C0 + NE); float* c0s = (float*)(cntl + NE);
            __syncthreads();
            if (tid < NE) cntl[tid] = 0u;
            const int li = lane & 15, kk = lane >> 4;
            for (int it = 0; (blockIdx.x + it * G) * 128 < T; ++it) {
                const int tokbase = (blockIdx.x + it * G) * 128, b = tokbase >> 11;
                __syncthreads();
                for (int k = tid; k < D; k += NTHREADS) { CAl[k] = nw[k] * (1.0f + mod[(size_t)b * NMOD + 4 * D + k]); CBl[k] = mod[(size_t)b * NMOD + 3 * D + k]; }
                __syncthreads();
                {   const int q = tid & 7; float c0p[4] = {0.f, 0.f, 0.f, 0.f};
                    for (int i = tid; i < D * 8; i += NTHREADS) { const int k = i >> 3, kq = k >> 8, sx = k & 255; const f32x4 w4 = *(const f32x4*)(wr + (size_t)k * NE + 4 * q); const float ca = CAl[k], cb = CBl[k];
#pragma unroll
                        for (int j = 0; j < 4; ++j) { WT[(kq * 32 + 4 * q + j) * WTLD + sx] = ca * w4[j]; c0p[j] += cb * w4[j]; } }
#pragma unroll
                    for (int j = 0; j < 4; ++j) c0s[(tid >> 3) * NE + 4 * q + j] = c0p[j]; }
                __syncthreads();
                if (tid < NE) { float a = br[tid]; for (int r2 = 0; r2 < 64; ++r2) a += c0s[r2 * NE + tid]; C0[tid] = a; }
                __syncthreads();
                const int tok = tokbase + wave * 16 + li;
                const bf16_t* xrow = X1 + (size_t)tok * D + 256 * kk;
                const float* wt0 = WT + (kk * 32 + li) * WTLD; const float* wt1 = wt0 + 16 * WTLD;
                f32x4 d0a = {0.f, 0.f, 0.f, 0.f}, d0b = d0a, d1a = d0a, d1b = d0a; float ss = 0.f;
#pragma unroll 1
                for (int ub = 0; ub < 32; ub += 8) {
                    u32x4 xw[8];
#pragma unroll
                    for (int u = 0; u < 8; ++u) xw[u] = *(const u32x4*)(xrow + 8 * (ub + u));
#pragma unroll
                    for (int u = 0; u < 8; ++u) {
                        f32x4 xlo, xhi; pg8::bf8_to_f32(xw[u], xlo, xhi);
                        const f32x4 a00 = *(const f32x4*)(wt0 + 8 * (ub + u)), a01 = *(const f32x4*)(wt0 + 8 * (ub + u) + 4), a10 = *(const f32x4*)(wt1 + 8 * (ub + u)), a11 = *(const f32x4*)(wt1 + 8 * (ub + u) + 4);
#pragma unroll
                        for (int j = 0; j < 4; ++j) { d0a = __builtin_amdgcn_mfma_f32_16x16x4f32(a00[j], xlo[j], d0a, 0, 0, 0); d1a = __builtin_amdgcn_mfma_f32_16x16x4f32(a10[j], xlo[j], d1a, 0, 0, 0); }
#pragma unroll
                        for (int j = 0; j < 4; ++j) { d0b = __builtin_amdgcn_mfma_f32_16x16x4f32(a01[j], xhi[j], d0b, 0, 0, 0); d1b = __builtin_amdgcn_mfma_f32_16x16x4f32(a11[j], xhi[j], d1b, 0, 0, 0); }
                        ss += xlo[0] * xlo[0] + xlo[1] * xlo[1] + xlo[2] * xlo[2] + xlo[3] * xlo[3] + xhi[0] * xhi[0] + xhi[1] * xhi[1] + xhi[2] * xhi[2] + xhi[3] * xhi[3];
                    }
                }
                ss += __shfl_xor(ss, 16); ss += __shfl_xor(ss, 32);
                const float r = rsqrtf(ss * (1.0f / D) + EPS);
                float lg[8]; int eid[8];
#pragma unroll
                for (int j = 0; j < 4; ++j) { lg[j] = r * (d0a[j] + d0b[j]) + C0[4 * kk + j]; lg[4 + j] = r * (d1a[j] + d1b[j]) + C0[16 + 4 * kk + j]; eid[j] = 4 * kk + j; eid[4 + j] = 16 + 4 * kk + j; }
                float tv[4]; int ti[4];
#pragma unroll
                for (int k = 0; k < 4; ++k) {
                    float bv = lg[0]; int bi = eid[0];
#pragma unroll
                    for (int j = 1; j < 8; ++j) { const bool take = lg[j] > bv; bv = take ? lg[j] : bv; bi = take ? eid[j] : bi; }
#pragma unroll
                    for (int o = 16; o <= 32; o <<= 1) { const float ov = __shfl_xor(bv, o); const int oi = __shfl_xor(bi, o); const bool take = (ov > bv) | ((ov == bv) & (oi < bi)); bv = take ? ov : bv; bi = take ? oi : bi; }
                    tv[k] = bv; ti[k] = bi;
#pragma unroll
                    for (int j = 0; j < 8; ++j) lg[j] = (eid[j] == bi) ? -INFINITY : lg[j];
                }
                const float e1 = __expf(tv[1] - tv[0]), e2 = __expf(tv[2] - tv[0]), e3 = __expf(tv[3] - tv[0]); const float inv = 1.0f / (1.0f + e1 + e2 + e3);
                {   const int ee = kk == 0 ? ti[0] : kk == 1 ? ti[1] : kk == 2 ? ti[2] : ti[3]; const float gg = (kk == 0 ? 1.0f : kk == 1 ? e1 : kk == 2 ? e2 : e3) * inv;
                    TOKE[tok * 4 + kk] = ee; TOKG[tok * 4 + kk] = gg; TOKP[tok * 4 + kk] = (int)atomicAdd(&cntl[ee], 1u); }
                bf16_t* hrow = H + (size_t)tok * D + 256 * kk; const float* cal = CAl + 256 * kk; const float* cbl = CBl + 256 * kk;
#pragma unroll 1
                for (int ub = 0; ub < 32; ub += 8) {
                    u32x4 xw[8];
#pragma unroll
                    for (int u = 0; u < 8; ++u) xw[u] = *(const u32x4*)(xrow + 8 * (ub + u));
#pragma unroll
                    for (int u = 0; u < 8; ++u) {
                        f32x4 xlo, xhi; pg8::bf8_to_f32(xw[u], xlo, xhi);
                        const f32x4 ca0 = *(const f32x4*)(cal + 8 * (ub + u)), ca1 = *(const f32x4*)(cal + 8 * (ub + u) + 4), cb0 = *(const f32x4*)(cbl + 8 * (ub + u)), cb1 = *(const f32x4*)(cbl + 8 * (ub + u) + 4);
                        const f32x4 h0 = xlo * r * ca0 + cb0, h1 = xhi * r * ca1 + cb1;
                        u32x4 w; w.x = pg8::cvt_pk_bf16(h0[0], h0[1]); w.y = pg8::cvt_pk_bf16(h0[2], h0[3]); w.z = pg8::cvt_pk_bf16(h1[0], h1[1]); w.w = pg8::cvt_pk_bf16(h1[2], h1[3]);
                        *(u32x4*)(hrow + 8 * (ub + u)) = w;
                    }
                }
            }
            __syncthreads();
            if (tid < NE) BCNT[blockIdx.x * NE + tid] = (int)cntl[tid];
        }
        SEAM(P + 6);
        if (IN(P + 7)) for (int prep_ = 0; prep_ < probe_reps(7); ++prep_) {
            WS_OPAQUE();
            int* ps = (int*)lds; int* tot = ps + 64; int* basel = tot + 32; int* pall = basel + 32; int* pbef = pall + 16 * NE;
            __syncthreads();
            {
                const int e = tid & 31, pt = tid >> 5, per = (G + 15) / 16; int sa = 0, sb = 0;
                for (int bb = pt * per; bb < (pt + 1) * per && bb < G; ++bb) { const int c = BCNT[bb * NE + e]; sa += c; sb += bb < (int)blockIdx.x ? c : 0; }
                pall[pt * NE + e] = sa; pbef[pt * NE + e] = sb;
            }
            __syncthreads();
            if (tid < NE) { int sa = 0, sb = 0; for (int pt = 0; pt < 16; ++pt) { sa += pall[pt * NE + tid]; sb += pbef[pt * NE + tid]; } tot[tid] = sa; basel[tid] = sb; }
            __syncthreads();
            if (tid == 0) { int a = 0; for (int e = 0; e < NE; ++e) { ps[e] = a; a += ((tot[e] + 255) / 256) * 256; } ps[NE] = a; }
            __syncthreads();
            const int gt = blockIdx.x * NTHREADS + tid, gn = G * NTHREADS;
            for (int grp = blockIdx.x * NWAVES + wave; grp < T / 16; grp += G * NWAVES) {
                const int tok0 = grp * 16;
                const int e_l = TOKE[tok0 * 4 + lane]; const int slot_l = ps[e_l] + basel[e_l] + TOKP[tok0 * 4 + lane];
                TOKS[tok0 * 4 + lane] = slot_l; SLOTTOK[slot_l] = tok0 + (lane >> 2);
            }
            {
                for (int e = blockIdx.x; e < NE; e += G) { if (tid < 256) { const int si = tot[e] + tid; if (si < ps[e + 1] - ps[e]) SLOTTOK[ps[e] + si] = 0; } }
                if (blockIdx.x == G - 1) { const int end8 = ((ps[NE] / 256 + 7) & ~7) * 256; for (int i = ps[NE] + tid; i < end8; i += NTHREADS) SLOTTOK[i] = 0; }
            }
            const int nblk = ps[NE] / 256, nblk8 = (nblk + 7) & ~7;
            for (int mb = gt; mb < nblk8; mb += gn) { int e = 0; if (mb < nblk) { while (e < NE - 1 && mb * 256 >= ps[e + 1]) ++e; } BLKE[mb] = e; }
            if (gt == 0) ctl[CW_NBLK + l] = (unsigned)nblk8;
            __syncthreads();
        }
        SEAM(P + 7);
        if (IN(P + 8)) for (int prep_ = 0; prep_ < probe_reps(8); ++prep_) {
            WS_OPAQUE();
            const int nblk = __builtin_amdgcn_readfirstlane((int)ctl[CW_NBLK + l]);
            PG8_LAS int* const blk_l = (PG8_LAS int*)(lds3 + pg8::STAGE_BYTES);
            for (int i = tid; i < nblk; i += NTHREADS) blk_l[i] = BLKE[i];
            __syncthreads();
            pg8::Gemm g{H, W1 + (size_t)l * NE * 2 * DFF * D, nblk * 256, 2 * DFF, D}; pg8::MoeOrder<8, true> S; S.init(nblk, G, (int)blockIdx.x, blk_l, SLOTTOK);
            pg8::EpiSwigluG E{ACT, args.in[I_B1] + (size_t)l * NE * 2 * DFF}; pg8::gemm_phase(lds3, tid, g, S, E);
        }
        SEAM(P + 8);
        if (IN(P + 9)) for (int prep_ = 0; prep_ < probe_reps(9); ++prep_) {
            WS_OPAQUE();
            const int nblk = __builtin_amdgcn_readfirstlane((int)ctl[CW_NBLK + l]);
            PG8_LAS int* const blk_l = (PG8_LAS int*)(lds3 + pg8::STAGE_BYTES);
            for (int i = tid; i < nblk; i += NTHREADS) blk_l[i] = BLKE[i];
            __syncthreads();
            pg8::Gemm g{ACT, W2 + (size_t)l * NE * D * DFF, nblk * 256, D, DFF}; pg8::MoeOrder<4> S; S.init(nblk, G, (int)blockIdx.x, blk_l);
            pg8::EpiYG E{Y, args.in[I_B2] + (size_t)l * NE * D}; pg8::gemm_phase(lds3, tid, g, S, E);
        }
        SEAM(P + 9);
        if (IN(P + 10)) for (int prep_ = 0; prep_ < probe_reps(10); ++prep_) {
            WS_OPAQUE();
            const bool last = (l == DEPTH - 1);
            const float* nw = last ? args.in[I_FNW] : args.in[I_NMW] + (size_t)(l + 1) * D;
            const float* modn = MOD + (size_t)(l + 1) * NB * NMOD;
            for (int grp = blockIdx.x * NWAVES + wave; grp < T / 16; grp += G * NWAVES) {
                const int tok0 = grp * 16, b = tok0 >> 11;
                const int slot_l = TOKS[tok0 * 4 + lane]; const float g_l = TOKG[tok0 * 4 + lane];
                f32x4 gf4[4], ca4[4], cb4[4];
#pragma unroll
                for (int i = 0; i < 4; ++i) { const int c = (lane + 64 * i) * 4; gf4[i] = *(const f32x4*)(mod + (size_t)b * NMOD + 5 * D + c); const f32x4 w4 = *(const f32x4*)(nw + c);
                    if (last) { ca4[i] = w4; cb4[i] = (f32x4){0.f, 0.f, 0.f, 0.f}; } else { ca4[i] = w4 * (1.0f + *(const f32x4*)(modn + (size_t)b * NMOD + D + c)); cb4[i] = *(const f32x4*)(modn + (size_t)b * NMOD + c); } }
                for (int j = 0; j < 16; ++j) {
                    const int tok = tok0 + j; f32x4 v[4]; unsigned long long yw[4][4];
#pragma unroll
                    for (int i = 0; i < 4; ++i) { const unsigned long long xw = *(const unsigned long long*)(X1 + (size_t)tok * D + (lane + 64 * i) * 4); const unsigned x0 = (unsigned)xw, x1w = (unsigned)(xw >> 32);
                        v[i][0] = __uint_as_float(x0 << 16); v[i][1] = __uint_as_float(x0 & 0xffff0000u); v[i][2] = __uint_as_float(x1w << 16); v[i][3] = __uint_as_float(x1w & 0xffff0000u); }
                    float gk[4];
#pragma unroll
                    for (int k = 0; k < 4; ++k) { const int slot = __shfl(slot_l, 4 * j + k); gk[k] = __shfl(g_l, 4 * j + k);
#pragma unroll
                        for (int i = 0; i < 4; ++i) yw[k][i] = *(const unsigned long long*)(Y + (size_t)slot * D + (lane + 64 * i) * 4); }
                    float ss = 0.f;
#pragma unroll
                    for (int i = 0; i < 4; ++i) { f32x4 a = {0.f, 0.f, 0.f, 0.f};
#pragma unroll
                        for (int k = 0; k < 4; ++k) { const unsigned y0 = (unsigned)yw[k][i], y1 = (unsigned)(yw[k][i] >> 32);
                            f32x4 y; y[0] = __uint_as_float(y0 << 16); y[1] = __uint_as_float(y0 & 0xffff0000u); y[2] = __uint_as_float(y1 << 16); y[3] = __uint_as_float(y1 & 0xffff0000u); a += gk[k] * y; }
                        v[i] = v[i] + gf4[i] * a; ss += v[i][0] * v[i][0] + v[i][1] * v[i][1] + v[i][2] * v[i][2] + v[i][3] * v[i][3]; }
                    ss = wave_sum(ss); const float r = rsqrtf(ss * (1.0f / D) + EPS);
#pragma unroll
                    for (int i = 0; i < 4; ++i) { const int c = (lane + 64 * i) * 4;
                        if (last) { *(f32x4*)(args.out + (size_t)tok * D + c) = v[i] * r * ca4[i]; }
                        else { *(unsigned long long*)(X2 + (size_t)tok * D + c) = (unsigned long long)pg8::cvt_pk_bf16(v[i][0], v[i][1]) | ((unsigned long long)pg8::cvt_pk_bf16(v[i][2], v[i][3]) << 32);
                            const f32x4 hv = v[i] * r * ca4[i] + cb4[i];
                            *(unsigned long long*)(H + (size_t)tok * D + c) = (unsigned long long)pg8::cvt_pk_bf16(hv[0], hv[1]) | ((unsigned long long)pg8::cvt_pk_bf16(hv[2], hv[3]) << 32); } }
                }
            }
        }
        if (KIND < 0 && DEPTH == 2 && l == 0 && IN(P + 10)) bg_convert(lds, (int)threadIdx.x, false, 0u, 0u, 1);
        SEAM(P + 10);
    }
#undef IN
}

constexpr int N_PHASES = 1 + 11 * DEPTH;
typedef void (*kern_t)(Args);
template <int K> static kern_t kern_of() { return fwd<K>; }
static kern_t kern_for(int kind) {
    switch (kind) { case 0: return fwd<0>; case 1: return fwd<1>; case 2: return fwd<2>; case 3: return fwd<3>; case 4: return fwd<4>; case 5: return fwd<5>;
                    case 6: return fwd<6>; case 7: return fwd<7>; case 8: return fwd<8>; case 9: return fwd<9>; case 10: return fwd<10>; default: return fwd<100>; }
}

extern "C" void kernel_launch(void* const* d_in, const int* in_sizes, int n_in, void* d_out, int out_size, void* d_ws, size_t ws_size, hipStream_t stream) {
    static int grid = 0;
    if (grid == 0) {
        if (n_in != 20 || out_size != T * D || ws_size < WS_END) { fprintf(stderr, "kernel_launch: unexpected problem (n_in %d, out %d, ws %zu, need %zu)\n", n_in, out_size, ws_size, (size_t)WS_END); grid = -1; return; }
        int dev = 0, cus = 0;
        if (hipGetDevice(&dev) != hipSuccess || hipDeviceGetAttribute(&cus, hipDeviceAttributeMultiprocessorCount, dev) != hipSuccess) { grid = -1; return; }
        for (int k = 0; k <= 12; ++k) {
            if (hipFuncSetAttribute((const void*)(k == 12 ? (kern_t)fwd<-1> : kern_for(k)), hipFuncAttributeMaxDynamicSharedMemorySize, LDS_BYTES) != hipSuccess) { fprintf(stderr, "kernel_launch: hipFuncSetAttribute failed\n"); grid = -1; return; }
        }
        grid = cus > 0 ? cus : 256;
    }
    if (grid < 0) return;
    (void)hipMemsetAsync((char*)d_ws + WS_CTL, 0, CTL_BYTES, stream);
    Args a{};
    for (int i = 0; i < 20; ++i) a.in[i] = (const float*)d_in[i];
    a.out = (float*)d_out; a.ws = (unsigned char*)d_ws;
#if defined(MULTI_LAUNCH)
    for (int p = 0; p < N_PHASES; ++p) {
        if (p == 1 + 11) continue;
        a.ph_lo = p; a.ph_hi = p + 1;
        const int kind = p == 0 ? 11 : (p - 1) % 11;
        hipLaunchKernelGGL(kern_for(kind), dim3(grid), dim3(NTHREADS), LDS_BYTES, stream, a);
    }
#else
    a.ph_lo = 0; a.ph_hi = N_PHASES;
    hipLaunchKernelGGL(fwd<-1>, dim3(grid), dim3(NTHREADS), LDS_BYTES, stream, a);
#endif
}
```

```cpp
#include <hip/hip_runtime.h>
#include <stdint.h>
#include <stdio.h>

typedef unsigned short bf16_t;
typedef short bf16x8 __attribute__((ext_vector_type(8)));
typedef float f32x4 __attribute__((ext_vector_type(4)));
typedef float f32x16 __attribute__((ext_vector_type(16)));
typedef unsigned u32x4 __attribute__((ext_vector_type(4)));
#define LAS __attribute__((address_space(3)))
#define GAS __attribute__((address_space(1)))

constexpr int T = 32768, D = 1024, NB = 16, SEQ = 2048, DEPTH = 2;
constexpr int ZC = 5320, ZLD = 5376;
constexpr int C_QA = 0, C_FA = 512, C_IA = 1024, C_GA = 1536, C_QB = 2048, C_KB = 2560, C_VB = 2624, C_IQ = 2688, C_IK = 3200, C_IW = 3264, C_GTA = 3272, C_GTB = 4296;
constexpr int NE = 32, DFF = 1024, NSLOT = 131072 + 32 * 256, NBLK_MAX = NSLOT / 256;
constexpr int NMOD = 6 * D;
constexpr float EPS = 1e-6f;
constexpr int NTHREADS = 512, NWAVES = 8;
#ifndef PROBE_GROUP
#define PROBE_GROUP 0
#endif
constexpr int probe_reps(int kind) { return (PROBE_GROUP == 1 && (kind == 1 || kind == 4 || kind == 5 || kind == 8 || kind == 9)) || (PROBE_GROUP == 2 && kind == 2) || (PROBE_GROUP == 3 && kind == 3) || (PROBE_GROUP == 4 && kind == 100) || (PROBE_GROUP == 5 && (kind == 6 || kind == 7 || kind == 10)) || (PROBE_GROUP == 9 && kind == 8) || (PROBE_GROUP == 10 && kind == 1) || (PROBE_GROUP == 11 && kind == 9) || (PROBE_GROUP == 12 && (kind == 4 || kind == 5)) || (PROBE_GROUP == 14 && kind == 4) || (PROBE_GROUP == 15 && kind == 5) ? 2 : 1; }
constexpr int LDS_BYTES = 160 * 1024;

constexpr size_t al256(size_t x) { return (x + 255) & ~(size_t)255; }
constexpr size_t WS_CTL = 0;
constexpr size_t CTL_BYTES = 65536;
constexpr size_t WS_MOD = WS_CTL + CTL_BYTES;
constexpr size_t WS_LB = WS_MOD + al256((size_t)DEPTH * NB * NMOD * 4);
constexpr size_t WS_WIN = WS_LB + al256((size_t)DEPTH * 512 * 4);
constexpr size_t WS_WPA = WS_WIN + (size_t)DEPTH * ZLD * D * 2;
constexpr size_t WS_WPB = WS_WPA + (size_t)DEPTH * D * 512 * 2;
constexpr size_t WS_WOUT = WS_WPB + (size_t)DEPTH * D * 512 * 2;
constexpr size_t WS_W1 = WS_WOUT + (size_t)DEPTH * D * D * 2;
constexpr size_t WS_W2 = WS_W1 + (size_t)DEPTH * NE * 2 * DFF * D * 2;
constexpr size_t WS_H = WS_W2 + (size_t)DEPTH * NE * D * DFF * 2;
constexpr size_t WS_Z = WS_H + (size_t)T * D * 2;
constexpr size_t WS_Y = WS_Z;
constexpr size_t WS_ACT = WS_Z + (size_t)T * ZLD * 2;
constexpr size_t WS_QEG = WS_ACT;
constexpr size_t WS_KEG = WS_QEG + (size_t)T * 512 * 2;
constexpr size_t WS_KETG = WS_KEG + (size_t)T * 512 * 2;
constexpr size_t WS_HVEC = WS_KETG + (size_t)T * 512 * 2;
constexpr size_t WS_XS = WS_ACT + (size_t)NSLOT * DFF * 2;
constexpr size_t WS_HA = WS_XS + (size_t)NSLOT * D * 2;
constexpr size_t WS_ATT = WS_HA + (size_t)T * 512 * 2;
constexpr size_t WS_MASK = WS_ATT + (size_t)T * 512 * 2;
constexpr size_t WS_VBT = WS_MASK + (size_t)T * 64 * 4;
constexpr size_t WS_MERGED = WS_VBT + (size_t)T * 64 * 2;
constexpr size_t WS_X1 = WS_MERGED + (size_t)T * D * 2;
constexpr size_t WS_X2 = WS_X1 + (size_t)T * D * 4;
constexpr size_t WS_TOKE = WS_X2 + (size_t)T * D * 4;
constexpr size_t WS_TOKG = WS_TOKE + (size_t)T * 4 * 4;
constexpr size_t WS_TOKP = WS_TOKG + (size_t)T * 4 * 4;
constexpr size_t WS_TOKS = WS_TOKP + (size_t)T * 4 * 4;
constexpr size_t WS_BLKE = WS_TOKS + (size_t)T * 4 * 4;
constexpr size_t WS_BCNT = WS_BLKE + al256((size_t)(NBLK_MAX + 64) * 4);
constexpr size_t WS_END = WS_BCNT + (size_t)1024 * NE * 4;
static_assert((size_t)NSLOT * D * 2 <= (size_t)T * ZLD * 2, "Y must fit in Z");
static_assert((size_t)T * 512 * 2 * 3 + (size_t)NB * 4 * 32 * 384 * 4 <= (size_t)NSLOT * DFF * 2, "HGRN2 gate tensors must fit in ACT");
static_assert(WS_END <= ((size_t)1 << 31), "workspace layout exceeds 2 GiB");
constexpr int CW_CNT = 1024;
constexpr int CW_NBLK = 1200;
constexpr int CW_Q = 1216;

__device__ __forceinline__ bf16_t f2bf(float f) { unsigned u = __float_as_uint(f); u += 0x7fffu + ((u >> 16) & 1u); return (bf16_t)(u >> 16); }
__device__ __forceinline__ float bf2f(bf16_t b) { return __uint_as_float(((unsigned)b) << 16); }
__device__ __forceinline__ float sigmoidf_(float x) { return __builtin_amdgcn_rcpf(1.0f + __builtin_amdgcn_exp2f(-1.4426950408889634f * x)); }
__device__ __forceinline__ float wave_sum(float v) {
#pragma unroll
    for (int o = 32; o >= 1; o >>= 1) v += __shfl_xor(v, o);
    return v;
}
__device__ __forceinline__ int wave_sum_i(int v) {
#pragma unroll
    for (int o = 32; o >= 1; o >>= 1) v += __shfl_xor(v, o);
    return v;
}
__device__ const unsigned char T5_BUCKET[128] = {
    0, 1, 2, 3, 4, 5, 6, 7, 8, 9, 10, 11, 12, 13, 14, 15, 16, 16, 16, 17, 17, 18, 18, 18, 19, 19, 19, 20, 20, 20, 20, 21, 21, 21, 21, 22, 22, 22, 22, 22, 23, 23, 23, 23, 23, 23, 24, 24, 24, 24, 24, 24, 25,
    25, 25, 25, 25, 25, 25, 26, 26, 26, 26, 26, 26, 26, 26, 27, 27, 27, 27, 27, 27, 27, 27, 27, 27, 28, 28, 28, 28, 28, 28, 28, 28, 28, 28, 29, 29, 29, 29, 29, 29, 29, 29, 29, 29, 29, 29, 30, 30, 30, 30, 30,
    30, 30, 30, 30, 30, 30, 30, 30, 30, 31, 31, 31, 31, 31, 31, 31, 31, 31, 31, 31, 31, 31, 31, 31};
__device__ __forceinline__ int t5_bucket(int rel) { return rel >= 128 ? 31 : (int)T5_BUCKET[rel]; }


#define XB_TMO      128
#define XB_XCNT(j)  (256  + 64 * (j))
#define XB_XSUB(j)  (1280 + 64 * (j))
#define XB_XGEN(j)  (2304 + 64 * (j))
#define XB_TOP      3328
#define XB_TOPGEN   3392
#define XCD_BAR_WORDS 3456
#define XB_SPIN_CAP (1u << 18)
__device__ __forceinline__ unsigned xb_ld(unsigned* p)              { return __hip_atomic_load(p, __ATOMIC_RELAXED, __HIP_MEMORY_SCOPE_AGENT); }
__device__ __forceinline__ unsigned xb_add(unsigned* p, unsigned v) { return __hip_atomic_fetch_add(p, v, __ATOMIC_RELAXED, __HIP_MEMORY_SCOPE_AGENT); }
__device__ __forceinline__ unsigned xb_xcc_id() { return (unsigned)__builtin_amdgcn_s_getreg((3 << 11) | 20) & 0xFu; }
#define XB_SPIN(cond, bar) do { unsigned _sp = 0; while (cond) { __builtin_amdgcn_s_sleep(1); \
    if ((++_sp & 255u) == 0u) { if (xb_ld(&(bar)[XB_TMO])) break; if (_sp > XB_SPIN_CAP) { atomicAdd(&(bar)[XB_TMO], 1u); break; } } } } while (0)
struct XcdBarrier { unsigned* bar; unsigned x; volatile LAS unsigned* st; };
__device__ __forceinline__ XcdBarrier xcd_barrier_post(unsigned* bar, volatile LAS unsigned* st) {
    XcdBarrier b; b.bar = bar; b.x = xb_xcc_id(); b.st = st;
    if (threadIdx.x == 0) (void)xb_add(&bar[XB_XCNT(b.x)], 1u);
    return b;
}
__device__ __forceinline__ void xcd_barrier_complete(unsigned* bar, unsigned x, unsigned& nloc, unsigned& nx) {
    const unsigned G = gridDim.x * gridDim.y * gridDim.z;
    unsigned sum, cnt, mine, sp = 0u;
    for (;;) {
        sum = 0u; cnt = 0u; mine = 0u;
#pragma unroll
        for (unsigned j = 0; j < 16; ++j) { const unsigned c = xb_ld(&bar[XB_XCNT(j)]); sum += c; cnt += (c > 0u) ? 1u : 0u; mine = (j == x) ? c : mine; }
        if (sum == G) break;
        __builtin_amdgcn_s_sleep(1);
        if ((++sp & 255u) == 0u) { if (xb_ld(&bar[XB_TMO])) break; if (sp > XB_SPIN_CAP) { atomicAdd(&bar[XB_TMO], 1u); break; } }
    }
    nloc = mine > 0u ? mine : 1u; nx = cnt > 0u ? cnt : 1u;
}
__device__ __forceinline__ void xcd_barrier(const XcdBarrier& b) {
    asm volatile("s_waitcnt vmcnt(0)" ::: "memory");
    __syncthreads();
    if (threadIdx.x == 0) {
        unsigned* bar = b.bar; asm volatile("" : "+s"(bar));
        __builtin_amdgcn_s_waitcnt(0);
        unsigned nloc = b.st[0], nx = b.st[1];
        if (nloc == 0u) { xcd_barrier_complete(bar, b.x, nloc, nx); b.st[0] = nloc; b.st[1] = nx; }
        const unsigned old = xb_add(&bar[XB_XSUB(b.x)], 1u);
        const unsigned gen = old / nloc;
        if (old + 1u == (gen + 1u) * nloc) {
            __builtin_amdgcn_fence(__ATOMIC_RELEASE, "agent");
            asm volatile("s_waitcnt vmcnt(0)" ::: "memory");
            const unsigned og = xb_add(&bar[XB_TOP], 1u);
            const unsigned tg = og / nx;
            if (og + 1u == (tg + 1u) * nx) xb_add(&bar[XB_TOPGEN], 1u);
            else XB_SPIN(xb_ld(&bar[XB_TOPGEN]) == tg, bar);
            __builtin_amdgcn_fence(__ATOMIC_ACQUIRE, "agent");
            xb_add(&bar[XB_XGEN(b.x)], 1u);
            asm volatile("s_waitcnt vmcnt(0)" ::: "memory");
        } else {
            XB_SPIN(xb_ld(&bar[XB_XGEN(b.x)]) == gen, bar);
            __builtin_amdgcn_fence(__ATOMIC_ACQUIRE, "agent");
            asm volatile("s_waitcnt vmcnt(0)" ::: "memory");
        }
    }
    __syncthreads();
}
constexpr int CW_BAR = 4096;

struct Args { const float* in[20]; float* out; unsigned char* ws; int ph_lo, ph_hi; };
enum { I_X = 0, I_C, I_WADA, I_BADA, I_NMW, I_WIN, I_LBL, I_HNW, I_RELB, I_WPA, I_WPB, I_WOUT, I_NFW, I_WR, I_BR, I_W1, I_B1, I_W2, I_B2, I_FNW };

namespace pg8 {
#define PG8_LAS __attribute__((address_space(3)))
constexpr int BM = 256, BK = 64, HALF = 128, HTB = HALF * BK * 2, STAGE_BYTES = 8 * HTB, NXCD = 8, WGM = 8;
__host__ __device__ __forceinline__ int lds_byte(int r, int c) { const int st = (r >> 4) * 2 + (c >> 5), rr = r & 15, cc = c & 31, ob = rr * 64 + cc * 2; return st * 1024 + (ob ^ (((ob >> 9) & 1) << 5)); }
__host__ __device__ __forceinline__ void stage_rc(int b, int& R, int& C) { const int st = b / 1024, sb = b % 1024, swz = sb ^ (((sb >> 9) & 1) << 5); R = (st >> 1) * 16 + swz / 64; C = (st & 1) * 32 + (swz % 64) / 2; }
__host__ __device__ __forceinline__ int perm32(int rho) { const int n = rho >> 4, i = rho & 15; return 8 * (i >> 2) + 4 * n + (i & 3); }
struct Unit { int pm, pn, brow, e; };
struct Gemm { const bf16_t* A; const bf16_t* Bt; int M, N, K; };
struct StaticOrder {
    int nM, nN, nwg, G, c;
    __device__ void init(int M, int N, int G_, int c_) { nM = M / BM; nN = N / BM; nwg = nM * nN; G = G_; c = c_; }
    __device__ bool next(int i, Unit& u) const {
        const long L = (long)i * G + c; if (L >= nwg) return false;
        int wgid = (int)L; { const int q = nwg / NXCD, r = nwg % NXCD, xcd = wgid % NXCD, off = wgid / NXCD; wgid = (xcd < r ? xcd * (q + 1) : r * (q + 1) + (xcd - r) * q) + off; }
        const int nig = WGM * nN, gid = wgid / nig, fm = gid * WGM, gsz = (nM - fm) < WGM ? (nM - fm) : WGM;
        u.pm = fm + ((wgid % nig) % gsz); u.pn = (wgid % nig) / gsz; u.brow = u.pn * BM; u.e = 0; return true;
    }
    __device__ __forceinline__ void a_ready(const Unit&) const {}
    __device__ __forceinline__ void done(const Unit&) const {}
};
template <int NN, bool GATH = false> struct MoeOrder {
    static constexpr bool GATHER = GATH;
    int nwg, G, c; const PG8_LAS int* blke; const int* rowtok;
    __device__ void init(int nM, int G_, int c_, const PG8_LAS int* blke_, const int* rowtok_ = nullptr) { nwg = nM * NN; G = G_; c = c_; blke = blke_; rowtok = rowtok_; }
    __device__ bool next(int i, Unit& u) const {
        const int L = i * G + c; if (L >= nwg) return false;
        const int wgid = (L & 7) * (nwg >> 3) + (L >> 3);
        const int gid = wgid / (8 * NN), rem = wgid % (8 * NN);
        u.pm = gid * 8 + (rem & 7); u.pn = rem >> 3; u.e = __builtin_amdgcn_readfirstlane(blke[u.pm]); u.brow = u.e * (NN * BM) + u.pn * BM; return true;
    }
    __device__ __forceinline__ void a_ready(const Unit&) const {}
    __device__ __forceinline__ void done(const Unit&) const {}
};
typedef __bf16 bf16x2v_t __attribute__((ext_vector_type(2)));
typedef float f32x2v_t __attribute__((ext_vector_type(2)));
__device__ __forceinline__ unsigned cvt_pk_bf16(float lo, float hi) { const f32x2v_t v = {lo, hi}; const bf16x2v_t r = __builtin_convertvector(v, bf16x2v_t); return __builtin_bit_cast(unsigned, r); }


struct EpiZ {
    static constexpr bool PERM = true, AFTER_DRAIN = false;
    bf16_t* C; int ldc;
    __device__ __forceinline__ void operator()(const f32x4 (&acc)[2][2][4][2], const Unit& u, int wr, int wc, int fr, int fq) const {
        const int row0 = u.pm * BM + wr * 64 + fr, col0 = u.pn * BM + wc * 32 + 8 * fq;
#pragma unroll
        for (int ai = 0; ai < 2; ++ai)
#pragma unroll
            for (int m = 0; m < 4; ++m) { bf16_t* rowp = C + (size_t)(row0 + ai * HALF + m * 16) * ldc + col0;
#pragma unroll
                for (int bj = 0; bj < 2; ++bj) { const f32x4 v0 = acc[ai][bj][m][0], v1 = acc[ai][bj][m][1];
                    u32x4 w; w.x = cvt_pk_bf16(v0[0], v0[1]); w.y = cvt_pk_bf16(v0[2], v0[3]); w.z = cvt_pk_bf16(v1[0], v1[1]); w.w = cvt_pk_bf16(v1[2], v1[3]);
                    *(u32x4*)(rowp + bj * HALF) = w; } }
    }
};
__device__ __forceinline__ void bf8_to_f32(const u32x4 w, f32x4& lo, f32x4& hi) {
    lo[0] = __uint_as_float(w.x << 16); lo[1] = __uint_as_float(w.x & 0xffff0000u); lo[2] = __uint_as_float(w.y << 16); lo[3] = __uint_as_float(w.y & 0xffff0000u);
    hi[0] = __uint_as_float(w.z << 16); hi[1] = __uint_as_float(w.z & 0xffff0000u); hi[2] = __uint_as_float(w.w << 16); hi[3] = __uint_as_float(w.w & 0xffff0000u);
}
__device__ __forceinline__ f32x4 sig4(f32x4 g) { f32x4 r; r[0] = sigmoidf_(g[0]); r[1] = sigmoidf_(g[1]); r[2] = sigmoidf_(g[2]); r[3] = sigmoidf_(g[3]); return r; }
struct EpiMergeF {
    static constexpr bool PERM = true, AFTER_DRAIN = false, MIDK = true;
    bf16_t* merged; const bf16_t* Zga; const bf16_t* Zgb;
    __device__ __forceinline__ void mid(f32x4 (&acc)[2][2][4][2], const Unit& u, int wr, int wc, int fr, int fq) const {
        int row0 = u.pm * BM + wr * 64 + fr, col0 = u.pn * BM + wc * 32 + 8 * fq;
        asm volatile("" : "+v"(row0), "+v"(col0));
#pragma unroll
        for (int ai = 0; ai < 2; ++ai)
#pragma unroll
            for (int mp = 0; mp < 2; ++mp) {
                u32x4 ga[2][2], gb[2][2];
#pragma unroll
                for (int mi = 0; mi < 2; ++mi)
#pragma unroll
                    for (int bj = 0; bj < 2; ++bj) { const size_t row = (size_t)(row0 + ai * HALF + (2 * mp + mi) * 16); const int col = col0 + bj * HALF;
                        ga[mi][bj] = *(const u32x4*)(Zga + row * ZLD + col); gb[mi][bj] = *(const u32x4*)(Zgb + row * ZLD + col); }
#pragma unroll
                for (int mi = 0; mi < 2; ++mi)
#pragma unroll
                    for (int bj = 0; bj < 2; ++bj) { const int m = 2 * mp + mi;
                        f32x4 a0, a1, b0, b1; bf8_to_f32(ga[mi][bj], a0, a1); bf8_to_f32(gb[mi][bj], b0, b1);
#pragma unroll
                        for (int j = 0; j < 4; ++j) {
                            acc[ai][bj][m][0][j] *= (1.0f + __builtin_amdgcn_exp2f(-1.4426950408889634f * b0[j])) * __builtin_amdgcn_rcpf(1.0f + __builtin_amdgcn_exp2f(-1.4426950408889634f * a0[j]));
                            acc[ai][bj][m][1][j] *= (1.0f + __builtin_amdgcn_exp2f(-1.4426950408889634f * b1[j])) * __builtin_amdgcn_rcpf(1.0f + __builtin_amdgcn_exp2f(-1.4426950408889634f * a1[j])); } }
                asm volatile("" : "+v"(acc[ai][0][2 * mp][0]), "+v"(acc[ai][0][2 * mp][1]), "+v"(acc[ai][1][2 * mp][0]), "+v"(acc[ai][1][2 * mp][1]),
                                  "+v"(acc[ai][0][2 * mp + 1][0]), "+v"(acc[ai][0][2 * mp + 1][1]), "+v"(acc[ai][1][2 * mp + 1][0]), "+v"(acc[ai][1][2 * mp + 1][1]) :: "memory");
            }
    }
    __device__ __forceinline__ void operator()(const f32x4 (&acc)[2][2][4][2], const Unit& u, int wr, int wc, int fr, int fq) const {
        int row0 = u.pm * BM + wr * 64 + fr, col0 = u.pn * BM + wc * 32 + 8 * fq;
        asm volatile("" : "+v"(row0), "+v"(col0));
#pragma unroll
        for (int ai = 0; ai < 2; ++ai) {
            u32x4 gb[4][2];
#pragma unroll
            for (int m = 0; m < 4; ++m)
#pragma unroll
                for (int bj = 0; bj < 2; ++bj) gb[m][bj] = *(const u32x4*)(Zgb + (size_t)(row0 + ai * HALF + m * 16) * ZLD + col0 + bj * HALF);
#pragma unroll
            for (int m = 0; m < 4; ++m)
#pragma unroll
                for (int bj = 0; bj < 2; ++bj) {
                    f32x4 g0, g1; bf8_to_f32(gb[m][bj], g0, g1); g0 = sig4(g0); g1 = sig4(g1);
                    const f32x4 v0 = g0 * acc[ai][bj][m][0], v1 = g1 * acc[ai][bj][m][1];
                    u32x4 w; w.x = cvt_pk_bf16(v0[0], v0[1]); w.y = cvt_pk_bf16(v0[2], v0[3]); w.z = cvt_pk_bf16(v1[0], v1[1]); w.w = cvt_pk_bf16(v1[2], v1[3]);
                    *(u32x4*)(merged + (size_t)(row0 + ai * HALF + m * 16) * D + col0 + bj * HALF) = w; }
        }
    }
};
struct EpiOutG {
    static constexpr bool PERM = true, AFTER_DRAIN = false;
    const bf16_t* xin; bf16_t* x1; const float* gate  ;
    __device__ __forceinline__ void operator()(const f32x4 (&acc)[2][2][4][2], const Unit& u, int wr, int wc, int fr, int fq) const {
        const int row0 = u.pm * BM + wr * 64 + fr, col0 = u.pn * BM + wc * 32 + 8 * fq; const int b = (u.pm * BM) >> 11;
        f32x4 gv[2][2];
#pragma unroll
        for (int bj = 0; bj < 2; ++bj)
#pragma unroll
            for (int n = 0; n < 2; ++n) gv[bj][n] = *(const f32x4*)(gate + (size_t)b * NMOD + col0 + bj * HALF + 4 * n);
#pragma unroll
        for (int ai = 0; ai < 2; ++ai) {
            u32x4 xv[4][2];
#pragma unroll
            for (int m = 0; m < 4; ++m)
#pragma unroll
                for (int bj = 0; bj < 2; ++bj) xv[m][bj] = *(const u32x4*)(xin + (size_t)(row0 + ai * HALF + m * 16) * D + col0 + bj * HALF);
#pragma unroll
            for (int m = 0; m < 4; ++m)
#pragma unroll
                for (int bj = 0; bj < 2; ++bj) {
                    f32x4 x0, x1f; bf8_to_f32(xv[m][bj], x0, x1f);
                    const f32x4 v0 = x0 + gv[bj][0] * acc[ai][bj][m][0], v1 = x1f + gv[bj][1] * acc[ai][bj][m][1];
                    u32x4 w; w.x = cvt_pk_bf16(v0[0], v0[1]); w.y = cvt_pk_bf16(v0[2], v0[3]); w.z = cvt_pk_bf16(v1[0], v1[1]); w.w = cvt_pk_bf16(v1[2], v1[3]);
                    *(u32x4*)(x1 + (size_t)(row0 + ai * HALF + m * 16) * D + col0 + bj * HALF) = w; }
        }
    }
};
struct EpiSwigluG {
    static constexpr bool PERM = true, AFTER_DRAIN = false;
    bf16_t* act; const float* b1  ;
    __device__ __forceinline__ void operator()(const f32x4 (&acc)[2][2][4][2], const Unit& u, int wr, int wc, int fr, int fq) const {
        typedef float f32x2 __attribute__((ext_vector_type(2)));
        const int row0 = u.pm * BM + wr * 64 + fr, col0 = u.pn * HALF + wc * 32 + 8 * fq;
        f32x2 bg[2][2], bl[2][2];
#pragma unroll
        for (int n = 0; n < 2; ++n) { const f32x4 g4 = *(const f32x4*)(b1 + (size_t)u.e * 2 * DFF + col0 + 4 * n), l4 = *(const f32x4*)(b1 + (size_t)u.e * 2 * DFF + DFF + col0 + 4 * n);
            bg[n][0] = (f32x2){g4[0], g4[1]}; bg[n][1] = (f32x2){g4[2], g4[3]}; bl[n][0] = (f32x2){l4[0] + 1.0f, l4[1] + 1.0f}; bl[n][1] = (f32x2){l4[2] + 1.0f, l4[3] + 1.0f}; }
#pragma unroll
        for (int ai = 0; ai < 2; ++ai)
#pragma unroll
            for (int m = 0; m < 4; ++m) { unsigned o[4];
#pragma unroll
                for (int n = 0; n < 2; ++n)
#pragma unroll
                    for (int h = 0; h < 2; ++h) {
                        f32x2 g = (f32x2){acc[ai][0][m][n][2 * h], acc[ai][0][m][n][2 * h + 1]} + bg[n][h];
                        f32x2 l = (f32x2){acc[ai][1][m][n][2 * h], acc[ai][1][m][n][2 * h + 1]} + bl[n][h];
                        g = (f32x2){fminf(g[0], 7.0f), fminf(g[1], 7.0f)};
                        l = (f32x2){__builtin_amdgcn_fmed3f(l[0], -6.0f, 8.0f), __builtin_amdgcn_fmed3f(l[1], -6.0f, 8.0f)};
                        const f32x2 t = g * (-1.702f * 1.4426950408889634f);
                        const f32x2 d = (f32x2){__builtin_amdgcn_exp2f(t[0]), __builtin_amdgcn_exp2f(t[1])} + 1.0f;
                        const f32x2 r = (f32x2){__builtin_amdgcn_rcpf(d[0]), __builtin_amdgcn_rcpf(d[1])};
                        const f32x2 ov = g * r * l;
                        o[2 * n + h] = cvt_pk_bf16(ov[0], ov[1]); }
                u32x4 w; w.x = o[0]; w.y = o[1]; w.z = o[2]; w.w = o[3];
                *(u32x4*)(act + (size_t)(row0 + ai * HALF + m * 16) * DFF + col0) = w; }
    }
};
struct EpiYG {
    static constexpr bool PERM = true, AFTER_DRAIN = false;
    bf16_t* Yb; const float* b2  ;
    __device__ __forceinline__ void operator()(const f32x4 (&acc)[2][2][4][2], const Unit& u, int wr, int wc, int fr, int fq) const {
        const int row0 = u.pm * BM + wr * 64 + fr, col0 = u.pn * BM + wc * 32 + 8 * fq;
        f32x4 bv[2][2];
#pragma unroll
        for (int bj = 0; bj < 2; ++bj)
#pragma unroll
            for (int n = 0; n < 2; ++n) bv[bj][n] = *(const f32x4*)(b2 + (size_t)u.e * D + col0 + bj * HALF + 4 * n);
#pragma unroll
        for (int ai = 0; ai < 2; ++ai)
#pragma unroll
            for (int m = 0; m < 4; ++m) { bf16_t* rowp = Yb + (size_t)(row0 + ai * HALF + m * 16) * D + col0;
#pragma unroll
                for (int bj = 0; bj < 2; ++bj) { const f32x4 v0 = acc[ai][bj][m][0] + bv[bj][0], v1 = acc[ai][bj][m][1] + bv[bj][1];
                    u32x4 w; w.x = cvt_pk_bf16(v0[0], v0[1]); w.y = cvt_pk_bf16(v0[2], v0[3]); w.z = cvt_pk_bf16(v1[0], v1[1]); w.w = cvt_pk_bf16(v1[2], v1[3]);
                    *(u32x4*)(rowp + bj * HALF) = w; } }
    }
};

template <class E, class = void> struct has_midk { static constexpr bool value = false; };
template <class E> struct has_midk<E, decltype((void)E::MIDK)> { static constexpr bool value = E::MIDK; };
template <class S_, class = void> struct sched_gather { static constexpr bool value = false; };
template <class S_> struct sched_gather<S_, decltype((void)S_::GATHER)> { static constexpr bool value = S_::GATHER; };
template <class Epi, class Sched>
__device__ __forceinline__ void gemm_phase(PG8_LAS unsigned char* lds, const int tid, const Gemm g, const Sched& S, const Epi& E) {
    const int wid = __builtin_amdgcn_readfirstlane(tid >> 6), lane = tid & 63, wr = wid >> 2, wc = wid & 3, fr = lane & 15, fq = lane >> 4;
    const int K = g.K, nt = K / BK;
    unsigned voffA[2], voffB[2]; int gR[2], gC[2];
#pragma unroll
    for (int i = 0; i < 2; ++i) { int R, C; stage_rc(tid * 16 + i * 8192, R, C); const int Rb = Epi::PERM ? ((R & ~31) + perm32(R & 31)) : R;
        voffA[i] = (unsigned)(R * K + C) * 2u; voffB[i] = (unsigned)(Rb * K + C) * 2u; gR[i] = R; gC[i] = C; }
    const size_t kstep = (size_t)(BK * 2);
    const size_t hstep = (size_t)HALF * K * 2;
    const size_t tstep = 2 * hstep;
    const unsigned ldsw = (unsigned)wid * 1024u;
    const int aoff = lds_byte(wr * 64 + fr, fq * 8), boff = lds_byte(wc * 32 + fr, fq * 8);
#define PG8_SA(b, h) (((b) * 2 + (h)) * HTB)
#define PG8_SB(b, h) ((4 + (b) * 2 + (h)) * HTB)
#define PG8_STAGE(bufoff, gbase, voff) do { _Pragma("unroll") for (int _i = 0; _i < 2; ++_i) \
        __builtin_amdgcn_global_load_lds((const unsigned*)((const char*)(gbase) + (voff)[_i]), (PG8_LAS unsigned*)(lds + (bufoff) + ldsw + _i * 8192), 16, 0, 0); } while (0)
#define PG8_LDA(dst, b, h) do { _Pragma("unroll") for (int m = 0; m < 4; ++m) _Pragma("unroll") for (int k = 0; k < 2; ++k) dst[m][k] = *(const PG8_LAS bf16x8*)(lds + PG8_SA(b, h) + aoff + m * 2048 + k * 1024); } while (0)
#define PG8_LDB(dst, b, h) do { _Pragma("unroll") for (int n = 0; n < 2; ++n) _Pragma("unroll") for (int k = 0; k < 2; ++k) dst[n][k] = *(const PG8_LAS bf16x8*)(lds + PG8_SB(b, h) + boff + n * 2048 + k * 1024); } while (0)
#define PG8_MMA(ai, bj, At, Bt) do { __builtin_amdgcn_s_setprio(1); _Pragma("unroll") for (int m = 0; m < 4; ++m) _Pragma("unroll") for (int n = 0; n < 2; ++n) _Pragma("unroll") for (int k = 0; k < 2; ++k) \
        acc[ai][bj][m][n] = __builtin_amdgcn_mfma_f32_16x16x32_bf16(Bt[n][k], At[m][k], acc[ai][bj][m][n], 0, 0, 0); __builtin_amdgcn_s_setprio(0); } while (0)
#define PG8_WAIT_V(n) asm volatile("s_waitcnt vmcnt(" #n ")" ::: "memory")
#define PG8_WAIT_L(n) asm volatile("s_waitcnt lgkmcnt(" #n ")" ::: "memory")
#define PG8_BAR __builtin_amdgcn_s_barrier()
#define PG8_SCHED __builtin_amdgcn_sched_barrier(0)
    Unit cur, nxt; int ui = 0;
    if (!S.next(0, cur)) return;
    f32x4 acc[2][2][4][2];
#pragma unroll
    for (int a = 0; a < 2; ++a)
#pragma unroll
        for (int b = 0; b < 2; ++b)
#pragma unroll
            for (int m = 0; m < 4; ++m)
#pragma unroll
                for (int n = 0; n < 2; ++n) acc[a][b][m][n] = (f32x4){0.f, 0.f, 0.f, 0.f};
    bf16x8 At[4][2], B0[2][2], B1[2][2];
    unsigned vC0[2], vC1[2], vN0[2], vN1[2];
    if constexpr (sched_gather<Sched>::value) {
#pragma unroll
        for (int i = 0; i < 2; ++i) { vC0[i] = ((unsigned)S.rowtok[cur.pm * BM + gR[i]] * (unsigned)K + (unsigned)gC[i]) * 2u; vC1[i] = ((unsigned)S.rowtok[cur.pm * BM + HALF + gR[i]] * (unsigned)K + (unsigned)gC[i]) * 2u; vN0[i] = vC0[i]; vN1[i] = vC1[i]; }
    } else {
#pragma unroll
        for (int i = 0; i < 2; ++i) { vC0[i] = voffA[i]; vC1[i] = voffA[i] + (unsigned)hstep; vN0[i] = vC0[i]; vN1[i] = vC1[i]; }
    }
    const char* cA = sched_gather<Sched>::value ? (const char*)g.A : (const char*)g.A + (size_t)cur.pm * tstep; const char* cB = (const char*)g.Bt + (size_t)cur.brow * K * 2;
    S.a_ready(cur);
    PG8_STAGE(PG8_SB(0, 0), cB, voffB); PG8_STAGE(PG8_SA(0, 0), cA, vC0); PG8_STAGE(PG8_SB(0, 1), cB + hstep, voffB); PG8_STAGE(PG8_SA(0, 1), cA, vC1);
    if (wr == 1) PG8_BAR;
    PG8_WAIT_V(4); PG8_BAR;
    PG8_STAGE(PG8_SB(1, 0), cB + kstep, voffB); PG8_STAGE(PG8_SA(1, 0), cA + kstep, vC0); PG8_STAGE(PG8_SB(1, 1), cB + hstep + kstep, voffB);
    PG8_WAIT_V(6); PG8_BAR;
    for (;;) {
        const bool has_next = S.next(ui + 1, nxt);
        const char* nA = sched_gather<Sched>::value ? cA : (has_next ? (const char*)g.A + (size_t)nxt.pm * tstep : cA); const char* nB = has_next ? (const char*)g.Bt + (size_t)nxt.brow * K * 2 : cB;
        PG8_LAS int* const tokb = (PG8_LAS int*)(lds + STAGE_BYTES + 4096) + ((ui + 1) & 1) * BM;
        if constexpr (sched_gather<Sched>::value) { if (has_next && wid == 0)
            __builtin_amdgcn_global_load_lds((const unsigned*)(S.rowtok + nxt.pm * BM + lane * 4), (PG8_LAS unsigned*)tokb, 16, 0, 0); }
        for (int t = 0; t < nt; t += 2) {
            if constexpr (has_midk<Epi>::value) { if (t == nt / 2) E.mid(acc, cur, wr, wc, fr, fq); }
            const bool last = (t == nt - 2);
            const char* a1 = cA + (size_t)(t + 1) * kstep;
            const char* a2 = last ? nA : cA + (size_t)(t + 2) * kstep; const char* b2 = last ? nB : cB + (size_t)(t + 2) * kstep;
            const char* a3 = a2 + kstep; const char* b3 = b2 + kstep;
            unsigned w0[2], w1[2];
#pragma unroll
            for (int i = 0; i < 2; ++i) { w0[i] = vC0[i]; w1[i] = vC1[i]; }
            if constexpr (sched_gather<Sched>::value) { if (last && has_next) {
#pragma unroll
                for (int i = 0; i < 2; ++i) { vN0[i] = ((unsigned)tokb[gR[i]] * (unsigned)K + (unsigned)gC[i]) * 2u; vN1[i] = ((unsigned)tokb[HALF + gR[i]] * (unsigned)K + (unsigned)gC[i]) * 2u; w0[i] = vN0[i]; w1[i] = vN1[i]; } } }
            if (last && has_next) S.a_ready(nxt);
            PG8_LDB(B0, 0, 0); PG8_SCHED; PG8_LDA(At, 0, 0); PG8_STAGE(PG8_SA(1, 1), a1, vC1);
            PG8_WAIT_L(8); PG8_BAR; PG8_WAIT_L(0); PG8_MMA(0, 0, At, B0); PG8_BAR; PG8_SCHED;
            PG8_LDB(B1, 0, 1); PG8_STAGE(PG8_SB(0, 0), b2, voffB);
            PG8_BAR; PG8_WAIT_L(0); PG8_MMA(0, 1, At, B1); PG8_BAR;
            PG8_LDA(At, 0, 1); PG8_STAGE(PG8_SA(0, 0), a2, w0);
            PG8_BAR; PG8_WAIT_L(0); PG8_MMA(1, 0, At, B0); PG8_BAR; PG8_SCHED;
            PG8_STAGE(PG8_SB(0, 1), b2 + hstep, voffB);
            PG8_WAIT_V(6); PG8_BAR; PG8_MMA(1, 1, At, B1); PG8_BAR;
            PG8_LDB(B0, 1, 0); PG8_SCHED; PG8_LDA(At, 1, 0); PG8_STAGE(PG8_SA(0, 1), a2, w1);
            PG8_WAIT_L(8); PG8_BAR; PG8_WAIT_L(0); PG8_MMA(0, 0, At, B0); PG8_BAR; PG8_SCHED;
            PG8_LDB(B1, 1, 1); PG8_STAGE(PG8_SB(1, 0), b3, voffB);
            PG8_BAR; PG8_WAIT_L(0); PG8_MMA(0, 1, At, B1); PG8_BAR;
            PG8_LDA(At, 1, 1); PG8_STAGE(PG8_SA(1, 0), a3, w0);
            PG8_BAR; PG8_WAIT_L(0); PG8_MMA(1, 0, At, B0); PG8_BAR; PG8_SCHED;
            PG8_STAGE(PG8_SB(1, 1), b3 + hstep, voffB);
            PG8_WAIT_V(6); PG8_BAR; PG8_MMA(1, 1, At, B1); PG8_BAR;
        }
        if constexpr (!Epi::AFTER_DRAIN) { E(acc, cur, wr, wc, fr, fq); S.done(cur); }
        if (!has_next) break;
#pragma unroll
        for (int a = 0; a < 2; ++a)
#pragma unroll
            for (int b = 0; b < 2; ++b)
#pragma unroll
                for (int m = 0; m < 4; ++m)
#pragma unroll
                    for (int n = 0; n < 2; ++n) acc[a][b][m][n] = (f32x4){0.f, 0.f, 0.f, 0.f};
        cur = nxt; cA = nA; cB = nB; ++ui;
#pragma unroll
        for (int i = 0; i < 2; ++i) { vC0[i] = vN0[i]; vC1[i] = vN1[i]; }
    }
    PG8_WAIT_V(0);
    if (wr == 0) PG8_BAR;
    PG8_BAR;
    if constexpr (Epi::AFTER_DRAIN) { E.fused(acc, cur, wr, wc, fr, fq, lds, wid, lane); S.done(cur); }
#undef PG8_SA
#undef PG8_SB
#undef PG8_STAGE
#undef PG8_LDA
#undef PG8_LDB
#undef PG8_MMA
#undef PG8_WAIT_V
#undef PG8_WAIT_L
#undef PG8_BAR
#undef PG8_SCHED
}
}


struct CvtJob { const float* src; bf16_t* dst; int N  , K  , nvalid  , sc0, sc1  ; };
constexpr int CJ_WIN = DEPTH * 16 * 21, CJ_WPA = DEPTH * 8 * 4, CJ_WPB = CJ_WPA, CJ_WOUT = DEPTH * 16 * 4, CJ_W1 = DEPTH * NE * 16 * 8, CJ_W2 = DEPTH * NE * 16 * 4;
constexpr int CJ_TOTAL = CJ_WIN + CJ_WPA + CJ_WPB + CJ_WOUT + CJ_W1 + CJ_W2;
__device__ __forceinline__ CvtJob cvt_job(int J, const float* const* in, unsigned char* ws) {
    CvtJob j;
    if (J < CJ_WIN) { const int m = J / (16 * 21), r = J % (16 * 21), kt = r / 21, ns = r % 21;
        j.src = in[I_WIN] + (size_t)m * D * ZC + (size_t)kt * 64 * ZC; j.dst = (bf16_t*)(ws + WS_WIN) + (size_t)m * ZLD * D + (size_t)ns * 256 * D + kt * 64; j.N = ZC; j.K = D;
        j.nvalid = ZC - ns * 256 < 256 ? ZC - ns * 256 : 256; j.sc0 = ns * 256; j.sc1 = ns * 256 + 128; return j; }
    J -= CJ_WIN;
    if (J < CJ_WPA + CJ_WPB) { const int which = J / CJ_WPA, JJ = J % CJ_WPA; const int m = JJ / 32, r = JJ % 32, kt = r / 4, ns = r % 4;
        j.src = in[which ? I_WPB : I_WPA] + (size_t)m * 512 * D + (size_t)kt * 64 * D; j.dst = (bf16_t*)(ws + WS_WPA) + (size_t)m * D * D + (size_t)ns * 256 * D + which * 512 + kt * 64; j.N = D; j.K = D;
        j.nvalid = 256; j.sc0 = ns * 256; j.sc1 = ns * 256 + 128; return j; }
    J -= CJ_WPA + CJ_WPB;
    if (J < CJ_WOUT) { const int m = J / 64, r = J % 64, kt = r / 4, ns = r % 4;
        j.src = in[I_WOUT] + (size_t)m * D * D + (size_t)kt * 64 * D; j.dst = (bf16_t*)(ws + WS_WOUT) + (size_t)m * D * D + (size_t)ns * 256 * D + kt * 64; j.N = D; j.K = D;
        j.nvalid = 256; j.sc0 = ns * 256; j.sc1 = ns * 256 + 128; return j; }
    J -= CJ_WOUT;
    if (J < CJ_W1) { const int m = J / 128, r = J % 128, kt = r / 8, ns = r % 8;
        j.src = in[I_W1] + (size_t)m * D * 2 * DFF + (size_t)kt * 64 * 2 * DFF; j.dst = (bf16_t*)(ws + WS_W1) + (size_t)m * 2 * DFF * D + (size_t)ns * 256 * D + kt * 64; j.N = 2 * DFF; j.K = D;
        j.nvalid = 256; j.sc0 = 128 * ns; j.sc1 = DFF + 128 * ns; return j; }
    J -= CJ_W1;
    { const int m = J / 64, r = J % 64, kt = r / 4, ns = r % 4;
        j.src = in[I_W2] + (size_t)m * DFF * D + (size_t)kt * 64 * D; j.dst = (bf16_t*)(ws + WS_W2) + (size_t)m * D * DFF + (size_t)ns * 256 * DFF + kt * 64; j.N = D; j.K = DFF;
        j.nvalid = 256; j.sc0 = ns * 256; j.sc1 = ns * 256 + 128; return j; }
}
__device__ __forceinline__ void cvt_load(const CvtJob& j, const int tid, f32x4 (&v)[8]) {
    const int i = tid >> 3, c0 = (tid & 7) * 32; const float* p = j.src + (size_t)i * j.N + (c0 < 128 ? j.sc0 + c0 : j.sc1 + c0 - 128);
#pragma unroll
    for (int q = 0; q < 8; ++q) v[q] = (c0 + 4 * q < j.nvalid) ? *(const f32x4*)(p + 4 * q) : (f32x4){0.f, 0.f, 0.f, 0.f};
}

constexpr int CJ_LAYER = CJ_TOTAL / DEPTH;
constexpr int CW_BGQ = 1300;
__device__ __forceinline__ int layer_job(const int layer, int j) {
    constexpr int H_WIN = CJ_WIN / DEPTH, H_WPA = CJ_WPA / DEPTH, H_WOUT = CJ_WOUT / DEPTH, H_W1 = CJ_W1 / DEPTH, H_W2 = CJ_W2 / DEPTH;
    if (j < H_WIN) return layer * H_WIN + j; j -= H_WIN;
    if (j < H_WPA) return CJ_WIN + layer * H_WPA + j; j -= H_WPA;
    if (j < H_WPA) return CJ_WIN + CJ_WPA + layer * H_WPA + j; j -= H_WPA;
    if (j < H_WOUT) return CJ_WIN + CJ_WPA + CJ_WPB + layer * H_WOUT + j; j -= H_WOUT;
    if (j < H_W1) return CJ_WIN + CJ_WPA + CJ_WPB + CJ_WOUT + layer * H_W1 + j; j -= H_W1;
    return CJ_WIN + CJ_WPA + CJ_WPB + CJ_WOUT + CJ_W1 + layer * H_W2 + j;
}
constexpr int CJ_SMALL = (CJ_WIN + CJ_WPA + CJ_WPB + CJ_WOUT) / DEPTH;
constexpr int BG_A = CJ_W2 / DEPTH, BG_B = BG_A + CJ_SMALL, BG_C = BG_B + CJ_W1 / DEPTH, BG_E = BG_C + CJ_W2 / DEPTH;
constexpr int CJ_PH0 = CJ_SMALL + CJ_W1 / DEPTH;
__device__ __forceinline__ int bg_job_index(const int t) {
    constexpr int B1 = CJ_WIN + CJ_WPA + CJ_WPB + CJ_WOUT, B2 = B1 + CJ_W1;
    if (t < BG_A) return B2 + t;
    if (t < BG_B) return layer_job(1, t - BG_A);
    if (t < BG_C) return B1 + CJ_W1 / DEPTH + (t - BG_B);
    return B2 + CJ_W2 / DEPTH + (t - BG_C);
}
__device__ __forceinline__ int ph0_job_index(const int j) { return j < CJ_SMALL ? layer_job(0, j) : (CJ_WIN + CJ_WPA + CJ_WPB + CJ_WOUT) + (j - CJ_SMALL); }
__device__ __forceinline__ void bg_convert(unsigned char* ldsb, const int tid_in, const bool use_stop, unsigned stop_off, const unsigned stop_val, const int limit) {
    int tid = tid_in; asm volatile("" : "+v"(tid));
    typedef __attribute__((address_space(4))) const unsigned long long* kaptr_t;
    kaptr_t ka = (kaptr_t)__builtin_amdgcn_kernarg_segment_ptr(); asm volatile("" : "+s"(ka));
    const float* const* in = (const float* const*)ka;
    unsigned char* ws = (unsigned char*)ka[21];
    unsigned* q = (unsigned*)(ws + WS_CTL) + CW_BGQ; unsigned* stop = use_stop ? (unsigned*)(ws + WS_CTL) + stop_off : nullptr;
    bf16_t* lt = (bf16_t*)ldsb;
    volatile int* tk = (volatile int*)(ldsb + LDS_BYTES - 64);
    f32x4 v[8];
    __syncthreads();
    if (tid == 0) { int t = -1; if (stop ? (__hip_atomic_load(stop, __ATOMIC_RELAXED, __HIP_MEMORY_SCOPE_AGENT) == stop_val) : ((int)__hip_atomic_load(q, __ATOMIC_RELAXED, __HIP_MEMORY_SCOPE_AGENT) < limit)) { t = (int)atomicAdd(q, 1u); if (t >= BG_E) t = -1; } *tk = t; }
    __syncthreads();
    int J = __builtin_amdgcn_readfirstlane(*tk);
    CvtJob cur = cvt_job(bg_job_index(J < 0 ? 0 : J), in, ws);
    if (J >= 0) cvt_load(cur, tid, v);
    while (J >= 0) {
        {
            const int i = tid >> 3, c0 = (tid & 7) * 32;
#pragma unroll
            for (int qq = 0; qq < 8; qq += 2) { u32x4 w; w.x = pg8::cvt_pk_bf16(v[qq][0], v[qq][1]); w.y = pg8::cvt_pk_bf16(v[qq][2], v[qq][3]); w.z = pg8::cvt_pk_bf16(v[qq + 1][0], v[qq + 1][1]); w.w = pg8::cvt_pk_bf16(v[qq + 1][2], v[qq + 1][3]);
                *(u32x4*)(lt + i * 264 + c0 + 4 * qq) = w; }
        }
        if (tid == 0) { int t = -1; if (stop ? (__hip_atomic_load(stop, __ATOMIC_RELAXED, __HIP_MEMORY_SCOPE_AGENT) == stop_val) : ((int)__hip_atomic_load(q, __ATOMIC_RELAXED, __HIP_MEMORY_SCOPE_AGENT) < limit)) { t = (int)atomicAdd(q, 1u); if (t >= BG_E) t = -1; } *tk = t; }
        __syncthreads();
        const CvtJob me = cur; const int Jn = __builtin_amdgcn_readfirstlane(*tk);
        if (Jn >= 0) { cur = cvt_job(bg_job_index(Jn), in, ws); cvt_load(cur, tid, v); }
        {
            const int n = tid & 255, kh = tid >> 8;
            unsigned w[16];
#pragma unroll
            for (int qq = 0; qq < 16; ++qq) w[qq] = (unsigned)lt[(kh * 32 + 2 * qq) * 264 + n] | ((unsigned)lt[(kh * 32 + 2 * qq + 1) * 264 + n] << 16);
            bf16_t* dp = me.dst + (size_t)n * me.K + kh * 32;
#pragma unroll
            for (int qq = 0; qq < 4; ++qq) { u32x4 o; o.x = w[4 * qq]; o.y = w[4 * qq + 1]; o.z = w[4 * qq + 2]; o.w = w[4 * qq + 3]; *(u32x4*)(dp + 8 * qq) = o; }
        }
        __syncthreads();
        J = Jn;
    }
}

__device__ __forceinline__ void hgrn_prep_item(const bf16_t* __restrict__ zb, const float* __restrict__ lbv, bf16_t* __restrict__ qeg, bf16_t* __restrict__ keg, bf16_t* __restrict__ ketg, float* __restrict__ hvec,
                                               float* ex  , const int b, const int h, const int c, const int tid) {
    const int lane = tid & 63, wave = __builtin_amdgcn_readfirstlane(tid >> 6);
    const int tg = wave >> 1, d = (wave & 1) * 64 + lane;
    const float lb = lbv[h * 128 + d], oml = 1.0f - lb;
    const int row0 = b * SEQ + c * 64 + 16 * tg;
    const bf16_t* fbase = zb + (size_t)row0 * ZLD + C_FA + h * 128;
    const bf16_t* qbase = zb + (size_t)row0 * ZLD + C_QA + h * 128;
    float g[16], kk[16], qv[16]; float run = 0.f;
#pragma unroll
    for (int j = 0; j < 16; ++j) {
        const float zf = fminf(fmaxf(bf2f((fbase + (size_t)j * ZLD)[d]), -60.f), 60.f), zq = bf2f((qbase + (size_t)j * ZLD)[d]);
        const float e = __builtin_amdgcn_exp2f(-1.4426950408889634f * zf), sg = __builtin_amdgcn_rcpf(1.0f + e);
        run += 0.6931471805599453f * __builtin_amdgcn_logf(lb + oml * sg); g[j] = run; kk[j] = oml * e * sg; qv[j] = zq * sigmoidf_(zq);
    }
    __syncthreads();
    ex[tg * 128 + d] = run;
    __syncthreads();
    const float e0 = ex[d], e1 = ex[128 + d], e2 = ex[256 + d], e3 = ex[384 + d];
    const float pre = tg == 0 ? 0.f : tg == 1 ? e0 : tg == 2 ? e0 + e1 : e0 + e1 + e2;
    const float r = e0 + e1, tot = (e0 + e1) + (e2 + e3);
    unsigned kt[8];
    bf16_t* qo = qeg + (size_t)row0 * 512 + h * 128 + d; bf16_t* ko = keg + (size_t)row0 * 512 + h * 128 + d;
#pragma unroll
    for (int j = 0; j < 16; j += 2) {
        const float bt0 = pre + g[j], bt1 = pre + g[j + 1];
        const float L2E = 1.4426950408889634f;
        const float qe0 = qv[j] * __builtin_amdgcn_exp2f(L2E * fminf(bt0 - r, 80.f)), qe1 = qv[j + 1] * __builtin_amdgcn_exp2f(L2E * fminf(bt1 - r, 80.f));
        const float ke0 = kk[j] * __builtin_amdgcn_exp2f(L2E * fminf(r - bt0, 80.f)), ke1 = kk[j + 1] * __builtin_amdgcn_exp2f(L2E * fminf(r - bt1, 80.f));
        const unsigned qp = pg8::cvt_pk_bf16(qe0, qe1), kp = pg8::cvt_pk_bf16(ke0, ke1);
        qo[(size_t)j * 512] = (bf16_t)(qp & 0xffffu); qo[(size_t)(j + 1) * 512] = (bf16_t)(qp >> 16);
        ko[(size_t)j * 512] = (bf16_t)(kp & 0xffffu); ko[(size_t)(j + 1) * 512] = (bf16_t)(kp >> 16);
        kt[j >> 1] = kp;
    }
    const size_t item = ((size_t)(b * 4 + h) * 32 + c);
    u32x4 w0, w1; w0.x = kt[0]; w0.y = kt[1]; w0.z = kt[2]; w0.w = kt[3]; w1.x = kt[4]; w1.y = kt[5]; w1.z = kt[6]; w1.w = kt[7];
    bf16_t* kto = ketg + item * (128 * 64) + d * 64 + 16 * tg;
    *(u32x4*)kto = w0; *(u32x4*)(kto + 8) = w1;
    if (tg == 0) { float* hv = hvec + item * 384; hv[d] = __expf(r); hv[128 + d] = __expf(tot); hv[256 + d] = __expf(tot - r); }
}

__device__ __forceinline__ void hgrn_item(const bf16_t* __restrict__ zb, const bf16_t* __restrict__ qeg, const bf16_t* __restrict__ keg, const bf16_t* __restrict__ ketg, const float* __restrict__ hvec,
                                          const float* __restrict__ hnw, bf16_t* __restrict__ ha, unsigned char* ldsb, const int b, const int h, const int tid) {
    typedef unsigned long long u64;
    const int lane = tid & 63, wave = __builtin_amdgcn_readfirstlane(tid >> 6), r31 = lane & 31, hh = lane >> 5;
    bf16_t* QE = (bf16_t*)ldsb;
    bf16_t* KE = QE + 64 * 136;
    bf16_t* KET = KE + 64 * 136;
    bf16_t* VT = KET + 128 * 72;
    bf16_t* SBT = VT + 128 * 72;
    float* er = (float*)(SBT + 128 * 136); float* el = er + 128; float* elr = el + 128;
    float* ssq = elr + 128;
    const int lt = tid >> 3, lp = tid & 7, kd = tid >> 2, kp = tid & 3;
    const bf16_t* gq = qeg + (size_t)(b * SEQ + lt) * 512 + h * 128 + lp * 8;
    const bf16_t* gk = keg + (size_t)(b * SEQ + lt) * 512 + h * 128 + lp * 8;
    const bf16_t* gt = ketg + (size_t)(b * 4 + h) * 32 * (128 * 64) + kd * 64 + kp * 8;
    const float* gv = hvec + (size_t)(b * 4 + h) * 32 * 384;
    const int v0 = wave * 16;
    const bf16_t* vbase = zb + (size_t)(b * SEQ) * ZLD + C_IA + h * 128 + v0;
    const unsigned voff = (unsigned)lane * ZLD;
    u32x4 nq0, nq1, nk0, nk1, nt0, nt1, nv0, nv1; f32x4 nvec = {0.f, 0.f, 0.f, 0.f};
    nq0 = *(const u32x4*)gq; nq1 = *(const u32x4*)(gq + 64); nk0 = *(const u32x4*)gk; nk1 = *(const u32x4*)(gk + 64); nt0 = *(const u32x4*)gt; nt1 = *(const u32x4*)(gt + 32);
    nv0 = *(const u32x4*)(vbase + voff); nv1 = *(const u32x4*)(vbase + voff + 8);
    if (tid < 96) nvec = *(const f32x4*)(gv + tid * 4);
    const int tt = wave & 1, oq = wave >> 1, dq = wave & 3, sv = wave >> 2;
    f32x4 hw4[4];
#pragma unroll
    for (int g4 = 0; g4 < 4; ++g4) hw4[g4] = *(const f32x4*)(hnw + h * 128 + 32 * oq + 4 * hh + 8 * g4);
    f32x16 S0, S1;
#pragma unroll
    for (int i = 0; i < 16; ++i) { S0[i] = 0.f; S1[i] = 0.f; }
    for (int c = 0; c < SEQ / 64; ++c) {
        const int row0 = b * SEQ + c * 64;
        *(u32x4*)(QE + lt * 136 + lp * 8) = nq0; *(u32x4*)(QE + lt * 136 + 64 + lp * 8) = nq1;
        *(u32x4*)(KE + lt * 136 + lp * 8) = nk0; *(u32x4*)(KE + lt * 136 + 64 + lp * 8) = nk1;
        *(u32x4*)(KET + kd * 72 + kp * 8) = nt0; *(u32x4*)(KET + kd * 72 + 32 + kp * 8) = nt1;
        if (tid < 96) *(f32x4*)(er + tid * 4) = nvec;
        { const unsigned vw[8] = {nv0.x, nv0.y, nv0.z, nv0.w, nv1.x, nv1.y, nv1.z, nv1.w};
#pragma unroll
          for (int q = 0; q < 8; ++q) { VT[(v0 + 2 * q) * 72 + lane] = (bf16_t)(vw[q] & 0xffffu); VT[(v0 + 2 * q + 1) * 72 + lane] = (bf16_t)(vw[q] >> 16); } }
        __syncthreads();
        u64 gw[4];
        {
            const bf16_t* gp = zb + (size_t)(row0 + 32 * tt + r31) * ZLD + C_GA + h * 128 + 32 * oq + 4 * hh;
#pragma unroll
            for (int g4 = 0; g4 < 4; ++g4) gw[g4] = *(const u64*)(gp + 8 * g4);
        }
        if (c + 1 < SEQ / 64) {
            const size_t ro = (size_t)(c + 1) * 64 * 512;
            nq0 = *(const u32x4*)(gq + ro); nq1 = *(const u32x4*)(gq + ro + 64); nk0 = *(const u32x4*)(gk + ro); nk1 = *(const u32x4*)(gk + ro + 64);
            nt0 = *(const u32x4*)(gt + (size_t)(c + 1) * (128 * 64)); nt1 = *(const u32x4*)(gt + (size_t)(c + 1) * (128 * 64) + 32);
            nv0 = *(const u32x4*)(vbase + (size_t)(c + 1) * 64 * ZLD + voff); nv1 = *(const u32x4*)(vbase + (size_t)(c + 1) * 64 * ZLD + voff + 8);
            if (tid < 96) nvec = *(const f32x4*)(gv + (size_t)(c + 1) * 384 + tid * 4);
        }
#pragma unroll
        for (int ti = 0; ti < 2; ++ti) {
            const int vq = 2 * sv + ti;
#pragma unroll
            for (int g4 = 0; g4 < 4; ++g4) {
                const int dd = 32 * dq + 8 * g4 + 4 * hh;
                const float s0 = ti ? S1[4 * g4] : S0[4 * g4], s1 = ti ? S1[4 * g4 + 1] : S0[4 * g4 + 1], s2 = ti ? S1[4 * g4 + 2] : S0[4 * g4 + 2], s3 = ti ? S1[4 * g4 + 3] : S0[4 * g4 + 3];
                const unsigned a0 = pg8::cvt_pk_bf16(er[dd] * s0, er[dd + 1] * s1), a1 = pg8::cvt_pk_bf16(er[dd + 2] * s2, er[dd + 3] * s3);
                *(u64*)(SBT + (32 * vq + r31) * 136 + dd) = (u64)a0 | ((u64)a1 << 32);
            }
        }
        __syncthreads();
        f32x16 Oacc;
#pragma unroll
        for (int i = 0; i < 16; ++i) Oacc[i] = 0.f;
        {
            bf16x8 qf[8];
#pragma unroll
            for (int ks = 0; ks < 8; ++ks) qf[ks] = *(const bf16x8*)(QE + (32 * tt + r31) * 136 + 16 * ks + 8 * hh);
#pragma unroll
            for (int ks = 0; ks < 8; ++ks) { const bf16x8 sa = *(const bf16x8*)(SBT + (32 * oq + r31) * 136 + 16 * ks + 8 * hh); Oacc = __builtin_amdgcn_mfma_f32_32x32x16_bf16(sa, qf[ks], Oacc, 0, 0, 0); }
            for (int st = 0; st <= tt; ++st) {
                f32x16 At;
#pragma unroll
                for (int i = 0; i < 16; ++i) At[i] = 0.f;
#pragma unroll
                for (int ks = 0; ks < 8; ++ks) { const bf16x8 ka = *(const bf16x8*)(KE + (32 * st + r31) * 136 + 16 * ks + 8 * hh); At = __builtin_amdgcn_mfma_f32_32x32x16_bf16(ka, qf[ks], At, 0, 0, 0); }
                if (st == tt) {
#pragma unroll
                    for (int i = 0; i < 16; ++i) { const int sl = (i & 3) + 8 * (i >> 2) + 4 * hh; if (sl > r31) At[i] = 0.f; }
                }
                union { unsigned u[4]; bf16x8 v; } pb0, pb1;
#pragma unroll
                for (int j = 0; j < 4; ++j) { pb0.u[j] = pg8::cvt_pk_bf16(At[2 * j], At[2 * j + 1]); pb1.u[j] = pg8::cvt_pk_bf16(At[8 + 2 * j], At[8 + 2 * j + 1]); }
                union { u64 q[2]; bf16x8 v; } a0, a1;
                const bf16_t* vr = VT + (32 * oq + r31) * 72 + 32 * st + 4 * hh;
                a0.q[0] = *(const u64*)(vr); a0.q[1] = *(const u64*)(vr + 8); a1.q[0] = *(const u64*)(vr + 16); a1.q[1] = *(const u64*)(vr + 24);
                Oacc = __builtin_amdgcn_mfma_f32_32x32x16_bf16(a0.v, pb0.v, Oacc, 0, 0, 0);
                Oacc = __builtin_amdgcn_mfma_f32_32x32x16_bf16(a1.v, pb1.v, Oacc, 0, 0, 0);
            }
        }
        {
            float q2 = 0.f;
#pragma unroll
            for (int i = 0; i < 16; ++i) q2 += Oacc[i] * Oacc[i];
            q2 += __shfl_xor(q2, 32);
            if (hh == 0) ssq[(32 * tt + r31) * 4 + oq] = q2;
        }
        {
            f32x16 d0, d1;
#pragma unroll
            for (int i = 0; i < 16; ++i) { d0[i] = 0.f; d1[i] = 0.f; }
#pragma unroll
            for (int ks = 0; ks < 4; ++ks) {
                const bf16x8 ka = *(const bf16x8*)(KET + (32 * dq + r31) * 72 + 16 * ks + 8 * hh);
                const bf16x8 vb0 = *(const bf16x8*)(VT + (64 * sv + r31) * 72 + 16 * ks + 8 * hh), vb1 = *(const bf16x8*)(VT + (64 * sv + 32 + r31) * 72 + 16 * ks + 8 * hh);
                d0 = __builtin_amdgcn_mfma_f32_32x32x16_bf16(ka, vb0, d0, 0, 0, 0); d1 = __builtin_amdgcn_mfma_f32_32x32x16_bf16(ka, vb1, d1, 0, 0, 0);
            }
#pragma unroll
            for (int i = 0; i < 16; ++i) { const int dd = 32 * dq + (i & 3) + 8 * (i >> 2) + 4 * hh; const float a = el[dd], bb = elr[dd]; S0[i] = a * S0[i] + bb * d0[i]; S1[i] = a * S1[i] + bb * d1[i]; }
        }
        __syncthreads();
        {
            const int t = 32 * tt + r31;
            const f32x4 sq = *(const f32x4*)(ssq + t * 4);
            const float rn = rsqrtf(((sq[0] + sq[1]) + (sq[2] + sq[3])) * (1.0f / 128.0f) + EPS);
            const int vcol = h * 128 + 32 * oq + 4 * hh;
            bf16_t* op = ha + (size_t)(row0 + t) * D + vcol;
#pragma unroll
            for (int g4 = 0; g4 < 4; ++g4) {
                const f32x4 w4 = hw4[g4];
                float o[4];
#pragma unroll
                for (int j = 0; j < 4; ++j) { const float gg = bf2f((bf16_t)((gw[g4] >> (16 * j)) & 0xffffu)); o[j] = Oacc[4 * g4 + j] * rn * w4[j] * (gg * sigmoidf_(gg)); }
                *(u64*)(op + 8 * g4) = (u64)pg8::cvt_pk_bf16(o[0], o[1]) | ((u64)pg8::cvt_pk_bf16(o[2], o[3]) << 32);
            }
        }
    }
    __syncthreads();
}

#define DPP_STEP(v, op, ctrl) v = v op __builtin_amdgcn_update_dpp(v, v, ctrl, 0xf, 0xf, false)
__device__ __forceinline__ int wave_sum_dpp(int v) { DPP_STEP(v, +, 0xB1); DPP_STEP(v, +, 0x4E); DPP_STEP(v, +, 0x141); DPP_STEP(v, +, 0x140);
    return __builtin_amdgcn_readlane(v, 0) + __builtin_amdgcn_readlane(v, 16) + __builtin_amdgcn_readlane(v, 32) + __builtin_amdgcn_readlane(v, 48); }
__device__ __forceinline__ int wave_and_u(int v) { DPP_STEP(v, &, 0xB1); DPP_STEP(v, &, 0x4E); DPP_STEP(v, &, 0x141); DPP_STEP(v, &, 0x140);
    return __builtin_amdgcn_readlane(v, 0) & __builtin_amdgcn_readlane(v, 16) & __builtin_amdgcn_readlane(v, 32) & __builtin_amdgcn_readlane(v, 48); }
__device__ __forceinline__ int wave_or_u(int v) { DPP_STEP(v, |, 0xB1); DPP_STEP(v, |, 0x4E); DPP_STEP(v, |, 0x141); DPP_STEP(v, |, 0x140);
    return __builtin_amdgcn_readlane(v, 0) | __builtin_amdgcn_readlane(v, 16) | __builtin_amdgcn_readlane(v, 32) | __builtin_amdgcn_readlane(v, 48); }


#define CNT8(OP, cl, cand, k) do { unsigned long long m0_, m1_, m2_, m3_, m4_, m5_, m6_, m7_, dd_; \
    asm volatile("v_cmp_" OP "_u32_e64 %[m0], %[k0], %[c]\n\tv_cmp_" OP "_u32_e64 %[m1], %[k1], %[c]\n\tv_cmp_" OP "_u32_e64 %[m2], %[k2], %[c]\n\tv_cmp_" OP "_u32_e64 %[m3], %[k3], %[c]\n\t" \
                 "v_cmp_" OP "_u32_e64 %[m4], %[k4], %[c]\n\tv_cmp_" OP "_u32_e64 %[m5], %[k5], %[c]\n\tv_cmp_" OP "_u32_e64 %[m6], %[k6], %[c]\n\tv_cmp_" OP "_u32_e64 %[m7], %[k7], %[c]\n\t" \
                 "v_addc_co_u32_e64 %[a], %[dd], %[a], 0, %[m0]\n\tv_addc_co_u32_e64 %[a], %[dd], %[a], 0, %[m1]\n\tv_addc_co_u32_e64 %[a], %[dd], %[a], 0, %[m2]\n\tv_addc_co_u32_e64 %[a], %[dd], %[a], 0, %[m3]\n\t" \
                 "v_addc_co_u32_e64 %[a], %[dd], %[a], 0, %[m4]\n\tv_addc_co_u32_e64 %[a], %[dd], %[a], 0, %[m5]\n\tv_addc_co_u32_e64 %[a], %[dd], %[a], 0, %[m6]\n\tv_addc_co_u32_e64 %[a], %[dd], %[a], 0, %[m7]\n\t" \
                 : [a] "+v"(cl), [m0] "=&s"(m0_), [m1] "=&s"(m1_), [m2] "=&s"(m2_), [m3] "=&s"(m3_), [m4] "=&s"(m4_), [m5] "=&s"(m5_), [m6] "=&s"(m6_), [m7] "=&s"(m7_), [dd] "=&s"(dd_) \
                 : [k0] "v"((k)[0]), [k1] "v"((k)[1]), [k2] "v"((k)[2]), [k3] "v"((k)[3]), [k4] "v"((k)[4]), [k5] "v"((k)[5]), [k6] "v"((k)[6]), [k7] "v"((k)[7]), [c] "s"(cand)); } while (0)

#define SCNT8(OP, cnt, cand, k) do { unsigned long long m0_, m1_, m2_, m3_, m4_, m5_, m6_, m7_; int c0_, c1_, c2_, c3_, c4_, c5_, c6_, c7_; \
    asm volatile("v_cmp_" OP "_u32_e64 %[m0], %[k0], %[c]\n\tv_cmp_" OP "_u32_e64 %[m1], %[k1], %[c]\n\tv_cmp_" OP "_u32_e64 %[m2], %[k2], %[c]\n\tv_cmp_" OP "_u32_e64 %[m3], %[k3], %[c]\n\t" \
                 "v_cmp_" OP "_u32_e64 %[m4], %[k4], %[c]\n\tv_cmp_" OP "_u32_e64 %[m5], %[k5], %[c]\n\tv_cmp_" OP "_u32_e64 %[m6], %[k6], %[c]\n\tv_cmp_" OP "_u32_e64 %[m7], %[k7], %[c]\n\t" \
                 "s_bcnt1_i32_b64 %[c0], %[m0]\n\ts_bcnt1_i32_b64 %[c1], %[m1]\n\ts_bcnt1_i32_b64 %[c2], %[m2]\n\ts_bcnt1_i32_b64 %[c3], %[m3]\n\t" \
                 "s_bcnt1_i32_b64 %[c4], %[m4]\n\ts_bcnt1_i32_b64 %[c5], %[m5]\n\ts_bcnt1_i32_b64 %[c6], %[m6]\n\ts_bcnt1_i32_b64 %[c7], %[m7]\n\t" \
                 : [m0] "=&s"(m0_), [m1] "=&s"(m1_), [m2] "=&s"(m2_), [m3] "=&s"(m3_), [m4] "=&s"(m4_), [m5] "=&s"(m5_), [m6] "=&s"(m6_), [m7] "=&s"(m7_), \
                   [c0] "=&s"(c0_), [c1] "=&s"(c1_), [c2] "=&s"(c2_), [c3] "=&s"(c3_), [c4] "=&s"(c4_), [c5] "=&s"(c5_), [c6] "=&s"(c6_), [c7] "=&s"(c7_) \
                 : [k0] "v"((k)[0]), [k1] "v"((k)[1]), [k2] "v"((k)[2]), [k3] "v"((k)[3]), [k4] "v"((k)[4]), [k5] "v"((k)[5]), [k6] "v"((k)[6]), [k7] "v"((k)[7]), [c] "s"(cand) : "scc"); \
    cnt += ((c0_ + c1_) + (c2_ + c3_)) + ((c4_ + c5_) + (c6_ + c7_)); } while (0)

__device__ __forceinline__ unsigned ordered_key(float f) { const unsigned u = __float_as_uint(f); return (u & 0x80000000u) ? ~u : (u | 0x80000000u); }
__device__ __forceinline__ void indexer_unit(const bf16_t* __restrict__ zb, unsigned* __restrict__ maskp, unsigned* sc  , bf16_t* ring  ,
                                             const int b, const int t0, const int tid) {
    typedef unsigned long long u64;
    const int lane = tid & 63, wave = tid >> 6;
    const int r31 = lane & 31, hh = lane >> 5;
    constexpr int IDX_TILE = 32 * 72, IDX_SLOT = 2 * IDX_TILE;
    unsigned* hist = (unsigned*)ring + wave * 256;
    {
        const int g = wave & 3, par = wave >> 2;
        const int head = (r31 & 3) + 4 * ((r31 >> 3) & 1), ql = 2 * ((r31 >> 4) & 1) + ((r31 >> 2) & 1);
        const bf16_t* ap = zb + (size_t)(b * SEQ + t0 + 4 * g + ql) * ZLD + C_IQ + head * 64 + 8 * hh;
        bf16x8 a[4];
#pragma unroll
        for (int s4 = 0; s4 < 4; ++s4) a[s4] = *(const bf16x8*)(ap + 16 * s4);
        float wq[16];
        {
            const int qa = t0 + 4 * g + hh, qb = qa + 2;
            f32x4 w0, w1, w2, w3; pg8::bf8_to_f32(*(const u32x4*)(zb + (size_t)(b * SEQ + qa) * ZLD + C_IW), w0, w1); pg8::bf8_to_f32(*(const u32x4*)(zb + (size_t)(b * SEQ + qb) * ZLD + C_IW), w2, w3);
#pragma unroll
            for (int i = 0; i < 4; ++i) { wq[i] = w0[i] * 0.04419417382415922f; wq[4 + i] = w1[i] * 0.04419417382415922f; wq[8 + i] = w2[i] * 0.04419417382415922f; wq[12 + i] = w3[i] * 0.04419417382415922f; }
        }
        const int ta = t0 + 4 * g + hh, tb_ = ta + 2;
        const int kt_max = (t0 + 15) >> 5, nit = (kt_max >> 1) + 1;
        const int lsub = tid >> 8, lkey = (tid & 255) >> 3, lpc = tid & 7;
        const bf16_t* gsrc = zb + ((size_t)b * SEQ + lsub * 32 + lkey) * ZLD + C_IK + lpc * 8;
        const int loff = lsub * IDX_TILE + lkey * 72 + lpc * 8;
        u32x4 stg;
        __syncthreads();
        if (lsub <= kt_max) { stg = *(const u32x4*)gsrc; *(u32x4*)(ring + loff) = stg; }
        if (nit > 1 && 2 + lsub <= kt_max) { stg = *(const u32x4*)(gsrc + (size_t)64 * ZLD); *(u32x4*)(ring + IDX_SLOT + loff) = stg; }
        __syncthreads();
        for (int it = 0; it < nit; ++it) {
            const bool more = (it + 2 < nit) && (2 * (it + 2) + lsub <= kt_max);
            if (more) stg = *(const u32x4*)(gsrc + (size_t)(it + 2) * 64 * ZLD);
            const int kt = 2 * it + par;
            if (kt <= kt_max) {
                const bf16_t* tl = ring + (it % 3) * IDX_SLOT + par * IDX_TILE + r31 * 72 + 8 * hh;
                f32x16 acc;
#pragma unroll
                for (int q = 0; q < 16; ++q) acc[q] = 0.f;
#pragma unroll
                for (int s4 = 0; s4 < 4; ++s4) { const bf16x8 bk = *(const bf16x8*)(tl + 16 * s4); acc = __builtin_amdgcn_mfma_f32_32x32x16_bf16(a[s4], bk, acc, 0, 0, 0); }
                float sa = 0.f, sb = 0.f;
#pragma unroll
                for (int i = 0; i < 8; ++i) { sa += wq[i] * fmaxf(acc[i], 0.f); sb += wq[8 + i] * fmaxf(acc[8 + i], 0.f); }
                const int key = kt * 32 + r31;
                sc[(4 * g + hh) * 2048 + key] = key <= ta ? ordered_key(sa) : 0u;
                sc[(4 * g + 2 + hh) * 2048 + key] = key <= tb_ ? ordered_key(sb) : 0u;
            }
            if (more) *(u32x4*)(ring + ((it + 2) % 3) * IDX_SLOT + loff) = stg;
            __syncthreads();
        }
    }
    for (int srep_ = 0; srep_ < (PROBE_GROUP == 8 ? 2 : 1); ++srep_)
    for (int qq = 2 * wave; qq < 2 * wave + 2; ++qq) {
        const int t = t0 + qq;
        unsigned kreg[32];
#pragma unroll
        for (int i = 0; i < 32; ++i) kreg[i] = sc[qq * 2048 + lane + 64 * i];
        asm volatile("" ::: "memory");
#pragma unroll
        for (int i = 0; i < 32; ++i) kreg[i] = (lane + 64 * i <= t) ? kreg[i] : 0u;
        const int ngrp = __builtin_amdgcn_readfirstlane((t >> 9) + 1);
        unsigned kand = 0xffffffffu, kor = 0u;
#pragma unroll
        for (int i = 0; i < 32; ++i) { if (lane + 64 * i <= t) { kand &= kreg[i]; kor |= kreg[i]; } }
        kand = (unsigned)wave_and_u(kand); kor = (unsigned)wave_or_u(kor);
        const unsigned diff = kand ^ kor;
        unsigned prefix; int hb;
        if (diff == 0u) { prefix = kor; hb = -1; } else { hb = 31 - __builtin_clz(diff); prefix = (hb == 31) ? 0u : (kor & ~((2u << hb) - 1u)); }
        bool exact = false;
        for (int bit = hb; bit >= 0; --bit) {
            const unsigned cand = prefix | (1u << bit);
            int cnt = 0;
            SCNT8("ge", cnt, cand, kreg); if (ngrp > 1) SCNT8("ge", cnt, cand, kreg + 8); if (ngrp > 2) SCNT8("ge", cnt, cand, kreg + 16); if (ngrp > 3) SCNT8("ge", cnt, cand, kreg + 24);
            if (cnt >= 256) prefix = cand;
            if (cnt == 256) { exact = true; break; }
        }
        int kk = 0;
        if (!exact) { int cg = 0;
            SCNT8("gt", cg, prefix, kreg); if (ngrp > 1) SCNT8("gt", cg, prefix, kreg + 8); if (ngrp > 2) SCNT8("gt", cg, prefix, kreg + 16); if (ngrp > 3) SCNT8("gt", cg, prefix, kreg + 24);
            kk = 256 - cg; }
        const unsigned gtv = exact ? prefix - 1u : prefix;
        unsigned myword = 0u; int eqbefore = 0;
#pragma unroll
        for (int gi = 0; gi < 4; ++gi) {
            if (gi < ngrp) {
                if (exact) {
#pragma unroll
                    for (int i = 8 * gi; i < 8 * gi + 8; ++i) { const unsigned long long bs = __ballot(kreg[i] > gtv); if (lane == 2 * i) myword = (unsigned)bs; if (lane == 2 * i + 1) myword = (unsigned)(bs >> 32); }
                } else {
#pragma unroll
                    for (int i = 8 * gi; i < 8 * gi + 8; ++i) {
                        const bool eq = kreg[i] == prefix;
                        const unsigned long long beq = __ballot(eq);
                        const int rank = eqbefore + __popcll(beq & ((1ull << lane) - 1ull));
                        const bool sel = kreg[i] > gtv || (eq && rank < kk);
                        const unsigned long long bs = __ballot(sel);
                        eqbefore += __popcll(beq);
                        if (lane == 2 * i) myword = (unsigned)bs;
                        if (lane == 2 * i + 1) myword = (unsigned)(bs >> 32);
                    }
                }
            }
        }
        maskp[(size_t)(b * SEQ + t) * 64 + lane] = myword;
    }
    __syncthreads();
}

constexpr int ATT_KROW = 72, ATT_VROW = 68, ATT_SLOT = 64 * ATT_KROW + 64 * ATT_VROW;
__device__ __forceinline__ void attn_block(const bf16_t* __restrict__ zb, const bf16_t* __restrict__ vbt, const unsigned* __restrict__ maskp, bf16_t* __restrict__ att, const float* tb  ,
                                           bf16_t* ring  , const int b, const int qt, const int tid) {
    typedef unsigned long long u64;
    const int lane = tid & 63, wave = tid >> 6;
    const int c = lane & 31, hh = lane >> 5, h = c & 7;
    const int t0w = qt * 32 + 4 * wave;
    const int tq = t0w + (c >> 3);
    const size_t rowq = (size_t)b * SEQ + tq;
    bf16x8 bq[4];
#pragma unroll
    for (int s4 = 0; s4 < 4; ++s4) bq[s4] = *(const bf16x8*)(zb + rowq * ZLD + C_QB + h * 64 + 16 * s4 + 8 * hh);
    const int nstep = (qt >> 1) + 1;
    const float bfar = tb[127 * 8 + h];
    const float QS = 0.125f * 1.4426950408889634f;
    float m = -1e30f, lsum = 0.f;
    f32x16 O0, O1;
#pragma unroll
    for (int q = 0; q < 16; ++q) { O0[q] = 0.f; O1[q] = 0.f; }
    const u64* mbase = (const u64*)(maskp + rowq * 64);
    const int lrow = tid >> 3, lpc = tid & 7;
    const bf16_t* gk = zb + ((size_t)b * SEQ + lrow) * ZLD + C_KB + lpc * 8;
    const bf16_t* gv = vbt + ((size_t)b * 64 + lrow) * SEQ + lpc * 8;
    const int lk = lrow * ATT_KROW + lpc * 8, lv = 64 * ATT_KROW + lrow * ATT_VROW + lpc * 8;
    u32x4 sk = *(const u32x4*)gk, sv = *(const u32x4*)gv;
    { *(u32x4*)(ring + lk) = sk; u64* d = (u64*)(ring + lv); d[0] = (u64)sv.x | ((u64)sv.y << 32); d[1] = (u64)sv.z | ((u64)sv.w << 32); }
    if (nstep > 1) { sk = *(const u32x4*)(gk + (size_t)64 * ZLD); sv = *(const u32x4*)(gv + 64);
        *(u32x4*)(ring + ATT_SLOT + lk) = sk; u64* d = (u64*)(ring + ATT_SLOT + lv); d[0] = (u64)sv.x | ((u64)sv.y << 32); d[1] = (u64)sv.z | ((u64)sv.w << 32); }
    u64 mw2 = mbase[0];
    __syncthreads();
    for (int st = 0; st < nstep; ++st) {
        const int key0 = st * 64;
        const bf16_t* sl = ring + (st % 3) * ATT_SLOT;
        const bool more = st + 2 < nstep;
        if (more) { sk = *(const u32x4*)(gk + (size_t)(st + 2) * 64 * ZLD); sv = *(const u32x4*)(gv + (st + 2) * 64); }
        const unsigned cm0 = (unsigned)mw2 >> (4 * hh), cm1 = (unsigned)(mw2 >> 32) >> (4 * hh);
        mw2 = mbase[st + 1 < nstep ? st + 1 : st];
        f32x16 S0, S1;
#pragma unroll
        for (int q = 0; q < 16; ++q) { S0[q] = 0.f; S1[q] = 0.f; }
#pragma unroll
        for (int s4 = 0; s4 < 4; ++s4) {
            const bf16x8 k0 = *(const bf16x8*)(sl + c * ATT_KROW + 16 * s4 + 8 * hh), k1 = *(const bf16x8*)(sl + (32 + c) * ATT_KROW + 16 * s4 + 8 * hh);
            S0 = __builtin_amdgcn_mfma_f32_32x32x16_bf16(k0, bq[s4], S0, 0, 0, 0);
            S1 = __builtin_amdgcn_mfma_f32_32x32x16_bf16(k1, bq[s4], S1, 0, 0, 0);
        }
        float x0[16], x1[16]; float tmax = -1e30f;
        {
            float bs[16];
            if ((t0w - key0 - 31) < 113) {
                const int relb = tq - key0 - 4 * hh;
#pragma unroll
                for (int i = 0; i < 16; ++i) { int rel = relb - ((i & 3) + 8 * (i >> 2)); rel = rel < 0 ? 0 : (rel > 127 ? 127 : rel); bs[i] = tb[rel * 8 + h]; }
            } else {
#pragma unroll
                for (int i = 0; i < 16; ++i) bs[i] = bfar;
            }
#pragma unroll
            for (int i = 0; i < 16; ++i) { const int ko = (i & 3) + 8 * (i >> 2); const float xv = __builtin_fmaf(S0[i], QS, bs[i]); x0[i] = (cm0 & (1u << ko)) ? xv : -2e30f; tmax = fmaxf(tmax, x0[i]); }
        }
        {
            float bs[16];
            if ((t0w - key0 - 63) < 113) {
                const int relb = tq - key0 - 32 - 4 * hh;
#pragma unroll
                for (int i = 0; i < 16; ++i) { int rel = relb - ((i & 3) + 8 * (i >> 2)); rel = rel < 0 ? 0 : (rel > 127 ? 127 : rel); bs[i] = tb[rel * 8 + h]; }
            } else {
#pragma unroll
                for (int i = 0; i < 16; ++i) bs[i] = bfar;
            }
#pragma unroll
            for (int i = 0; i < 16; ++i) { const int ko = (i & 3) + 8 * (i >> 2); const float xv = __builtin_fmaf(S1[i], QS, bs[i]); x1[i] = (cm1 & (1u << ko)) ? xv : -2e30f; tmax = fmaxf(tmax, x1[i]); }
        }
        tmax = fmaxf(tmax, __shfl_xor(tmax, 32));
        const float mn = fmaxf(m, tmax);
        if (__ballot(mn > m) != 0ull) {
            const float scl = __builtin_amdgcn_exp2f(m - mn);
            lsum *= scl;
#pragma unroll
            for (int q = 0; q < 16; ++q) { O0[q] *= scl; O1[q] *= scl; }
        }
        m = mn;
        float p0[16], p1[16];
#pragma unroll
        for (int i = 0; i < 16; ++i) { const int ko = (i & 3) + 8 * (i >> 2);
            (void)ko; p0[i] = __builtin_amdgcn_exp2f(x0[i] - m); p1[i] = __builtin_amdgcn_exp2f(x1[i] - m); lsum += p0[i] + p1[i]; }
        union { unsigned u[4]; bf16x8 v; } pb00, pb01, pb10, pb11;
#pragma unroll
        for (int j = 0; j < 4; ++j) { pb00.u[j] = pg8::cvt_pk_bf16(p0[2 * j], p0[2 * j + 1]); pb01.u[j] = pg8::cvt_pk_bf16(p0[8 + 2 * j], p0[8 + 2 * j + 1]);
                                      pb10.u[j] = pg8::cvt_pk_bf16(p1[2 * j], p1[2 * j + 1]); pb11.u[j] = pg8::cvt_pk_bf16(p1[8 + 2 * j], p1[8 + 2 * j + 1]); }
        const bf16_t* vt = sl + 64 * ATT_KROW + c * ATT_VROW + 4 * hh;
#pragma unroll
        for (int sub = 0; sub < 2; ++sub) {
            union { u64 q[2]; bf16x8 v; } a00, a01, a10, a11;
            const bf16_t* vs = vt + 32 * sub;
            a00.q[0] = *(const u64*)(vs); a00.q[1] = *(const u64*)(vs + 8); a01.q[0] = *(const u64*)(vs + 16); a01.q[1] = *(const u64*)(vs + 24);
            a10.q[0] = *(const u64*)(vs + 32 * ATT_VROW); a10.q[1] = *(const u64*)(vs + 32 * ATT_VROW + 8); a11.q[0] = *(const u64*)(vs + 32 * ATT_VROW + 16); a11.q[1] = *(const u64*)(vs + 32 * ATT_VROW + 24);
            O0 = __builtin_amdgcn_mfma_f32_32x32x16_bf16(a00.v, sub ? pb10.v : pb00.v, O0, 0, 0, 0);
            O1 = __builtin_amdgcn_mfma_f32_32x32x16_bf16(a10.v, sub ? pb10.v : pb00.v, O1, 0, 0, 0);
            O0 = __builtin_amdgcn_mfma_f32_32x32x16_bf16(a01.v, sub ? pb11.v : pb01.v, O0, 0, 0, 0);
            O1 = __builtin_amdgcn_mfma_f32_32x32x16_bf16(a11.v, sub ? pb11.v : pb01.v, O1, 0, 0, 0);
        }
        if (more) { bf16_t* ds = ring + ((st + 2) % 3) * ATT_SLOT; *(u32x4*)(ds + lk) = sk; u64* d = (u64*)(ds + lv); d[0] = (u64)sv.x | ((u64)sv.y << 32); d[1] = (u64)sv.z | ((u64)sv.w << 32); }
        __syncthreads();
    }
    lsum += __shfl_xor(lsum, 32);
    const float inv = __builtin_amdgcn_rcpf(lsum);
    bf16_t* op = att + rowq * D + 512 + h * 64 + 4 * hh;
#pragma unroll
    for (int g4 = 0; g4 < 4; ++g4) {
        unsigned w0 = pg8::cvt_pk_bf16(O0[4 * g4] * inv, O0[4 * g4 + 1] * inv), w1 = pg8::cvt_pk_bf16(O0[4 * g4 + 2] * inv, O0[4 * g4 + 3] * inv);
        *(u64*)(op + 8 * g4) = (u64)w0 | ((u64)w1 << 32);
        w0 = pg8::cvt_pk_bf16(O1[4 * g4] * inv, O1[4 * g4 + 1] * inv); w1 = pg8::cvt_pk_bf16(O1[4 * g4 + 2] * inv, O1[4 * g4 + 3] * inv);
        *(u64*)(op + 32 + 8 * g4) = (u64)w0 | ((u64)w1 << 32);
    }
}

__device__ __forceinline__ void xcd_barrier_bg(const XcdBarrier& b, unsigned char* ldsb) {
    asm volatile("s_waitcnt vmcnt(0)" ::: "memory");
    __syncthreads();
    if (threadIdx.x == 0) {
        unsigned* bar = b.bar; asm volatile("" : "+s"(bar));
        __builtin_amdgcn_s_waitcnt(0);
        unsigned nloc = b.st[0], nx = b.st[1];
        if (nloc == 0u) { xcd_barrier_complete(bar, b.x, nloc, nx); b.st[0] = nloc; b.st[1] = nx; }
        const unsigned old = xb_add(&bar[XB_XSUB(b.x)], 1u);
        const unsigned gen = old / nloc;
        if (old + 1u == (gen + 1u) * nloc) {
            __builtin_amdgcn_fence(__ATOMIC_RELEASE, "agent");
            asm volatile("s_waitcnt vmcnt(0)" ::: "memory");
            const unsigned og = xb_add(&bar[XB_TOP], 1u);
            const unsigned tg = og / nx;
            if (og + 1u == (tg + 1u) * nx) xb_add(&bar[XB_TOPGEN], 1u);
            else XB_SPIN(xb_ld(&bar[XB_TOPGEN]) == tg, bar);
            __builtin_amdgcn_fence(__ATOMIC_ACQUIRE, "agent");
            xb_add(&bar[XB_XGEN(b.x)], 1u);
            asm volatile("s_waitcnt vmcnt(0)" ::: "memory");
            b.st[2] = 0u;
        } else { b.st[2] = 1u; b.st[3] = gen; }
    }
    __syncthreads();
    if (b.st[2] != 0u) {
        const unsigned gen = __builtin_amdgcn_readfirstlane(b.st[3]);
        bg_convert(ldsb, (int)threadIdx.x, true, CW_BAR + XB_XGEN(b.x), gen, BG_E);
        asm volatile("s_waitcnt vmcnt(0)" ::: "memory");
        __syncthreads();
        if (threadIdx.x == 0) {
            unsigned* bar = b.bar; asm volatile("" : "+s"(bar));
            XB_SPIN(xb_ld(&bar[XB_XGEN(b.x)]) == gen, bar);
            __builtin_amdgcn_fence(__ATOMIC_ACQUIRE, "agent");
            asm volatile("s_waitcnt vmcnt(0)" ::: "memory");
        }
    }
    __syncthreads();
}

template <int KIND> __global__ void __launch_bounds__(NTHREADS, 2) fwd(Args args) {
    extern __shared__ __attribute__((aligned(16))) unsigned char lds[];
    const int tid = threadIdx.x, lane = tid & 63, wave = tid >> 6;
    const int G = gridDim.x;
    PG8_LAS unsigned char* const lds3 = (PG8_LAS unsigned char*)lds;
#define WS_OPAQUE() unsigned long long ws_raw_ = (unsigned long long)args.ws; asm volatile("" : "+s"(ws_raw_)); GAS unsigned char* const wsg_ = (GAS unsigned char*)ws_raw_; unsigned char* const ws = (unsigned char*)wsg_; int tid = threadIdx.x; asm volatile("" : "+v"(tid)); const int lane = tid & 63, wave = tid >> 6; (void)lane; (void)wave
#define ctl ((unsigned*)(ws + WS_CTL))
#define MOD ((float*)(ws + WS_MOD))
#define LB ((float*)(ws + WS_LB))
#define WIN ((bf16_t*)(ws + WS_WIN))
#define WPA ((bf16_t*)(ws + WS_WPA))
#define WPB ((bf16_t*)(ws + WS_WPB))
#define WOUT ((bf16_t*)(ws + WS_WOUT))
#define W1 ((bf16_t*)(ws + WS_W1))
#define W2 ((bf16_t*)(ws + WS_W2))
#define H ((bf16_t*)(ws + WS_H))
#define ZB ((bf16_t*)(ws + WS_Z))
#define VBT ((bf16_t*)(ws + WS_VBT))
#define Y ((bf16_t*)(ws + WS_Y))
#define XS ((bf16_t*)(ws + WS_XS))
#define ACT ((bf16_t*)(ws + WS_ACT))
#define QEG ((bf16_t*)(ws + WS_QEG))
#define KEG ((bf16_t*)(ws + WS_KEG))
#define KETG ((bf16_t*)(ws + WS_KETG))
#define HVEC ((float*)(ws + WS_HVEC))
#define HA ((bf16_t*)(ws + WS_HA))
#define ATT ((bf16_t*)(ws + WS_ATT))
#define MASK ((unsigned*)(ws + WS_MASK))
#define MERGED ((bf16_t*)(ws + WS_MERGED))
#define X1 ((bf16_t*)(ws + WS_X1))
#define X2 ((bf16_t*)(ws + WS_X2))
#define TOKE ((int*)(ws + WS_TOKE))
#define TOKG ((float*)(ws + WS_TOKG))
#define TOKP ((int*)(ws + WS_TOKP))
#define TOKS ((int*)(ws + WS_TOKS))
#define BLKE ((int*)(ws + WS_BLKE))
#define SLOTTOK ((int*)(ws + WS_XS))
#define BCNT ((int*)(ws + WS_BCNT))
    const int lo = args.ph_lo, hi = args.ph_hi;
#define IN(k) ((KIND < 0 || ((k) == 0 ? KIND == 100 : KIND == ((k) - 1) % 11)) && lo <= (k) && (k) < hi)
#define SEAM(k) do { if (KIND < 0 && IN(k) && IN((k) + 1)) { if (DEPTH == 2) xcd_barrier_bg(bar, lds); else xcd_barrier(bar); } } while (0)
    XcdBarrier bar; bar.bar = (unsigned*)(args.ws + WS_CTL) + CW_BAR; bar.x = 0; bar.st = nullptr;
    if (KIND < 0) {
        volatile LAS unsigned* xbw = (volatile LAS unsigned*)((LAS unsigned char*)lds + (LDS_BYTES - 16));
        if (tid == 0) { xbw[0] = 0u; xbw[1] = 0u; xbw[2] = 0u; xbw[3] = 0u; }
        __syncthreads();
        bar = xcd_barrier_post((unsigned*)(args.ws + WS_CTL) + CW_BAR, xbw);
    }

    if (IN(0)) for (int prep_ = 0; prep_ < probe_reps(100); ++prep_) {
        WS_OPAQUE();
        {
            bf16_t* lt = (bf16_t*)lds;
            f32x4 v[8];
            constexpr bool BGL1 = (DEPTH == 2 && KIND < 0); constexpr int CJ_P0 = BGL1 ? CJ_PH0 : CJ_TOTAL;
            int J = blockIdx.x;
            CvtJob cur = cvt_job(J < CJ_P0 ? (BGL1 ? ph0_job_index(J) : J) : 0, args.in, ws);
            if (J < CJ_P0) cvt_load(cur, tid, v);
            __syncthreads();
            for (; J < CJ_P0; J += G) {
                {
                    const int i = tid >> 3, c0 = (tid & 7) * 32;
#pragma unroll
                    for (int q = 0; q < 8; q += 2) { u32x4 w; w.x = pg8::cvt_pk_bf16(v[q][0], v[q][1]); w.y = pg8::cvt_pk_bf16(v[q][2], v[q][3]); w.z = pg8::cvt_pk_bf16(v[q + 1][0], v[q + 1][1]); w.w = pg8::cvt_pk_bf16(v[q + 1][2], v[q + 1][3]);
                        *(u32x4*)(lt + i * 264 + c0 + 4 * q) = w; }
                }
                __syncthreads();
                const CvtJob me = cur;
                if (J + G < CJ_P0) { cur = cvt_job(BGL1 ? ph0_job_index(J + G) : J + G, args.in, ws); cvt_load(cur, tid, v); }
                {
                    const int n = tid & 255, kh = tid >> 8;
                    unsigned w[16];
#pragma unroll
                    for (int q = 0; q < 16; ++q) w[q] = (unsigned)lt[(kh * 32 + 2 * q) * 264 + n] | ((unsigned)lt[(kh * 32 + 2 * q + 1) * 264 + n] << 16);
                    bf16_t* dp = me.dst + (size_t)n * me.K + kh * 32;
#pragma unroll
                    for (int q = 0; q < 4; ++q) { u32x4 o; o.x = w[4 * q]; o.y = w[4 * q + 1]; o.z = w[4 * q + 2]; o.w = w[4 * q + 3]; *(u32x4*)(dp + 8 * q) = o; }
                }
                __syncthreads();
            }
        }
        {
            float* ca = (float*)lds;
            float* red = ca + NB * D;
            __syncthreads();
            for (int i = tid; i < NB * D; i += NTHREADS) { const float c = args.in[I_C][i]; ca[i] = c * sigmoidf_(c); }
            __syncthreads();
            for (int u = blockIdx.x; u < DEPTH * NMOD / 48; u += G) {
                const int jc = tid % 48, kg = tid / 48;
                const int ln = u * 48 + jc, l = ln / NMOD, n = ln % NMOD;
                if (kg < 10) {
                    const float* w = args.in[I_WADA] + (size_t)l * D * NMOD + n;
                    float acc[NB];
#pragma unroll
                    for (int b = 0; b < NB; ++b) acc[b] = 0.f;
                    for (int k = kg; k < D; k += 10) { const float wv = w[(size_t)k * NMOD];
#pragma unroll
                        for (int b = 0; b < NB; ++b) acc[b] += ca[b * D + k] * wv; }
#pragma unroll
                    for (int b = 0; b < NB; ++b) red[(kg * NB + b) * 48 + jc] = acc[b];
                }
                __syncthreads();
                for (int o = tid; o < NB * 48; o += NTHREADS) { const int b = o / 48, jj = o % 48; float a = 0.f;
#pragma unroll
                    for (int q = 0; q < 10; ++q) a += red[(q * NB + b) * 48 + jj];
                    const int ln2 = u * 48 + jj, l2 = ln2 / NMOD, n2 = ln2 % NMOD;
                    MOD[((size_t)l2 * NB + b) * NMOD + n2] = a + args.in[I_BADA][(size_t)l2 * NMOD + n2]; }
                __syncthreads();
            }
        }
        if (blockIdx.x == G - 1) {
            for (int j = tid; j < 512; j += NTHREADS) { const float a0 = args.in[I_LBL][j], a1 = args.in[I_LBL][512 + j]; LB[j] = 0.f; LB[512 + j] = 1.0f / (1.0f + __expf(a0 - a1)); }
        }
    }

    SEAM(0);
    if (PROBE_GROUP == 13 && KIND < 0) { for (int i = 0; i < 20; ++i) xcd_barrier(bar); }
#pragma unroll
    for (int l = 0; l < DEPTH; ++l) {
        const int P = 1 + 11 * l;
#define mod (MOD + (size_t)l * NB * NMOD)
        if (IN(P + 0) && l == 0) {
            WS_OPAQUE();
            const float* nw = args.in[I_NMW] + (size_t)l * D;
            for (int row = blockIdx.x * NWAVES + wave; row < T; row += G * NWAVES) {
                const int b = row >> 11; f32x4 v[4]; float ss = 0.f;
#pragma unroll
                for (int i = 0; i < 4; ++i) { v[i] = *(const f32x4*)(args.in[I_X] + (size_t)row * D + (lane + 64 * i) * 4); ss += v[i][0] * v[i][0] + v[i][1] * v[i][1] + v[i][2] * v[i][2] + v[i][3] * v[i][3]; }
                ss = wave_sum(ss); const float r = rsqrtf(ss * (1.0f / D) + EPS);
#pragma unroll
                for (int i = 0; i < 4; ++i) { const int c = (lane + 64 * i) * 4;
                    const f32x4 w4 = *(const f32x4*)(nw + c), sc4 = *(const f32x4*)(mod + (size_t)b * NMOD + D + c), sh4 = *(const f32x4*)(mod + (size_t)b * NMOD + c);
                    const f32x4 hv = v[i] * r * w4 * (1.0f + sc4) + sh4;
                    *(unsigned long long*)(H + (size_t)row * D + c) = (unsigned long long)pg8::cvt_pk_bf16(hv[0], hv[1]) | ((unsigned long long)pg8::cvt_pk_bf16(hv[2], hv[3]) << 32);
                    *(unsigned long long*)(X2 + (size_t)row * D + c) = (unsigned long long)pg8::cvt_pk_bf16(v[i][0], v[i][1]) | ((unsigned long long)pg8::cvt_pk_bf16(v[i][2], v[i][3]) << 32); }
            }
        }
        if (l == 0) SEAM(P + 0);
        if (IN(P + 1)) for (int prep_ = 0; prep_ < probe_reps(1); ++prep_) {
            WS_OPAQUE();
            pg8::Gemm g{H, WIN + (size_t)l * ZLD * D, T, ZLD, D}; pg8::StaticOrder S; S.init(T, ZLD, G, (int)blockIdx.x);
            pg8::EpiZ E{ZB, ZLD};
            pg8::gemm_phase(lds3, tid, g, S, E);
        }
        SEAM(P + 1);
        if (IN(P + 2)) for (int prep_ = 0; prep_ < probe_reps(2); ++prep_) {
            WS_OPAQUE();
            {
                for (int wt = blockIdx.x * NWAVES + wave; wt < (T / 64) * 8; wt += G * NWAVES) {
                    const int rg = wt >> 3, dg = wt & 7; const int row = rg * 64 + lane, bb = row >> 11, sidx = row & 2047;
                    const u32x4 w = *(const u32x4*)(ZB + (size_t)row * ZLD + C_VB + dg * 8);
                    bf16_t* vp = VBT + ((size_t)bb * 64 + dg * 8) * SEQ + sidx;
                    vp[0] = (bf16_t)(w.x & 0xffffu); vp[SEQ] = (bf16_t)(w.x >> 16); vp[2 * SEQ] = (bf16_t)(w.y & 0xffffu); vp[3 * SEQ] = (bf16_t)(w.y >> 16);
                    vp[4 * SEQ] = (bf16_t)(w.z & 0xffffu); vp[5 * SEQ] = (bf16_t)(w.z >> 16); vp[6 * SEQ] = (bf16_t)(w.w & 0xffffu); vp[7 * SEQ] = (bf16_t)(w.w >> 16);
                }
            }
            for (int it = blockIdx.x; it < NB * 4 * 32; it += G) {
                int tid_p = threadIdx.x; asm volatile("" : "+v"(tid_p));
                hgrn_prep_item(ZB, LB + l * 512, QEG, KEG, KETG, HVEC, (float*)lds, it >> 7, (it >> 5) & 3, it & 31, tid_p);
            }
            {
                unsigned* sc = (unsigned*)lds; bf16_t* iring = (bf16_t*)(sc + 16 * 2048);
                int* tk = (int*)(lds + LDS_BYTES - 64);
                for (;;) {
                    __syncthreads();
                    if (tid == 0) *tk = (int)atomicAdd(&ctl[CW_Q + l + 8 * prep_], 1u);
                    __syncthreads();
                    const int ticket = *tk;
                    if (ticket >= T / 16) break;
                    int tid_q = threadIdx.x; asm volatile("" : "+v"(tid_q));
                    const int u = ticket; const int b = u & 15, q16 = 127 - (u >> 4), t0 = q16 * 16;
                    if (t0 < 256) {
                        for (int i = tid_q; i < 16 * 64; i += NTHREADS) { const int qq = i >> 6, w = i & 63, n = t0 + qq + 1, lo_ = w * 32;
                            unsigned mm = 0u; if (n >= lo_ + 32) mm = 0xffffffffu; else if (n > lo_) mm = (1u << (n - lo_)) - 1u; MASK[(size_t)(b * SEQ + t0 + qq) * 64 + w] = mm; }
                    } else indexer_unit(ZB, MASK, sc, iring, b, t0, tid_q);
                }
                __syncthreads();
            }
        }
        SEAM(P + 2);
        if (IN(P + 3)) for (int prep_ = 0; prep_ < probe_reps(3); ++prep_) {
            WS_OPAQUE();
            {
                float* tb = (float*)lds;
                int* tk = (int*)(lds + LDS_BYTES - 64);
                const float* hnw = args.in[I_HNW] + (size_t)l * 512;
                bool tb_ok = false;
                for (;;) {
                    __syncthreads();
                    if (tid == 0) *tk = (int)atomicAdd(&ctl[CW_Q + 2 + l + 8 * prep_], 1u);
                    __syncthreads();
                    const int ticket = *tk;
                    if (ticket >= NB * 4 + T / 32) break;
                    int tid_q = threadIdx.x; asm volatile("" : "+v"(tid_q));
                    if (ticket < NB * 4) { hgrn_item(ZB, QEG, KEG, KETG, HVEC, hnw, HA, lds, ticket >> 2, ticket & 3, tid_q); tb_ok = false; continue; }
                    if (!tb_ok) { for (int i = tid_q; i < 1024; i += NTHREADS) tb[i] = 1.4426950408889634f * args.in[I_RELB][(int)T5_BUCKET[i >> 3] * 8 + (i & 7)]; __syncthreads(); tb_ok = true; }
                    const int u = ticket - NB * 4; const int b = u & 15, qt = 63 - (u >> 4);
                    attn_block(ZB, VBT, MASK, HA, tb, (bf16_t*)(tb + 1024), b, qt, tid_q);
                }
                __syncthreads();
            }
        }
        SEAM(P + 3);
        if (IN(P + 4)) for (int prep_ = 0; prep_ < probe_reps(4); ++prep_) {
            WS_OPAQUE();
            pg8::StaticOrder S; S.init(T, D, G, (int)blockIdx.x);
            pg8::Gemm g{HA, WPA + (size_t)l * D * D, T, D, D}; pg8::EpiMergeF E{MERGED, ZB + C_GTA, ZB + C_GTB}; pg8::gemm_phase(lds3, tid, g, S, E);
        }
        SEAM(P + 4);
        if (IN(P + 5)) for (int prep_ = 0; prep_ < probe_reps(5); ++prep_) {
            WS_OPAQUE();
            pg8::Gemm g{MERGED, WOUT + (size_t)l * D * D, T, D, D}; pg8::StaticOrder S; S.init(T, D, G, (int)blockIdx.x);
            pg8::EpiOutG E{X2, X1, mod + 2 * D}; pg8::gemm_phase(lds3, tid, g, S, E);
        }
        SEAM(P + 5);
        if (IN(P + 6)) for (int prep_ = 0; prep_ < probe_reps(6); ++prep_) {
            WS_OPAQUE();
            const float* nw = args.in[I_NFW] + (size_t)l * D; const float* wr = args.in[I_WR] + (size_t)l * D * NE; const float* br = args.in[I_BR] + (size_t)l * NE;
            constexpr int WTLD = 260;
            float* WT = (float*)lds; float* CAl = WT + 128 * WTLD; float* CBl = CAl + D; float* C0 = CBl + D; unsigned* cntl = (unsigned*)(C0 + NE); float* c0s = (float*)(cntl + NE);
            __syncthreads();
            if (tid < NE) cntl[tid] = 0u;
            const int li = lane & 15, kk = lane >> 4;
            for (int it = 0; (blockIdx.x + it * G) * 128 < T; ++it) {
                const int tokbase = (blockIdx.x + it * G) * 128, b = tokbase >> 11;
                __syncthreads();
                for (int k = tid; k < D; k += NTHREADS) { CAl[k] = nw[k] * (1.0f + mod[(size_t)b * NMOD + 4 * D + k]); CBl[k] = mod[(size_t)b * NMOD + 3 * D + k]; }
                __syncthreads();
                {   const int q = tid & 7; float c0p[4] = {0.f, 0.f, 0.f, 0.f};
                    for (int i = tid; i < D * 8; i += NTHREADS) { const int k = i >> 3, kq = k >> 8, sx = k & 255; const f32x4 w4 = *(const f32x4*)(wr + (size_t)k * NE + 4 * q); const float ca = CAl[k], cb = CBl[k];
#pragma unroll
                        for (int j = 0; j < 4; ++j) { WT[(kq * 32 + 4 * q + j) * WTLD + sx] = ca * w4[j]; c0p[j] += cb * w4[j]; } }
#pragma unroll
                    for (int j = 0; j < 4; ++j) c0s[(tid >> 3) * NE + 4 * q + j] = c0p[j]; }
                __syncthreads();
                if (tid < NE) { float a = br[tid]; for (int r2 = 0; r2 < 64; ++r2) a += c0s[r2 * NE + tid]; C0[tid] = a; }
                __syncthreads();
                const int tok = tokbase + wave * 16 + li;
                const bf16_t* xrow = X1 + (size_t)tok * D + 256 * kk;
                const float* wt0 = WT + (kk * 32 + li) * WTLD; const float* wt1 = wt0 + 16 * WTLD;
                f32x4 d0a = {0.f, 0.f, 0.f, 0.f}, d0b = d0a, d1a = d0a, d1b = d0a; float ss = 0.f;
#pragma unroll 1
                for (int ub = 0; ub < 32; ub += 8) {
                    u32x4 xw[8];
#pragma unroll
                    for (int u = 0; u < 8; ++u) xw[u] = *(const u32x4*)(xrow + 8 * (ub + u));
#pragma unroll
                    for (int u = 0; u < 8; ++u) {
                        f32x4 xlo, xhi; pg8::bf8_to_f32(xw[u], xlo, xhi);
                        const f32x4 a00 = *(const f32x4*)(wt0 + 8 * (ub + u)), a01 = *(const f32x4*)(wt0 + 8 * (ub + u) + 4), a10 = *(const f32x4*)(wt1 + 8 * (ub + u)), a11 = *(const f32x4*)(wt1 + 8 * (ub + u) + 4);
#pragma unroll
                        for (int j = 0; j < 4; ++j) { d0a = __builtin_amdgcn_mfma_f32_16x16x4f32(a00[j], xlo[j], d0a, 0, 0, 0); d1a = __builtin_amdgcn_mfma_f32_16x16x4f32(a10[j], xlo[j], d1a, 0, 0, 0); }
#pragma unroll
                        for (int j = 0; j < 4; ++j) { d0b = __builtin_amdgcn_mfma_f32_16x16x4f32(a01[j], xhi[j], d0b, 0, 0, 0); d1b = __builtin_amdgcn_mfma_f32_16x16x4f32(a11[j], xhi[j], d1b, 0, 0, 0); }
                        ss += xlo[0] * xlo[0] + xlo[1] * xlo[1] + xlo[2] * xlo[2] + xlo[3] * xlo[3] + xhi[0] * xhi[0] + xhi[1] * xhi[1] + xhi[2] * xhi[2] + xhi[3] * xhi[3];
                    }
                }
                ss += __shfl_xor(ss, 16); ss += __shfl_xor(ss, 32);
                const float r = rsqrtf(ss * (1.0f / D) + EPS);
                float lg[8]; int eid[8];
#pragma unroll
                for (int j = 0; j < 4; ++j) { lg[j] = r * (d0a[j] + d0b[j]) + C0[4 * kk + j]; lg[4 + j] = r * (d1a[j] + d1b[j]) + C0[16 + 4 * kk + j]; eid[j] = 4 * kk + j; eid[4 + j] = 16 + 4 * kk + j; }
                float tv[4]; int ti[4];
#pragma unroll
                for (int k = 0; k < 4; ++k) {
                    float bv = lg[0]; int bi = eid[0];
#pragma unroll
                    for (int j = 1; j < 8; ++j) { const bool take = lg[j] > bv; bv = take ? lg[j] : bv; bi = take ? eid[j] : bi; }
#pragma unroll
                    for (int o = 16; o <= 32; o <<= 1) { const float ov = __shfl_xor(bv, o); const int oi = __shfl_xor(bi, o); const bool take = (ov > bv) | ((ov == bv) & (oi < bi)); bv = take ? ov : bv; bi = take ? oi : bi; }
                    tv[k] = bv; ti[k] = bi;
#pragma unroll
                    for (int j = 0; j < 8; ++j) lg[j] = (eid[j] == bi) ? -INFINITY : lg[j];
                }
                const float e1 = __expf(tv[1] - tv[0]), e2 = __expf(tv[2] - tv[0]), e3 = __expf(tv[3] - tv[0]); const float inv = 1.0f / (1.0f + e1 + e2 + e3);
                {   const int ee = kk == 0 ? ti[0] : kk == 1 ? ti[1] : kk == 2 ? ti[2] : ti[3]; const float gg = (kk == 0 ? 1.0f : kk == 1 ? e1 : kk == 2 ? e2 : e3) * inv;
                    TOKE[tok * 4 + kk] = ee; TOKG[tok * 4 + kk] = gg; TOKP[tok * 4 + kk] = (int)atomicAdd(&cntl[ee], 1u); }
                bf16_t* hrow = H + (size_t)tok * D + 256 * kk; const float* cal = CAl + 256 * kk; const float* cbl = CBl + 256 * kk;
#pragma unroll 1
                for (int ub = 0; ub < 32; ub += 8) {
                    u32x4 xw[8];
#pragma unroll
                    for (int u = 0; u < 8; ++u) xw[u] = *(const u32x4*)(xrow + 8 * (ub + u));
#pragma unroll
                    for (int u = 0; u < 8; ++u) {
                        f32x4 xlo, xhi; pg8::bf8_to_f32(xw[u], xlo, xhi);
                        const f32x4 ca0 = *(const f32x4*)(cal + 8 * (ub + u)), ca1 = *(const f32x4*)(cal + 8 * (ub + u) + 4), cb0 = *(const f32x4*)(cbl + 8 * (ub + u)), cb1 = *(const f32x4*)(cbl + 8 * (ub + u) + 4);
                        const f32x4 h0 = xlo * r * ca0 + cb0, h1 = xhi * r * ca1 + cb1;
                        u32x4 w; w.x = pg8::cvt_pk_bf16(h0[0], h0[1]); w.y = pg8::cvt_pk_bf16(h0[2], h0[3]); w.z = pg8::cvt_pk_bf16(h1[0], h1[1]); w.w = pg8::cvt_pk_bf16(h1[2], h1[3]);
                        *(u32x4*)(hrow + 8 * (ub + u)) = w;
                    }
                }
            }
            __syncthreads();
            if (tid < NE) BCNT[blockIdx.x * NE + tid] = (int)cntl[tid];
        }
        SEAM(P + 6);
        if (IN(P + 7)) for (int prep_ = 0; prep_ < probe_reps(7); ++prep_) {
            WS_OPAQUE();
            int* ps = (int*)lds; int* tot = ps + 64; int* basel = tot + 32; int* pall = basel + 32; int* pbef = pall + 16 * NE;
            __syncthreads();
            {
                const int e = tid & 31, pt = tid >> 5, per = (G + 15) / 16; int sa = 0, sb = 0;
                for (int bb = pt * per; bb < (pt + 1) * per && bb < G; ++bb) { const int c = BCNT[bb * NE + e]; sa += c; sb += bb < (int)blockIdx.x ? c : 0; }
                pall[pt * NE + e] = sa; pbef[pt * NE + e] = sb;
            }
            __syncthreads();
            if (tid < NE) { int sa = 0, sb = 0; for (int pt = 0; pt < 16; ++pt) { sa += pall[pt * NE + tid]; sb += pbef[pt * NE + tid]; } tot[tid] = sa; basel[tid] = sb; }
            __syncthreads();
            if (tid == 0) { int a = 0; for (int e = 0; e < NE; ++e) { ps[e] = a; a += ((tot[e] + 255) / 256) * 256; } ps[NE] = a; }
            __syncthreads();
            const int gt = blockIdx.x * NTHREADS + tid, gn = G * NTHREADS;
            for (int grp = blockIdx.x * NWAVES + wave; grp < T / 16; grp += G * NWAVES) {
                const int tok0 = grp * 16;
                const int e_l = TOKE[tok0 * 4 + lane]; const int slot_l = ps[e_l] + basel[e_l] + TOKP[tok0 * 4 + lane];
                TOKS[tok0 * 4 + lane] = slot_l; SLOTTOK[slot_l] = tok0 + (lane >> 2);
            }
            {
                for (int e = blockIdx.x; e < NE; e += G) { if (tid < 256) { const int si = tot[e] + tid; if (si < ps[e + 1] - ps[e]) SLOTTOK[ps[e] + si] = 0; } }
                if (blockIdx.x == G - 1) { const int end8 = ((ps[NE] / 256 + 7) & ~7) * 256; for (int i = ps[NE] + tid; i < end8; i += NTHREADS) SLOTTOK[i] = 0; }
            }
            const int nblk = ps[NE] / 256, nblk8 = (nblk + 7) & ~7;
            for (int mb = gt; mb < nblk8; mb += gn) { int e = 0; if (mb < nblk) { while (e < NE - 1 && mb * 256 >= ps[e + 1]) ++e; } BLKE[mb] = e; }
            if (gt == 0) ctl[CW_NBLK + l] = (unsigned)nblk8;
            __syncthreads();
        }
        if (KIND < 0 && DEPTH == 2 && l == 1 && IN(P + 7)) bg_convert(lds, (int)threadIdx.x, false, 0u, 0u, BG_C);
        SEAM(P + 7);
        if (IN(P + 8)) for (int prep_ = 0; prep_ < probe_reps(8); ++prep_) {
            WS_OPAQUE();
            const int nblk = __builtin_amdgcn_readfirstlane((int)ctl[CW_NBLK + l]);
            PG8_LAS int* const blk_l = (PG8_LAS int*)(lds3 + pg8::STAGE_BYTES);
            for (int i = tid; i < nblk; i += NTHREADS) blk_l[i] = BLKE[i];
            __syncthreads();
            pg8::Gemm g{H, W1 + (size_t)l * NE * 2 * DFF * D, nblk * 256, 2 * DFF, D}; pg8::MoeOrder<8, true> S; S.init(nblk, G, (int)blockIdx.x, blk_l, SLOTTOK);
            pg8::EpiSwigluG E{ACT, args.in[I_B1] + (size_t)l * NE * 2 * DFF}; pg8::gemm_phase(lds3, tid, g, S, E);
        }
        if (KIND < 0 && DEPTH == 2 && IN(P + 8)) bg_convert(lds, (int)threadIdx.x, false, 0u, 0u, l == 0 ? BG_A : BG_E);
        SEAM(P + 8);
        if (IN(P + 9)) for (int prep_ = 0; prep_ < probe_reps(9); ++prep_) {
            WS_OPAQUE();
            const int nblk = __builtin_amdgcn_readfirstlane((int)ctl[CW_NBLK + l]);
            PG8_LAS int* const blk_l = (PG8_LAS int*)(lds3 + pg8::STAGE_BYTES);
            for (int i = tid; i < nblk; i += NTHREADS) blk_l[i] = BLKE[i];
            __syncthreads();
            pg8::Gemm g{ACT, W2 + (size_t)l * NE * D * DFF, nblk * 256, D, DFF}; pg8::MoeOrder<4> S; S.init(nblk, G, (int)blockIdx.x, blk_l);
            pg8::EpiYG E{Y, args.in[I_B2] + (size_t)l * NE * D}; pg8::gemm_phase(lds3, tid, g, S, E);
        }
        SEAM(P + 9);
        if (IN(P + 10)) for (int prep_ = 0; prep_ < probe_reps(10); ++prep_) {
            WS_OPAQUE();
            const bool last = (l == DEPTH - 1);
            const float* nw = last ? args.in[I_FNW] : args.in[I_NMW] + (size_t)(l + 1) * D;
            const float* modn = MOD + (size_t)(l + 1) * NB * NMOD;
            for (int grp = blockIdx.x * NWAVES + wave; grp < T / 16; grp += G * NWAVES) {
                const int tok0 = grp * 16, b = tok0 >> 11;
                const int slot_l = TOKS[tok0 * 4 + lane]; const float g_l = TOKG[tok0 * 4 + lane];
                f32x4 gf4[4], ca4[4], cb4[4];
#pragma unroll
                for (int i = 0; i < 4; ++i) { const int c = (lane + 64 * i) * 4; gf4[i] = *(const f32x4*)(mod + (size_t)b * NMOD + 5 * D + c); const f32x4 w4 = *(const f32x4*)(nw + c);
                    if (last) { ca4[i] = w4; cb4[i] = (f32x4){0.f, 0.f, 0.f, 0.f}; } else { ca4[i] = w4 * (1.0f + *(const f32x4*)(modn + (size_t)b * NMOD + D + c)); cb4[i] = *(const f32x4*)(modn + (size_t)b * NMOD + c); } }
                for (int j = 0; j < 16; ++j) {
                    const int tok = tok0 + j; f32x4 v[4]; unsigned long long yw[4][4];
#pragma unroll
                    for (int i = 0; i < 4; ++i) { const unsigned long long xw = *(const unsigned long long*)(X1 + (size_t)tok * D + (lane + 64 * i) * 4); const unsigned x0 = (unsigned)xw, x1w = (unsigned)(xw >> 32);
                        v[i][0] = __uint_as_float(x0 << 16); v[i][1] = __uint_as_float(x0 & 0xffff0000u); v[i][2] = __uint_as_float(x1w << 16); v[i][3] = __uint_as_float(x1w & 0xffff0000u); }
                    float gk[4];
#pragma unroll
                    for (int k = 0; k < 4; ++k) { const int slot = __shfl(slot_l, 4 * j + k); gk[k] = __shfl(g_l, 4 * j + k);
#pragma unroll
                        for (int i = 0; i < 4; ++i) yw[k][i] = *(const unsigned long long*)(Y + (size_t)slot * D + (lane + 64 * i) * 4); }
                    float ss = 0.f;
#pragma unroll
                    for (int i = 0; i < 4; ++i) { f32x4 a = {0.f, 0.f, 0.f, 0.f};
#pragma unroll
                        for (int k = 0; k < 4; ++k) { const unsigned y0 = (unsigned)yw[k][i], y1 = (unsigned)(yw[k][i] >> 32);
                            f32x4 y; y[0] = __uint_as_float(y0 << 16); y[1] = __uint_as_float(y0 & 0xffff0000u); y[2] = __uint_as_float(y1 << 16); y[3] = __uint_as_float(y1 & 0xffff0000u); a += gk[k] * y; }
                        v[i] = v[i] + gf4[i] * a; ss += v[i][0] * v[i][0] + v[i][1] * v[i][1] + v[i][2] * v[i][2] + v[i][3] * v[i][3]; }
                    ss = wave_sum(ss); const float r = rsqrtf(ss * (1.0f / D) + EPS);
#pragma unroll
                    for (int i = 0; i < 4; ++i) { const int c = (lane + 64 * i) * 4;
                        if (last) { *(f32x4*)(args.out + (size_t)tok * D + c) = v[i] * r * ca4[i]; }
                        else { *(unsigned long long*)(X2 + (size_t)tok * D + c) = (unsigned long long)pg8::cvt_pk_bf16(v[i][0], v[i][1]) | ((unsigned long long)pg8::cvt_pk_bf16(v[i][2], v[i][3]) << 32);
                            const f32x4 hv = v[i] * r * ca4[i] + cb4[i];
                            *(unsigned long long*)(H + (size_t)tok * D + c) = (unsigned long long)pg8::cvt_pk_bf16(hv[0], hv[1]) | ((unsigned long long)pg8::cvt_pk_bf16(hv[2], hv[3]) << 32); } }
                }
            }
        }
        if (KIND < 0 && DEPTH == 2 && l == 0 && IN(P + 10)) bg_convert(lds, (int)threadIdx.x, false, 0u, 0u, BG_B);
        SEAM(P + 10);
    }
#undef IN
}

constexpr int N_PHASES = 1 + 11 * DEPTH;
typedef void (*kern_t)(Args);
template <int K> static kern_t kern_of() { return fwd<K>; }
static kern_t kern_for(int kind) {
    switch (kind) { case 0: return fwd<0>; case 1: return fwd<1>; case 2: return fwd<2>; case 3: return fwd<3>; case 4: return fwd<4>; case 5: return fwd<5>;
                    case 6: return fwd<6>; case 7: return fwd<7>; case 8: return fwd<8>; case 9: return fwd<9>; case 10: return fwd<10>; default: return fwd<100>; }
}

extern "C" void kernel_launch(void* const* d_in, const int* in_sizes, int n_in, void* d_out, int out_size, void* d_ws, size_t ws_size, hipStream_t stream) {
    static int grid = 0;
    if (grid == 0) {
        if (n_in != 20 || out_size != T * D || ws_size < WS_END) { fprintf(stderr, "kernel_launch: unexpected problem (n_in %d, out %d, ws %zu, need %zu)\n", n_in, out_size, ws_size, (size_t)WS_END); grid = -1; return; }
        int dev = 0, cus = 0;
        if (hipGetDevice(&dev) != hipSuccess || hipDeviceGetAttribute(&cus, hipDeviceAttributeMultiprocessorCount, dev) != hipSuccess) { grid = -1; return; }
        for (int k = 0; k <= 12; ++k) {
            if (hipFuncSetAttribute((const void*)(k == 12 ? (kern_t)fwd<-1> : kern_for(k)), hipFuncAttributeMaxDynamicSharedMemorySize, LDS_BYTES) != hipSuccess) { fprintf(stderr, "kernel_launch: hipFuncSetAttribute failed\n"); grid = -1; return; }
        }
        grid = cus > 0 ? cus : 256;
    }
    if (grid < 0) return;
    (void)hipMemsetAsync((char*)d_ws + WS_CTL, 0, CTL_BYTES, stream);
    Args a{};
    for (int i = 0; i < 20; ++i) a.in[i] = (const float*)d_in[i];
    a.out = (float*)d_out; a.ws = (unsigned char*)d_ws;
#if defined(MULTI_LAUNCH)
    for (int p = 0; p < N_PHASES; ++p) {
        if (p == 1 + 11) continue;
        a.ph_lo = p; a.ph_hi = p + 1;
        const int kind = p == 0 ? 11 : (p - 1) % 11;
        hipLaunchKernelGGL(kern_for(kind), dim3(grid), dim3(NTHREADS), LDS_BYTES, stream, a);
    }
#else
    a.ph_lo = 0; a.ph_hi = N_PHASES;
    hipLaunchKernelGGL(fwd<-1>, dim3(grid), dim3(NTHREADS), LDS_BYTES, stream, a);
#endif
}
```

```cpp
#include <hip/hip_runtime.h>
#include <stdint.h>
#include <stdio.h>

typedef unsigned short bf16_t;
typedef short bf16x8 __attribute__((ext_vector_type(8)));
typedef float f32x4 __attribute__((ext_vector_type(4)));
typedef float f32x16 __attribute__((ext_vector_type(16)));
typedef unsigned u32x4 __attribute__((ext_vector_type(4)));
#define LAS __attribute__((address_space(3)))
#define GAS __attribute__((address_space(1)))

constexpr int T = 32768, D = 1024, NB = 16, SEQ = 2048, DEPTH = 2;
constexpr int ZC = 5320, ZLD = 5376;
constexpr int C_QA = 0, C_FA = 512, C_IA = 1024, C_GA = 1536, C_QB = 2048, C_KB = 2560, C_VB = 2624, C_IQ = 2688, C_IK = 3200, C_IW = 3264, C_GTA = 3272, C_GTB = 4296;
constexpr int NE = 32, DFF = 1024, NSLOT = 131072 + 32 * 256, NBLK_MAX = NSLOT / 256;
constexpr int NMOD = 6 * D;
constexpr float EPS = 1e-6f;
constexpr int NTHREADS = 512, NWAVES = 8;
#ifndef PROBE_GROUP
#define PROBE_GROUP 0
#endif
constexpr int probe_reps(int kind) { return (PROBE_GROUP == 1 && (kind == 1 || kind == 4 || kind == 5 || kind == 8 || kind == 9)) || (PROBE_GROUP == 2 && kind == 2) || (PROBE_GROUP == 3 && kind == 3) || (PROBE_GROUP == 4 && kind == 100) || (PROBE_GROUP == 5 && (kind == 6 || kind == 7 || kind == 10)) || (PROBE_GROUP == 9 && kind == 8) || (PROBE_GROUP == 10 && kind == 1) || (PROBE_GROUP == 11 && kind == 9) || (PROBE_GROUP == 12 && (kind == 4 || kind == 5)) || (PROBE_GROUP == 14 && kind == 4) || (PROBE_GROUP == 15 && kind == 5) ? 2 : 1; }
constexpr int LDS_BYTES = 160 * 1024;

constexpr size_t al256(size_t x) { return (x + 255) & ~(size_t)255; }
constexpr size_t WS_CTL = 0;
constexpr size_t CTL_BYTES = 65536;
constexpr size_t WS_MOD = WS_CTL + CTL_BYTES;
constexpr size_t WS_LB = WS_MOD + al256((size_t)DEPTH * NB * NMOD * 4);
constexpr size_t WS_WIN = WS_LB + al256((size_t)DEPTH * 512 * 4);
constexpr size_t WS_WPA = WS_WIN + (size_t)DEPTH * ZLD * D * 2;
constexpr size_t WS_WPB = WS_WPA + (size_t)DEPTH * D * 512 * 2;
constexpr size_t WS_WOUT = WS_WPB + (size_t)DEPTH * D * 512 * 2;
constexpr size_t WS_W1 = WS_WOUT + (size_t)DEPTH * D * D * 2;
constexpr size_t WS_W2 = WS_W1 + (size_t)DEPTH * NE * 2 * DFF * D * 2;
constexpr size_t WS_H = WS_W2 + (size_t)DEPTH * NE * D * DFF * 2;
constexpr size_t WS_Z = WS_H + (size_t)T * D * 2;
constexpr size_t WS_Y = WS_Z;
constexpr size_t WS_ACT = WS_Z + (size_t)T * ZLD * 2;
constexpr size_t WS_QEG = WS_ACT;
constexpr size_t WS_KEG = WS_QEG + (size_t)T * 512 * 2;
constexpr size_t WS_KETG = WS_KEG + (size_t)T * 512 * 2;
constexpr size_t WS_HVEC = WS_KETG + (size_t)T * 512 * 2;
constexpr size_t WS_XS = WS_ACT + (size_t)NSLOT * DFF * 2;
constexpr size_t WS_HA = WS_XS + (size_t)NSLOT * D * 2;
constexpr size_t WS_ATT = WS_HA + (size_t)T * 512 * 2;
constexpr size_t WS_MASK = WS_ATT + (size_t)T * 512 * 2;
constexpr size_t WS_VBT = WS_MASK + (size_t)T * 64 * 4;
constexpr size_t WS_MERGED = WS_VBT + (size_t)T * 64 * 2;
constexpr size_t WS_X1 = WS_MERGED + (size_t)T * D * 2;
constexpr size_t WS_X2 = WS_X1 + (size_t)T * D * 4;
constexpr size_t WS_TOKE = WS_X2 + (size_t)T * D * 4;
constexpr size_t WS_TOKG = WS_TOKE + (size_t)T * 4 * 4;
constexpr size_t WS_TOKP = WS_TOKG + (size_t)T * 4 * 4;
constexpr size_t WS_TOKS = WS_TOKP + (size_t)T * 4 * 4;
constexpr size_t WS_BLKE = WS_TOKS + (size_t)T * 4 * 4;
constexpr size_t WS_BCNT = WS_BLKE + al256((size_t)(NBLK_MAX + 64) * 4);
constexpr size_t WS_END = WS_BCNT + (size_t)1024 * NE * 4;
static_assert((size_t)NSLOT * D * 2 <= (size_t)T * ZLD * 2, "Y must fit in Z");
static_assert((size_t)T * 512 * 2 * 3 + (size_t)NB * 4 * 32 * 384 * 4 <= (size_t)NSLOT * DFF * 2, "HGRN2 gate tensors must fit in ACT");
static_assert(WS_END <= ((size_t)1 << 31), "workspace layout exceeds 2 GiB");
constexpr int CW_CNT = 1024;
constexpr int CW_NBLK = 1200;
constexpr int CW_Q = 1216;

__device__ __forceinline__ bf16_t f2bf(float f) { unsigned u = __float_as_uint(f); u += 0x7fffu + ((u >> 16) & 1u); return (bf16_t)(u >> 16); }
__device__ __forceinline__ float bf2f(bf16_t b) { return __uint_as_float(((unsigned)b) << 16); }
__device__ __forceinline__ float sigmoidf_(float x) { return __builtin_amdgcn_rcpf(1.0f + __builtin_amdgcn_exp2f(-1.4426950408889634f * x)); }
__device__ __forceinline__ float wave_sum(float v) {
#pragma unroll
    for (int o = 32; o >= 1; o >>= 1) v += __shfl_xor(v, o);
    return v;
}
__device__ __forceinline__ int wave_sum_i(int v) {
#pragma unroll
    for (int o = 32; o >= 1; o >>= 1) v += __shfl_xor(v, o);
    return v;
}
__device__ const unsigned char T5_BUCKET[128] = {
    0, 1, 2, 3, 4, 5, 6, 7, 8, 9, 10, 11, 12, 13, 14, 15, 16, 16, 16, 17, 17, 18, 18, 18, 19, 19, 19, 20, 20, 20, 20, 21, 21, 21, 21, 22, 22, 22, 22, 22, 23, 23, 23, 23, 23, 23, 24, 24, 24, 24, 24, 24, 25,
    25, 25, 25, 25, 25, 25, 26, 26, 26, 26, 26, 26, 26, 26, 27, 27, 27, 27, 27, 27, 27, 27, 27, 27, 28, 28, 28, 28, 28, 28, 28, 28, 28, 28, 29, 29, 29, 29, 29, 29, 29, 29, 29, 29, 29, 29, 30, 30, 30, 30, 30,
    30, 30, 30, 30, 30, 30, 30, 30, 30, 31, 31, 31, 31, 31, 31, 31, 31, 31, 31, 31, 31, 31, 31, 31};
__device__ __forceinline__ int t5_bucket(int rel) { return rel >= 128 ? 31 : (int)T5_BUCKET[rel]; }


#define XB_TMO      128
#define XB_XCNT(j)  (256  + 64 * (j))
#define XB_XSUB(j)  (1280 + 64 * (j))
#define XB_XGEN(j)  (2304 + 64 * (j))
#define XB_TOP      3328
#define XB_TOPGEN   3392
#define XCD_BAR_WORDS 3456
#define XB_SPIN_CAP (1u << 18)
__device__ __forceinline__ unsigned xb_ld(unsigned* p)              { return __hip_atomic_load(p, __ATOMIC_RELAXED, __HIP_MEMORY_SCOPE_AGENT); }
__device__ __forceinline__ unsigned xb_add(unsigned* p, unsigned v) { return __hip_atomic_fetch_add(p, v, __ATOMIC_RELAXED, __HIP_MEMORY_SCOPE_AGENT); }
__device__ __forceinline__ unsigned xb_xcc_id() { return (unsigned)__builtin_amdgcn_s_getreg((3 << 11) | 20) & 0xFu; }
#define XB_SPIN(cond, bar) do { unsigned _sp = 0; while (cond) { __builtin_amdgcn_s_sleep(1); \
    if ((++_sp & 255u) == 0u) { if (xb_ld(&(bar)[XB_TMO])) break; if (_sp > XB_SPIN_CAP) { atomicAdd(&(bar)[XB_TMO], 1u); break; } } } } while (0)
struct XcdBarrier { unsigned* bar; unsigned x; volatile LAS unsigned* st; };
__device__ __forceinline__ XcdBarrier xcd_barrier_post(unsigned* bar, volatile LAS unsigned* st) {
    XcdBarrier b; b.bar = bar; b.x = xb_xcc_id(); b.st = st;
    if (threadIdx.x == 0) (void)xb_add(&bar[XB_XCNT(b.x)], 1u);
    return b;
}
__device__ __forceinline__ void xcd_barrier_complete(unsigned* bar, unsigned x, unsigned& nloc, unsigned& nx) {
    const unsigned G = gridDim.x * gridDim.y * gridDim.z;
    unsigned sum, cnt, mine, sp = 0u;
    for (;;) {
        sum = 0u; cnt = 0u; mine = 0u;
#pragma unroll
        for (unsigned j = 0; j < 16; ++j) { const unsigned c = xb_ld(&bar[XB_XCNT(j)]); sum += c; cnt += (c > 0u) ? 1u : 0u; mine = (j == x) ? c : mine; }
        if (sum == G) break;
        __builtin_amdgcn_s_sleep(1);
        if ((++sp & 255u) == 0u) { if (xb_ld(&bar[XB_TMO])) break; if (sp > XB_SPIN_CAP) { atomicAdd(&bar[XB_TMO], 1u); break; } }
    }
    nloc = mine > 0u ? mine : 1u; nx = cnt > 0u ? cnt : 1u;
}
__device__ __forceinline__ void xcd_barrier(const XcdBarrier& b) {
    asm volatile("s_waitcnt vmcnt(0)" ::: "memory");
    __syncthreads();
    if (threadIdx.x == 0) {
        unsigned* bar = b.bar; asm volatile("" : "+s"(bar));
        __builtin_amdgcn_s_waitcnt(0);
        unsigned nloc = b.st[0], nx = b.st[1];
        if (nloc == 0u) { xcd_barrier_complete(bar, b.x, nloc, nx); b.st[0] = nloc; b.st[1] = nx; }
        const unsigned old = xb_add(&bar[XB_XSUB(b.x)], 1u);
        const unsigned gen = old / nloc;
        if (old + 1u == (gen + 1u) * nloc) {
            __builtin_amdgcn_fence(__ATOMIC_RELEASE, "agent");
            asm volatile("s_waitcnt vmcnt(0)" ::: "memory");
            const unsigned og = xb_add(&bar[XB_TOP], 1u);
            const unsigned tg = og / nx;
            if (og + 1u == (tg + 1u) * nx) xb_add(&bar[XB_TOPGEN], 1u);
            else XB_SPIN(xb_ld(&bar[XB_TOPGEN]) == tg, bar);
            __builtin_amdgcn_fence(__ATOMIC_ACQUIRE, "agent");
            xb_add(&bar[XB_XGEN(b.x)], 1u);
            asm volatile("s_waitcnt vmcnt(0)" ::: "memory");
        } else {
            XB_SPIN(xb_ld(&bar[XB_XGEN(b.x)]) == gen, bar);
            __builtin_amdgcn_fence(__ATOMIC_ACQUIRE, "agent");
            asm volatile("s_waitcnt vmcnt(0)" ::: "memory");
        }
    }
    __syncthreads();
}
constexpr int CW_BAR = 4096;

struct Args { const float* in[20]; float* out; unsigned char* ws; int ph_lo, ph_hi; };
enum { I_X = 0, I_C, I_WADA, I_BADA, I_NMW, I_WIN, I_LBL, I_HNW, I_RELB, I_WPA, I_WPB, I_WOUT, I_NFW, I_WR, I_BR, I_W1, I_B1, I_W2, I_B2, I_FNW };

namespace pg8 {
#define PG8_LAS __attribute__((address_space(3)))
constexpr int BM = 256, BK = 64, HALF = 128, HTB = HALF * BK * 2, STAGE_BYTES = 8 * HTB, NXCD = 8, WGM = 8;
__host__ __device__ __forceinline__ int lds_byte(int r, int c) { const int st = (r >> 4) * 2 + (c >> 5), rr = r & 15, cc = c & 31, ob = rr * 64 + cc * 2; return st * 1024 + (ob ^ (((ob >> 9) & 1) << 5)); }
__host__ __device__ __forceinline__ void stage_rc(int b, int& R, int& C) { const int st = b / 1024, sb = b % 1024, swz = sb ^ (((sb >> 9) & 1) << 5); R = (st >> 1) * 16 + swz / 64; C = (st & 1) * 32 + (swz % 64) / 2; }
__host__ __device__ __forceinline__ int perm32(int rho) { const int n = rho >> 4, i = rho & 15; return 8 * (i >> 2) + 4 * n + (i & 3); }
struct Unit { int pm, pn, brow, e; };
struct Gemm { const bf16_t* A; const bf16_t* Bt; int M, N, K; };
struct StaticOrder {
    int nM, nN, nwg, G, c;
    __device__ void init(int M, int N, int G_, int c_) { nM = M / BM; nN = N / BM; nwg = nM * nN; G = G_; c = c_; }
    __device__ bool next(int i, Unit& u) const {
        const long L = (long)i * G + c; if (L >= nwg) return false;
        int wgid = (int)L; { const int q = nwg / NXCD, r = nwg % NXCD, xcd = wgid % NXCD, off = wgid / NXCD; wgid = (xcd < r ? xcd * (q + 1) : r * (q + 1) + (xcd - r) * q) + off; }
        const int nig = WGM * nN, gid = wgid / nig, fm = gid * WGM, gsz = (nM - fm) < WGM ? (nM - fm) : WGM;
        u.pm = fm + ((wgid % nig) % gsz); u.pn = (wgid % nig) / gsz; u.brow = u.pn * BM; u.e = 0; return true;
    }
    __device__ __forceinline__ void a_ready(const Unit&) const {}
    __device__ __forceinline__ void done(const Unit&) const {}
};
template <int NN, bool GATH = false, bool REV = false> struct MoeOrder {
    static constexpr bool GATHER = GATH;
    int nwg, G, c; const PG8_LAS int* blke; const int* rowtok;
    __device__ void init(int nM, int G_, int c_, const PG8_LAS int* blke_, const int* rowtok_ = nullptr) { nwg = nM * NN; G = G_; c = c_; blke = blke_; rowtok = rowtok_; }
    __device__ bool next(int i, Unit& u) const {
        const int L = i * G + c; if (L >= nwg) return false;
        const int wgid = (L & 7) * (nwg >> 3) + (REV ? (nwg >> 3) - 1 - (L >> 3) : (L >> 3));
        const int gid = wgid / (8 * NN), rem = wgid % (8 * NN);
        u.pm = gid * 8 + (rem & 7); u.pn = rem >> 3; u.e = __builtin_amdgcn_readfirstlane(blke[u.pm]); u.brow = u.e * (NN * BM) + u.pn * BM; return true;
    }
    __device__ __forceinline__ void a_ready(const Unit&) const {}
    __device__ __forceinline__ void done(const Unit&) const {}
};
typedef __bf16 bf16x2v_t __attribute__((ext_vector_type(2)));
typedef float f32x2v_t __attribute__((ext_vector_type(2)));
__device__ __forceinline__ unsigned cvt_pk_bf16(float lo, float hi) { const f32x2v_t v = {lo, hi}; const bf16x2v_t r = __builtin_convertvector(v, bf16x2v_t); return __builtin_bit_cast(unsigned, r); }


struct EpiZ {
    static constexpr bool PERM = true, AFTER_DRAIN = false;
    bf16_t* C; int ldc;
    __device__ __forceinline__ void operator()(const f32x4 (&acc)[2][2][4][2], const Unit& u, int wr, int wc, int fr, int fq) const {
        const int row0 = u.pm * BM + wr * 64 + fr, col0 = u.pn * BM + wc * 32 + 8 * fq;
#pragma unroll
        for (int ai = 0; ai < 2; ++ai)
#pragma unroll
            for (int m = 0; m < 4; ++m) { bf16_t* rowp = C + (size_t)(row0 + ai * HALF + m * 16) * ldc + col0;
#pragma unroll
                for (int bj = 0; bj < 2; ++bj) { const f32x4 v0 = acc[ai][bj][m][0], v1 = acc[ai][bj][m][1];
                    u32x4 w; w.x = cvt_pk_bf16(v0[0], v0[1]); w.y = cvt_pk_bf16(v0[2], v0[3]); w.z = cvt_pk_bf16(v1[0], v1[1]); w.w = cvt_pk_bf16(v1[2], v1[3]);
                    *(u32x4*)(rowp + bj * HALF) = w; } }
    }
};
__device__ __forceinline__ void bf8_to_f32(const u32x4 w, f32x4& lo, f32x4& hi) {
    lo[0] = __uint_as_float(w.x << 16); lo[1] = __uint_as_float(w.x & 0xffff0000u); lo[2] = __uint_as_float(w.y << 16); lo[3] = __uint_as_float(w.y & 0xffff0000u);
    hi[0] = __uint_as_float(w.z << 16); hi[1] = __uint_as_float(w.z & 0xffff0000u); hi[2] = __uint_as_float(w.w << 16); hi[3] = __uint_as_float(w.w & 0xffff0000u);
}
__device__ __forceinline__ f32x4 sig4(f32x4 g) { f32x4 r; r[0] = sigmoidf_(g[0]); r[1] = sigmoidf_(g[1]); r[2] = sigmoidf_(g[2]); r[3] = sigmoidf_(g[3]); return r; }
struct EpiMergeF {
    static constexpr bool PERM = true, AFTER_DRAIN = false, MIDK = true;
    bf16_t* merged; const bf16_t* Zga; const bf16_t* Zgb;
    __device__ __forceinline__ void mid(f32x4 (&acc)[2][2][4][2], const Unit& u, int wr, int wc, int fr, int fq) const {
        int row0 = u.pm * BM + wr * 64 + fr, col0 = u.pn * BM + wc * 32 + 8 * fq;
        asm volatile("" : "+v"(row0), "+v"(col0));
#pragma unroll
        for (int ai = 0; ai < 2; ++ai)
#pragma unroll
            for (int mp = 0; mp < 2; ++mp) {
                u32x4 ga[2][2], gb[2][2];
#pragma unroll
                for (int mi = 0; mi < 2; ++mi)
#pragma unroll
                    for (int bj = 0; bj < 2; ++bj) { const size_t row = (size_t)(row0 + ai * HALF + (2 * mp + mi) * 16); const int col = col0 + bj * HALF;
                        ga[mi][bj] = *(const u32x4*)(Zga + row * ZLD + col); gb[mi][bj] = *(const u32x4*)(Zgb + row * ZLD + col); }
#pragma unroll
                for (int mi = 0; mi < 2; ++mi)
#pragma unroll
                    for (int bj = 0; bj < 2; ++bj) { const int m = 2 * mp + mi;
                        f32x4 a0, a1, b0, b1; bf8_to_f32(ga[mi][bj], a0, a1); bf8_to_f32(gb[mi][bj], b0, b1);
#pragma unroll
                        for (int j = 0; j < 4; ++j) {
                            acc[ai][bj][m][0][j] *= (1.0f + __builtin_amdgcn_exp2f(-1.4426950408889634f * b0[j])) * __builtin_amdgcn_rcpf(1.0f + __builtin_amdgcn_exp2f(-1.4426950408889634f * a0[j]));
                            acc[ai][bj][m][1][j] *= (1.0f + __builtin_amdgcn_exp2f(-1.4426950408889634f * b1[j])) * __builtin_amdgcn_rcpf(1.0f + __builtin_amdgcn_exp2f(-1.4426950408889634f * a1[j])); } }
                asm volatile("" : "+v"(acc[ai][0][2 * mp][0]), "+v"(acc[ai][0][2 * mp][1]), "+v"(acc[ai][1][2 * mp][0]), "+v"(acc[ai][1][2 * mp][1]),
                                  "+v"(acc[ai][0][2 * mp + 1][0]), "+v"(acc[ai][0][2 * mp + 1][1]), "+v"(acc[ai][1][2 * mp + 1][0]), "+v"(acc[ai][1][2 * mp + 1][1]) :: "memory");
            }
    }
    __device__ __forceinline__ void operator()(const f32x4 (&acc)[2][2][4][2], const Unit& u, int wr, int wc, int fr, int fq) const {
        int row0 = u.pm * BM + wr * 64 + fr, col0 = u.pn * BM + wc * 32 + 8 * fq;
        asm volatile("" : "+v"(row0), "+v"(col0));
#pragma unroll
        for (int ai = 0; ai < 2; ++ai) {
            u32x4 gb[4][2];
#pragma unroll
            for (int m = 0; m < 4; ++m)
#pragma unroll
                for (int bj = 0; bj < 2; ++bj) gb[m][bj] = *(const u32x4*)(Zgb + (size_t)(row0 + ai * HALF + m * 16) * ZLD + col0 + bj * HALF);
#pragma unroll
            for (int m = 0; m < 4; ++m)
#pragma unroll
                for (int bj = 0; bj < 2; ++bj) {
                    f32x4 g0, g1; bf8_to_f32(gb[m][bj], g0, g1); g0 = sig4(g0); g1 = sig4(g1);
                    const f32x4 v0 = g0 * acc[ai][bj][m][0], v1 = g1 * acc[ai][bj][m][1];
                    u32x4 w; w.x = cvt_pk_bf16(v0[0], v0[1]); w.y = cvt_pk_bf16(v0[2], v0[3]); w.z = cvt_pk_bf16(v1[0], v1[1]); w.w = cvt_pk_bf16(v1[2], v1[3]);
                    *(u32x4*)(merged + (size_t)(row0 + ai * HALF + m * 16) * D + col0 + bj * HALF) = w; }
        }
    }
};
struct EpiOutG {
    static constexpr bool PERM = true, AFTER_DRAIN = false;
    const bf16_t* xin; bf16_t* x1; const float* gate  ;
    __device__ __forceinline__ void operator()(const f32x4 (&acc)[2][2][4][2], const Unit& u, int wr, int wc, int fr, int fq) const {
        const int row0 = u.pm * BM + wr * 64 + fr, col0 = u.pn * BM + wc * 32 + 8 * fq; const int b = (u.pm * BM) >> 11;
        f32x4 gv[2][2];
#pragma unroll
        for (int bj = 0; bj < 2; ++bj)
#pragma unroll
            for (int n = 0; n < 2; ++n) gv[bj][n] = *(const f32x4*)(gate + (size_t)b * NMOD + col0 + bj * HALF + 4 * n);
#pragma unroll
        for (int ai = 0; ai < 2; ++ai) {
            u32x4 xv[4][2];
#pragma unroll
            for (int m = 0; m < 4; ++m)
#pragma unroll
                for (int bj = 0; bj < 2; ++bj) xv[m][bj] = *(const u32x4*)(xin + (size_t)(row0 + ai * HALF + m * 16) * D + col0 + bj * HALF);
#pragma unroll
            for (int m = 0; m < 4; ++m)
#pragma unroll
                for (int bj = 0; bj < 2; ++bj) {
                    f32x4 x0, x1f; bf8_to_f32(xv[m][bj], x0, x1f);
                    const f32x4 v0 = x0 + gv[bj][0] * acc[ai][bj][m][0], v1 = x1f + gv[bj][1] * acc[ai][bj][m][1];
                    u32x4 w; w.x = cvt_pk_bf16(v0[0], v0[1]); w.y = cvt_pk_bf16(v0[2], v0[3]); w.z = cvt_pk_bf16(v1[0], v1[1]); w.w = cvt_pk_bf16(v1[2], v1[3]);
                    *(u32x4*)(x1 + (size_t)(row0 + ai * HALF + m * 16) * D + col0 + bj * HALF) = w; }
        }
    }
};
struct EpiSwigluG {
    static constexpr bool PERM = true, AFTER_DRAIN = false;
    bf16_t* act; const float* b1  ;
    __device__ __forceinline__ void operator()(const f32x4 (&acc)[2][2][4][2], const Unit& u, int wr, int wc, int fr, int fq) const {
        typedef float f32x2 __attribute__((ext_vector_type(2)));
        const int row0 = u.pm * BM + wr * 64 + fr, col0 = u.pn * HALF + wc * 32 + 8 * fq;
        f32x2 bg[2][2], bl[2][2];
#pragma unroll
        for (int n = 0; n < 2; ++n) { const f32x4 g4 = *(const f32x4*)(b1 + (size_t)u.e * 2 * DFF + col0 + 4 * n), l4 = *(const f32x4*)(b1 + (size_t)u.e * 2 * DFF + DFF + col0 + 4 * n);
            bg[n][0] = (f32x2){g4[0], g4[1]}; bg[n][1] = (f32x2){g4[2], g4[3]}; bl[n][0] = (f32x2){l4[0] + 1.0f, l4[1] + 1.0f}; bl[n][1] = (f32x2){l4[2] + 1.0f, l4[3] + 1.0f}; }
#pragma unroll
        for (int ai = 0; ai < 2; ++ai)
#pragma unroll
            for (int m = 0; m < 4; ++m) { unsigned o[4];
#pragma unroll
                for (int n = 0; n < 2; ++n)
#pragma unroll
                    for (int h = 0; h < 2; ++h) {
                        f32x2 g = (f32x2){acc[ai][0][m][n][2 * h], acc[ai][0][m][n][2 * h + 1]} + bg[n][h];
                        f32x2 l = (f32x2){acc[ai][1][m][n][2 * h], acc[ai][1][m][n][2 * h + 1]} + bl[n][h];
                        g = (f32x2){fminf(g[0], 7.0f), fminf(g[1], 7.0f)};
                        l = (f32x2){__builtin_amdgcn_fmed3f(l[0], -6.0f, 8.0f), __builtin_amdgcn_fmed3f(l[1], -6.0f, 8.0f)};
                        const f32x2 t = g * (-1.702f * 1.4426950408889634f);
                        const f32x2 d = (f32x2){__builtin_amdgcn_exp2f(t[0]), __builtin_amdgcn_exp2f(t[1])} + 1.0f;
                        const f32x2 r = (f32x2){__builtin_amdgcn_rcpf(d[0]), __builtin_amdgcn_rcpf(d[1])};
                        const f32x2 ov = g * r * l;
                        o[2 * n + h] = cvt_pk_bf16(ov[0], ov[1]); }
                u32x4 w; w.x = o[0]; w.y = o[1]; w.z = o[2]; w.w = o[3];
                *(u32x4*)(act + (size_t)(row0 + ai * HALF + m * 16) * DFF + col0) = w; }
    }
};
struct EpiYG {
    static constexpr bool PERM = true, AFTER_DRAIN = false;
    bf16_t* Yb; const float* b2  ;
    __device__ __forceinline__ void operator()(const f32x4 (&acc)[2][2][4][2], const Unit& u, int wr, int wc, int fr, int fq) const {
        const int row0 = u.pm * BM + wr * 64 + fr, col0 = u.pn * BM + wc * 32 + 8 * fq;
        f32x4 bv[2][2];
#pragma unroll
        for (int bj = 0; bj < 2; ++bj)
#pragma unroll
            for (int n = 0; n < 2; ++n) bv[bj][n] = *(const f32x4*)(b2 + (size_t)u.e * D + col0 + bj * HALF + 4 * n);
#pragma unroll
        for (int ai = 0; ai < 2; ++ai)
#pragma unroll
            for (int m = 0; m < 4; ++m) { bf16_t* rowp = Yb + (size_t)(row0 + ai * HALF + m * 16) * D + col0;
#pragma unroll
                for (int bj = 0; bj < 2; ++bj) { const f32x4 v0 = acc[ai][bj][m][0] + bv[bj][0], v1 = acc[ai][bj][m][1] + bv[bj][1];
                    u32x4 w; w.x = cvt_pk_bf16(v0[0], v0[1]); w.y = cvt_pk_bf16(v0[2], v0[3]); w.z = cvt_pk_bf16(v1[0], v1[1]); w.w = cvt_pk_bf16(v1[2], v1[3]);
                    *(u32x4*)(rowp + bj * HALF) = w; } }
    }
};

template <class E, class = void> struct has_midk { static constexpr bool value = false; };
template <class E> struct has_midk<E, decltype((void)E::MIDK)> { static constexpr bool value = E::MIDK; };
template <class S_, class = void> struct sched_gather { static constexpr bool value = false; };
template <class S_> struct sched_gather<S_, decltype((void)S_::GATHER)> { static constexpr bool value = S_::GATHER; };
template <class Epi, class Sched>
__device__ __forceinline__ void gemm_phase(PG8_LAS unsigned char* lds, const int tid, const Gemm g, const Sched& S, const Epi& E) {
    const int wid = __builtin_amdgcn_readfirstlane(tid >> 6), lane = tid & 63, wr = wid >> 2, wc = wid & 3, fr = lane & 15, fq = lane >> 4;
    const int K = g.K, nt = K / BK;
    unsigned voffA[2], voffB[2]; int gR[2], gC[2];
#pragma unroll
    for (int i = 0; i < 2; ++i) { int R, C; stage_rc(tid * 16 + i * 8192, R, C); const int Rb = Epi::PERM ? ((R & ~31) + perm32(R & 31)) : R;
        voffA[i] = (unsigned)(R * K + C) * 2u; voffB[i] = (unsigned)(Rb * K + C) * 2u; gR[i] = R; gC[i] = C; }
    const size_t kstep = (size_t)(BK * 2);
    const size_t hstep = (size_t)HALF * K * 2;
    const size_t tstep = 2 * hstep;
    const unsigned ldsw = (unsigned)wid * 1024u;
    const int aoff = lds_byte(wr * 64 + fr, fq * 8), boff = lds_byte(wc * 32 + fr, fq * 8);
#define PG8_SA(b, h) (((b) * 2 + (h)) * HTB)
#define PG8_SB(b, h) ((4 + (b) * 2 + (h)) * HTB)
#define PG8_STAGE(bufoff, gbase, voff) do { _Pragma("unroll") for (int _i = 0; _i < 2; ++_i) \
        __builtin_amdgcn_global_load_lds((const unsigned*)((const char*)(gbase) + (voff)[_i]), (PG8_LAS unsigned*)(lds + (bufoff) + ldsw + _i * 8192), 16, 0, 0); } while (0)
#define PG8_LDA(dst, b, h) do { _Pragma("unroll") for (int m = 0; m < 4; ++m) _Pragma("unroll") for (int k = 0; k < 2; ++k) dst[m][k] = *(const PG8_LAS bf16x8*)(lds + PG8_SA(b, h) + aoff + m * 2048 + k * 1024); } while (0)
#define PG8_LDB(dst, b, h) do { _Pragma("unroll") for (int n = 0; n < 2; ++n) _Pragma("unroll") for (int k = 0; k < 2; ++k) dst[n][k] = *(const PG8_LAS bf16x8*)(lds + PG8_SB(b, h) + boff + n * 2048 + k * 1024); } while (0)
#define PG8_MMA(ai, bj, At, Bt) do { __builtin_amdgcn_s_setprio(1); _Pragma("unroll") for (int m = 0; m < 4; ++m) _Pragma("unroll") for (int n = 0; n < 2; ++n) _Pragma("unroll") for (int k = 0; k < 2; ++k) \
        acc[ai][bj][m][n] = __builtin_amdgcn_mfma_f32_16x16x32_bf16(Bt[n][k], At[m][k], acc[ai][bj][m][n], 0, 0, 0); __builtin_amdgcn_s_setprio(0); } while (0)
#define PG8_WAIT_V(n) asm volatile("s_waitcnt vmcnt(" #n ")" ::: "memory")
#define PG8_WAIT_L(n) asm volatile("s_waitcnt lgkmcnt(" #n ")" ::: "memory")
#define PG8_BAR __builtin_amdgcn_s_barrier()
#define PG8_SCHED __builtin_amdgcn_sched_barrier(0)
    Unit cur, nxt; int ui = 0;
    if (!S.next(0, cur)) return;
    f32x4 acc[2][2][4][2];
#pragma unroll
    for (int a = 0; a < 2; ++a)
#pragma unroll
        for (int b = 0; b < 2; ++b)
#pragma unroll
            for (int m = 0; m < 4; ++m)
#pragma unroll
                for (int n = 0; n < 2; ++n) acc[a][b][m][n] = (f32x4){0.f, 0.f, 0.f, 0.f};
    bf16x8 At[4][2], B0[2][2], B1[2][2];
    unsigned vC0[2], vC1[2], vN0[2], vN1[2];
    if constexpr (sched_gather<Sched>::value) {
#pragma unroll
        for (int i = 0; i < 2; ++i) { vC0[i] = ((unsigned)S.rowtok[cur.pm * BM + gR[i]] * (unsigned)K + (unsigned)gC[i]) * 2u; vC1[i] = ((unsigned)S.rowtok[cur.pm * BM + HALF + gR[i]] * (unsigned)K + (unsigned)gC[i]) * 2u; vN0[i] = vC0[i]; vN1[i] = vC1[i]; }
    } else {
#pragma unroll
        for (int i = 0; i < 2; ++i) { vC0[i] = voffA[i]; vC1[i] = voffA[i] + (unsigned)hstep; vN0[i] = vC0[i]; vN1[i] = vC1[i]; }
    }
    const char* cA = sched_gather<Sched>::value ? (const char*)g.A : (const char*)g.A + (size_t)cur.pm * tstep; const char* cB = (const char*)g.Bt + (size_t)cur.brow * K * 2;
    S.a_ready(cur);
    PG8_STAGE(PG8_SB(0, 0), cB, voffB); PG8_STAGE(PG8_SA(0, 0), cA, vC0); PG8_STAGE(PG8_SB(0, 1), cB + hstep, voffB); PG8_STAGE(PG8_SA(0, 1), cA, vC1);
    if (wr == 1) PG8_BAR;
    PG8_WAIT_V(4); PG8_BAR;
    PG8_STAGE(PG8_SB(1, 0), cB + kstep, voffB); PG8_STAGE(PG8_SA(1, 0), cA + kstep, vC0); PG8_STAGE(PG8_SB(1, 1), cB + hstep + kstep, voffB);
    PG8_WAIT_V(6); PG8_BAR;
    for (;;) {
        const bool has_next = S.next(ui + 1, nxt);
        const char* nA = sched_gather<Sched>::value ? cA : (has_next ? (const char*)g.A + (size_t)nxt.pm * tstep : cA); const char* nB = has_next ? (const char*)g.Bt + (size_t)nxt.brow * K * 2 : cB;
        PG8_LAS int* const tokb = (PG8_LAS int*)(lds + STAGE_BYTES + 4096) + ((ui + 1) & 1) * BM;
        if constexpr (sched_gather<Sched>::value) { if (has_next && wid == 0)
            __builtin_amdgcn_global_load_lds((const unsigned*)(S.rowtok + nxt.pm * BM + lane * 4), (PG8_LAS unsigned*)tokb, 16, 0, 0); }
        for (int t = 0; t < nt; t += 2) {
            if constexpr (has_midk<Epi>::value) { if (t == nt / 2) E.mid(acc, cur, wr, wc, fr, fq); }
            const bool last = (t == nt - 2);
            const char* a1 = cA + (size_t)(t + 1) * kstep;
            const char* a2 = last ? nA : cA + (size_t)(t + 2) * kstep; const char* b2 = last ? nB : cB + (size_t)(t + 2) * kstep;
            const char* a3 = a2 + kstep; const char* b3 = b2 + kstep;
            unsigned w0[2], w1[2];
#pragma unroll
            for (int i = 0; i < 2; ++i) { w0[i] = vC0[i]; w1[i] = vC1[i]; }
            if constexpr (sched_gather<Sched>::value) { if (last && has_next) {
#pragma unroll
                for (int i = 0; i < 2; ++i) { vN0[i] = ((unsigned)tokb[gR[i]] * (unsigned)K + (unsigned)gC[i]) * 2u; vN1[i] = ((unsigned)tokb[HALF + gR[i]] * (unsigned)K + (unsigned)gC[i]) * 2u; w0[i] = vN0[i]; w1[i] = vN1[i]; } } }
            if (last && has_next) S.a_ready(nxt);
            PG8_LDB(B0, 0, 0); PG8_SCHED; PG8_LDA(At, 0, 0); PG8_STAGE(PG8_SA(1, 1), a1, vC1);
            PG8_WAIT_L(8); PG8_BAR; PG8_WAIT_L(0); PG8_MMA(0, 0, At, B0); PG8_BAR; PG8_SCHED;
            PG8_LDB(B1, 0, 1); PG8_STAGE(PG8_SB(0, 0), b2, voffB);
            PG8_BAR; PG8_WAIT_L(0); PG8_MMA(0, 1, At, B1); PG8_BAR;
            PG8_LDA(At, 0, 1); PG8_STAGE(PG8_SA(0, 0), a2, w0);
            PG8_BAR; PG8_WAIT_L(0); PG8_MMA(1, 0, At, B0); PG8_BAR; PG8_SCHED;
            PG8_STAGE(PG8_SB(0, 1), b2 + hstep, voffB);
            PG8_WAIT_V(6); PG8_BAR; PG8_MMA(1, 1, At, B1); PG8_BAR;
            PG8_LDB(B0, 1, 0); PG8_SCHED; PG8_LDA(At, 1, 0); PG8_STAGE(PG8_SA(0, 1), a2, w1);
            PG8_WAIT_L(8); PG8_BAR; PG8_WAIT_L(0); PG8_MMA(0, 0, At, B0); PG8_BAR; PG8_SCHED;
            PG8_LDB(B1, 1, 1); PG8_STAGE(PG8_SB(1, 0), b3, voffB);
            PG8_BAR; PG8_WAIT_L(0); PG8_MMA(0, 1, At, B1); PG8_BAR;
            PG8_LDA(At, 1, 1); PG8_STAGE(PG8_SA(1, 0), a3, w0);
            PG8_BAR; PG8_WAIT_L(0); PG8_MMA(1, 0, At, B0); PG8_BAR; PG8_SCHED;
            PG8_STAGE(PG8_SB(1, 1), b3 + hstep, voffB);
            PG8_WAIT_V(6); PG8_BAR; PG8_MMA(1, 1, At, B1); PG8_BAR;
        }
        if constexpr (!Epi::AFTER_DRAIN) { E(acc, cur, wr, wc, fr, fq); S.done(cur); }
        if (!has_next) break;
#pragma unroll
        for (int a = 0; a < 2; ++a)
#pragma unroll
            for (int b = 0; b < 2; ++b)
#pragma unroll
                for (int m = 0; m < 4; ++m)
#pragma unroll
                    for (int n = 0; n < 2; ++n) acc[a][b][m][n] = (f32x4){0.f, 0.f, 0.f, 0.f};
        cur = nxt; cA = nA; cB = nB; ++ui;
#pragma unroll
        for (int i = 0; i < 2; ++i) { vC0[i] = vN0[i]; vC1[i] = vN1[i]; }
    }
    PG8_WAIT_V(0);
    if (wr == 0) PG8_BAR;
    PG8_BAR;
    if constexpr (Epi::AFTER_DRAIN) { E.fused(acc, cur, wr, wc, fr, fq, lds, wid, lane); S.done(cur); }
#undef PG8_SA
#undef PG8_SB
#undef PG8_STAGE
#undef PG8_LDA
#undef PG8_LDB
#undef PG8_MMA
#undef PG8_WAIT_V
#undef PG8_WAIT_L
#undef PG8_BAR
#undef PG8_SCHED
}
}


struct CvtJob { const float* src; bf16_t* dst; int N  , K  , nvalid  , sc0, sc1  ; };
constexpr int CJ_WIN = DEPTH * 16 * 21, CJ_WPA = DEPTH * 8 * 4, CJ_WPB = CJ_WPA, CJ_WOUT = DEPTH * 16 * 4, CJ_W1 = DEPTH * NE * 16 * 8, CJ_W2 = DEPTH * NE * 16 * 4;
constexpr int CJ_TOTAL = CJ_WIN + CJ_WPA + CJ_WPB + CJ_WOUT + CJ_W1 + CJ_W2;
__device__ __forceinline__ CvtJob cvt_job(int J, const float* const* in, unsigned char* ws) {
    CvtJob j;
    if (J < CJ_WIN) { const int m = J / (16 * 21), r = J % (16 * 21), kt = r / 21, ns = r % 21;
        j.src = in[I_WIN] + (size_t)m * D * ZC + (size_t)kt * 64 * ZC; j.dst = (bf16_t*)(ws + WS_WIN) + (size_t)m * ZLD * D + (size_t)ns * 256 * D + kt * 64; j.N = ZC; j.K = D;
        j.nvalid = ZC - ns * 256 < 256 ? ZC - ns * 256 : 256; j.sc0 = ns * 256; j.sc1 = ns * 256 + 128; return j; }
    J -= CJ_WIN;
    if (J < CJ_WPA + CJ_WPB) { const int which = J / CJ_WPA, JJ = J % CJ_WPA; const int m = JJ / 32, r = JJ % 32, kt = r / 4, ns = r % 4;
        j.src = in[which ? I_WPB : I_WPA] + (size_t)m * 512 * D + (size_t)kt * 64 * D; j.dst = (bf16_t*)(ws + WS_WPA) + (size_t)m * D * D + (size_t)ns * 256 * D + which * 512 + kt * 64; j.N = D; j.K = D;
        j.nvalid = 256; j.sc0 = ns * 256; j.sc1 = ns * 256 + 128; return j; }
    J -= CJ_WPA + CJ_WPB;
    if (J < CJ_WOUT) { const int m = J / 64, r = J % 64, kt = r / 4, ns = r % 4;
        j.src = in[I_WOUT] + (size_t)m * D * D + (size_t)kt * 64 * D; j.dst = (bf16_t*)(ws + WS_WOUT) + (size_t)m * D * D + (size_t)ns * 256 * D + kt * 64; j.N = D; j.K = D;
        j.nvalid = 256; j.sc0 = ns * 256; j.sc1 = ns * 256 + 128; return j; }
    J -= CJ_WOUT;
    if (J < CJ_W1) { const int m = J / 128, r = J % 128, kt = r / 8, ns = r % 8;
        j.src = in[I_W1] + (size_t)m * D * 2 * DFF + (size_t)kt * 64 * 2 * DFF; j.dst = (bf16_t*)(ws + WS_W1) + (size_t)m * 2 * DFF * D + (size_t)ns * 256 * D + kt * 64; j.N = 2 * DFF; j.K = D;
        j.nvalid = 256; j.sc0 = 128 * ns; j.sc1 = DFF + 128 * ns; return j; }
    J -= CJ_W1;
    { const int m = J / 64, r = J % 64, kt = r / 4, ns = r % 4;
        j.src = in[I_W2] + (size_t)m * DFF * D + (size_t)kt * 64 * D; j.dst = (bf16_t*)(ws + WS_W2) + (size_t)m * D * DFF + (size_t)ns * 256 * DFF + kt * 64; j.N = D; j.K = DFF;
        j.nvalid = 256; j.sc0 = ns * 256; j.sc1 = ns * 256 + 128; return j; }
}
__device__ __forceinline__ void cvt_load(const CvtJob& j, const int tid, f32x4 (&v)[8]) {
    const int i = tid >> 3, c0 = (tid & 7) * 32; const float* p = j.src + (size_t)i * j.N + (c0 < 128 ? j.sc0 + c0 : j.sc1 + c0 - 128);
#pragma unroll
    for (int q = 0; q < 8; ++q) v[q] = (c0 + 4 * q < j.nvalid) ? *(const f32x4*)(p + 4 * q) : (f32x4){0.f, 0.f, 0.f, 0.f};
}

constexpr int CJ_LAYER = CJ_TOTAL / DEPTH;
constexpr int CW_BGQ = 1300;
__device__ __forceinline__ int layer_job(const int layer, int j) {
    constexpr int H_WIN = CJ_WIN / DEPTH, H_WPA = CJ_WPA / DEPTH, H_WOUT = CJ_WOUT / DEPTH, H_W1 = CJ_W1 / DEPTH, H_W2 = CJ_W2 / DEPTH;
    if (j < H_WIN) return layer * H_WIN + j; j -= H_WIN;
    if (j < H_WPA) return CJ_WIN + layer * H_WPA + j; j -= H_WPA;
    if (j < H_WPA) return CJ_WIN + CJ_WPA + layer * H_WPA + j; j -= H_WPA;
    if (j < H_WOUT) return CJ_WIN + CJ_WPA + CJ_WPB + layer * H_WOUT + j; j -= H_WOUT;
    if (j < H_W1) return CJ_WIN + CJ_WPA + CJ_WPB + CJ_WOUT + layer * H_W1 + j; j -= H_W1;
    return CJ_WIN + CJ_WPA + CJ_WPB + CJ_WOUT + CJ_W1 + layer * H_W2 + j;
}
constexpr int CJ_SMALL = (CJ_WIN + CJ_WPA + CJ_WPB + CJ_WOUT) / DEPTH;
constexpr int BG_A = CJ_W2 / DEPTH, BG_B = BG_A + CJ_SMALL, BG_C = BG_B + CJ_W1 / DEPTH, BG_E = BG_C + CJ_W2 / DEPTH;
constexpr int CJ_PH0 = CJ_SMALL + CJ_W1 / DEPTH;
__device__ __forceinline__ int bg_job_index(const int t) {
    constexpr int B1 = CJ_WIN + CJ_WPA + CJ_WPB + CJ_WOUT, B2 = B1 + CJ_W1;
    if (t < BG_A) return B2 + t;
    if (t < BG_B) return layer_job(1, t - BG_A);
    if (t < BG_C) return B1 + CJ_W1 / DEPTH + (t - BG_B);
    return B2 + CJ_W2 / DEPTH + (t - BG_C);
}
__device__ __forceinline__ int ph0_job_index(const int j) { return j < CJ_SMALL ? layer_job(0, j) : (CJ_WIN + CJ_WPA + CJ_WPB + CJ_WOUT) + (j - CJ_SMALL); }
__device__ __forceinline__ void bg_convert(unsigned char* ldsb, const int tid_in, const bool use_stop, unsigned stop_off, const unsigned stop_val, const int limit) {
    int tid = tid_in; asm volatile("" : "+v"(tid));
    typedef __attribute__((address_space(4))) const unsigned long long* kaptr_t;
    kaptr_t ka = (kaptr_t)__builtin_amdgcn_kernarg_segment_ptr(); asm volatile("" : "+s"(ka));
    const float* const* in = (const float* const*)ka;
    unsigned char* ws = (unsigned char*)ka[21];
    unsigned* q = (unsigned*)(ws + WS_CTL) + CW_BGQ; unsigned* stop = use_stop ? (unsigned*)(ws + WS_CTL) + stop_off : nullptr;
    bf16_t* lt = (bf16_t*)ldsb;
    volatile int* tk = (volatile int*)(ldsb + LDS_BYTES - 64);
    f32x4 v[8];
    __syncthreads();
    if (tid == 0) { int t = -1; if (stop ? (__hip_atomic_load(stop, __ATOMIC_RELAXED, __HIP_MEMORY_SCOPE_AGENT) == stop_val) : ((int)__hip_atomic_load(q, __ATOMIC_RELAXED, __HIP_MEMORY_SCOPE_AGENT) < limit)) { t = (int)atomicAdd(q, 1u); if (t >= BG_E) t = -1; } *tk = t; }
    __syncthreads();
    int J = __builtin_amdgcn_readfirstlane(*tk);
    CvtJob cur = cvt_job(bg_job_index(J < 0 ? 0 : J), in, ws);
    if (J >= 0) cvt_load(cur, tid, v);
    while (J >= 0) {
        {
            const int i = tid >> 3, c0 = (tid & 7) * 32;
#pragma unroll
            for (int qq = 0; qq < 8; qq += 2) { u32x4 w; w.x = pg8::cvt_pk_bf16(v[qq][0], v[qq][1]); w.y = pg8::cvt_pk_bf16(v[qq][2], v[qq][3]); w.z = pg8::cvt_pk_bf16(v[qq + 1][0], v[qq + 1][1]); w.w = pg8::cvt_pk_bf16(v[qq + 1][2], v[qq + 1][3]);
                *(u32x4*)(lt + i * 264 + c0 + 4 * qq) = w; }
        }
        if (tid == 0) { int t = -1; if (stop ? (__hip_atomic_load(stop, __ATOMIC_RELAXED, __HIP_MEMORY_SCOPE_AGENT) == stop_val) : ((int)__hip_atomic_load(q, __ATOMIC_RELAXED, __HIP_MEMORY_SCOPE_AGENT) < limit)) { t = (int)atomicAdd(q, 1u); if (t >= BG_E) t = -1; } *tk = t; }
        __syncthreads();
        const CvtJob me = cur; const int Jn = __builtin_amdgcn_readfirstlane(*tk);
        if (Jn >= 0) { cur = cvt_job(bg_job_index(Jn), in, ws); cvt_load(cur, tid, v); }
        {
            const int n = tid & 255, kh = tid >> 8;
            unsigned w[16];
#pragma unroll
            for (int qq = 0; qq < 16; ++qq) w[qq] = (unsigned)lt[(kh * 32 + 2 * qq) * 264 + n] | ((unsigned)lt[(kh * 32 + 2 * qq + 1) * 264 + n] << 16);
            bf16_t* dp = me.dst + (size_t)n * me.K + kh * 32;
#pragma unroll
            for (int qq = 0; qq < 4; ++qq) { u32x4 o; o.x = w[4 * qq]; o.y = w[4 * qq + 1]; o.z = w[4 * qq + 2]; o.w = w[4 * qq + 3]; *(u32x4*)(dp + 8 * qq) = o; }
        }
        __syncthreads();
        J = Jn;
    }
}

__device__ __forceinline__ void hgrn_prep_item(const bf16_t* __restrict__ zb, const float* __restrict__ lbv, bf16_t* __restrict__ qeg, bf16_t* __restrict__ keg, bf16_t* __restrict__ ketg, float* __restrict__ hvec,
                                               float* ex  , const int b, const int h, const int c, const int tid) {
    const int lane = tid & 63, wave = __builtin_amdgcn_readfirstlane(tid >> 6);
    const int tg = wave >> 1, d = (wave & 1) * 64 + lane;
    const float lb = lbv[h * 128 + d], oml = 1.0f - lb;
    const int row0 = b * SEQ + c * 64 + 16 * tg;
    const bf16_t* fbase = zb + (size_t)row0 * ZLD + C_FA + h * 128;
    const bf16_t* qbase = zb + (size_t)row0 * ZLD + C_QA + h * 128;
    float g[16], kk[16], qv[16]; float run = 0.f;
#pragma unroll
    for (int j = 0; j < 16; ++j) {
        const float zf = fminf(fmaxf(bf2f((fbase + (size_t)j * ZLD)[d]), -60.f), 60.f), zq = bf2f((qbase + (size_t)j * ZLD)[d]);
        const float e = __builtin_amdgcn_exp2f(-1.4426950408889634f * zf), sg = __builtin_amdgcn_rcpf(1.0f + e);
        run += 0.6931471805599453f * __builtin_amdgcn_logf(lb + oml * sg); g[j] = run; kk[j] = oml * e * sg; qv[j] = zq * sigmoidf_(zq);
    }
    __syncthreads();
    ex[tg * 128 + d] = run;
    __syncthreads();
    const float e0 = ex[d], e1 = ex[128 + d], e2 = ex[256 + d], e3 = ex[384 + d];
    const float pre = tg == 0 ? 0.f : tg == 1 ? e0 : tg == 2 ? e0 + e1 : e0 + e1 + e2;
    const float r = e0 + e1, tot = (e0 + e1) + (e2 + e3);
    unsigned kt[8];
    bf16_t* qo = qeg + (size_t)row0 * 512 + h * 128 + d; bf16_t* ko = keg + (size_t)row0 * 512 + h * 128 + d;
#pragma unroll
    for (int j = 0; j < 16; j += 2) {
        const float bt0 = pre + g[j], bt1 = pre + g[j + 1];
        const float L2E = 1.4426950408889634f;
        const float qe0 = qv[j] * __builtin_amdgcn_exp2f(L2E * fminf(bt0 - r, 80.f)), qe1 = qv[j + 1] * __builtin_amdgcn_exp2f(L2E * fminf(bt1 - r, 80.f));
        const float ke0 = kk[j] * __builtin_amdgcn_exp2f(L2E * fminf(r - bt0, 80.f)), ke1 = kk[j + 1] * __builtin_amdgcn_exp2f(L2E * fminf(r - bt1, 80.f));
        const unsigned qp = pg8::cvt_pk_bf16(qe0, qe1), kp = pg8::cvt_pk_bf16(ke0, ke1);
        qo[(size_t)j * 512] = (bf16_t)(qp & 0xffffu); qo[(size_t)(j + 1) * 512] = (bf16_t)(qp >> 16);
        ko[(size_t)j * 512] = (bf16_t)(kp & 0xffffu); ko[(size_t)(j + 1) * 512] = (bf16_t)(kp >> 16);
        kt[j >> 1] = kp;
    }
    const size_t item = ((size_t)(b * 4 + h) * 32 + c);
    u32x4 w0, w1; w0.x = kt[0]; w0.y = kt[1]; w0.z = kt[2]; w0.w = kt[3]; w1.x = kt[4]; w1.y = kt[5]; w1.z = kt[6]; w1.w = kt[7];
    bf16_t* kto = ketg + item * (128 * 64) + d * 64 + 16 * tg;
    *(u32x4*)kto = w0; *(u32x4*)(kto + 8) = w1;
    if (tg == 0) { float* hv = hvec + item * 384; hv[d] = __expf(r); hv[128 + d] = __expf(tot); hv[256 + d] = __expf(tot - r); }
}

__device__ __forceinline__ void hgrn_item(const bf16_t* __restrict__ zb, const bf16_t* __restrict__ qeg, const bf16_t* __restrict__ keg, const bf16_t* __restrict__ ketg, const float* __restrict__ hvec,
                                          const float* __restrict__ hnw, bf16_t* __restrict__ ha, unsigned char* ldsb, const int b, const int h, const int tid) {
    typedef unsigned long long u64;
    const int lane = tid & 63, wave = __builtin_amdgcn_readfirstlane(tid >> 6), r31 = lane & 31, hh = lane >> 5;
    bf16_t* QE = (bf16_t*)ldsb;
    bf16_t* KE = QE + 64 * 136;
    bf16_t* KET = KE + 64 * 136;
    bf16_t* VT = KET + 128 * 72;
    bf16_t* SBT = VT + 128 * 72;
    float* er = (float*)(SBT + 128 * 136); float* el = er + 128; float* elr = el + 128;
    float* ssq = elr + 128;
    const int lt = tid >> 3, lp = tid & 7, kd = tid >> 2, kp = tid & 3;
    const bf16_t* gq = qeg + (size_t)(b * SEQ + lt) * 512 + h * 128 + lp * 8;
    const bf16_t* gk = keg + (size_t)(b * SEQ + lt) * 512 + h * 128 + lp * 8;
    const bf16_t* gt = ketg + (size_t)(b * 4 + h) * 32 * (128 * 64) + kd * 64 + kp * 8;
    const float* gv = hvec + (size_t)(b * 4 + h) * 32 * 384;
    const int v0 = wave * 16;
    const bf16_t* vbase = zb + (size_t)(b * SEQ) * ZLD + C_IA + h * 128 + v0;
    const unsigned voff = (unsigned)lane * ZLD;
    u32x4 nq0, nq1, nk0, nk1, nt0, nt1, nv0, nv1; f32x4 nvec = {0.f, 0.f, 0.f, 0.f};
    nq0 = *(const u32x4*)gq; nq1 = *(const u32x4*)(gq + 64); nk0 = *(const u32x4*)gk; nk1 = *(const u32x4*)(gk + 64); nt0 = *(const u32x4*)gt; nt1 = *(const u32x4*)(gt + 32);
    nv0 = *(const u32x4*)(vbase + voff); nv1 = *(const u32x4*)(vbase + voff + 8);
    if (tid < 96) nvec = *(const f32x4*)(gv + tid * 4);
    const int tt = wave & 1, oq = wave >> 1, dq = wave & 3, sv = wave >> 2;
    f32x4 hw4[4];
#pragma unroll
    for (int g4 = 0; g4 < 4; ++g4) hw4[g4] = *(const f32x4*)(hnw + h * 128 + 32 * oq + 4 * hh + 8 * g4);
    f32x16 S0, S1;
#pragma unroll
    for (int i = 0; i < 16; ++i) { S0[i] = 0.f; S1[i] = 0.f; }
    for (int c = 0; c < SEQ / 64; ++c) {
        const int row0 = b * SEQ + c * 64;
        *(u32x4*)(QE + lt * 136 + lp * 8) = nq0; *(u32x4*)(QE + lt * 136 + 64 + lp * 8) = nq1;
        *(u32x4*)(KE + lt * 136 + lp * 8) = nk0; *(u32x4*)(KE + lt * 136 + 64 + lp * 8) = nk1;
        *(u32x4*)(KET + kd * 72 + kp * 8) = nt0; *(u32x4*)(KET + kd * 72 + 32 + kp * 8) = nt1;
        if (tid < 96) *(f32x4*)(er + tid * 4) = nvec;
        { const unsigned vw[8] = {nv0.x, nv0.y, nv0.z, nv0.w, nv1.x, nv1.y, nv1.z, nv1.w};
#pragma unroll
          for (int q = 0; q < 8; ++q) { VT[(v0 + 2 * q) * 72 + lane] = (bf16_t)(vw[q] & 0xffffu); VT[(v0 + 2 * q + 1) * 72 + lane] = (bf16_t)(vw[q] >> 16); } }
        __syncthreads();
        u64 gw[4];
        {
            const bf16_t* gp = zb + (size_t)(row0 + 32 * tt + r31) * ZLD + C_GA + h * 128 + 32 * oq + 4 * hh;
#pragma unroll
            for (int g4 = 0; g4 < 4; ++g4) gw[g4] = *(const u64*)(gp + 8 * g4);
        }
        if (c + 1 < SEQ / 64) {
            const size_t ro = (size_t)(c + 1) * 64 * 512;
            nq0 = *(const u32x4*)(gq + ro); nq1 = *(const u32x4*)(gq + ro + 64); nk0 = *(const u32x4*)(gk + ro); nk1 = *(const u32x4*)(gk + ro + 64);
            nt0 = *(const u32x4*)(gt + (size_t)(c + 1) * (128 * 64)); nt1 = *(const u32x4*)(gt + (size_t)(c + 1) * (128 * 64) + 32);
            nv0 = *(const u32x4*)(vbase + (size_t)(c + 1) * 64 * ZLD + voff); nv1 = *(const u32x4*)(vbase + (size_t)(c + 1) * 64 * ZLD + voff + 8);
            if (tid < 96) nvec = *(const f32x4*)(gv + (size_t)(c + 1) * 384 + tid * 4);
        }
#pragma unroll
        for (int ti = 0; ti < 2; ++ti) {
            const int vq = 2 * sv + ti;
#pragma unroll
            for (int g4 = 0; g4 < 4; ++g4) {
                const int dd = 32 * dq + 8 * g4 + 4 * hh;
                const float s0 = ti ? S1[4 * g4] : S0[4 * g4], s1 = ti ? S1[4 * g4 + 1] : S0[4 * g4 + 1], s2 = ti ? S1[4 * g4 + 2] : S0[4 * g4 + 2], s3 = ti ? S1[4 * g4 + 3] : S0[4 * g4 + 3];
                const unsigned a0 = pg8::cvt_pk_bf16(er[dd] * s0, er[dd + 1] * s1), a1 = pg8::cvt_pk_bf16(er[dd + 2] * s2, er[dd + 3] * s3);
                *(u64*)(SBT + (32 * vq + r31) * 136 + dd) = (u64)a0 | ((u64)a1 << 32);
            }
        }
        __syncthreads();
        f32x16 Oacc;
#pragma unroll
        for (int i = 0; i < 16; ++i) Oacc[i] = 0.f;
        {
            bf16x8 qf[8];
#pragma unroll
            for (int ks = 0; ks < 8; ++ks) qf[ks] = *(const bf16x8*)(QE + (32 * tt + r31) * 136 + 16 * ks + 8 * hh);
#pragma unroll
            for (int ks = 0; ks < 8; ++ks) { const bf16x8 sa = *(const bf16x8*)(SBT + (32 * oq + r31) * 136 + 16 * ks + 8 * hh); Oacc = __builtin_amdgcn_mfma_f32_32x32x16_bf16(sa, qf[ks], Oacc, 0, 0, 0); }
            for (int st = 0; st <= tt; ++st) {
                f32x16 At;
#pragma unroll
                for (int i = 0; i < 16; ++i) At[i] = 0.f;
#pragma unroll
                for (int ks = 0; ks < 8; ++ks) { const bf16x8 ka = *(const bf16x8*)(KE + (32 * st + r31) * 136 + 16 * ks + 8 * hh); At = __builtin_amdgcn_mfma_f32_32x32x16_bf16(ka, qf[ks], At, 0, 0, 0); }
                if (st == tt) {
#pragma unroll
                    for (int i = 0; i < 16; ++i) { const int sl = (i & 3) + 8 * (i >> 2) + 4 * hh; if (sl > r31) At[i] = 0.f; }
                }
                union { unsigned u[4]; bf16x8 v; } pb0, pb1;
#pragma unroll
                for (int j = 0; j < 4; ++j) { pb0.u[j] = pg8::cvt_pk_bf16(At[2 * j], At[2 * j + 1]); pb1.u[j] = pg8::cvt_pk_bf16(At[8 + 2 * j], At[8 + 2 * j + 1]); }
                union { u64 q[2]; bf16x8 v; } a0, a1;
                const bf16_t* vr = VT + (32 * oq + r31) * 72 + 32 * st + 4 * hh;
                a0.q[0] = *(const u64*)(vr); a0.q[1] = *(const u64*)(vr + 8); a1.q[0] = *(const u64*)(vr + 16); a1.q[1] = *(const u64*)(vr + 24);
                Oacc = __builtin_amdgcn_mfma_f32_32x32x16_bf16(a0.v, pb0.v, Oacc, 0, 0, 0);
                Oacc = __builtin_amdgcn_mfma_f32_32x32x16_bf16(a1.v, pb1.v, Oacc, 0, 0, 0);
            }
        }
        {
            float q2 = 0.f;
#pragma unroll
            for (int i = 0; i < 16; ++i) q2 += Oacc[i] * Oacc[i];
            q2 += __shfl_xor(q2, 32);
            if (hh == 0) ssq[(32 * tt + r31) * 4 + oq] = q2;
        }
        {
            f32x16 d0, d1;
#pragma unroll
            for (int i = 0; i < 16; ++i) { d0[i] = 0.f; d1[i] = 0.f; }
#pragma unroll
            for (int ks = 0; ks < 4; ++ks) {
                const bf16x8 ka = *(const bf16x8*)(KET + (32 * dq + r31) * 72 + 16 * ks + 8 * hh);
                const bf16x8 vb0 = *(const bf16x8*)(VT + (64 * sv + r31) * 72 + 16 * ks + 8 * hh), vb1 = *(const bf16x8*)(VT + (64 * sv + 32 + r31) * 72 + 16 * ks + 8 * hh);
                d0 = __builtin_amdgcn_mfma_f32_32x32x16_bf16(ka, vb0, d0, 0, 0, 0); d1 = __builtin_amdgcn_mfma_f32_32x32x16_bf16(ka, vb1, d1, 0, 0, 0);
            }
#pragma unroll
            for (int i = 0; i < 16; ++i) { const int dd = 32 * dq + (i & 3) + 8 * (i >> 2) + 4 * hh; const float a = el[dd], bb = elr[dd]; S0[i] = a * S0[i] + bb * d0[i]; S1[i] = a * S1[i] + bb * d1[i]; }
        }
        __syncthreads();
        {
            const int t = 32 * tt + r31;
            const f32x4 sq = *(const f32x4*)(ssq + t * 4);
            const float rn = rsqrtf(((sq[0] + sq[1]) + (sq[2] + sq[3])) * (1.0f / 128.0f) + EPS);
            const int vcol = h * 128 + 32 * oq + 4 * hh;
            bf16_t* op = ha + (size_t)(row0 + t) * D + vcol;
#pragma unroll
            for (int g4 = 0; g4 < 4; ++g4) {
                const f32x4 w4 = hw4[g4];
                float o[4];
#pragma unroll
                for (int j = 0; j < 4; ++j) { const float gg = bf2f((bf16_t)((gw[g4] >> (16 * j)) & 0xffffu)); o[j] = Oacc[4 * g4 + j] * rn * w4[j] * (gg * sigmoidf_(gg)); }
                *(u64*)(op + 8 * g4) = (u64)pg8::cvt_pk_bf16(o[0], o[1]) | ((u64)pg8::cvt_pk_bf16(o[2], o[3]) << 32);
            }
        }
    }
    __syncthreads();
}

#define DPP_STEP(v, op, ctrl) v = v op __builtin_amdgcn_update_dpp(v, v, ctrl, 0xf, 0xf, false)
__device__ __forceinline__ int wave_sum_dpp(int v) { DPP_STEP(v, +, 0xB1); DPP_STEP(v, +, 0x4E); DPP_STEP(v, +, 0x141); DPP_STEP(v, +, 0x140);
    return __builtin_amdgcn_readlane(v, 0) + __builtin_amdgcn_readlane(v, 16) + __builtin_amdgcn_readlane(v, 32) + __builtin_amdgcn_readlane(v, 48); }
__device__ __forceinline__ int wave_and_u(int v) { DPP_STEP(v, &, 0xB1); DPP_STEP(v, &, 0x4E); DPP_STEP(v, &, 0x141); DPP_STEP(v, &, 0x140);
    return __builtin_amdgcn_readlane(v, 0) & __builtin_amdgcn_readlane(v, 16) & __builtin_amdgcn_readlane(v, 32) & __builtin_amdgcn_readlane(v, 48); }
__device__ __forceinline__ int wave_or_u(int v) { DPP_STEP(v, |, 0xB1); DPP_STEP(v, |, 0x4E); DPP_STEP(v, |, 0x141); DPP_STEP(v, |, 0x140);
    return __builtin_amdgcn_readlane(v, 0) | __builtin_amdgcn_readlane(v, 16) | __builtin_amdgcn_readlane(v, 32) | __builtin_amdgcn_readlane(v, 48); }


#define CNT8(OP, cl, cand, k) do { unsigned long long m0_, m1_, m2_, m3_, m4_, m5_, m6_, m7_, dd_; \
    asm volatile("v_cmp_" OP "_u32_e64 %[m0], %[k0], %[c]\n\tv_cmp_" OP "_u32_e64 %[m1], %[k1], %[c]\n\tv_cmp_" OP "_u32_e64 %[m2], %[k2], %[c]\n\tv_cmp_" OP "_u32_e64 %[m3], %[k3], %[c]\n\t" \
                 "v_cmp_" OP "_u32_e64 %[m4], %[k4], %[c]\n\tv_cmp_" OP "_u32_e64 %[m5], %[k5], %[c]\n\tv_cmp_" OP "_u32_e64 %[m6], %[k6], %[c]\n\tv_cmp_" OP "_u32_e64 %[m7], %[k7], %[c]\n\t" \
                 "v_addc_co_u32_e64 %[a], %[dd], %[a], 0, %[m0]\n\tv_addc_co_u32_e64 %[a], %[dd], %[a], 0, %[m1]\n\tv_addc_co_u32_e64 %[a], %[dd], %[a], 0, %[m2]\n\tv_addc_co_u32_e64 %[a], %[dd], %[a], 0, %[m3]\n\t" \
                 "v_addc_co_u32_e64 %[a], %[dd], %[a], 0, %[m4]\n\tv_addc_co_u32_e64 %[a], %[dd], %[a], 0, %[m5]\n\tv_addc_co_u32_e64 %[a], %[dd], %[a], 0, %[m6]\n\tv_addc_co_u32_e64 %[a], %[dd], %[a], 0, %[m7]\n\t" \
                 : [a] "+v"(cl), [m0] "=&s"(m0_), [m1] "=&s"(m1_), [m2] "=&s"(m2_), [m3] "=&s"(m3_), [m4] "=&s"(m4_), [m5] "=&s"(m5_), [m6] "=&s"(m6_), [m7] "=&s"(m7_), [dd] "=&s"(dd_) \
                 : [k0] "v"((k)[0]), [k1] "v"((k)[1]), [k2] "v"((k)[2]), [k3] "v"((k)[3]), [k4] "v"((k)[4]), [k5] "v"((k)[5]), [k6] "v"((k)[6]), [k7] "v"((k)[7]), [c] "s"(cand)); } while (0)

#define SCNT8(OP, cnt, cand, k) do { unsigned long long m0_, m1_, m2_, m3_, m4_, m5_, m6_, m7_; int c0_, c1_, c2_, c3_, c4_, c5_, c6_, c7_; \
    asm volatile("v_cmp_" OP "_u32_e64 %[m0], %[k0], %[c]\n\tv_cmp_" OP "_u32_e64 %[m1], %[k1], %[c]\n\tv_cmp_" OP "_u32_e64 %[m2], %[k2], %[c]\n\tv_cmp_" OP "_u32_e64 %[m3], %[k3], %[c]\n\t" \
                 "v_cmp_" OP "_u32_e64 %[m4], %[k4], %[c]\n\tv_cmp_" OP "_u32_e64 %[m5], %[k5], %[c]\n\tv_cmp_" OP "_u32_e64 %[m6], %[k6], %[c]\n\tv_cmp_" OP "_u32_e64 %[m7], %[k7], %[c]\n\t" \
                 "s_bcnt1_i32_b64 %[c0], %[m0]\n\ts_bcnt1_i32_b64 %[c1], %[m1]\n\ts_bcnt1_i32_b64 %[c2], %[m2]\n\ts_bcnt1_i32_b64 %[c3], %[m3]\n\t" \
                 "s_bcnt1_i32_b64 %[c4], %[m4]\n\ts_bcnt1_i32_b64 %[c5], %[m5]\n\ts_bcnt1_i32_b64 %[c6], %[m6]\n\ts_bcnt1_i32_b64 %[c7], %[m7]\n\t" \
                 : [m0] "=&s"(m0_), [m1] "=&s"(m1_), [m2] "=&s"(m2_), [m3] "=&s"(m3_), [m4] "=&s"(m4_), [m5] "=&s"(m5_), [m6] "=&s"(m6_), [m7] "=&s"(m7_), \
                   [c0] "=&s"(c0_), [c1] "=&s"(c1_), [c2] "=&s"(c2_), [c3] "=&s"(c3_), [c4] "=&s"(c4_), [c5] "=&s"(c5_), [c6] "=&s"(c6_), [c7] "=&s"(c7_) \
                 : [k0] "v"((k)[0]), [k1] "v"((k)[1]), [k2] "v"((k)[2]), [k3] "v"((k)[3]), [k4] "v"((k)[4]), [k5] "v"((k)[5]), [k6] "v"((k)[6]), [k7] "v"((k)[7]), [c] "s"(cand) : "scc"); \
    cnt += ((c0_ + c1_) + (c2_ + c3_)) + ((c4_ + c5_) + (c6_ + c7_)); } while (0)

__device__ __forceinline__ unsigned ordered_key(float f) { const unsigned u = __float_as_uint(f); return (u & 0x80000000u) ? ~u : (u | 0x80000000u); }
__device__ __forceinline__ void indexer_unit(const bf16_t* __restrict__ zb, unsigned* __restrict__ maskp, unsigned* sc  , bf16_t* ring  ,
                                             const int b, const int t0, const int tid) {
    typedef unsigned long long u64;
    const int lane = tid & 63, wave = tid >> 6;
    const int r31 = lane & 31, hh = lane >> 5;
    constexpr int IDX_TILE = 32 * 72, IDX_SLOT = 2 * IDX_TILE;
    unsigned* hist = (unsigned*)ring + wave * 256;
    {
        const int g = wave & 3, par = wave >> 2;
        const int head = (r31 & 3) + 4 * ((r31 >> 3) & 1), ql = 2 * ((r31 >> 4) & 1) + ((r31 >> 2) & 1);
        const bf16_t* ap = zb + (size_t)(b * SEQ + t0 + 4 * g + ql) * ZLD + C_IQ + head * 64 + 8 * hh;
        bf16x8 a[4];
#pragma unroll
        for (int s4 = 0; s4 < 4; ++s4) a[s4] = *(const bf16x8*)(ap + 16 * s4);
        float wq[16];
        {
            const int qa = t0 + 4 * g + hh, qb = qa + 2;
            f32x4 w0, w1, w2, w3; pg8::bf8_to_f32(*(const u32x4*)(zb + (size_t)(b * SEQ + qa) * ZLD + C_IW), w0, w1); pg8::bf8_to_f32(*(const u32x4*)(zb + (size_t)(b * SEQ + qb) * ZLD + C_IW), w2, w3);
#pragma unroll
            for (int i = 0; i < 4; ++i) { wq[i] = w0[i] * 0.04419417382415922f; wq[4 + i] = w1[i] * 0.04419417382415922f; wq[8 + i] = w2[i] * 0.04419417382415922f; wq[12 + i] = w3[i] * 0.04419417382415922f; }
        }
        const int ta = t0 + 4 * g + hh, tb_ = ta + 2;
        const int kt_max = (t0 + 15) >> 5, nit = (kt_max >> 1) + 1;
        const int lsub = tid >> 8, lkey = (tid & 255) >> 3, lpc = tid & 7;
        const bf16_t* gsrc = zb + ((size_t)b * SEQ + lsub * 32 + lkey) * ZLD + C_IK + lpc * 8;
        const int loff = lsub * IDX_TILE + lkey * 72 + lpc * 8;
        u32x4 stg;
        __syncthreads();
        if (lsub <= kt_max) { stg = *(const u32x4*)gsrc; *(u32x4*)(ring + loff) = stg; }
        if (nit > 1 && 2 + lsub <= kt_max) { stg = *(const u32x4*)(gsrc + (size_t)64 * ZLD); *(u32x4*)(ring + IDX_SLOT + loff) = stg; }
        __syncthreads();
        for (int it = 0; it < nit; ++it) {
            const bool more = (it + 2 < nit) && (2 * (it + 2) + lsub <= kt_max);
            if (more) stg = *(const u32x4*)(gsrc + (size_t)(it + 2) * 64 * ZLD);
            const int kt = 2 * it + par;
            if (kt <= kt_max) {
                const bf16_t* tl = ring + (it % 3) * IDX_SLOT + par * IDX_TILE + r31 * 72 + 8 * hh;
                f32x16 acc;
#pragma unroll
                for (int q = 0; q < 16; ++q) acc[q] = 0.f;
#pragma unroll
                for (int s4 = 0; s4 < 4; ++s4) { const bf16x8 bk = *(const bf16x8*)(tl + 16 * s4); acc = __builtin_amdgcn_mfma_f32_32x32x16_bf16(a[s4], bk, acc, 0, 0, 0); }
                float sa = 0.f, sb = 0.f;
#pragma unroll
                for (int i = 0; i < 8; ++i) { sa += wq[i] * fmaxf(acc[i], 0.f); sb += wq[8 + i] * fmaxf(acc[8 + i], 0.f); }
                const int key = kt * 32 + r31;
                sc[(4 * g + hh) * 2048 + key] = key <= ta ? ordered_key(sa) : 0u;
                sc[(4 * g + 2 + hh) * 2048 + key] = key <= tb_ ? ordered_key(sb) : 0u;
            }
            if (more) *(u32x4*)(ring + ((it + 2) % 3) * IDX_SLOT + loff) = stg;
            __syncthreads();
        }
    }
    for (int srep_ = 0; srep_ < (PROBE_GROUP == 8 ? 2 : 1); ++srep_)
    for (int qq = 2 * wave; qq < 2 * wave + 2; ++qq) {
        const int t = t0 + qq;
        unsigned kreg[32];
#pragma unroll
        for (int i = 0; i < 32; ++i) kreg[i] = sc[qq * 2048 + lane + 64 * i];
        asm volatile("" ::: "memory");
#pragma unroll
        for (int i = 0; i < 32; ++i) kreg[i] = (lane + 64 * i <= t) ? kreg[i] : 0u;
        const int ngrp = __builtin_amdgcn_readfirstlane((t >> 9) + 1);
        unsigned kand = 0xffffffffu, kor = 0u;
#pragma unroll
        for (int i = 0; i < 32; ++i) { if (lane + 64 * i <= t) { kand &= kreg[i]; kor |= kreg[i]; } }
        kand = (unsigned)wave_and_u(kand); kor = (unsigned)wave_or_u(kor);
        const unsigned diff = kand ^ kor;
        unsigned prefix; int hb;
        if (diff == 0u) { prefix = kor; hb = -1; } else { hb = 31 - __builtin_clz(diff); prefix = (hb == 31) ? 0u : (kor & ~((2u << hb) - 1u)); }
        bool exact = false;
        for (int bit = hb; bit >= 0; --bit) {
            const unsigned cand = prefix | (1u << bit);
            int cnt = 0;
            SCNT8("ge", cnt, cand, kreg); if (ngrp > 1) SCNT8("ge", cnt, cand, kreg + 8); if (ngrp > 2) SCNT8("ge", cnt, cand, kreg + 16); if (ngrp > 3) SCNT8("ge", cnt, cand, kreg + 24);
            if (cnt >= 256) prefix = cand;
            if (cnt == 256) { exact = true; break; }
        }
        int kk = 0;
        if (!exact) { int cg = 0;
            SCNT8("gt", cg, prefix, kreg); if (ngrp > 1) SCNT8("gt", cg, prefix, kreg + 8); if (ngrp > 2) SCNT8("gt", cg, prefix, kreg + 16); if (ngrp > 3) SCNT8("gt", cg, prefix, kreg + 24);
            kk = 256 - cg; }
        const unsigned gtv = exact ? prefix - 1u : prefix;
        unsigned myword = 0u; int eqbefore = 0;
#pragma unroll
        for (int gi = 0; gi < 4; ++gi) {
            if (gi < ngrp) {
                if (exact) {
#pragma unroll
                    for (int i = 8 * gi; i < 8 * gi + 8; ++i) { const unsigned long long bs = __ballot(kreg[i] > gtv); if (lane == 2 * i) myword = (unsigned)bs; if (lane == 2 * i + 1) myword = (unsigned)(bs >> 32); }
                } else {
#pragma unroll
                    for (int i = 8 * gi; i < 8 * gi + 8; ++i) {
                        const bool eq = kreg[i] == prefix;
                        const unsigned long long beq = __ballot(eq);
                        const int rank = eqbefore + __popcll(beq & ((1ull << lane) - 1ull));
                        const bool sel = kreg[i] > gtv || (eq && rank < kk);
                        const unsigned long long bs = __ballot(sel);
                        eqbefore += __popcll(beq);
                        if (lane == 2 * i) myword = (unsigned)bs;
                        if (lane == 2 * i + 1) myword = (unsigned)(bs >> 32);
                    }
                }
            }
        }
        maskp[(size_t)(b * SEQ + t) * 64 + lane] = myword;
    }
    __syncthreads();
}

constexpr int ATT_KROW = 72, ATT_VROW = 68, ATT_SLOT = 64 * ATT_KROW + 64 * ATT_VROW;
__device__ __forceinline__ void attn_block(const bf16_t* __restrict__ zb, const bf16_t* __restrict__ vbt, const unsigned* __restrict__ maskp, bf16_t* __restrict__ att, const float* tb  ,
                                           bf16_t* ring  , const int b, const int qt, const int tid) {
    typedef unsigned long long u64;
    const int lane = tid & 63, wave = tid >> 6;
    const int c = lane & 31, hh = lane >> 5, h = c & 7;
    const int t0w = qt * 32 + 4 * wave;
    const int tq = t0w + (c >> 3);
    const size_t rowq = (size_t)b * SEQ + tq;
    bf16x8 bq[4];
#pragma unroll
    for (int s4 = 0; s4 < 4; ++s4) bq[s4] = *(const bf16x8*)(zb + rowq * ZLD + C_QB + h * 64 + 16 * s4 + 8 * hh);
    const int nstep = (qt >> 1) + 1;
    const float bfar = tb[127 * 8 + h];
    const float QS = 0.125f * 1.4426950408889634f;
    float m = -1e30f, lsum = 0.f;
    f32x16 O0, O1;
#pragma unroll
    for (int q = 0; q < 16; ++q) { O0[q] = 0.f; O1[q] = 0.f; }
    const u64* mbase = (const u64*)(maskp + rowq * 64);
    const int lrow = tid >> 3, lpc = tid & 7;
    const bf16_t* gk = zb + ((size_t)b * SEQ + lrow) * ZLD + C_KB + lpc * 8;
    const bf16_t* gv = vbt + ((size_t)b * 64 + lrow) * SEQ + lpc * 8;
    const int lk = lrow * ATT_KROW + lpc * 8, lv = 64 * ATT_KROW + lrow * ATT_VROW + lpc * 8;
    u32x4 sk = *(const u32x4*)gk, sv = *(const u32x4*)gv;
    { *(u32x4*)(ring + lk) = sk; u64* d = (u64*)(ring + lv); d[0] = (u64)sv.x | ((u64)sv.y << 32); d[1] = (u64)sv.z | ((u64)sv.w << 32); }
    if (nstep > 1) { sk = *(const u32x4*)(gk + (size_t)64 * ZLD); sv = *(const u32x4*)(gv + 64);
        *(u32x4*)(ring + ATT_SLOT + lk) = sk; u64* d = (u64*)(ring + ATT_SLOT + lv); d[0] = (u64)sv.x | ((u64)sv.y << 32); d[1] = (u64)sv.z | ((u64)sv.w << 32); }
    u64 mw2 = mbase[0];
    __syncthreads();
    for (int st = 0; st < nstep; ++st) {
        const int key0 = st * 64;
        const bf16_t* sl = ring + (st % 3) * ATT_SLOT;
        const bool more = st + 2 < nstep;
        if (more) { sk = *(const u32x4*)(gk + (size_t)(st + 2) * 64 * ZLD); sv = *(const u32x4*)(gv + (st + 2) * 64); }
        const unsigned cm0 = (unsigned)mw2 >> (4 * hh), cm1 = (unsigned)(mw2 >> 32) >> (4 * hh);
        mw2 = mbase[st + 1 < nstep ? st + 1 : st];
        f32x16 S0, S1;
#pragma unroll
        for (int q = 0; q < 16; ++q) { S0[q] = 0.f; S1[q] = 0.f; }
#pragma unroll
        for (int s4 = 0; s4 < 4; ++s4) {
            const bf16x8 k0 = *(const bf16x8*)(sl + c * ATT_KROW + 16 * s4 + 8 * hh), k1 = *(const bf16x8*)(sl + (32 + c) * ATT_KROW + 16 * s4 + 8 * hh);
            S0 = __builtin_amdgcn_mfma_f32_32x32x16_bf16(k0, bq[s4], S0, 0, 0, 0);
            S1 = __builtin_amdgcn_mfma_f32_32x32x16_bf16(k1, bq[s4], S1, 0, 0, 0);
        }
        float x0[16], x1[16]; float tmax = -1e30f;
        {
            float bs[16];
            if ((t0w - key0 - 31) < 113) {
                const int relb = tq - key0 - 4 * hh;
#pragma unroll
                for (int i = 0; i < 16; ++i) { int rel = relb - ((i & 3) + 8 * (i >> 2)); rel = rel < 0 ? 0 : (rel > 127 ? 127 : rel); bs[i] = tb[rel * 8 + h]; }
            } else {
#pragma unroll
                for (int i = 0; i < 16; ++i) bs[i] = bfar;
            }
#pragma unroll
            for (int i = 0; i < 16; ++i) { const int ko = (i & 3) + 8 * (i >> 2); const float xv = __builtin_fmaf(S0[i], QS, bs[i]); x0[i] = (cm0 & (1u << ko)) ? xv : -2e30f; tmax = fmaxf(tmax, x0[i]); }
        }
        {
            float bs[16];
            if ((t0w - key0 - 63) < 113) {
                const int relb = tq - key0 - 32 - 4 * hh;
#pragma unroll
                for (int i = 0; i < 16; ++i) { int rel = relb - ((i & 3) + 8 * (i >> 2)); rel = rel < 0 ? 0 : (rel > 127 ? 127 : rel); bs[i] = tb[rel * 8 + h]; }
            } else {
#pragma unroll
                for (int i = 0; i < 16; ++i) bs[i] = bfar;
            }
#pragma unroll
            for (int i = 0; i < 16; ++i) { const int ko = (i & 3) + 8 * (i >> 2); const float xv = __builtin_fmaf(S1[i], QS, bs[i]); x1[i] = (cm1 & (1u << ko)) ? xv : -2e30f; tmax = fmaxf(tmax, x1[i]); }
        }
        tmax = fmaxf(tmax, __shfl_xor(tmax, 32));
        const float mn = fmaxf(m, tmax);
        if (__ballot(mn > m) != 0ull) {
            const float scl = __builtin_amdgcn_exp2f(m - mn);
            lsum *= scl;
#pragma unroll
            for (int q = 0; q < 16; ++q) { O0[q] *= scl; O1[q] *= scl; }
        }
        m = mn;
        float p0[16], p1[16];
#pragma unroll
        for (int i = 0; i < 16; ++i) { const int ko = (i & 3) + 8 * (i >> 2);
            (void)ko; p0[i] = __builtin_amdgcn_exp2f(x0[i] - m); p1[i] = __builtin_amdgcn_exp2f(x1[i] - m); lsum += p0[i] + p1[i]; }
        union { unsigned u[4]; bf16x8 v; } pb00, pb01, pb10, pb11;
#pragma unroll
        for (int j = 0; j < 4; ++j) { pb00.u[j] = pg8::cvt_pk_bf16(p0[2 * j], p0[2 * j + 1]); pb01.u[j] = pg8::cvt_pk_bf16(p0[8 + 2 * j], p0[8 + 2 * j + 1]);
                                      pb10.u[j] = pg8::cvt_pk_bf16(p1[2 * j], p1[2 * j + 1]); pb11.u[j] = pg8::cvt_pk_bf16(p1[8 + 2 * j], p1[8 + 2 * j + 1]); }
        const bf16_t* vt = sl + 64 * ATT_KROW + c * ATT_VROW + 4 * hh;
#pragma unroll
        for (int sub = 0; sub < 2; ++sub) {
            union { u64 q[2]; bf16x8 v; } a00, a01, a10, a11;
            const bf16_t* vs = vt + 32 * sub;
            a00.q[0] = *(const u64*)(vs); a00.q[1] = *(const u64*)(vs + 8); a01.q[0] = *(const u64*)(vs + 16); a01.q[1] = *(const u64*)(vs + 24);
            a10.q[0] = *(const u64*)(vs + 32 * ATT_VROW); a10.q[1] = *(const u64*)(vs + 32 * ATT_VROW + 8); a11.q[0] = *(const u64*)(vs + 32 * ATT_VROW + 16); a11.q[1] = *(const u64*)(vs + 32 * ATT_VROW + 24);
            O0 = __builtin_amdgcn_mfma_f32_32x32x16_bf16(a00.v, sub ? pb10.v : pb00.v, O0, 0, 0, 0);
            O1 = __builtin_amdgcn_mfma_f32_32x32x16_bf16(a10.v, sub ? pb10.v : pb00.v, O1, 0, 0, 0);
            O0 = __builtin_amdgcn_mfma_f32_32x32x16_bf16(a01.v, sub ? pb11.v : pb01.v, O0, 0, 0, 0);
            O1 = __builtin_amdgcn_mfma_f32_32x32x16_bf16(a11.v, sub ? pb11.v : pb01.v, O1, 0, 0, 0);
        }
        if (more) { bf16_t* ds = ring + ((st + 2) % 3) * ATT_SLOT; *(u32x4*)(ds + lk) = sk; u64* d = (u64*)(ds + lv); d[0] = (u64)sv.x | ((u64)sv.y << 32); d[1] = (u64)sv.z | ((u64)sv.w << 32); }
        __syncthreads();
    }
    lsum += __shfl_xor(lsum, 32);
    const float inv = __builtin_amdgcn_rcpf(lsum);
    bf16_t* op = att + rowq * D + 512 + h * 64 + 4 * hh;
#pragma unroll
    for (int g4 = 0; g4 < 4; ++g4) {
        unsigned w0 = pg8::cvt_pk_bf16(O0[4 * g4] * inv, O0[4 * g4 + 1] * inv), w1 = pg8::cvt_pk_bf16(O0[4 * g4 + 2] * inv, O0[4 * g4 + 3] * inv);
        *(u64*)(op + 8 * g4) = (u64)w0 | ((u64)w1 << 32);
        w0 = pg8::cvt_pk_bf16(O1[4 * g4] * inv, O1[4 * g4 + 1] * inv); w1 = pg8::cvt_pk_bf16(O1[4 * g4 + 2] * inv, O1[4 * g4 + 3] * inv);
        *(u64*)(op + 32 + 8 * g4) = (u64)w0 | ((u64)w1 << 32);
    }
}

__device__ __forceinline__ void xcd_barrier_bg(const XcdBarrier& b, unsigned char* ldsb) {
    asm volatile("s_waitcnt vmcnt(0)" ::: "memory");
    __syncthreads();
    if (threadIdx.x == 0) {
        unsigned* bar = b.bar; asm volatile("" : "+s"(bar));
        __builtin_amdgcn_s_waitcnt(0);
        unsigned nloc = b.st[0], nx = b.st[1];
        if (nloc == 0u) { xcd_barrier_complete(bar, b.x, nloc, nx); b.st[0] = nloc; b.st[1] = nx; }
        const unsigned old = xb_add(&bar[XB_XSUB(b.x)], 1u);
        const unsigned gen = old / nloc;
        if (old + 1u == (gen + 1u) * nloc) {
            __builtin_amdgcn_fence(__ATOMIC_RELEASE, "agent");
            asm volatile("s_waitcnt vmcnt(0)" ::: "memory");
            const unsigned og = xb_add(&bar[XB_TOP], 1u);
            const unsigned tg = og / nx;
            if (og + 1u == (tg + 1u) * nx) xb_add(&bar[XB_TOPGEN], 1u);
            else XB_SPIN(xb_ld(&bar[XB_TOPGEN]) == tg, bar);
            __builtin_amdgcn_fence(__ATOMIC_ACQUIRE, "agent");
            xb_add(&bar[XB_XGEN(b.x)], 1u);
            asm volatile("s_waitcnt vmcnt(0)" ::: "memory");
            b.st[2] = 0u;
        } else { b.st[2] = 1u; b.st[3] = gen; }
    }
    __syncthreads();
    if (b.st[2] != 0u) {
        const unsigned gen = __builtin_amdgcn_readfirstlane(b.st[3]);
        bg_convert(ldsb, (int)threadIdx.x, true, CW_BAR + XB_XGEN(b.x), gen, BG_E);
        asm volatile("s_waitcnt vmcnt(0)" ::: "memory");
        __syncthreads();
        if (threadIdx.x == 0) {
            unsigned* bar = b.bar; asm volatile("" : "+s"(bar));
            XB_SPIN(xb_ld(&bar[XB_XGEN(b.x)]) == gen, bar);
            __builtin_amdgcn_fence(__ATOMIC_ACQUIRE, "agent");
            asm volatile("s_waitcnt vmcnt(0)" ::: "memory");
        }
    }
    __syncthreads();
}

template <int KIND> __global__ void __launch_bounds__(NTHREADS, 2) fwd(Args args) {
    extern __shared__ __attribute__((aligned(16))) unsigned char lds[];
    const int tid = threadIdx.x, lane = tid & 63, wave = tid >> 6;
    const int G = gridDim.x;
    PG8_LAS unsigned char* const lds3 = (PG8_LAS unsigned char*)lds;
#define WS_OPAQUE() unsigned long long ws_raw_ = (unsigned long long)args.ws; asm volatile("" : "+s"(ws_raw_)); GAS unsigned char* const wsg_ = (GAS unsigned char*)ws_raw_; unsigned char* const ws = (unsigned char*)wsg_; int tid = threadIdx.x; asm volatile("" : "+v"(tid)); const int lane = tid & 63, wave = tid >> 6; (void)lane; (void)wave
#define ctl ((unsigned*)(ws + WS_CTL))
#define MOD ((float*)(ws + WS_MOD))
#define LB ((float*)(ws + WS_LB))
#define WIN ((bf16_t*)(ws + WS_WIN))
#define WPA ((bf16_t*)(ws + WS_WPA))
#define WPB ((bf16_t*)(ws + WS_WPB))
#define WOUT ((bf16_t*)(ws + WS_WOUT))
#define W1 ((bf16_t*)(ws + WS_W1))
#define W2 ((bf16_t*)(ws + WS_W2))
#define H ((bf16_t*)(ws + WS_H))
#define ZB ((bf16_t*)(ws + WS_Z))
#define VBT ((bf16_t*)(ws + WS_VBT))
#define Y ((bf16_t*)(ws + WS_Y))
#define XS ((bf16_t*)(ws + WS_XS))
#define ACT ((bf16_t*)(ws + WS_ACT))
#define QEG ((bf16_t*)(ws + WS_QEG))
#define KEG ((bf16_t*)(ws + WS_KEG))
#define KETG ((bf16_t*)(ws + WS_KETG))
#define HVEC ((float*)(ws + WS_HVEC))
#define HA ((bf16_t*)(ws + WS_HA))
#define ATT ((bf16_t*)(ws + WS_ATT))
#define MASK ((unsigned*)(ws + WS_MASK))
#define MERGED ((bf16_t*)(ws + WS_MERGED))
#define X1 ((bf16_t*)(ws + WS_X1))
#define X2 ((bf16_t*)(ws + WS_X2))
#define TOKE ((int*)(ws + WS_TOKE))
#define TOKG ((float*)(ws + WS_TOKG))
#define TOKP ((int*)(ws + WS_TOKP))
#define TOKS ((int*)(ws + WS_TOKS))
#define BLKE ((int*)(ws + WS_BLKE))
#define SLOTTOK ((int*)(ws + WS_XS))
#define BCNT ((int*)(ws + WS_BCNT))
    const int lo = args.ph_lo, hi = args.ph_hi;
#define IN(k) ((KIND < 0 || ((k) == 0 ? KIND == 100 : KIND == ((k) - 1) % 11)) && lo <= (k) && (k) < hi)
#define SEAM(k) do { if (KIND < 0 && IN(k) && IN((k) + 1)) { if (DEPTH == 2) xcd_barrier_bg(bar, lds); else xcd_barrier(bar); } } while (0)
    XcdBarrier bar; bar.bar = (unsigned*)(args.ws + WS_CTL) + CW_BAR; bar.x = 0; bar.st = nullptr;
    if (KIND < 0) {
        volatile LAS unsigned* xbw = (volatile LAS unsigned*)((LAS unsigned char*)lds + (LDS_BYTES - 16));
        if (tid == 0) { xbw[0] = 0u; xbw[1] = 0u; xbw[2] = 0u; xbw[3] = 0u; }
        __syncthreads();
        bar = xcd_barrier_post((unsigned*)(args.ws + WS_CTL) + CW_BAR, xbw);
    }

    if (IN(0)) for (int prep_ = 0; prep_ < probe_reps(100); ++prep_) {
        WS_OPAQUE();
        {
            bf16_t* lt = (bf16_t*)lds;
            f32x4 v[8];
            constexpr bool BGL1 = (DEPTH == 2 && KIND < 0); constexpr int CJ_P0 = BGL1 ? CJ_PH0 : CJ_TOTAL;
            int J = blockIdx.x;
            CvtJob cur = cvt_job(J < CJ_P0 ? (BGL1 ? ph0_job_index(J) : J) : 0, args.in, ws);
            if (J < CJ_P0) cvt_load(cur, tid, v);
            __syncthreads();
            for (; J < CJ_P0; J += G) {
                {
                    const int i = tid >> 3, c0 = (tid & 7) * 32;
#pragma unroll
                    for (int q = 0; q < 8; q += 2) { u32x4 w; w.x = pg8::cvt_pk_bf16(v[q][0], v[q][1]); w.y = pg8::cvt_pk_bf16(v[q][2], v[q][3]); w.z = pg8::cvt_pk_bf16(v[q + 1][0], v[q + 1][1]); w.w = pg8::cvt_pk_bf16(v[q + 1][2], v[q + 1][3]);
                        *(u32x4*)(lt + i * 264 + c0 + 4 * q) = w; }
                }
                __syncthreads();
                const CvtJob me = cur;
                if (J + G < CJ_P0) { cur = cvt_job(BGL1 ? ph0_job_index(J + G) : J + G, args.in, ws); cvt_load(cur, tid, v); }
                {
                    const int n = tid & 255, kh = tid >> 8;
                    unsigned w[16];
#pragma unroll
                    for (int q = 0; q < 16; ++q) w[q] = (unsigned)lt[(kh * 32 + 2 * q) * 264 + n] | ((unsigned)lt[(kh * 32 + 2 * q + 1) * 264 + n] << 16);
                    bf16_t* dp = me.dst + (size_t)n * me.K + kh * 32;
#pragma unroll
                    for (int q = 0; q < 4; ++q) { u32x4 o; o.x = w[4 * q]; o.y = w[4 * q + 1]; o.z = w[4 * q + 2]; o.w = w[4 * q + 3]; *(u32x4*)(dp + 8 * q) = o; }
                }
                __syncthreads();
            }
        }
        {
            float* ca = (float*)lds;
            float* red = ca + NB * D;
            __syncthreads();
            for (int i = tid; i < NB * D; i += NTHREADS) { const float c = args.in[I_C][i]; ca[i] = c * sigmoidf_(c); }
            __syncthreads();
            for (int u = blockIdx.x; u < DEPTH * NMOD / 48; u += G) {
                const int jc = tid % 48, kg = tid / 48;
                const int ln = u * 48 + jc, l = ln / NMOD, n = ln % NMOD;
                if (kg < 10) {
                    const float* w = args.in[I_WADA] + (size_t)l * D * NMOD + n;
                    float acc[NB];
#pragma unroll
                    for (int b = 0; b < NB; ++b) acc[b] = 0.f;
                    for (int k = kg; k < D; k += 10) { const float wv = w[(size_t)k * NMOD];
#pragma unroll
                        for (int b = 0; b < NB; ++b) acc[b] += ca[b * D + k] * wv; }
#pragma unroll
                    for (int b = 0; b < NB; ++b) red[(kg * NB + b) * 48 + jc] = acc[b];
                }
                __syncthreads();
                for (int o = tid; o < NB * 48; o += NTHREADS) { const int b = o / 48, jj = o % 48; float a = 0.f;
#pragma unroll
                    for (int q = 0; q < 10; ++q) a += red[(q * NB + b) * 48 + jj];
                    const int ln2 = u * 48 + jj, l2 = ln2 / NMOD, n2 = ln2 % NMOD;
                    MOD[((size_t)l2 * NB + b) * NMOD + n2] = a + args.in[I_BADA][(size_t)l2 * NMOD + n2]; }
                __syncthreads();
            }
        }
        if (blockIdx.x == G - 1) {
            for (int j = tid; j < 512; j += NTHREADS) { const float a0 = args.in[I_LBL][j], a1 = args.in[I_LBL][512 + j]; LB[j] = 0.f; LB[512 + j] = 1.0f / (1.0f + __expf(a0 - a1)); }
        }
    }

    SEAM(0);
    if (PROBE_GROUP == 13 && KIND < 0) { for (int i = 0; i < 20; ++i) xcd_barrier(bar); }
#pragma unroll
    for (int l = 0; l < DEPTH; ++l) {
        const int P = 1 + 11 * l;
#define mod (MOD + (size_t)l * NB * NMOD)
        if (IN(P + 0) && l == 0) {
            WS_OPAQUE();
            const float* nw = args.in[I_NMW] + (size_t)l * D;
            for (int row = blockIdx.x * NWAVES + wave; row < T; row += G * NWAVES) {
                const int b = row >> 11; f32x4 v[4]; float ss = 0.f;
#pragma unroll
                for (int i = 0; i < 4; ++i) { v[i] = *(const f32x4*)(args.in[I_X] + (size_t)row * D + (lane + 64 * i) * 4); ss += v[i][0] * v[i][0] + v[i][1] * v[i][1] + v[i][2] * v[i][2] + v[i][3] * v[i][3]; }
                ss = wave_sum(ss); const float r = rsqrtf(ss * (1.0f / D) + EPS);
#pragma unroll
                for (int i = 0; i < 4; ++i) { const int c = (lane + 64 * i) * 4;
                    const f32x4 w4 = *(const f32x4*)(nw + c), sc4 = *(const f32x4*)(mod + (size_t)b * NMOD + D + c), sh4 = *(const f32x4*)(mod + (size_t)b * NMOD + c);
                    const f32x4 hv = v[i] * r * w4 * (1.0f + sc4) + sh4;
                    *(unsigned long long*)(H + (size_t)row * D + c) = (unsigned long long)pg8::cvt_pk_bf16(hv[0], hv[1]) | ((unsigned long long)pg8::cvt_pk_bf16(hv[2], hv[3]) << 32);
                    *(unsigned long long*)(X2 + (size_t)row * D + c) = (unsigned long long)pg8::cvt_pk_bf16(v[i][0], v[i][1]) | ((unsigned long long)pg8::cvt_pk_bf16(v[i][2], v[i][3]) << 32); }
            }
        }
        if (l == 0) SEAM(P + 0);
        if (IN(P + 1)) for (int prep_ = 0; prep_ < probe_reps(1); ++prep_) {
            WS_OPAQUE();
            pg8::Gemm g{H, WIN + (size_t)l * ZLD * D, T, ZLD, D}; pg8::StaticOrder S; S.init(T, ZLD, G, (int)blockIdx.x);
            pg8::EpiZ E{ZB, ZLD};
            pg8::gemm_phase(lds3, tid, g, S, E);
        }
        SEAM(P + 1);
        if (IN(P + 2)) for (int prep_ = 0; prep_ < probe_reps(2); ++prep_) {
            WS_OPAQUE();
            {
                for (int wt = blockIdx.x * NWAVES + wave; wt < (T / 64) * 8; wt += G * NWAVES) {
                    const int rg = wt >> 3, dg = wt & 7; const int row = rg * 64 + lane, bb = row >> 11, sidx = row & 2047;
                    const u32x4 w = *(const u32x4*)(ZB + (size_t)row * ZLD + C_VB + dg * 8);
                    bf16_t* vp = VBT + ((size_t)bb * 64 + dg * 8) * SEQ + sidx;
                    vp[0] = (bf16_t)(w.x & 0xffffu); vp[SEQ] = (bf16_t)(w.x >> 16); vp[2 * SEQ] = (bf16_t)(w.y & 0xffffu); vp[3 * SEQ] = (bf16_t)(w.y >> 16);
                    vp[4 * SEQ] = (bf16_t)(w.z & 0xffffu); vp[5 * SEQ] = (bf16_t)(w.z >> 16); vp[6 * SEQ] = (bf16_t)(w.w & 0xffffu); vp[7 * SEQ] = (bf16_t)(w.w >> 16);
                }
            }
            for (int it = blockIdx.x; it < NB * 4 * 32; it += G) {
                int tid_p = threadIdx.x; asm volatile("" : "+v"(tid_p));
                hgrn_prep_item(ZB, LB + l * 512, QEG, KEG, KETG, HVEC, (float*)lds, it >> 7, (it >> 5) & 3, it & 31, tid_p);
            }
            {
                unsigned* sc = (unsigned*)lds; bf16_t* iring = (bf16_t*)(sc + 16 * 2048);
                int* tk = (int*)(lds + LDS_BYTES - 64);
                for (;;) {
                    __syncthreads();
                    if (tid == 0) *tk = (int)atomicAdd(&ctl[CW_Q + l + 8 * prep_], 1u);
                    __syncthreads();
                    const int ticket = *tk;
                    if (ticket >= T / 16) break;
                    int tid_q = threadIdx.x; asm volatile("" : "+v"(tid_q));
                    const int u = ticket; const int b = u & 15, q16 = 127 - (u >> 4), t0 = q16 * 16;
                    if (t0 < 256) {
                        for (int i = tid_q; i < 16 * 64; i += NTHREADS) { const int qq = i >> 6, w = i & 63, n = t0 + qq + 1, lo_ = w * 32;
                            unsigned mm = 0u; if (n >= lo_ + 32) mm = 0xffffffffu; else if (n > lo_) mm = (1u << (n - lo_)) - 1u; MASK[(size_t)(b * SEQ + t0 + qq) * 64 + w] = mm; }
                    } else indexer_unit(ZB, MASK, sc, iring, b, t0, tid_q);
                }
                __syncthreads();
            }
        }
        SEAM(P + 2);
        if (IN(P + 3)) for (int prep_ = 0; prep_ < probe_reps(3); ++prep_) {
            WS_OPAQUE();
            {
                float* tb = (float*)lds;
                int* tk = (int*)(lds + LDS_BYTES - 64);
                const float* hnw = args.in[I_HNW] + (size_t)l * 512;
                bool tb_ok = false;
                for (;;) {
                    __syncthreads();
                    if (tid == 0) *tk = (int)atomicAdd(&ctl[CW_Q + 2 + l + 8 * prep_], 1u);
                    __syncthreads();
                    const int ticket = *tk;
                    if (ticket >= NB * 4 + T / 32) break;
                    int tid_q = threadIdx.x; asm volatile("" : "+v"(tid_q));
                    if (ticket < NB * 4) { hgrn_item(ZB, QEG, KEG, KETG, HVEC, hnw, HA, lds, ticket >> 2, ticket & 3, tid_q); tb_ok = false; continue; }
                    if (!tb_ok) { for (int i = tid_q; i < 1024; i += NTHREADS) tb[i] = 1.4426950408889634f * args.in[I_RELB][(int)T5_BUCKET[i >> 3] * 8 + (i & 7)]; __syncthreads(); tb_ok = true; }
                    const int u = ticket - NB * 4; const int b = u & 15, qt = 63 - (u >> 4);
                    attn_block(ZB, VBT, MASK, HA, tb, (bf16_t*)(tb + 1024), b, qt, tid_q);
                }
                __syncthreads();
            }
        }
        SEAM(P + 3);
        if (IN(P + 4)) for (int prep_ = 0; prep_ < probe_reps(4); ++prep_) {
            WS_OPAQUE();
            pg8::StaticOrder S; S.init(T, D, G, (int)blockIdx.x);
            pg8::Gemm g{HA, WPA + (size_t)l * D * D, T, D, D}; pg8::EpiMergeF E{MERGED, ZB + C_GTA, ZB + C_GTB}; pg8::gemm_phase(lds3, tid, g, S, E);
        }
        SEAM(P + 4);
        if (IN(P + 5)) for (int prep_ = 0; prep_ < probe_reps(5); ++prep_) {
            WS_OPAQUE();
            pg8::Gemm g{MERGED, WOUT + (size_t)l * D * D, T, D, D}; pg8::StaticOrder S; S.init(T, D, G, (int)blockIdx.x);
            pg8::EpiOutG E{X2, X1, mod + 2 * D}; pg8::gemm_phase(lds3, tid, g, S, E);
        }
        SEAM(P + 5);
        if (IN(P + 6)) for (int prep_ = 0; prep_ < probe_reps(6); ++prep_) {
            WS_OPAQUE();
            const float* nw = args.in[I_NFW] + (size_t)l * D; const float* wr = args.in[I_WR] + (size_t)l * D * NE; const float* br = args.in[I_BR] + (size_t)l * NE;
            constexpr int WTLD = 260;
            float* WT = (float*)lds; float* CAl = WT + 128 * WTLD; float* CBl = CAl + D; float* C0 = CBl + D; unsigned* cntl = (unsigned*)(C0 + NE); float* c0s = (float*)(cntl + NE);
            __syncthreads();
            if (tid < NE) cntl[tid] = 0u;
            const int li = lane & 15, kk = lane >> 4;
            for (int it = 0; (blockIdx.x + it * G) * 128 < T; ++it) {
                const int tokbase = (blockIdx.x + it * G) * 128, b = tokbase >> 11;
                __syncthreads();
                for (int k = tid; k < D; k += NTHREADS) { CAl[k] = nw[k] * (1.0f + mod[(size_t)b * NMOD + 4 * D + k]); CBl[k] = mod[(size_t)b * NMOD + 3 * D + k]; }
                __syncthreads();
                {   const int q = tid & 7; float c0p[4] = {0.f, 0.f, 0.f, 0.f};
                    for (int i = tid; i < D * 8; i += NTHREADS) { const int k = i >> 3, kq = k >> 8, sx = k & 255; const f32x4 w4 = *(const f32x4*)(wr + (size_t)k * NE + 4 * q); const float ca = CAl[k], cb = CBl[k];
#pragma unroll
                        for (int j = 0; j < 4; ++j) { WT[(kq * 32 + 4 * q + j) * WTLD + sx] = ca * w4[j]; c0p[j] += cb * w4[j]; } }
#pragma unroll
                    for (int j = 0; j < 4; ++j) c0s[(tid >> 3) * NE + 4 * q + j] = c0p[j]; }
                __syncthreads();
                if (tid < NE) { float a = br[tid]; for (int r2 = 0; r2 < 64; ++r2) a += c0s[r2 * NE + tid]; C0[tid] = a; }
                __syncthreads();
                const int tok = tokbase + wave * 16 + li;
                const bf16_t* xrow = X1 + (size_t)tok * D + 256 * kk;
                const float* wt0 = WT + (kk * 32 + li) * WTLD; const float* wt1 = wt0 + 16 * WTLD;
                f32x4 d0a = {0.f, 0.f, 0.f, 0.f}, d0b = d0a, d1a = d0a, d1b = d0a; float ss = 0.f;
#pragma unroll 1
                for (int ub = 0; ub < 32; ub += 8) {
                    u32x4 xw[8];
#pragma unroll
                    for (int u = 0; u < 8; ++u) xw[u] = *(const u32x4*)(xrow + 8 * (ub + u));
#pragma unroll
                    for (int u = 0; u < 8; ++u) {
                        f32x4 xlo, xhi; pg8::bf8_to_f32(xw[u], xlo, xhi);
                        const f32x4 a00 = *(const f32x4*)(wt0 + 8 * (ub + u)), a01 = *(const f32x4*)(wt0 + 8 * (ub + u) + 4), a10 = *(const f32x4*)(wt1 + 8 * (ub + u)), a11 = *(const f32x4*)(wt1 + 8 * (ub + u) + 4);
#pragma unroll
                        for (int j = 0; j < 4; ++j) { d0a = __builtin_amdgcn_mfma_f32_16x16x4f32(a00[j], xlo[j], d0a, 0, 0, 0); d1a = __builtin_amdgcn_mfma_f32_16x16x4f32(a10[j], xlo[j], d1a, 0, 0, 0); }
#pragma unroll
                        for (int j = 0; j < 4; ++j) { d0b = __builtin_amdgcn_mfma_f32_16x16x4f32(a01[j], xhi[j], d0b, 0, 0, 0); d1b = __builtin_amdgcn_mfma_f32_16x16x4f32(a11[j], xhi[j], d1b, 0, 0, 0); }
                        ss += xlo[0] * xlo[0] + xlo[1] * xlo[1] + xlo[2] * xlo[2] + xlo[3] * xlo[3] + xhi[0] * xhi[0] + xhi[1] * xhi[1] + xhi[2] * xhi[2] + xhi[3] * xhi[3];
                    }
                }
                ss += __shfl_xor(ss, 16); ss += __shfl_xor(ss, 32);
                const float r = rsqrtf(ss * (1.0f / D) + EPS);
                float lg[8]; int eid[8];
#pragma unroll
                for (int j = 0; j < 4; ++j) { lg[j] = r * (d0a[j] + d0b[j]) + C0[4 * kk + j]; lg[4 + j] = r * (d1a[j] + d1b[j]) + C0[16 + 4 * kk + j]; eid[j] = 4 * kk + j; eid[4 + j] = 16 + 4 * kk + j; }
                float tv[4]; int ti[4];
#pragma unroll
                for (int k = 0; k < 4; ++k) {
                    float bv = lg[0]; int bi = eid[0];
#pragma unroll
                    for (int j = 1; j < 8; ++j) { const bool take = lg[j] > bv; bv = take ? lg[j] : bv; bi = take ? eid[j] : bi; }
#pragma unroll
                    for (int o = 16; o <= 32; o <<= 1) { const float ov = __shfl_xor(bv, o); const int oi = __shfl_xor(bi, o); const bool take = (ov > bv) | ((ov == bv) & (oi < bi)); bv = take ? ov : bv; bi = take ? oi : bi; }
                    tv[k] = bv; ti[k] = bi;
#pragma unroll
                    for (int j = 0; j < 8; ++j) lg[j] = (eid[j] == bi) ? -INFINITY : lg[j];
                }
                const float e1 = __expf(tv[1] - tv[0]), e2 = __expf(tv[2] - tv[0]), e3 = __expf(tv[3] - tv[0]); const float inv = 1.0f / (1.0f + e1 + e2 + e3);
                {   const int ee = kk == 0 ? ti[0] : kk == 1 ? ti[1] : kk == 2 ? ti[2] : ti[3]; const float gg = (kk == 0 ? 1.0f : kk == 1 ? e1 : kk == 2 ? e2 : e3) * inv;
                    TOKE[tok * 4 + kk] = ee; TOKG[tok * 4 + kk] = gg; TOKP[tok * 4 + kk] = (int)atomicAdd(&cntl[ee], 1u); }
                bf16_t* hrow = H + (size_t)tok * D + 256 * kk; const float* cal = CAl + 256 * kk; const float* cbl = CBl + 256 * kk;
#pragma unroll 1
                for (int ub = 0; ub < 32; ub += 8) {
                    u32x4 xw[8];
#pragma unroll
                    for (int u = 0; u < 8; ++u) xw[u] = *(const u32x4*)(xrow + 8 * (ub + u));
#pragma unroll
                    for (int u = 0; u < 8; ++u) {
                        f32x4 xlo, xhi; pg8::bf8_to_f32(xw[u], xlo, xhi);
                        const f32x4 ca0 = *(const f32x4*)(cal + 8 * (ub + u)), ca1 = *(const f32x4*)(cal + 8 * (ub + u) + 4), cb0 = *(const f32x4*)(cbl + 8 * (ub + u)), cb1 = *(const f32x4*)(cbl + 8 * (ub + u) + 4);
                        const f32x4 h0 = xlo * r * ca0 + cb0, h1 = xhi * r * ca1 + cb1;
                        u32x4 w; w.x = pg8::cvt_pk_bf16(h0[0], h0[1]); w.y = pg8::cvt_pk_bf16(h0[2], h0[3]); w.z = pg8::cvt_pk_bf16(h1[0], h1[1]); w.w = pg8::cvt_pk_bf16(h1[2], h1[3]);
                        *(u32x4*)(hrow + 8 * (ub + u)) = w;
                    }
                }
            }
            __syncthreads();
            if (tid < NE) BCNT[blockIdx.x * NE + tid] = (int)cntl[tid];
        }
        SEAM(P + 6);
        if (IN(P + 7)) for (int prep_ = 0; prep_ < probe_reps(7); ++prep_) {
            WS_OPAQUE();
            int* ps = (int*)lds; int* tot = ps + 64; int* basel = tot + 32; int* pall = basel + 32; int* pbef = pall + 16 * NE;
            __syncthreads();
            {
                const int e = tid & 31, pt = tid >> 5, per = (G + 15) / 16; int sa = 0, sb = 0;
                for (int bb = pt * per; bb < (pt + 1) * per && bb < G; ++bb) { const int c = BCNT[bb * NE + e]; sa += c; sb += bb < (int)blockIdx.x ? c : 0; }
                pall[pt * NE + e] = sa; pbef[pt * NE + e] = sb;
            }
            __syncthreads();
            if (tid < NE) { int sa = 0, sb = 0; for (int pt = 0; pt < 16; ++pt) { sa += pall[pt * NE + tid]; sb += pbef[pt * NE + tid]; } tot[tid] = sa; basel[tid] = sb; }
            __syncthreads();
            if (tid == 0) { int a = 0; for (int e = 0; e < NE; ++e) { ps[e] = a; a += ((tot[e] + 255) / 256) * 256; } ps[NE] = a; }
            __syncthreads();
            const int gt = blockIdx.x * NTHREADS + tid, gn = G * NTHREADS;
            for (int grp = blockIdx.x * NWAVES + wave; grp < T / 16; grp += G * NWAVES) {
                const int tok0 = grp * 16;
                const int e_l = TOKE[tok0 * 4 + lane]; const int slot_l = ps[e_l] + basel[e_l] + TOKP[tok0 * 4 + lane];
                TOKS[tok0 * 4 + lane] = slot_l; SLOTTOK[slot_l] = tok0 + (lane >> 2);
            }
            {
                for (int e = blockIdx.x; e < NE; e += G) { if (tid < 256) { const int si = tot[e] + tid; if (si < ps[e + 1] - ps[e]) SLOTTOK[ps[e] + si] = 0; } }
                if (blockIdx.x == G - 1) { const int end8 = ((ps[NE] / 256 + 7) & ~7) * 256; for (int i = ps[NE] + tid; i < end8; i += NTHREADS) SLOTTOK[i] = 0; }
            }
            const int nblk = ps[NE] / 256, nblk8 = (nblk + 7) & ~7;
            for (int mb = gt; mb < nblk8; mb += gn) { int e = 0; if (mb < nblk) { while (e < NE - 1 && mb * 256 >= ps[e + 1]) ++e; } BLKE[mb] = e; }
            if (gt == 0) ctl[CW_NBLK + l] = (unsigned)nblk8;
            __syncthreads();
        }
        if (KIND < 0 && DEPTH == 2 && l == 1 && IN(P + 7)) bg_convert(lds, (int)threadIdx.x, false, 0u, 0u, BG_C);
        SEAM(P + 7);
        if (IN(P + 8)) for (int prep_ = 0; prep_ < probe_reps(8); ++prep_) {
            WS_OPAQUE();
            const int nblk = __builtin_amdgcn_readfirstlane((int)ctl[CW_NBLK + l]);
            PG8_LAS int* const blk_l = (PG8_LAS int*)(lds3 + pg8::STAGE_BYTES);
            for (int i = tid; i < nblk; i += NTHREADS) blk_l[i] = BLKE[i];
            __syncthreads();
            pg8::Gemm g{H, W1 + (size_t)l * NE * 2 * DFF * D, nblk * 256, 2 * DFF, D}; pg8::MoeOrder<8, true> S; S.init(nblk, G, (int)blockIdx.x, blk_l, SLOTTOK);
            pg8::EpiSwigluG E{ACT, args.in[I_B1] + (size_t)l * NE * 2 * DFF}; pg8::gemm_phase(lds3, tid, g, S, E);
        }
        if (KIND < 0 && DEPTH == 2 && IN(P + 8)) bg_convert(lds, (int)threadIdx.x, false, 0u, 0u, l == 0 ? BG_A : BG_E);
        SEAM(P + 8);
        if (IN(P + 9)) for (int prep_ = 0; prep_ < probe_reps(9); ++prep_) {
            WS_OPAQUE();
            const int nblk = __builtin_amdgcn_readfirstlane((int)ctl[CW_NBLK + l]);
            PG8_LAS int* const blk_l = (PG8_LAS int*)(lds3 + pg8::STAGE_BYTES);
            for (int i = tid; i < nblk; i += NTHREADS) blk_l[i] = BLKE[i];
            __syncthreads();
            pg8::Gemm g{ACT, W2 + (size_t)l * NE * D * DFF, nblk * 256, D, DFF}; pg8::MoeOrder<4, false, true> S; S.init(nblk, G, (int)blockIdx.x, blk_l);
            pg8::EpiYG E{Y, args.in[I_B2] + (size_t)l * NE * D}; pg8::gemm_phase(lds3, tid, g, S, E);
        }
        SEAM(P + 9);
        if (IN(P + 10)) for (int prep_ = 0; prep_ < probe_reps(10); ++prep_) {
            WS_OPAQUE();
            const bool last = (l == DEPTH - 1);
            const float* nw = last ? args.in[I_FNW] : args.in[I_NMW] + (size_t)(l + 1) * D;
            const float* modn = MOD + (size_t)(l + 1) * NB * NMOD;
            for (int grp = blockIdx.x * NWAVES + wave; grp < T / 16; grp += G * NWAVES) {
                const int tok0 = grp * 16, b = tok0 >> 11;
                const int slot_l = TOKS[tok0 * 4 + lane]; const float g_l = TOKG[tok0 * 4 + lane];
                f32x4 gf4[4], ca4[4], cb4[4];
#pragma unroll
                for (int i = 0; i < 4; ++i) { const int c = (lane + 64 * i) * 4; gf4[i] = *(const f32x4*)(mod + (size_t)b * NMOD + 5 * D + c); const f32x4 w4 = *(const f32x4*)(nw + c);
                    if (last) { ca4[i] = w4; cb4[i] = (f32x4){0.f, 0.f, 0.f, 0.f}; } else { ca4[i] = w4 * (1.0f + *(const f32x4*)(modn + (size_t)b * NMOD + D + c)); cb4[i] = *(const f32x4*)(modn + (size_t)b * NMOD + c); } }
                for (int j = 0; j < 16; ++j) {
                    const int tok = tok0 + j; f32x4 v[4]; unsigned long long yw[4][4];
#pragma unroll
                    for (int i = 0; i < 4; ++i) { const unsigned long long xw = *(const unsigned long long*)(X1 + (size_t)tok * D + (lane + 64 * i) * 4); const unsigned x0 = (unsigned)xw, x1w = (unsigned)(xw >> 32);
                        v[i][0] = __uint_as_float(x0 << 16); v[i][1] = __uint_as_float(x0 & 0xffff0000u); v[i][2] = __uint_as_float(x1w << 16); v[i][3] = __uint_as_float(x1w & 0xffff0000u); }
                    float gk[4];
#pragma unroll
                    for (int k = 0; k < 4; ++k) { const int slot = __shfl(slot_l, 4 * j + k); gk[k] = __shfl(g_l, 4 * j + k);
#pragma unroll
                        for (int i = 0; i < 4; ++i) yw[k][i] = *(const unsigned long long*)(Y + (size_t)slot * D + (lane + 64 * i) * 4); }
                    float ss = 0.f;
#pragma unroll
                    for (int i = 0; i < 4; ++i) { f32x4 a = {0.f, 0.f, 0.f, 0.f};
#pragma unroll
                        for (int k = 0; k < 4; ++k) { const unsigned y0 = (unsigned)yw[k][i], y1 = (unsigned)(yw[k][i] >> 32);
                            f32x4 y; y[0] = __uint_as_float(y0 << 16); y[1] = __uint_as_float(y0 & 0xffff0000u); y[2] = __uint_as_float(y1 << 16); y[3] = __uint_as_float(y1 & 0xffff0000u); a += gk[k] * y; }
                        v[i] = v[i] + gf4[i] * a; ss += v[i][0] * v[i][0] + v[i][1] * v[i][1] + v[i][2] * v[i][2] + v[i][3] * v[i][3]; }
                    ss = wave_sum(ss); const float r = rsqrtf(ss * (1.0f / D) + EPS);
#pragma unroll
                    for (int i = 0; i < 4; ++i) { const int c = (lane + 64 * i) * 4;
                        if (last) { *(f32x4*)(args.out + (size_t)tok * D + c) = v[i] * r * ca4[i]; }
                        else { *(unsigned long long*)(X2 + (size_t)tok * D + c) = (unsigned long long)pg8::cvt_pk_bf16(v[i][0], v[i][1]) | ((unsigned long long)pg8::cvt_pk_bf16(v[i][2], v[i][3]) << 32);
                            const f32x4 hv = v[i] * r * ca4[i] + cb4[i];
                            *(unsigned long long*)(H + (size_t)tok * D + c) = (unsigned long long)pg8::cvt_pk_bf16(hv[0], hv[1]) | ((unsigned long long)pg8::cvt_pk_bf16(hv[2], hv[3]) << 32); } }
                }
            }
        }
        if (KIND < 0 && DEPTH == 2 && l == 0 && IN(P + 10)) bg_convert(lds, (int)threadIdx.x, false, 0u, 0u, BG_B);
        SEAM(P + 10);
    }
#undef IN
}

constexpr int N_PHASES = 1 + 11 * DEPTH;
typedef void (*kern_t)(Args);
template <int K> static kern_t kern_of() { return fwd<K>; }
static kern_t kern_for(int kind) {
    switch (kind) { case 0: return fwd<0>; case 1: return fwd<1>; case 2: return fwd<2>; case 3: return fwd<3>; case 4: return fwd<4>; case 5: return fwd<5>;
                    case 6: return fwd<6>; case 7: return fwd<7>; case 8: return fwd<8>; case 9: return fwd<9>; case 10: return fwd<10>; default: return fwd<100>; }
}

extern "C" void kernel_launch(void* const* d_in, const int* in_sizes, int n_in, void* d_out, int out_size, void* d_ws, size_t ws_size, hipStream_t stream) {
    static int grid = 0;
    if (grid == 0) {
        if (n_in != 20 || out_size != T * D || ws_size < WS_END) { fprintf(stderr, "kernel_launch: unexpected problem (n_in %d, out %d, ws %zu, need %zu)\n", n_in, out_size, ws_size, (size_t)WS_END); grid = -1; return; }
        int dev = 0, cus = 0;
        if (hipGetDevice(&dev) != hipSuccess || hipDeviceGetAttribute(&cus, hipDeviceAttributeMultiprocessorCount, dev) != hipSuccess) { grid = -1; return; }
        for (int k = 0; k <= 12; ++k) {
            if (hipFuncSetAttribute((const void*)(k == 12 ? (kern_t)fwd<-1> : kern_for(k)), hipFuncAttributeMaxDynamicSharedMemorySize, LDS_BYTES) != hipSuccess) { fprintf(stderr, "kernel_launch: hipFuncSetAttribute failed\n"); grid = -1; return; }
        }
        grid = cus > 0 ? cus : 256;
    }
    if (grid < 0) return;
    (void)hipMemsetAsync((char*)d_ws + WS_CTL, 0, CTL_BYTES, stream);
    Args a{};
    for (int i = 0; i < 20; ++i) a.in[i] = (const float*)d_in[i];
    a.out = (float*)d_out; a.ws = (unsigned char*)d_ws;
#if defined(MULTI_LAUNCH)
    for (int p = 0; p < N_PHASES; ++p) {
        if (p == 1 + 11) continue;
        a.ph_lo = p; a.ph_hi = p + 1;
        const int kind = p == 0 ? 11 : (p - 1) % 11;
        hipLaunchKernelGGL(kern_for(kind), dim3(grid), dim3(NTHREADS), LDS_BYTES, stream, a);
    }
#else
    a.ph_lo = 0; a.ph_hi = N_PHASES;
    hipLaunchKernelGGL(fwd<-1>, dim3(grid), dim3(NTHREADS), LDS_BYTES, stream, a);
#endif
}
```

```cpp
#include <hip/hip_runtime.h>
#include <stdint.h>
#include <stdio.h>

typedef unsigned short bf16_t;
typedef short bf16x8 __attribute__((ext_vector_type(8)));
typedef float f32x4 __attribute__((ext_vector_type(4)));
typedef float f32x16 __attribute__((ext_vector_type(16)));
typedef unsigned u32x4 __attribute__((ext_vector_type(4)));
#define LAS __attribute__((address_space(3)))
#define GAS __attribute__((address_space(1)))

constexpr int T = 32768, D = 1024, NB = 16, SEQ = 2048, DEPTH = 2;
constexpr int ZC = 5320, ZLD = 5376;
constexpr int C_QA = 0, C_FA = 512, C_IA = 1024, C_GA = 1536, C_QB = 2048, C_KB = 2560, C_VB = 2624, C_IQ = 2688, C_IK = 3200, C_IW = 3264, C_GTA = 3272, C_GTB = 4296;
constexpr int NE = 32, DFF = 1024, NSLOT = 131072 + 32 * 256, NBLK_MAX = NSLOT / 256;
constexpr int NMOD = 6 * D;
constexpr float EPS = 1e-6f;
constexpr int NTHREADS = 512, NWAVES = 8;
#ifndef PROBE_GROUP
#define PROBE_GROUP 0
#endif
constexpr int probe_reps(int kind) { return (PROBE_GROUP == 1 && (kind == 1 || kind == 4 || kind == 5 || kind == 8 || kind == 9)) || (PROBE_GROUP == 2 && kind == 2) || (PROBE_GROUP == 3 && kind == 3) || (PROBE_GROUP == 4 && kind == 100) || (PROBE_GROUP == 5 && (kind == 6 || kind == 7 || kind == 10)) || (PROBE_GROUP == 9 && kind == 8) || (PROBE_GROUP == 10 && kind == 1) || (PROBE_GROUP == 11 && kind == 9) || (PROBE_GROUP == 12 && (kind == 4 || kind == 5)) || (PROBE_GROUP == 14 && kind == 4) || (PROBE_GROUP == 15 && kind == 5) ? 2 : 1; }
constexpr int LDS_BYTES = 160 * 1024;

constexpr size_t al256(size_t x) { return (x + 255) & ~(size_t)255; }
constexpr size_t WS_CTL = 0;
constexpr size_t CTL_BYTES = 65536;
constexpr size_t WS_MOD = WS_CTL + CTL_BYTES;
constexpr size_t WS_LB = WS_MOD + al256((size_t)DEPTH * NB * NMOD * 4);
constexpr size_t WS_WIN = WS_LB + al256((size_t)DEPTH * 512 * 4);
constexpr size_t WS_WPA = WS_WIN + (size_t)DEPTH * ZLD * D * 2;
constexpr size_t WS_WPB = WS_WPA + (size_t)DEPTH * D * 512 * 2;
constexpr size_t WS_WOUT = WS_WPB + (size_t)DEPTH * D * 512 * 2;
constexpr size_t WS_W1 = WS_WOUT + (size_t)DEPTH * D * D * 2;
constexpr size_t WS_W2 = WS_W1 + (size_t)DEPTH * NE * 2 * DFF * D * 2;
constexpr size_t WS_H = WS_W2 + (size_t)DEPTH * NE * D * DFF * 2;
constexpr size_t WS_Z = WS_H + (size_t)T * D * 2;
constexpr size_t WS_Y = WS_Z;
constexpr size_t WS_ACT = WS_Z + (size_t)T * ZLD * 2;
constexpr size_t WS_QEG = WS_ACT;
constexpr size_t WS_KEG = WS_QEG + (size_t)T * 512 * 2;
constexpr size_t WS_KETG = WS_KEG + (size_t)T * 512 * 2;
constexpr size_t WS_HVEC = WS_KETG + (size_t)T * 512 * 2;
constexpr size_t WS_XS = WS_ACT + (size_t)NSLOT * DFF * 2;
constexpr size_t WS_HA = WS_XS + (size_t)NSLOT * D * 2;
constexpr size_t WS_ATT = WS_HA + (size_t)T * 512 * 2;
constexpr size_t WS_MASK = WS_ATT + (size_t)T * 512 * 2;
constexpr size_t WS_VBT = WS_MASK + (size_t)T * 64 * 4;
constexpr size_t WS_MERGED = WS_VBT + (size_t)T * 64 * 2;
constexpr size_t WS_X1 = WS_MERGED + (size_t)T * D * 2;
constexpr size_t WS_X2 = WS_X1 + (size_t)T * D * 4;
constexpr size_t WS_TOKE = WS_X2 + (size_t)T * D * 4;
constexpr size_t WS_TOKG = WS_TOKE + (size_t)T * 4 * 4;
constexpr size_t WS_TOKP = WS_TOKG + (size_t)T * 4 * 4;
constexpr size_t WS_TOKS = WS_TOKP + (size_t)T * 4 * 4;
constexpr size_t WS_BLKE = WS_TOKS + (size_t)T * 4 * 4;
constexpr size_t WS_BCNT = WS_BLKE + al256((size_t)(NBLK_MAX + 64) * 4);
constexpr size_t WS_END = WS_BCNT + (size_t)1024 * NE * 4;
static_assert((size_t)NSLOT * D * 2 <= (size_t)T * ZLD * 2, "Y must fit in Z");
static_assert((size_t)T * 512 * 2 * 3 + (size_t)NB * 4 * 32 * 384 * 4 <= (size_t)NSLOT * DFF * 2, "HGRN2 gate tensors must fit in ACT");
static_assert(WS_END <= ((size_t)1 << 31), "workspace layout exceeds 2 GiB");
constexpr int CW_CNT = 1024;
constexpr int CW_NBLK = 1200;
constexpr int CW_Q = 1216;

__device__ __forceinline__ bf16_t f2bf(float f) { unsigned u = __float_as_uint(f); u += 0x7fffu + ((u >> 16) & 1u); return (bf16_t)(u >> 16); }
__device__ __forceinline__ float bf2f(bf16_t b) { return __uint_as_float(((unsigned)b) << 16); }
__device__ __forceinline__ float sigmoidf_(float x) { return __builtin_amdgcn_rcpf(1.0f + __builtin_amdgcn_exp2f(-1.4426950408889634f * x)); }
__device__ __forceinline__ float wave_sum(float v) {
#pragma unroll
    for (int o = 32; o >= 1; o >>= 1) v += __shfl_xor(v, o);
    return v;
}
__device__ __forceinline__ int wave_sum_i(int v) {
#pragma unroll
    for (int o = 32; o >= 1; o >>= 1) v += __shfl_xor(v, o);
    return v;
}
__device__ const unsigned char T5_BUCKET[128] = {
    0, 1, 2, 3, 4, 5, 6, 7, 8, 9, 10, 11, 12, 13, 14, 15, 16, 16, 16, 17, 17, 18, 18, 18, 19, 19, 19, 20, 20, 20, 20, 21, 21, 21, 21, 22, 22, 22, 22, 22, 23, 23, 23, 23, 23, 23, 24, 24, 24, 24, 24, 24, 25,
    25, 25, 25, 25, 25, 25, 26, 26, 26, 26, 26, 26, 26, 26, 27, 27, 27, 27, 27, 27, 27, 27, 27, 27, 28, 28, 28, 28, 28, 28, 28, 28, 28, 28, 29, 29, 29, 29, 29, 29, 29, 29, 29, 29, 29, 29, 30, 30, 30, 30, 30,
    30, 30, 30, 30, 30, 30, 30, 30, 30, 31, 31, 31, 31, 31, 31, 31, 31, 31, 31, 31, 31, 31, 31, 31};
__device__ __forceinline__ int t5_bucket(int rel) { return rel >= 128 ? 31 : (int)T5_BUCKET[rel]; }


#define XB_TMO      128
#define XB_XCNT(j)  (256  + 64 * (j))
#define XB_XSUB(j)  (1280 + 64 * (j))
#define XB_XGEN(j)  (2304 + 64 * (j))
#define XB_TOP      3328
#define XB_TOPGEN   3392
#define XCD_BAR_WORDS 3456
#define XB_SPIN_CAP (1u << 18)
__device__ __forceinline__ unsigned xb_ld(unsigned* p)              { return __hip_atomic_load(p, __ATOMIC_RELAXED, __HIP_MEMORY_SCOPE_AGENT); }
__device__ __forceinline__ unsigned xb_add(unsigned* p, unsigned v) { return __hip_atomic_fetch_add(p, v, __ATOMIC_RELAXED, __HIP_MEMORY_SCOPE_AGENT); }
__device__ __forceinline__ unsigned xb_xcc_id() { return (unsigned)__builtin_amdgcn_s_getreg((3 << 11) | 20) & 0xFu; }
#define XB_SPIN(cond, bar) do { unsigned _sp = 0; while (cond) { __builtin_amdgcn_s_sleep(1); \
    if ((++_sp & 255u) == 0u) { if (xb_ld(&(bar)[XB_TMO])) break; if (_sp > XB_SPIN_CAP) { atomicAdd(&(bar)[XB_TMO], 1u); break; } } } } while (0)
struct XcdBarrier { unsigned* bar; unsigned x; volatile LAS unsigned* st; };
__device__ __forceinline__ XcdBarrier xcd_barrier_post(unsigned* bar, volatile LAS unsigned* st) {
    XcdBarrier b; b.bar = bar; b.x = xb_xcc_id(); b.st = st;
    if (threadIdx.x == 0) (void)xb_add(&bar[XB_XCNT(b.x)], 1u);
    return b;
}
__device__ __forceinline__ void xcd_barrier_complete(unsigned* bar, unsigned x, unsigned& nloc, unsigned& nx) {
    const unsigned G = gridDim.x * gridDim.y * gridDim.z;
    unsigned sum, cnt, mine, sp = 0u;
    for (;;) {
        sum = 0u; cnt = 0u; mine = 0u;
#pragma unroll
        for (unsigned j = 0; j < 16; ++j) { const unsigned c = xb_ld(&bar[XB_XCNT(j)]); sum += c; cnt += (c > 0u) ? 1u : 0u; mine = (j == x) ? c : mine; }
        if (sum == G) break;
        __builtin_amdgcn_s_sleep(1);
        if ((++sp & 255u) == 0u) { if (xb_ld(&bar[XB_TMO])) break; if (sp > XB_SPIN_CAP) { atomicAdd(&bar[XB_TMO], 1u); break; } }
    }
    nloc = mine > 0u ? mine : 1u; nx = cnt > 0u ? cnt : 1u;
}
__device__ __forceinline__ void xcd_barrier(const XcdBarrier& b) {
    asm volatile("s_waitcnt vmcnt(0)" ::: "memory");
    __syncthreads();
    if (threadIdx.x == 0) {
        unsigned* bar = b.bar; asm volatile("" : "+s"(bar));
        __builtin_amdgcn_s_waitcnt(0);
        unsigned nloc = b.st[0], nx = b.st[1];
        if (nloc == 0u) { xcd_barrier_complete(bar, b.x, nloc, nx); b.st[0] = nloc; b.st[1] = nx; }
        const unsigned old = xb_add(&bar[XB_XSUB(b.x)], 1u);
        const unsigned gen = old / nloc;
        if (old + 1u == (gen + 1u) * nloc) {
            __builtin_amdgcn_fence(__ATOMIC_RELEASE, "agent");
            asm volatile("s_waitcnt vmcnt(0)" ::: "memory");
            const unsigned og = xb_add(&bar[XB_TOP], 1u);
            const unsigned tg = og / nx;
            if (og + 1u == (tg + 1u) * nx) xb_add(&bar[XB_TOPGEN], 1u);
            else XB_SPIN(xb_ld(&bar[XB_TOPGEN]) == tg, bar);
            __builtin_amdgcn_fence(__ATOMIC_ACQUIRE, "agent");
            xb_add(&bar[XB_XGEN(b.x)], 1u);
            asm volatile("s_waitcnt vmcnt(0)" ::: "memory");
        } else {
            XB_SPIN(xb_ld(&bar[XB_XGEN(b.x)]) == gen, bar);
            __builtin_amdgcn_fence(__ATOMIC_ACQUIRE, "agent");
            asm volatile("s_waitcnt vmcnt(0)" ::: "memory");
        }
    }
    __syncthreads();
}
constexpr int CW_BAR = 4096;

struct Args { const float* in[20]; float* out; unsigned char* ws; int ph_lo, ph_hi; };
enum { I_X = 0, I_C, I_WADA, I_BADA, I_NMW, I_WIN, I_LBL, I_HNW, I_RELB, I_WPA, I_WPB, I_WOUT, I_NFW, I_WR, I_BR, I_W1, I_B1, I_W2, I_B2, I_FNW };

namespace pg8 {
#define PG8_LAS __attribute__((address_space(3)))
constexpr int BM = 256, BK = 64, HALF = 128, HTB = HALF * BK * 2, STAGE_BYTES = 8 * HTB, NXCD = 8, WGM = 8;
__host__ __device__ __forceinline__ int lds_byte(int r, int c) { const int st = (r >> 4) * 2 + (c >> 5), rr = r & 15, cc = c & 31, ob = rr * 64 + cc * 2; return st * 1024 + (ob ^ (((ob >> 9) & 1) << 5)); }
__host__ __device__ __forceinline__ void stage_rc(int b, int& R, int& C) { const int st = b / 1024, sb = b % 1024, swz = sb ^ (((sb >> 9) & 1) << 5); R = (st >> 1) * 16 + swz / 64; C = (st & 1) * 32 + (swz % 64) / 2; }
__host__ __device__ __forceinline__ int perm32(int rho) { const int n = rho >> 4, i = rho & 15; return 8 * (i >> 2) + 4 * n + (i & 3); }
struct Unit { int pm, pn, brow, e; };
struct Gemm { const bf16_t* A; const bf16_t* Bt; int M, N, K; };
struct StaticOrder {
    int nM, nN, nwg, G, c;
    __device__ void init(int M, int N, int G_, int c_) { nM = M / BM; nN = N / BM; nwg = nM * nN; G = G_; c = c_; }
    __device__ bool next(int i, Unit& u) const {
        const long L = (long)i * G + c; if (L >= nwg) return false;
        int wgid = (int)L; { const int q = nwg / NXCD, r = nwg % NXCD, xcd = wgid % NXCD, off = wgid / NXCD; wgid = (xcd < r ? xcd * (q + 1) : r * (q + 1) + (xcd - r) * q) + off; }
        const int nig = WGM * nN, gid = wgid / nig, fm = gid * WGM, gsz = (nM - fm) < WGM ? (nM - fm) : WGM;
        u.pm = fm + ((wgid % nig) % gsz); u.pn = (wgid % nig) / gsz; u.brow = u.pn * BM; u.e = 0; return true;
    }
    __device__ __forceinline__ void a_ready(const Unit&) const {}
    __device__ __forceinline__ void done(const Unit&) const {}
};
template <int NN, bool GATH = false, bool REV = false> struct MoeOrder {
    static constexpr bool GATHER = GATH;
    int nwg, G, c; const PG8_LAS int* blke; const int* rowtok;
    __device__ void init(int nM, int G_, int c_, const PG8_LAS int* blke_, const int* rowtok_ = nullptr) { nwg = nM * NN; G = G_; c = c_; blke = blke_; rowtok = rowtok_; }
    __device__ bool next(int i, Unit& u) const {
        const int L = i * G + c; if (L >= nwg) return false;
        const int wgid = (L & 7) * (nwg >> 3) + (REV ? (nwg >> 3) - 1 - (L >> 3) : (L >> 3));
        const int gid = wgid / (8 * NN), rem = wgid % (8 * NN);
        u.pm = gid * 8 + (rem & 7); u.pn = rem >> 3; u.e = __builtin_amdgcn_readfirstlane(blke[u.pm]); u.brow = u.e * (NN * BM) + u.pn * BM; return true;
    }
    __device__ __forceinline__ void a_ready(const Unit&) const {}
    __device__ __forceinline__ void done(const Unit&) const {}
};
typedef __bf16 bf16x2v_t __attribute__((ext_vector_type(2)));
typedef float f32x2v_t __attribute__((ext_vector_type(2)));
__device__ __forceinline__ unsigned cvt_pk_bf16(float lo, float hi) { const f32x2v_t v = {lo, hi}; const bf16x2v_t r = __builtin_convertvector(v, bf16x2v_t); return __builtin_bit_cast(unsigned, r); }


struct EpiZ {
    static constexpr bool PERM = true, AFTER_DRAIN = false;
    bf16_t* C; int ldc;
    __device__ __forceinline__ void operator()(const f32x4 (&acc)[2][2][4][2], const Unit& u, int wr, int wc, int fr, int fq) const {
        const int row0 = u.pm * BM + wr * 64 + fr, col0 = u.pn * BM + wc * 32 + 8 * fq;
#pragma unroll
        for (int ai = 0; ai < 2; ++ai)
#pragma unroll
            for (int m = 0; m < 4; ++m) { bf16_t* rowp = C + (size_t)(row0 + ai * HALF + m * 16) * ldc + col0;
#pragma unroll
                for (int bj = 0; bj < 2; ++bj) { const f32x4 v0 = acc[ai][bj][m][0], v1 = acc[ai][bj][m][1];
                    u32x4 w; w.x = cvt_pk_bf16(v0[0], v0[1]); w.y = cvt_pk_bf16(v0[2], v0[3]); w.z = cvt_pk_bf16(v1[0], v1[1]); w.w = cvt_pk_bf16(v1[2], v1[3]);
                    *(u32x4*)(rowp + bj * HALF) = w; } }
    }
};
__device__ __forceinline__ void bf8_to_f32(const u32x4 w, f32x4& lo, f32x4& hi) {
    lo[0] = __uint_as_float(w.x << 16); lo[1] = __uint_as_float(w.x & 0xffff0000u); lo[2] = __uint_as_float(w.y << 16); lo[3] = __uint_as_float(w.y & 0xffff0000u);
    hi[0] = __uint_as_float(w.z << 16); hi[1] = __uint_as_float(w.z & 0xffff0000u); hi[2] = __uint_as_float(w.w << 16); hi[3] = __uint_as_float(w.w & 0xffff0000u);
}
__device__ __forceinline__ f32x4 sig4(f32x4 g) { f32x4 r; r[0] = sigmoidf_(g[0]); r[1] = sigmoidf_(g[1]); r[2] = sigmoidf_(g[2]); r[3] = sigmoidf_(g[3]); return r; }
struct EpiMergeF {
    static constexpr bool PERM = true, AFTER_DRAIN = false, MIDK = true;
    bf16_t* merged; const bf16_t* Zga; const bf16_t* Zgb;
    __device__ __forceinline__ void mid(f32x4 (&acc)[2][2][4][2], const Unit& u, int wr, int wc, int fr, int fq) const {
        int row0 = u.pm * BM + wr * 64 + fr, col0 = u.pn * BM + wc * 32 + 8 * fq;
        asm volatile("" : "+v"(row0), "+v"(col0));
        u32x4 ga[2][2][2], gb[2][2][2];
#define MG_LOAD(BUF, AI, MP) do { _Pragma("unroll") for (int mi = 0; mi < 2; ++mi) _Pragma("unroll") for (int bj = 0; bj < 2; ++bj) { const size_t row = (size_t)(row0 + (AI) * HALF + (2 * (MP) + mi) * 16); const int col = col0 + bj * HALF; \
            ga[BUF][mi][bj] = *(const u32x4*)(Zga + row * ZLD + col); gb[BUF][mi][bj] = *(const u32x4*)(Zgb + row * ZLD + col); } } while (0)
        MG_LOAD(0, 0, 0);
#pragma unroll
        for (int bi = 0; bi < 4; ++bi) {
            const int ai = bi >> 1, mp = bi & 1, cb = bi & 1;
            if (bi == 0) MG_LOAD(1, 0, 1); else if (bi == 1) MG_LOAD(0, 1, 0); else if (bi == 2) MG_LOAD(1, 1, 1);
#pragma unroll
            for (int mi = 0; mi < 2; ++mi)
#pragma unroll
                for (int bj = 0; bj < 2; ++bj) { const int m = 2 * mp + mi;
                    f32x4 a0, a1, b0, b1; bf8_to_f32(ga[cb][mi][bj], a0, a1); bf8_to_f32(gb[cb][mi][bj], b0, b1);
#pragma unroll
                    for (int j = 0; j < 4; ++j) {
                        acc[ai][bj][m][0][j] *= (1.0f + __builtin_amdgcn_exp2f(-1.4426950408889634f * b0[j])) * __builtin_amdgcn_rcpf(1.0f + __builtin_amdgcn_exp2f(-1.4426950408889634f * a0[j]));
                        acc[ai][bj][m][1][j] *= (1.0f + __builtin_amdgcn_exp2f(-1.4426950408889634f * b1[j])) * __builtin_amdgcn_rcpf(1.0f + __builtin_amdgcn_exp2f(-1.4426950408889634f * a1[j])); } }
            asm volatile("" : "+v"(acc[ai][0][2 * mp][0]), "+v"(acc[ai][0][2 * mp][1]), "+v"(acc[ai][1][2 * mp][0]), "+v"(acc[ai][1][2 * mp][1]),
                              "+v"(acc[ai][0][2 * mp + 1][0]), "+v"(acc[ai][0][2 * mp + 1][1]), "+v"(acc[ai][1][2 * mp + 1][0]), "+v"(acc[ai][1][2 * mp + 1][1]) :: "memory");
        }
#undef MG_LOAD
    }
    __device__ __forceinline__ void operator()(const f32x4 (&acc)[2][2][4][2], const Unit& u, int wr, int wc, int fr, int fq) const {
        int row0 = u.pm * BM + wr * 64 + fr, col0 = u.pn * BM + wc * 32 + 8 * fq;
        asm volatile("" : "+v"(row0), "+v"(col0));
        u32x4 gb[2][4][2];
#pragma unroll
        for (int ai = 0; ai < 2; ++ai)
#pragma unroll
            for (int m = 0; m < 4; ++m)
#pragma unroll
                for (int bj = 0; bj < 2; ++bj) gb[ai][m][bj] = *(const u32x4*)(Zgb + (size_t)(row0 + ai * HALF + m * 16) * ZLD + col0 + bj * HALF);
#pragma unroll
        for (int ai = 0; ai < 2; ++ai)
#pragma unroll
            for (int m = 0; m < 4; ++m)
#pragma unroll
                for (int bj = 0; bj < 2; ++bj) {
                    f32x4 g0, g1; bf8_to_f32(gb[ai][m][bj], g0, g1); g0 = sig4(g0); g1 = sig4(g1);
                    const f32x4 v0 = g0 * acc[ai][bj][m][0], v1 = g1 * acc[ai][bj][m][1];
                    u32x4 w; w.x = cvt_pk_bf16(v0[0], v0[1]); w.y = cvt_pk_bf16(v0[2], v0[3]); w.z = cvt_pk_bf16(v1[0], v1[1]); w.w = cvt_pk_bf16(v1[2], v1[3]);
                    *(u32x4*)(merged + (size_t)(row0 + ai * HALF + m * 16) * D + col0 + bj * HALF) = w; }
    }
};
struct EpiOutG {
    static constexpr bool PERM = true, AFTER_DRAIN = false;
    const bf16_t* xin; bf16_t* x1; const float* gate  ;
    __device__ __forceinline__ void operator()(const f32x4 (&acc)[2][2][4][2], const Unit& u, int wr, int wc, int fr, int fq) const {
        const int row0 = u.pm * BM + wr * 64 + fr, col0 = u.pn * BM + wc * 32 + 8 * fq; const int b = (u.pm * BM) >> 11;
        f32x4 gv[2][2];
#pragma unroll
        for (int bj = 0; bj < 2; ++bj)
#pragma unroll
            for (int n = 0; n < 2; ++n) gv[bj][n] = *(const f32x4*)(gate + (size_t)b * NMOD + col0 + bj * HALF + 4 * n);
#pragma unroll
        for (int ai = 0; ai < 2; ++ai) {
            u32x4 xv[4][2];
#pragma unroll
            for (int m = 0; m < 4; ++m)
#pragma unroll
                for (int bj = 0; bj < 2; ++bj) xv[m][bj] = *(const u32x4*)(xin + (size_t)(row0 + ai * HALF + m * 16) * D + col0 + bj * HALF);
#pragma unroll
            for (int m = 0; m < 4; ++m)
#pragma unroll
                for (int bj = 0; bj < 2; ++bj) {
                    f32x4 x0, x1f; bf8_to_f32(xv[m][bj], x0, x1f);
                    const f32x4 v0 = x0 + gv[bj][0] * acc[ai][bj][m][0], v1 = x1f + gv[bj][1] * acc[ai][bj][m][1];
                    u32x4 w; w.x = cvt_pk_bf16(v0[0], v0[1]); w.y = cvt_pk_bf16(v0[2], v0[3]); w.z = cvt_pk_bf16(v1[0], v1[1]); w.w = cvt_pk_bf16(v1[2], v1[3]);
                    *(u32x4*)(x1 + (size_t)(row0 + ai * HALF + m * 16) * D + col0 + bj * HALF) = w; }
        }
    }
};
struct EpiSwigluG {
    static constexpr bool PERM = true, AFTER_DRAIN = false;
    bf16_t* act; const float* b1  ;
    __device__ __forceinline__ void operator()(const f32x4 (&acc)[2][2][4][2], const Unit& u, int wr, int wc, int fr, int fq) const {
        typedef float f32x2 __attribute__((ext_vector_type(2)));
        const int row0 = u.pm * BM + wr * 64 + fr, col0 = u.pn * HALF + wc * 32 + 8 * fq;
        f32x2 bg[2][2], bl[2][2];
#pragma unroll
        for (int n = 0; n < 2; ++n) { const f32x4 g4 = *(const f32x4*)(b1 + (size_t)u.e * 2 * DFF + col0 + 4 * n), l4 = *(const f32x4*)(b1 + (size_t)u.e * 2 * DFF + DFF + col0 + 4 * n);
            bg[n][0] = (f32x2){g4[0], g4[1]}; bg[n][1] = (f32x2){g4[2], g4[3]}; bl[n][0] = (f32x2){l4[0] + 1.0f, l4[1] + 1.0f}; bl[n][1] = (f32x2){l4[2] + 1.0f, l4[3] + 1.0f}; }
#pragma unroll
        for (int ai = 0; ai < 2; ++ai)
#pragma unroll
            for (int m = 0; m < 4; ++m) { unsigned o[4];
#pragma unroll
                for (int n = 0; n < 2; ++n)
#pragma unroll
                    for (int h = 0; h < 2; ++h) {
                        f32x2 g = (f32x2){acc[ai][0][m][n][2 * h], acc[ai][0][m][n][2 * h + 1]} + bg[n][h];
                        f32x2 l = (f32x2){acc[ai][1][m][n][2 * h], acc[ai][1][m][n][2 * h + 1]} + bl[n][h];
                        g = (f32x2){fminf(g[0], 7.0f), fminf(g[1], 7.0f)};
                        l = (f32x2){__builtin_amdgcn_fmed3f(l[0], -6.0f, 8.0f), __builtin_amdgcn_fmed3f(l[1], -6.0f, 8.0f)};
                        const f32x2 t = g * (-1.702f * 1.4426950408889634f);
                        const f32x2 d = (f32x2){__builtin_amdgcn_exp2f(t[0]), __builtin_amdgcn_exp2f(t[1])} + 1.0f;
                        const f32x2 r = (f32x2){__builtin_amdgcn_rcpf(d[0]), __builtin_amdgcn_rcpf(d[1])};
                        const f32x2 ov = g * r * l;
                        o[2 * n + h] = cvt_pk_bf16(ov[0], ov[1]); }
                u32x4 w; w.x = o[0]; w.y = o[1]; w.z = o[2]; w.w = o[3];
                *(u32x4*)(act + (size_t)(row0 + ai * HALF + m * 16) * DFF + col0) = w; }
    }
};
struct EpiYG {
    static constexpr bool PERM = true, AFTER_DRAIN = false;
    bf16_t* Yb; const float* b2  ;
    __device__ __forceinline__ void operator()(const f32x4 (&acc)[2][2][4][2], const Unit& u, int wr, int wc, int fr, int fq) const {
        const int row0 = u.pm * BM + wr * 64 + fr, col0 = u.pn * BM + wc * 32 + 8 * fq;
        f32x4 bv[2][2];
#pragma unroll
        for (int bj = 0; bj < 2; ++bj)
#pragma unroll
            for (int n = 0; n < 2; ++n) bv[bj][n] = *(const f32x4*)(b2 + (size_t)u.e * D + col0 + bj * HALF + 4 * n);
#pragma unroll
        for (int ai = 0; ai < 2; ++ai)
#pragma unroll
            for (int m = 0; m < 4; ++m) { bf16_t* rowp = Yb + (size_t)(row0 + ai * HALF + m * 16) * D + col0;
#pragma unroll
                for (int bj = 0; bj < 2; ++bj) { const f32x4 v0 = acc[ai][bj][m][0] + bv[bj][0], v1 = acc[ai][bj][m][1] + bv[bj][1];
                    u32x4 w; w.x = cvt_pk_bf16(v0[0], v0[1]); w.y = cvt_pk_bf16(v0[2], v0[3]); w.z = cvt_pk_bf16(v1[0], v1[1]); w.w = cvt_pk_bf16(v1[2], v1[3]);
                    *(u32x4*)(rowp + bj * HALF) = w; } }
    }
};

template <class E, class = void> struct has_midk { static constexpr bool value = false; };
template <class E> struct has_midk<E, decltype((void)E::MIDK)> { static constexpr bool value = E::MIDK; };
template <class S_, class = void> struct sched_gather { static constexpr bool value = false; };
template <class S_> struct sched_gather<S_, decltype((void)S_::GATHER)> { static constexpr bool value = S_::GATHER; };
template <class Epi, class Sched>
__device__ __forceinline__ void gemm_phase(PG8_LAS unsigned char* lds, const int tid, const Gemm g, const Sched& S, const Epi& E) {
    const int wid = __builtin_amdgcn_readfirstlane(tid >> 6), lane = tid & 63, wr = wid >> 2, wc = wid & 3, fr = lane & 15, fq = lane >> 4;
    const int K = g.K, nt = K / BK;
    unsigned voffA[2], voffB[2]; int gR[2], gC[2];
#pragma unroll
    for (int i = 0; i < 2; ++i) { int R, C; stage_rc(tid * 16 + i * 8192, R, C); const int Rb = Epi::PERM ? ((R & ~31) + perm32(R & 31)) : R;
        voffA[i] = (unsigned)(R * K + C) * 2u; voffB[i] = (unsigned)(Rb * K + C) * 2u; gR[i] = R; gC[i] = C; }
    const size_t kstep = (size_t)(BK * 2);
    const size_t hstep = (size_t)HALF * K * 2;
    const size_t tstep = 2 * hstep;
    const unsigned ldsw = (unsigned)wid * 1024u;
    const int aoff = lds_byte(wr * 64 + fr, fq * 8), boff = lds_byte(wc * 32 + fr, fq * 8);
#define PG8_SA(b, h) (((b) * 2 + (h)) * HTB)
#define PG8_SB(b, h) ((4 + (b) * 2 + (h)) * HTB)
#define PG8_STAGE(bufoff, gbase, voff) do { _Pragma("unroll") for (int _i = 0; _i < 2; ++_i) \
        __builtin_amdgcn_global_load_lds((const unsigned*)((const char*)(gbase) + (voff)[_i]), (PG8_LAS unsigned*)(lds + (bufoff) + ldsw + _i * 8192), 16, 0, 0); } while (0)
#define PG8_LDA(dst, b, h) do { _Pragma("unroll") for (int m = 0; m < 4; ++m) _Pragma("unroll") for (int k = 0; k < 2; ++k) dst[m][k] = *(const PG8_LAS bf16x8*)(lds + PG8_SA(b, h) + aoff + m * 2048 + k * 1024); } while (0)
#define PG8_LDB(dst, b, h) do { _Pragma("unroll") for (int n = 0; n < 2; ++n) _Pragma("unroll") for (int k = 0; k < 2; ++k) dst[n][k] = *(const PG8_LAS bf16x8*)(lds + PG8_SB(b, h) + boff + n * 2048 + k * 1024); } while (0)
#define PG8_MMA(ai, bj, At, Bt) do { __builtin_amdgcn_s_setprio(1); _Pragma("unroll") for (int m = 0; m < 4; ++m) _Pragma("unroll") for (int n = 0; n < 2; ++n) _Pragma("unroll") for (int k = 0; k < 2; ++k) \
        acc[ai][bj][m][n] = __builtin_amdgcn_mfma_f32_16x16x32_bf16(Bt[n][k], At[m][k], acc[ai][bj][m][n], 0, 0, 0); __builtin_amdgcn_s_setprio(0); } while (0)
#define PG8_WAIT_V(n) asm volatile("s_waitcnt vmcnt(" #n ")" ::: "memory")
#define PG8_WAIT_L(n) asm volatile("s_waitcnt lgkmcnt(" #n ")" ::: "memory")
#define PG8_BAR __builtin_amdgcn_s_barrier()
#define PG8_SCHED __builtin_amdgcn_sched_barrier(0)
    Unit cur, nxt; int ui = 0;
    if (!S.next(0, cur)) return;
    f32x4 acc[2][2][4][2];
#pragma unroll
    for (int a = 0; a < 2; ++a)
#pragma unroll
        for (int b = 0; b < 2; ++b)
#pragma unroll
            for (int m = 0; m < 4; ++m)
#pragma unroll
                for (int n = 0; n < 2; ++n) acc[a][b][m][n] = (f32x4){0.f, 0.f, 0.f, 0.f};
    bf16x8 At[4][2], B0[2][2], B1[2][2];
    unsigned vC0[2], vC1[2], vN0[2], vN1[2];
    if constexpr (sched_gather<Sched>::value) {
#pragma unroll
        for (int i = 0; i < 2; ++i) { vC0[i] = ((unsigned)S.rowtok[cur.pm * BM + gR[i]] * (unsigned)K + (unsigned)gC[i]) * 2u; vC1[i] = ((unsigned)S.rowtok[cur.pm * BM + HALF + gR[i]] * (unsigned)K + (unsigned)gC[i]) * 2u; vN0[i] = vC0[i]; vN1[i] = vC1[i]; }
    } else {
#pragma unroll
        for (int i = 0; i < 2; ++i) { vC0[i] = voffA[i]; vC1[i] = voffA[i] + (unsigned)hstep; vN0[i] = vC0[i]; vN1[i] = vC1[i]; }
    }
    const char* cA = sched_gather<Sched>::value ? (const char*)g.A : (const char*)g.A + (size_t)cur.pm * tstep; const char* cB = (const char*)g.Bt + (size_t)cur.brow * K * 2;
    S.a_ready(cur);
    PG8_STAGE(PG8_SB(0, 0), cB, voffB); PG8_STAGE(PG8_SA(0, 0), cA, vC0); PG8_STAGE(PG8_SB(0, 1), cB + hstep, voffB); PG8_STAGE(PG8_SA(0, 1), cA, vC1);
    if (wr == 1) PG8_BAR;
    PG8_WAIT_V(4); PG8_BAR;
    PG8_STAGE(PG8_SB(1, 0), cB + kstep, voffB); PG8_STAGE(PG8_SA(1, 0), cA + kstep, vC0); PG8_STAGE(PG8_SB(1, 1), cB + hstep + kstep, voffB);
    PG8_WAIT_V(6); PG8_BAR;
    for (;;) {
        const bool has_next = S.next(ui + 1, nxt);
        const char* nA = sched_gather<Sched>::value ? cA : (has_next ? (const char*)g.A + (size_t)nxt.pm * tstep : cA); const char* nB = has_next ? (const char*)g.Bt + (size_t)nxt.brow * K * 2 : cB;
        PG8_LAS int* const tokb = (PG8_LAS int*)(lds + STAGE_BYTES + 4096) + ((ui + 1) & 1) * BM;
        if constexpr (sched_gather<Sched>::value) { if (has_next && wid == 0)
            __builtin_amdgcn_global_load_lds((const unsigned*)(S.rowtok + nxt.pm * BM + lane * 4), (PG8_LAS unsigned*)tokb, 16, 0, 0); }
        for (int t = 0; t < nt; t += 2) {
            if constexpr (has_midk<Epi>::value) { if (t == nt / 2) E.mid(acc, cur, wr, wc, fr, fq); }
            const bool last = (t == nt - 2);
            const char* a1 = cA + (size_t)(t + 1) * kstep;
            const char* a2 = last ? nA : cA + (size_t)(t + 2) * kstep; const char* b2 = last ? nB : cB + (size_t)(t + 2) * kstep;
            const char* a3 = a2 + kstep; const char* b3 = b2 + kstep;
            unsigned w0[2], w1[2];
#pragma unroll
            for (int i = 0; i < 2; ++i) { w0[i] = vC0[i]; w1[i] = vC1[i]; }
            if constexpr (sched_gather<Sched>::value) { if (last && has_next) {
#pragma unroll
                for (int i = 0; i < 2; ++i) { vN0[i] = ((unsigned)tokb[gR[i]] * (unsigned)K + (unsigned)gC[i]) * 2u; vN1[i] = ((unsigned)tokb[HALF + gR[i]] * (unsigned)K + (unsigned)gC[i]) * 2u; w0[i] = vN0[i]; w1[i] = vN1[i]; } } }
            if (last && has_next) S.a_ready(nxt);
            PG8_LDB(B0, 0, 0); PG8_SCHED; PG8_LDA(At, 0, 0); PG8_STAGE(PG8_SA(1, 1), a1, vC1);
            PG8_WAIT_L(8); PG8_BAR; PG8_WAIT_L(0); PG8_MMA(0, 0, At, B0); PG8_BAR; PG8_SCHED;
            PG8_LDB(B1, 0, 1); PG8_STAGE(PG8_SB(0, 0), b2, voffB);
            PG8_BAR; PG8_WAIT_L(0); PG8_MMA(0, 1, At, B1); PG8_BAR;
            PG8_LDA(At, 0, 1); PG8_STAGE(PG8_SA(0, 0), a2, w0);
            PG8_BAR; PG8_WAIT_L(0); PG8_MMA(1, 0, At, B0); PG8_BAR; PG8_SCHED;
            PG8_STAGE(PG8_SB(0, 1), b2 + hstep, voffB);
            PG8_WAIT_V(6); PG8_BAR; PG8_MMA(1, 1, At, B1); PG8_BAR;
            PG8_LDB(B0, 1, 0); PG8_SCHED; PG8_LDA(At, 1, 0); PG8_STAGE(PG8_SA(0, 1), a2, w1);
            PG8_WAIT_L(8); PG8_BAR; PG8_WAIT_L(0); PG8_MMA(0, 0, At, B0); PG8_BAR; PG8_SCHED;
            PG8_LDB(B1, 1, 1); PG8_STAGE(PG8_SB(1, 0), b3, voffB);
            PG8_BAR; PG8_WAIT_L(0); PG8_MMA(0, 1, At, B1); PG8_BAR;
            PG8_LDA(At, 1, 1); PG8_STAGE(PG8_SA(1, 0), a3, w0);
            PG8_BAR; PG8_WAIT_L(0); PG8_MMA(1, 0, At, B0); PG8_BAR; PG8_SCHED;
            PG8_STAGE(PG8_SB(1, 1), b3 + hstep, voffB);
            PG8_WAIT_V(6); PG8_BAR; PG8_MMA(1, 1, At, B1); PG8_BAR;
        }
        if constexpr (!Epi::AFTER_DRAIN) { E(acc, cur, wr, wc, fr, fq); S.done(cur); }
        if (!has_next) break;
#pragma unroll
        for (int a = 0; a < 2; ++a)
#pragma unroll
            for (int b = 0; b < 2; ++b)
#pragma unroll
                for (int m = 0; m < 4; ++m)
#pragma unroll
                    for (int n = 0; n < 2; ++n) acc[a][b][m][n] = (f32x4){0.f, 0.f, 0.f, 0.f};
        cur = nxt; cA = nA; cB = nB; ++ui;
#pragma unroll
        for (int i = 0; i < 2; ++i) { vC0[i] = vN0[i]; vC1[i] = vN1[i]; }
    }
    PG8_WAIT_V(0);
    if (wr == 0) PG8_BAR;
    PG8_BAR;
    if constexpr (Epi::AFTER_DRAIN) { E.fused(acc, cur, wr, wc, fr, fq, lds, wid, lane); S.done(cur); }
#undef PG8_SA
#undef PG8_SB
#undef PG8_STAGE
#undef PG8_LDA
#undef PG8_LDB
#undef PG8_MMA
#undef PG8_WAIT_V
#undef PG8_WAIT_L
#undef PG8_BAR
#undef PG8_SCHED
}
}


struct CvtJob { const float* src; bf16_t* dst; int N  , K  , nvalid  , sc0, sc1  ; };
constexpr int CJ_WIN = DEPTH * 16 * 21, CJ_WPA = DEPTH * 8 * 4, CJ_WPB = CJ_WPA, CJ_WOUT = DEPTH * 16 * 4, CJ_W1 = DEPTH * NE * 16 * 8, CJ_W2 = DEPTH * NE * 16 * 4;
constexpr int CJ_TOTAL = CJ_WIN + CJ_WPA + CJ_WPB + CJ_WOUT + CJ_W1 + CJ_W2;
__device__ __forceinline__ CvtJob cvt_job(int J, const float* const* in, unsigned char* ws) {
    CvtJob j;
    if (J < CJ_WIN) { const int m = J / (16 * 21), r = J % (16 * 21), kt = r / 21, ns = r % 21;
        j.src = in[I_WIN] + (size_t)m * D * ZC + (size_t)kt * 64 * ZC; j.dst = (bf16_t*)(ws + WS_WIN) + (size_t)m * ZLD * D + (size_t)ns * 256 * D + kt * 64; j.N = ZC; j.K = D;
        j.nvalid = ZC - ns * 256 < 256 ? ZC - ns * 256 : 256; j.sc0 = ns * 256; j.sc1 = ns * 256 + 128; return j; }
    J -= CJ_WIN;
    if (J < CJ_WPA + CJ_WPB) { const int which = J / CJ_WPA, JJ = J % CJ_WPA; const int m = JJ / 32, r = JJ % 32, kt = r / 4, ns = r % 4;
        j.src = in[which ? I_WPB : I_WPA] + (size_t)m * 512 * D + (size_t)kt * 64 * D; j.dst = (bf16_t*)(ws + WS_WPA) + (size_t)m * D * D + (size_t)ns * 256 * D + which * 512 + kt * 64; j.N = D; j.K = D;
        j.nvalid = 256; j.sc0 = ns * 256; j.sc1 = ns * 256 + 128; return j; }
    J -= CJ_WPA + CJ_WPB;
    if (J < CJ_WOUT) { const int m = J / 64, r = J % 64, kt = r / 4, ns = r % 4;
        j.src = in[I_WOUT] + (size_t)m * D * D + (size_t)kt * 64 * D; j.dst = (bf16_t*)(ws + WS_WOUT) + (size_t)m * D * D + (size_t)ns * 256 * D + kt * 64; j.N = D; j.K = D;
        j.nvalid = 256; j.sc0 = ns * 256; j.sc1 = ns * 256 + 128; return j; }
    J -= CJ_WOUT;
    if (J < CJ_W1) { const int m = J / 128, r = J % 128, kt = r / 8, ns = r % 8;
        j.src = in[I_W1] + (size_t)m * D * 2 * DFF + (size_t)kt * 64 * 2 * DFF; j.dst = (bf16_t*)(ws + WS_W1) + (size_t)m * 2 * DFF * D + (size_t)ns * 256 * D + kt * 64; j.N = 2 * DFF; j.K = D;
        j.nvalid = 256; j.sc0 = 128 * ns; j.sc1 = DFF + 128 * ns; return j; }
    J -= CJ_W1;
    { const int m = J / 64, r = J % 64, kt = r / 4, ns = r % 4;
        j.src = in[I_W2] + (size_t)m * DFF * D + (size_t)kt * 64 * D; j.dst = (bf16_t*)(ws + WS_W2) + (size_t)m * D * DFF + (size_t)ns * 256 * DFF + kt * 64; j.N = D; j.K = DFF;
        j.nvalid = 256; j.sc0 = ns * 256; j.sc1 = ns * 256 + 128; return j; }
}
__device__ __forceinline__ void cvt_load(const CvtJob& j, const int tid, f32x4 (&v)[8]) {
    const int i = tid >> 3, c0 = (tid & 7) * 32; const float* p = j.src + (size_t)i * j.N + (c0 < 128 ? j.sc0 + c0 : j.sc1 + c0 - 128);
#pragma unroll
    for (int q = 0; q < 8; ++q) v[q] = (c0 + 4 * q < j.nvalid) ? *(const f32x4*)(p + 4 * q) : (f32x4){0.f, 0.f, 0.f, 0.f};
}

constexpr int CJ_LAYER = CJ_TOTAL / DEPTH;
constexpr int CW_BGQ = 1300;
__device__ __forceinline__ int layer_job(const int layer, int j) {
    constexpr int H_WIN = CJ_WIN / DEPTH, H_WPA = CJ_WPA / DEPTH, H_WOUT = CJ_WOUT / DEPTH, H_W1 = CJ_W1 / DEPTH, H_W2 = CJ_W2 / DEPTH;
    if (j < H_WIN) return layer * H_WIN + j; j -= H_WIN;
    if (j < H_WPA) return CJ_WIN + layer * H_WPA + j; j -= H_WPA;
    if (j < H_WPA) return CJ_WIN + CJ_WPA + layer * H_WPA + j; j -= H_WPA;
    if (j < H_WOUT) return CJ_WIN + CJ_WPA + CJ_WPB + layer * H_WOUT + j; j -= H_WOUT;
    if (j < H_W1) return CJ_WIN + CJ_WPA + CJ_WPB + CJ_WOUT + layer * H_W1 + j; j -= H_W1;
    return CJ_WIN + CJ_WPA + CJ_WPB + CJ_WOUT + CJ_W1 + layer * H_W2 + j;
}
constexpr int CJ_SMALL = (CJ_WIN + CJ_WPA + CJ_WPB + CJ_WOUT) / DEPTH;
constexpr int BG_A = CJ_W2 / DEPTH, BG_B = BG_A + CJ_SMALL, BG_C = BG_B + CJ_W1 / DEPTH, BG_E = BG_C + CJ_W2 / DEPTH;
constexpr int CJ_PH0 = CJ_SMALL + CJ_W1 / DEPTH;
__device__ __forceinline__ int bg_job_index(const int t) {
    constexpr int B1 = CJ_WIN + CJ_WPA + CJ_WPB + CJ_WOUT, B2 = B1 + CJ_W1;
    if (t < BG_A) return B2 + t;
    if (t < BG_B) return layer_job(1, t - BG_A);
    if (t < BG_C) return B1 + CJ_W1 / DEPTH + (t - BG_B);
    return B2 + CJ_W2 / DEPTH + (t - BG_C);
}
__device__ __forceinline__ int ph0_job_index(const int j) { return j < CJ_SMALL ? layer_job(0, j) : (CJ_WIN + CJ_WPA + CJ_WPB + CJ_WOUT) + (j - CJ_SMALL); }
__device__ __forceinline__ void bg_convert(unsigned char* ldsb, const int tid_in, const bool use_stop, unsigned stop_off, const unsigned stop_val, const int limit) {
    int tid = tid_in; asm volatile("" : "+v"(tid));
    typedef __attribute__((address_space(4))) const unsigned long long* kaptr_t;
    kaptr_t ka = (kaptr_t)__builtin_amdgcn_kernarg_segment_ptr(); asm volatile("" : "+s"(ka));
    const float* const* in = (const float* const*)ka;
    unsigned char* ws = (unsigned char*)ka[21];
    unsigned* q = (unsigned*)(ws + WS_CTL) + CW_BGQ; unsigned* stop = use_stop ? (unsigned*)(ws + WS_CTL) + stop_off : nullptr;
    bf16_t* lt = (bf16_t*)ldsb;
    volatile int* tk = (volatile int*)(ldsb + LDS_BYTES - 64);
    f32x4 v[8];
    __syncthreads();
    if (tid == 0) { int t = -1; if (stop ? (__hip_atomic_load(stop, __ATOMIC_RELAXED, __HIP_MEMORY_SCOPE_AGENT) == stop_val) : ((int)__hip_atomic_load(q, __ATOMIC_RELAXED, __HIP_MEMORY_SCOPE_AGENT) < limit)) { t = (int)atomicAdd(q, 1u); if (t >= BG_E) t = -1; } *tk = t; }
    __syncthreads();
    int J = __builtin_amdgcn_readfirstlane(*tk);
    CvtJob cur = cvt_job(bg_job_index(J < 0 ? 0 : J), in, ws);
    if (J >= 0) cvt_load(cur, tid, v);
    while (J >= 0) {
        {
            const int i = tid >> 3, c0 = (tid & 7) * 32;
#pragma unroll
            for (int qq = 0; qq < 8; qq += 2) { u32x4 w; w.x = pg8::cvt_pk_bf16(v[qq][0], v[qq][1]); w.y = pg8::cvt_pk_bf16(v[qq][2], v[qq][3]); w.z = pg8::cvt_pk_bf16(v[qq + 1][0], v[qq + 1][1]); w.w = pg8::cvt_pk_bf16(v[qq + 1][2], v[qq + 1][3]);
                *(u32x4*)(lt + i * 264 + c0 + 4 * qq) = w; }
        }
        if (tid == 0) { int t = -1; if (stop ? (__hip_atomic_load(stop, __ATOMIC_RELAXED, __HIP_MEMORY_SCOPE_AGENT) == stop_val) : ((int)__hip_atomic_load(q, __ATOMIC_RELAXED, __HIP_MEMORY_SCOPE_AGENT) < limit)) { t = (int)atomicAdd(q, 1u); if (t >= BG_E) t = -1; } *tk = t; }
        __syncthreads();
        const CvtJob me = cur; const int Jn = __builtin_amdgcn_readfirstlane(*tk);
        if (Jn >= 0) { cur = cvt_job(bg_job_index(Jn), in, ws); cvt_load(cur, tid, v); }
        {
            const int n = tid & 255, kh = tid >> 8;
            unsigned w[16];
#pragma unroll
            for (int qq = 0; qq < 16; ++qq) w[qq] = (unsigned)lt[(kh * 32 + 2 * qq) * 264 + n] | ((unsigned)lt[(kh * 32 + 2 * qq + 1) * 264 + n] << 16);
            bf16_t* dp = me.dst + (size_t)n * me.K + kh * 32;
#pragma unroll
            for (int qq = 0; qq < 4; ++qq) { u32x4 o; o.x = w[4 * qq]; o.y = w[4 * qq + 1]; o.z = w[4 * qq + 2]; o.w = w[4 * qq + 3]; *(u32x4*)(dp + 8 * qq) = o; }
        }
        __syncthreads();
        J = Jn;
    }
}

__device__ __forceinline__ void hgrn_prep_item(const bf16_t* __restrict__ zb, const float* __restrict__ lbv, bf16_t* __restrict__ qeg, bf16_t* __restrict__ keg, bf16_t* __restrict__ ketg, float* __restrict__ hvec,
                                               float* ex  , const int b, const int h, const int c, const int tid) {
    const int lane = tid & 63, wave = __builtin_amdgcn_readfirstlane(tid >> 6);
    const int tg = wave >> 1, d = (wave & 1) * 64 + lane;
    const float lb = lbv[h * 128 + d], oml = 1.0f - lb;
    const int row0 = b * SEQ + c * 64 + 16 * tg;
    const bf16_t* fbase = zb + (size_t)row0 * ZLD + C_FA + h * 128;
    const bf16_t* qbase = zb + (size_t)row0 * ZLD + C_QA + h * 128;
    float g[16], kk[16], qv[16]; float run = 0.f;
#pragma unroll
    for (int j = 0; j < 16; ++j) {
        const float zf = fminf(fmaxf(bf2f((fbase + (size_t)j * ZLD)[d]), -60.f), 60.f), zq = bf2f((qbase + (size_t)j * ZLD)[d]);
        const float e = __builtin_amdgcn_exp2f(-1.4426950408889634f * zf), sg = __builtin_amdgcn_rcpf(1.0f + e);
        run += 0.6931471805599453f * __builtin_amdgcn_logf(lb + oml * sg); g[j] = run; kk[j] = oml * e * sg; qv[j] = zq * sigmoidf_(zq);
    }
    __syncthreads();
    ex[tg * 128 + d] = run;
    __syncthreads();
    const float e0 = ex[d], e1 = ex[128 + d], e2 = ex[256 + d], e3 = ex[384 + d];
    const float pre = tg == 0 ? 0.f : tg == 1 ? e0 : tg == 2 ? e0 + e1 : e0 + e1 + e2;
    const float r = e0 + e1, tot = (e0 + e1) + (e2 + e3);
    unsigned kt[8];
    bf16_t* qo = qeg + (size_t)row0 * 512 + h * 128 + d; bf16_t* ko = keg + (size_t)row0 * 512 + h * 128 + d;
#pragma unroll
    for (int j = 0; j < 16; j += 2) {
        const float bt0 = pre + g[j], bt1 = pre + g[j + 1];
        const float L2E = 1.4426950408889634f;
        const float qe0 = qv[j] * __builtin_amdgcn_exp2f(L2E * fminf(bt0 - r, 80.f)), qe1 = qv[j + 1] * __builtin_amdgcn_exp2f(L2E * fminf(bt1 - r, 80.f));
        const float ke0 = kk[j] * __builtin_amdgcn_exp2f(L2E * fminf(r - bt0, 80.f)), ke1 = kk[j + 1] * __builtin_amdgcn_exp2f(L2E * fminf(r - bt1, 80.f));
        const unsigned qp = pg8::cvt_pk_bf16(qe0, qe1), kp = pg8::cvt_pk_bf16(ke0, ke1);
        qo[(size_t)j * 512] = (bf16_t)(qp & 0xffffu); qo[(size_t)(j + 1) * 512] = (bf16_t)(qp >> 16);
        ko[(size_t)j * 512] = (bf16_t)(kp & 0xffffu); ko[(size_t)(j + 1) * 512] = (bf16_t)(kp >> 16);
        kt[j >> 1] = kp;
    }
    const size_t item = ((size_t)(b * 4 + h) * 32 + c);
    u32x4 w0, w1; w0.x = kt[0]; w0.y = kt[1]; w0.z = kt[2]; w0.w = kt[3]; w1.x = kt[4]; w1.y = kt[5]; w1.z = kt[6]; w1.w = kt[7];
    bf16_t* kto = ketg + item * (128 * 64) + d * 64 + 16 * tg;
    *(u32x4*)kto = w0; *(u32x4*)(kto + 8) = w1;
    if (tg == 0) { float* hv = hvec + item * 384; hv[d] = __expf(r); hv[128 + d] = __expf(tot); hv[256 + d] = __expf(tot - r); }
}

__device__ __forceinline__ void hgrn_item(const bf16_t* __restrict__ zb, const bf16_t* __restrict__ qeg, const bf16_t* __restrict__ keg, const bf16_t* __restrict__ ketg, const float* __restrict__ hvec,
                                          const float* __restrict__ hnw, bf16_t* __restrict__ ha, unsigned char* ldsb, const int b, const int h, const int tid) {
    typedef unsigned long long u64;
    const int lane = tid & 63, wave = __builtin_amdgcn_readfirstlane(tid >> 6), r31 = lane & 31, hh = lane >> 5;
    bf16_t* QE = (bf16_t*)ldsb;
    bf16_t* KE = QE + 64 * 136;
    bf16_t* KET = KE + 64 * 136;
    bf16_t* VT = KET + 128 * 72;
    bf16_t* SBT = VT + 128 * 72;
    float* er = (float*)(SBT + 128 * 136); float* el = er + 128; float* elr = el + 128;
    float* ssq = elr + 128;
    const int lt = tid >> 3, lp = tid & 7, kd = tid >> 2, kp = tid & 3;
    const bf16_t* gq = qeg + (size_t)(b * SEQ + lt) * 512 + h * 128 + lp * 8;
    const bf16_t* gk = keg + (size_t)(b * SEQ + lt) * 512 + h * 128 + lp * 8;
    const bf16_t* gt = ketg + (size_t)(b * 4 + h) * 32 * (128 * 64) + kd * 64 + kp * 8;
    const float* gv = hvec + (size_t)(b * 4 + h) * 32 * 384;
    const int v0 = wave * 16;
    const bf16_t* vbase = zb + (size_t)(b * SEQ) * ZLD + C_IA + h * 128 + v0;
    const unsigned voff = (unsigned)lane * ZLD;
    u32x4 nq0, nq1, nk0, nk1, nt0, nt1, nv0, nv1; f32x4 nvec = {0.f, 0.f, 0.f, 0.f};
    nq0 = *(const u32x4*)gq; nq1 = *(const u32x4*)(gq + 64); nk0 = *(const u32x4*)gk; nk1 = *(const u32x4*)(gk + 64); nt0 = *(const u32x4*)gt; nt1 = *(const u32x4*)(gt + 32);
    nv0 = *(const u32x4*)(vbase + voff); nv1 = *(const u32x4*)(vbase + voff + 8);
    if (tid < 96) nvec = *(const f32x4*)(gv + tid * 4);
    const int tt = wave & 1, oq = wave >> 1, dq = wave & 3, sv = wave >> 2;
    f32x4 hw4[4];
#pragma unroll
    for (int g4 = 0; g4 < 4; ++g4) hw4[g4] = *(const f32x4*)(hnw + h * 128 + 32 * oq + 4 * hh + 8 * g4);
    f32x16 S0, S1;
#pragma unroll
    for (int i = 0; i < 16; ++i) { S0[i] = 0.f; S1[i] = 0.f; }
    for (int c = 0; c < SEQ / 64; ++c) {
        const int row0 = b * SEQ + c * 64;
        *(u32x4*)(QE + lt * 136 + lp * 8) = nq0; *(u32x4*)(QE + lt * 136 + 64 + lp * 8) = nq1;
        *(u32x4*)(KE + lt * 136 + lp * 8) = nk0; *(u32x4*)(KE + lt * 136 + 64 + lp * 8) = nk1;
        *(u32x4*)(KET + kd * 72 + kp * 8) = nt0; *(u32x4*)(KET + kd * 72 + 32 + kp * 8) = nt1;
        if (tid < 96) *(f32x4*)(er + tid * 4) = nvec;
        { const unsigned vw[8] = {nv0.x, nv0.y, nv0.z, nv0.w, nv1.x, nv1.y, nv1.z, nv1.w};
#pragma unroll
          for (int q = 0; q < 8; ++q) { VT[(v0 + 2 * q) * 72 + lane] = (bf16_t)(vw[q] & 0xffffu); VT[(v0 + 2 * q + 1) * 72 + lane] = (bf16_t)(vw[q] >> 16); } }
        __syncthreads();
        u64 gw[4];
        {
            const bf16_t* gp = zb + (size_t)(row0 + 32 * tt + r31) * ZLD + C_GA + h * 128 + 32 * oq + 4 * hh;
#pragma unroll
            for (int g4 = 0; g4 < 4; ++g4) gw[g4] = *(const u64*)(gp + 8 * g4);
        }
        if (c + 1 < SEQ / 64) {
            const size_t ro = (size_t)(c + 1) * 64 * 512;
            nq0 = *(const u32x4*)(gq + ro); nq1 = *(const u32x4*)(gq + ro + 64); nk0 = *(const u32x4*)(gk + ro); nk1 = *(const u32x4*)(gk + ro + 64);
            nt0 = *(const u32x4*)(gt + (size_t)(c + 1) * (128 * 64)); nt1 = *(const u32x4*)(gt + (size_t)(c + 1) * (128 * 64) + 32);
            nv0 = *(const u32x4*)(vbase + (size_t)(c + 1) * 64 * ZLD + voff); nv1 = *(const u32x4*)(vbase + (size_t)(c + 1) * 64 * ZLD + voff + 8);
            if (tid < 96) nvec = *(const f32x4*)(gv + (size_t)(c + 1) * 384 + tid * 4);
        }
#pragma unroll
        for (int ti = 0; ti < 2; ++ti) {
            const int vq = 2 * sv + ti;
#pragma unroll
            for (int g4 = 0; g4 < 4; ++g4) {
                const int dd = 32 * dq + 8 * g4 + 4 * hh;
                const float s0 = ti ? S1[4 * g4] : S0[4 * g4], s1 = ti ? S1[4 * g4 + 1] : S0[4 * g4 + 1], s2 = ti ? S1[4 * g4 + 2] : S0[4 * g4 + 2], s3 = ti ? S1[4 * g4 + 3] : S0[4 * g4 + 3];
                const unsigned a0 = pg8::cvt_pk_bf16(er[dd] * s0, er[dd + 1] * s1), a1 = pg8::cvt_pk_bf16(er[dd + 2] * s2, er[dd + 3] * s3);
                *(u64*)(SBT + (32 * vq + r31) * 136 + dd) = (u64)a0 | ((u64)a1 << 32);
            }
        }
        __syncthreads();
        f32x16 Oacc;
#pragma unroll
        for (int i = 0; i < 16; ++i) Oacc[i] = 0.f;
        {
            bf16x8 qf[8];
#pragma unroll
            for (int ks = 0; ks < 8; ++ks) qf[ks] = *(const bf16x8*)(QE + (32 * tt + r31) * 136 + 16 * ks + 8 * hh);
#pragma unroll
            for (int ks = 0; ks < 8; ++ks) { const bf16x8 sa = *(const bf16x8*)(SBT + (32 * oq + r31) * 136 + 16 * ks + 8 * hh); Oacc = __builtin_amdgcn_mfma_f32_32x32x16_bf16(sa, qf[ks], Oacc, 0, 0, 0); }
            for (int st = 0; st <= tt; ++st) {
                f32x16 At;
#pragma unroll
                for (int i = 0; i < 16; ++i) At[i] = 0.f;
#pragma unroll
                for (int ks = 0; ks < 8; ++ks) { const bf16x8 ka = *(const bf16x8*)(KE + (32 * st + r31) * 136 + 16 * ks + 8 * hh); At = __builtin_amdgcn_mfma_f32_32x32x16_bf16(ka, qf[ks], At, 0, 0, 0); }
                if (st == tt) {
#pragma unroll
                    for (int i = 0; i < 16; ++i) { const int sl = (i & 3) + 8 * (i >> 2) + 4 * hh; if (sl > r31) At[i] = 0.f; }
                }
                union { unsigned u[4]; bf16x8 v; } pb0, pb1;
#pragma unroll
                for (int j = 0; j < 4; ++j) { pb0.u[j] = pg8::cvt_pk_bf16(At[2 * j], At[2 * j + 1]); pb1.u[j] = pg8::cvt_pk_bf16(At[8 + 2 * j], At[8 + 2 * j + 1]); }
                union { u64 q[2]; bf16x8 v; } a0, a1;
                const bf16_t* vr = VT + (32 * oq + r31) * 72 + 32 * st + 4 * hh;
                a0.q[0] = *(const u64*)(vr); a0.q[1] = *(const u64*)(vr + 8); a1.q[0] = *(const u64*)(vr + 16); a1.q[1] = *(const u64*)(vr + 24);
                Oacc = __builtin_amdgcn_mfma_f32_32x32x16_bf16(a0.v, pb0.v, Oacc, 0, 0, 0);
                Oacc = __builtin_amdgcn_mfma_f32_32x32x16_bf16(a1.v, pb1.v, Oacc, 0, 0, 0);
            }
        }
        {
            float q2 = 0.f;
#pragma unroll
            for (int i = 0; i < 16; ++i) q2 += Oacc[i] * Oacc[i];
            q2 += __shfl_xor(q2, 32);
            if (hh == 0) ssq[(32 * tt + r31) * 4 + oq] = q2;
        }
        {
            f32x16 d0, d1;
#pragma unroll
            for (int i = 0; i < 16; ++i) { d0[i] = 0.f; d1[i] = 0.f; }
#pragma unroll
            for (int ks = 0; ks < 4; ++ks) {
                const bf16x8 ka = *(const bf16x8*)(KET + (32 * dq + r31) * 72 + 16 * ks + 8 * hh);
                const bf16x8 vb0 = *(const bf16x8*)(VT + (64 * sv + r31) * 72 + 16 * ks + 8 * hh), vb1 = *(const bf16x8*)(VT + (64 * sv + 32 + r31) * 72 + 16 * ks + 8 * hh);
                d0 = __builtin_amdgcn_mfma_f32_32x32x16_bf16(ka, vb0, d0, 0, 0, 0); d1 = __builtin_amdgcn_mfma_f32_32x32x16_bf16(ka, vb1, d1, 0, 0, 0);
            }
#pragma unroll
            for (int i = 0; i < 16; ++i) { const int dd = 32 * dq + (i & 3) + 8 * (i >> 2) + 4 * hh; const float a = el[dd], bb = elr[dd]; S0[i] = a * S0[i] + bb * d0[i]; S1[i] = a * S1[i] + bb * d1[i]; }
        }
        __syncthreads();
        {
            const int t = 32 * tt + r31;
            const f32x4 sq = *(const f32x4*)(ssq + t * 4);
            const float rn = rsqrtf(((sq[0] + sq[1]) + (sq[2] + sq[3])) * (1.0f / 128.0f) + EPS);
            const int vcol = h * 128 + 32 * oq + 4 * hh;
            bf16_t* op = ha + (size_t)(row0 + t) * D + vcol;
#pragma unroll
            for (int g4 = 0; g4 < 4; ++g4) {
                const f32x4 w4 = hw4[g4];
                float o[4];
#pragma unroll
                for (int j = 0; j < 4; ++j) { const float gg = bf2f((bf16_t)((gw[g4] >> (16 * j)) & 0xffffu)); o[j] = Oacc[4 * g4 + j] * rn * w4[j] * (gg * sigmoidf_(gg)); }
                *(u64*)(op + 8 * g4) = (u64)pg8::cvt_pk_bf16(o[0], o[1]) | ((u64)pg8::cvt_pk_bf16(o[2], o[3]) << 32);
            }
        }
    }
    __syncthreads();
}

#define DPP_STEP(v, op, ctrl) v = v op __builtin_amdgcn_update_dpp(v, v, ctrl, 0xf, 0xf, false)
__device__ __forceinline__ int wave_sum_dpp(int v) { DPP_STEP(v, +, 0xB1); DPP_STEP(v, +, 0x4E); DPP_STEP(v, +, 0x141); DPP_STEP(v, +, 0x140);
    return __builtin_amdgcn_readlane(v, 0) + __builtin_amdgcn_readlane(v, 16) + __builtin_amdgcn_readlane(v, 32) + __builtin_amdgcn_readlane(v, 48); }
__device__ __forceinline__ int wave_and_u(int v) { DPP_STEP(v, &, 0xB1); DPP_STEP(v, &, 0x4E); DPP_STEP(v, &, 0x141); DPP_STEP(v, &, 0x140);
    return __builtin_amdgcn_readlane(v, 0) & __builtin_amdgcn_readlane(v, 16) & __builtin_amdgcn_readlane(v, 32) & __builtin_amdgcn_readlane(v, 48); }
__device__ __forceinline__ int wave_or_u(int v) { DPP_STEP(v, |, 0xB1); DPP_STEP(v, |, 0x4E); DPP_STEP(v, |, 0x141); DPP_STEP(v, |, 0x140);
    return __builtin_amdgcn_readlane(v, 0) | __builtin_amdgcn_readlane(v, 16) | __builtin_amdgcn_readlane(v, 32) | __builtin_amdgcn_readlane(v, 48); }


#define CNT8(OP, cl, cand, k) do { unsigned long long m0_, m1_, m2_, m3_, m4_, m5_, m6_, m7_, dd_; \
    asm volatile("v_cmp_" OP "_u32_e64 %[m0], %[k0], %[c]\n\tv_cmp_" OP "_u32_e64 %[m1], %[k1], %[c]\n\tv_cmp_" OP "_u32_e64 %[m2], %[k2], %[c]\n\tv_cmp_" OP "_u32_e64 %[m3], %[k3], %[c]\n\t" \
                 "v_cmp_" OP "_u32_e64 %[m4], %[k4], %[c]\n\tv_cmp_" OP "_u32_e64 %[m5], %[k5], %[c]\n\tv_cmp_" OP "_u32_e64 %[m6], %[k6], %[c]\n\tv_cmp_" OP "_u32_e64 %[m7], %[k7], %[c]\n\t" \
                 "v_addc_co_u32_e64 %[a], %[dd], %[a], 0, %[m0]\n\tv_addc_co_u32_e64 %[a], %[dd], %[a], 0, %[m1]\n\tv_addc_co_u32_e64 %[a], %[dd], %[a], 0, %[m2]\n\tv_addc_co_u32_e64 %[a], %[dd], %[a], 0, %[m3]\n\t" \
                 "v_addc_co_u32_e64 %[a], %[dd], %[a], 0, %[m4]\n\tv_addc_co_u32_e64 %[a], %[dd], %[a], 0, %[m5]\n\tv_addc_co_u32_e64 %[a], %[dd], %[a], 0, %[m6]\n\tv_addc_co_u32_e64 %[a], %[dd], %[a], 0, %[m7]\n\t" \
                 : [a] "+v"(cl), [m0] "=&s"(m0_), [m1] "=&s"(m1_), [m2] "=&s"(m2_), [m3] "=&s"(m3_), [m4] "=&s"(m4_), [m5] "=&s"(m5_), [m6] "=&s"(m6_), [m7] "=&s"(m7_), [dd] "=&s"(dd_) \
                 : [k0] "v"((k)[0]), [k1] "v"((k)[1]), [k2] "v"((k)[2]), [k3] "v"((k)[3]), [k4] "v"((k)[4]), [k5] "v"((k)[5]), [k6] "v"((k)[6]), [k7] "v"((k)[7]), [c] "s"(cand)); } while (0)

#define SCNT8(OP, cnt, cand, k) do { unsigned long long m0_, m1_, m2_, m3_, m4_, m5_, m6_, m7_; int c0_, c1_, c2_, c3_, c4_, c5_, c6_, c7_; \
    asm volatile("v_cmp_" OP "_u32_e64 %[m0], %[k0], %[c]\n\tv_cmp_" OP "_u32_e64 %[m1], %[k1], %[c]\n\tv_cmp_" OP "_u32_e64 %[m2], %[k2], %[c]\n\tv_cmp_" OP "_u32_e64 %[m3], %[k3], %[c]\n\t" \
                 "v_cmp_" OP "_u32_e64 %[m4], %[k4], %[c]\n\tv_cmp_" OP "_u32_e64 %[m5], %[k5], %[c]\n\tv_cmp_" OP "_u32_e64 %[m6], %[k6], %[c]\n\tv_cmp_" OP "_u32_e64 %[m7], %[k7], %[c]\n\t" \
                 "s_bcnt1_i32_b64 %[c0], %[m0]\n\ts_bcnt1_i32_b64 %[c1], %[m1]\n\ts_bcnt1_i32_b64 %[c2], %[m2]\n\ts_bcnt1_i32_b64 %[c3], %[m3]\n\t" \
                 "s_bcnt1_i32_b64 %[c4], %[m4]\n\ts_bcnt1_i32_b64 %[c5], %[m5]\n\ts_bcnt1_i32_b64 %[c6], %[m6]\n\ts_bcnt1_i32_b64 %[c7], %[m7]\n\t" \
                 : [m0] "=&s"(m0_), [m1] "=&s"(m1_), [m2] "=&s"(m2_), [m3] "=&s"(m3_), [m4] "=&s"(m4_), [m5] "=&s"(m5_), [m6] "=&s"(m6_), [m7] "=&s"(m7_), \
                   [c0] "=&s"(c0_), [c1] "=&s"(c1_), [c2] "=&s"(c2_), [c3] "=&s"(c3_), [c4] "=&s"(c4_), [c5] "=&s"(c5_), [c6] "=&s"(c6_), [c7] "=&s"(c7_) \
                 : [k0] "v"((k)[0]), [k1] "v"((k)[1]), [k2] "v"((k)[2]), [k3] "v"((k)[3]), [k4] "v"((k)[4]), [k5] "v"((k)[5]), [k6] "v"((k)[6]), [k7] "v"((k)[7]), [c] "s"(cand) : "scc"); \
    cnt += ((c0_ + c1_) + (c2_ + c3_)) + ((c4_ + c5_) + (c6_ + c7_)); } while (0)

__device__ __forceinline__ unsigned ordered_key(float f) { const unsigned u = __float_as_uint(f); return (u & 0x80000000u) ? ~u : (u | 0x80000000u); }
__device__ __forceinline__ void indexer_unit(const bf16_t* __restrict__ zb, unsigned* __restrict__ maskp, unsigned* sc  , bf16_t* ring  ,
                                             const int b, const int t0, const int tid) {
    typedef unsigned long long u64;
    const int lane = tid & 63, wave = tid >> 6;
    const int r31 = lane & 31, hh = lane >> 5;
    constexpr int IDX_TILE = 32 * 72, IDX_SLOT = 2 * IDX_TILE;
    unsigned* hist = (unsigned*)ring + wave * 256;
    {
        const int g = wave & 3, par = wave >> 2;
        const int head = (r31 & 3) + 4 * ((r31 >> 3) & 1), ql = 2 * ((r31 >> 4) & 1) + ((r31 >> 2) & 1);
        const bf16_t* ap = zb + (size_t)(b * SEQ + t0 + 4 * g + ql) * ZLD + C_IQ + head * 64 + 8 * hh;
        bf16x8 a[4];
#pragma unroll
        for (int s4 = 0; s4 < 4; ++s4) a[s4] = *(const bf16x8*)(ap + 16 * s4);
        float wq[16];
        {
            const int qa = t0 + 4 * g + hh, qb = qa + 2;
            f32x4 w0, w1, w2, w3; pg8::bf8_to_f32(*(const u32x4*)(zb + (size_t)(b * SEQ + qa) * ZLD + C_IW), w0, w1); pg8::bf8_to_f32(*(const u32x4*)(zb + (size_t)(b * SEQ + qb) * ZLD + C_IW), w2, w3);
#pragma unroll
            for (int i = 0; i < 4; ++i) { wq[i] = w0[i] * 0.04419417382415922f; wq[4 + i] = w1[i] * 0.04419417382415922f; wq[8 + i] = w2[i] * 0.04419417382415922f; wq[12 + i] = w3[i] * 0.04419417382415922f; }
        }
        const int ta = t0 + 4 * g + hh, tb_ = ta + 2;
        const int kt_max = (t0 + 15) >> 5, nit = (kt_max >> 1) + 1;
        const int lsub = tid >> 8, lkey = (tid & 255) >> 3, lpc = tid & 7;
        const bf16_t* gsrc = zb + ((size_t)b * SEQ + lsub * 32 + lkey) * ZLD + C_IK + lpc * 8;
        const int loff = lsub * IDX_TILE + lkey * 72 + lpc * 8;
        u32x4 stg;
        __syncthreads();
        if (lsub <= kt_max) { stg = *(const u32x4*)gsrc; *(u32x4*)(ring + loff) = stg; }
        if (nit > 1 && 2 + lsub <= kt_max) { stg = *(const u32x4*)(gsrc + (size_t)64 * ZLD); *(u32x4*)(ring + IDX_SLOT + loff) = stg; }
        __syncthreads();
        for (int it = 0; it < nit; ++it) {
            const bool more = (it + 2 < nit) && (2 * (it + 2) + lsub <= kt_max);
            if (more) stg = *(const u32x4*)(gsrc + (size_t)(it + 2) * 64 * ZLD);
            const int kt = 2 * it + par;
            if (kt <= kt_max) {
                const bf16_t* tl = ring + (it % 3) * IDX_SLOT + par * IDX_TILE + r31 * 72 + 8 * hh;
                f32x16 acc;
#pragma unroll
                for (int q = 0; q < 16; ++q) acc[q] = 0.f;
#pragma unroll
                for (int s4 = 0; s4 < 4; ++s4) { const bf16x8 bk = *(const bf16x8*)(tl + 16 * s4); acc = __builtin_amdgcn_mfma_f32_32x32x16_bf16(a[s4], bk, acc, 0, 0, 0); }
                float sa = 0.f, sb = 0.f;
#pragma unroll
                for (int i = 0; i < 8; ++i) { sa += wq[i] * fmaxf(acc[i], 0.f); sb += wq[8 + i] * fmaxf(acc[8 + i], 0.f); }
                const int key = kt * 32 + r31;
                sc[(4 * g + hh) * 2048 + key] = key <= ta ? ordered_key(sa) : 0u;
                sc[(4 * g + 2 + hh) * 2048 + key] = key <= tb_ ? ordered_key(sb) : 0u;
            }
            if (more) *(u32x4*)(ring + ((it + 2) % 3) * IDX_SLOT + loff) = stg;
            __syncthreads();
        }
    }
    for (int srep_ = 0; srep_ < (PROBE_GROUP == 8 ? 2 : 1); ++srep_)
    for (int qq = 2 * wave; qq < 2 * wave + 2; ++qq) {
        const int t = t0 + qq;
        unsigned kreg[32];
#pragma unroll
        for (int i = 0; i < 32; ++i) kreg[i] = sc[qq * 2048 + lane + 64 * i];
        asm volatile("" ::: "memory");
#pragma unroll
        for (int i = 0; i < 32; ++i) kreg[i] = (lane + 64 * i <= t) ? kreg[i] : 0u;
        const int ngrp = __builtin_amdgcn_readfirstlane((t >> 9) + 1);
        unsigned kand = 0xffffffffu, kor = 0u;
#pragma unroll
        for (int i = 0; i < 32; ++i) { if (lane + 64 * i <= t) { kand &= kreg[i]; kor |= kreg[i]; } }
        kand = (unsigned)wave_and_u(kand); kor = (unsigned)wave_or_u(kor);
        const unsigned diff = kand ^ kor;
        unsigned prefix; int hb;
        if (diff == 0u) { prefix = kor; hb = -1; } else { hb = 31 - __builtin_clz(diff); prefix = (hb == 31) ? 0u : (kor & ~((2u << hb) - 1u)); }
        bool exact = false;
        for (int bit = hb; bit >= 0; --bit) {
            const unsigned cand = prefix | (1u << bit);
            int cnt = 0;
            SCNT8("ge", cnt, cand, kreg); if (ngrp > 1) SCNT8("ge", cnt, cand, kreg + 8); if (ngrp > 2) SCNT8("ge", cnt, cand, kreg + 16); if (ngrp > 3) SCNT8("ge", cnt, cand, kreg + 24);
            if (cnt >= 256) prefix = cand;
            if (cnt == 256) { exact = true; break; }
        }
        int kk = 0;
        if (!exact) { int cg = 0;
            SCNT8("gt", cg, prefix, kreg); if (ngrp > 1) SCNT8("gt", cg, prefix, kreg + 8); if (ngrp > 2) SCNT8("gt", cg, prefix, kreg + 16); if (ngrp > 3) SCNT8("gt", cg, prefix, kreg + 24);
            kk = 256 - cg; }
        const unsigned gtv = exact ? prefix - 1u : prefix;
        unsigned myword = 0u; int eqbefore = 0;
#pragma unroll
        for (int gi = 0; gi < 4; ++gi) {
            if (gi < ngrp) {
                if (exact) {
#pragma unroll
                    for (int i = 8 * gi; i < 8 * gi + 8; ++i) { const unsigned long long bs = __ballot(kreg[i] > gtv); if (lane == 2 * i) myword = (unsigned)bs; if (lane == 2 * i + 1) myword = (unsigned)(bs >> 32); }
                } else {
#pragma unroll
                    for (int i = 8 * gi; i < 8 * gi + 8; ++i) {
                        const bool eq = kreg[i] == prefix;
                        const unsigned long long beq = __ballot(eq);
                        const int rank = eqbefore + __popcll(beq & ((1ull << lane) - 1ull));
                        const bool sel = kreg[i] > gtv || (eq && rank < kk);
                        const unsigned long long bs = __ballot(sel);
                        eqbefore += __popcll(beq);
                        if (lane == 2 * i) myword = (unsigned)bs;
                        if (lane == 2 * i + 1) myword = (unsigned)(bs >> 32);
                    }
                }
            }
        }
        maskp[(size_t)(b * SEQ + t) * 64 + lane] = myword;
    }
    __syncthreads();
}

constexpr int ATT_KROW = 72, ATT_VROW = 68, ATT_SLOT = 64 * ATT_KROW + 64 * ATT_VROW;
__device__ __forceinline__ void attn_block(const bf16_t* __restrict__ zb, const bf16_t* __restrict__ vbt, const unsigned* __restrict__ maskp, bf16_t* __restrict__ att, const float* tb  ,
                                           bf16_t* ring  , const int b, const int qt, const int tid) {
    typedef unsigned long long u64;
    const int lane = tid & 63, wave = tid >> 6;
    const int c = lane & 31, hh = lane >> 5, h = c & 7;
    const int t0w = qt * 32 + 4 * wave;
    const int tq = t0w + (c >> 3);
    const size_t rowq = (size_t)b * SEQ + tq;
    bf16x8 bq[4];
#pragma unroll
    for (int s4 = 0; s4 < 4; ++s4) bq[s4] = *(const bf16x8*)(zb + rowq * ZLD + C_QB + h * 64 + 16 * s4 + 8 * hh);
    const int nstep = (qt >> 1) + 1;
    const float bfar = tb[127 * 8 + h];
    const float QS = 0.125f * 1.4426950408889634f;
    float m = -1e30f, lsum = 0.f;
    f32x16 O0, O1;
#pragma unroll
    for (int q = 0; q < 16; ++q) { O0[q] = 0.f; O1[q] = 0.f; }
    const u64* mbase = (const u64*)(maskp + rowq * 64);
    const int lrow = tid >> 3, lpc = tid & 7;
    const bf16_t* gk = zb + ((size_t)b * SEQ + lrow) * ZLD + C_KB + lpc * 8;
    const bf16_t* gv = vbt + ((size_t)b * 64 + lrow) * SEQ + lpc * 8;
    const int lk = lrow * ATT_KROW + lpc * 8, lv = 64 * ATT_KROW + lrow * ATT_VROW + lpc * 8;
    u32x4 sk = *(const u32x4*)gk, sv = *(const u32x4*)gv;
    { *(u32x4*)(ring + lk) = sk; u64* d = (u64*)(ring + lv); d[0] = (u64)sv.x | ((u64)sv.y << 32); d[1] = (u64)sv.z | ((u64)sv.w << 32); }
    if (nstep > 1) { sk = *(const u32x4*)(gk + (size_t)64 * ZLD); sv = *(const u32x4*)(gv + 64);
        *(u32x4*)(ring + ATT_SLOT + lk) = sk; u64* d = (u64*)(ring + ATT_SLOT + lv); d[0] = (u64)sv.x | ((u64)sv.y << 32); d[1] = (u64)sv.z | ((u64)sv.w << 32); }
    u64 mw2 = mbase[0];
    __syncthreads();
    for (int st = 0; st < nstep; ++st) {
        const int key0 = st * 64;
        const bf16_t* sl = ring + (st % 3) * ATT_SLOT;
        const bool more = st + 2 < nstep;
        if (more) { sk = *(const u32x4*)(gk + (size_t)(st + 2) * 64 * ZLD); sv = *(const u32x4*)(gv + (st + 2) * 64); }
        const unsigned cm0 = (unsigned)mw2 >> (4 * hh), cm1 = (unsigned)(mw2 >> 32) >> (4 * hh);
        mw2 = mbase[st + 1 < nstep ? st + 1 : st];
        f32x16 S0, S1;
#pragma unroll
        for (int q = 0; q < 16; ++q) { S0[q] = 0.f; S1[q] = 0.f; }
#pragma unroll
        for (int s4 = 0; s4 < 4; ++s4) {
            const bf16x8 k0 = *(const bf16x8*)(sl + c * ATT_KROW + 16 * s4 + 8 * hh), k1 = *(const bf16x8*)(sl + (32 + c) * ATT_KROW + 16 * s4 + 8 * hh);
            S0 = __builtin_amdgcn_mfma_f32_32x32x16_bf16(k0, bq[s4], S0, 0, 0, 0);
            S1 = __builtin_amdgcn_mfma_f32_32x32x16_bf16(k1, bq[s4], S1, 0, 0, 0);
        }
        float x0[16], x1[16]; float tmax = -1e30f;
        {
            float bs[16];
            if ((t0w - key0 - 31) < 113) {
                const int relb = tq - key0 - 4 * hh;
#pragma unroll
                for (int i = 0; i < 16; ++i) { int rel = relb - ((i & 3) + 8 * (i >> 2)); rel = rel < 0 ? 0 : (rel > 127 ? 127 : rel); bs[i] = tb[rel * 8 + h]; }
            } else {
#pragma unroll
                for (int i = 0; i < 16; ++i) bs[i] = bfar;
            }
#pragma unroll
            for (int i = 0; i < 16; ++i) { const int ko = (i & 3) + 8 * (i >> 2); const float xv = __builtin_fmaf(S0[i], QS, bs[i]); x0[i] = (cm0 & (1u << ko)) ? xv : -2e30f; tmax = fmaxf(tmax, x0[i]); }
        }
        {
            float bs[16];
            if ((t0w - key0 - 63) < 113) {
                const int relb = tq - key0 - 32 - 4 * hh;
#pragma unroll
                for (int i = 0; i < 16; ++i) { int rel = relb - ((i & 3) + 8 * (i >> 2)); rel = rel < 0 ? 0 : (rel > 127 ? 127 : rel); bs[i] = tb[rel * 8 + h]; }
            } else {
#pragma unroll
                for (int i = 0; i < 16; ++i) bs[i] = bfar;
            }
#pragma unroll
            for (int i = 0; i < 16; ++i) { const int ko = (i & 3) + 8 * (i >> 2); const float xv = __builtin_fmaf(S1[i], QS, bs[i]); x1[i] = (cm1 & (1u << ko)) ? xv : -2e30f; tmax = fmaxf(tmax, x1[i]); }
        }
        tmax = fmaxf(tmax, __shfl_xor(tmax, 32));
        const float mn = fmaxf(m, tmax);
        if (__ballot(mn > m) != 0ull) {
            const float scl = __builtin_amdgcn_exp2f(m - mn);
            lsum *= scl;
#pragma unroll
            for (int q = 0; q < 16; ++q) { O0[q] *= scl; O1[q] *= scl; }
        }
        m = mn;
        float p0[16], p1[16];
#pragma unroll
        for (int i = 0; i < 16; ++i) { const int ko = (i & 3) + 8 * (i >> 2);
            (void)ko; p0[i] = __builtin_amdgcn_exp2f(x0[i] - m); p1[i] = __builtin_amdgcn_exp2f(x1[i] - m); lsum += p0[i] + p1[i]; }
        union { unsigned u[4]; bf16x8 v; } pb00, pb01, pb10, pb11;
#pragma unroll
        for (int j = 0; j < 4; ++j) { pb00.u[j] = pg8::cvt_pk_bf16(p0[2 * j], p0[2 * j + 1]); pb01.u[j] = pg8::cvt_pk_bf16(p0[8 + 2 * j], p0[8 + 2 * j + 1]);
                                      pb10.u[j] = pg8::cvt_pk_bf16(p1[2 * j], p1[2 * j + 1]); pb11.u[j] = pg8::cvt_pk_bf16(p1[8 + 2 * j], p1[8 + 2 * j + 1]); }
        const bf16_t* vt = sl + 64 * ATT_KROW + c * ATT_VROW + 4 * hh;
#pragma unroll
        for (int sub = 0; sub < 2; ++sub) {
            union { u64 q[2]; bf16x8 v; } a00, a01, a10, a11;
            const bf16_t* vs = vt + 32 * sub;
            a00.q[0] = *(const u64*)(vs); a00.q[1] = *(const u64*)(vs + 8); a01.q[0] = *(const u64*)(vs + 16); a01.q[1] = *(const u64*)(vs + 24);
            a10.q[0] = *(const u64*)(vs + 32 * ATT_VROW); a10.q[1] = *(const u64*)(vs + 32 * ATT_VROW + 8); a11.q[0] = *(const u64*)(vs + 32 * ATT_VROW + 16); a11.q[1] = *(const u64*)(vs + 32 * ATT_VROW + 24);
            O0 = __builtin_amdgcn_mfma_f32_32x32x16_bf16(a00.v, sub ? pb10.v : pb00.v, O0, 0, 0, 0);
            O1 = __builtin_amdgcn_mfma_f32_32x32x16_bf16(a10.v, sub ? pb10.v : pb00.v, O1, 0, 0, 0);
            O0 = __builtin_amdgcn_mfma_f32_32x32x16_bf16(a01.v, sub ? pb11.v : pb01.v, O0, 0, 0, 0);
            O1 = __builtin_amdgcn_mfma_f32_32x32x16_bf16(a11.v, sub ? pb11.v : pb01.v, O1, 0, 0, 0);
        }
        if (more) { bf16_t* ds = ring + ((st + 2) % 3) * ATT_SLOT; *(u32x4*)(ds + lk) = sk; u64* d = (u64*)(ds + lv); d[0] = (u64)sv.x | ((u64)sv.y << 32); d[1] = (u64)sv.z | ((u64)sv.w << 32); }
        __syncthreads();
    }
    lsum += __shfl_xor(lsum, 32);
    const float inv = __builtin_amdgcn_rcpf(lsum);
    bf16_t* op = att + rowq * D + 512 + h * 64 + 4 * hh;
#pragma unroll
    for (int g4 = 0; g4 < 4; ++g4) {
        unsigned w0 = pg8::cvt_pk_bf16(O0[4 * g4] * inv, O0[4 * g4 + 1] * inv), w1 = pg8::cvt_pk_bf16(O0[4 * g4 + 2] * inv, O0[4 * g4 + 3] * inv);
        *(u64*)(op + 8 * g4) = (u64)w0 | ((u64)w1 << 32);
        w0 = pg8::cvt_pk_bf16(O1[4 * g4] * inv, O1[4 * g4 + 1] * inv); w1 = pg8::cvt_pk_bf16(O1[4 * g4 + 2] * inv, O1[4 * g4 + 3] * inv);
        *(u64*)(op + 32 + 8 * g4) = (u64)w0 | ((u64)w1 << 32);
    }
}

__device__ __forceinline__ void xcd_barrier_bg(const XcdBarrier& b, unsigned char* ldsb) {
    asm volatile("s_waitcnt vmcnt(0)" ::: "memory");
    __syncthreads();
    if (threadIdx.x == 0) {
        unsigned* bar = b.bar; asm volatile("" : "+s"(bar));
        __builtin_amdgcn_s_waitcnt(0);
        unsigned nloc = b.st[0], nx = b.st[1];
        if (nloc == 0u) { xcd_barrier_complete(bar, b.x, nloc, nx); b.st[0] = nloc; b.st[1] = nx; }
        const unsigned old = xb_add(&bar[XB_XSUB(b.x)], 1u);
        const unsigned gen = old / nloc;
        if (old + 1u == (gen + 1u) * nloc) {
            __builtin_amdgcn_fence(__ATOMIC_RELEASE, "agent");
            asm volatile("s_waitcnt vmcnt(0)" ::: "memory");
            const unsigned og = xb_add(&bar[XB_TOP], 1u);
            const unsigned tg = og / nx;
            if (og + 1u == (tg + 1u) * nx) xb_add(&bar[XB_TOPGEN], 1u);
            else XB_SPIN(xb_ld(&bar[XB_TOPGEN]) == tg, bar);
            __builtin_amdgcn_fence(__ATOMIC_ACQUIRE, "agent");
            xb_add(&bar[XB_XGEN(b.x)], 1u);
            asm volatile("s_waitcnt vmcnt(0)" ::: "memory");
            b.st[2] = 0u;
        } else { b.st[2] = 1u; b.st[3] = gen; }
    }
    __syncthreads();
    if (b.st[2] != 0u) {
        const unsigned gen = __builtin_amdgcn_readfirstlane(b.st[3]);
        bg_convert(ldsb, (int)threadIdx.x, true, CW_BAR + XB_XGEN(b.x), gen, BG_E);
        asm volatile("s_waitcnt vmcnt(0)" ::: "memory");
        __syncthreads();
        if (threadIdx.x == 0) {
            unsigned* bar = b.bar; asm volatile("" : "+s"(bar));
            XB_SPIN(xb_ld(&bar[XB_XGEN(b.x)]) == gen, bar);
            __builtin_amdgcn_fence(__ATOMIC_ACQUIRE, "agent");
            asm volatile("s_waitcnt vmcnt(0)" ::: "memory");
        }
    }
    __syncthreads();
}

template <int KIND> __global__ void __launch_bounds__(NTHREADS, 2) fwd(Args args) {
    extern __shared__ __attribute__((aligned(16))) unsigned char lds[];
    const int tid = threadIdx.x, lane = tid & 63, wave = tid >> 6;
    const int G = gridDim.x;
    PG8_LAS unsigned char* const lds3 = (PG8_LAS unsigned char*)lds;
#define WS_OPAQUE() unsigned long long ws_raw_ = (unsigned long long)args.ws; asm volatile("" : "+s"(ws_raw_)); GAS unsigned char* const wsg_ = (GAS unsigned char*)ws_raw_; unsigned char* const ws = (unsigned char*)wsg_; int tid = threadIdx.x; asm volatile("" : "+v"(tid)); const int lane = tid & 63, wave = tid >> 6; (void)lane; (void)wave
#define ctl ((unsigned*)(ws + WS_CTL))
#define MOD ((float*)(ws + WS_MOD))
#define LB ((float*)(ws + WS_LB))
#define WIN ((bf16_t*)(ws + WS_WIN))
#define WPA ((bf16_t*)(ws + WS_WPA))
#define WPB ((bf16_t*)(ws + WS_WPB))
#define WOUT ((bf16_t*)(ws + WS_WOUT))
#define W1 ((bf16_t*)(ws + WS_W1))
#define W2 ((bf16_t*)(ws + WS_W2))
#define H ((bf16_t*)(ws + WS_H))
#define ZB ((bf16_t*)(ws + WS_Z))
#define VBT ((bf16_t*)(ws + WS_VBT))
#define Y ((bf16_t*)(ws + WS_Y))
#define XS ((bf16_t*)(ws + WS_XS))
#define ACT ((bf16_t*)(ws + WS_ACT))
#define QEG ((bf16_t*)(ws + WS_QEG))
#define KEG ((bf16_t*)(ws + WS_KEG))
#define KETG ((bf16_t*)(ws + WS_KETG))
#define HVEC ((float*)(ws + WS_HVEC))
#define HA ((bf16_t*)(ws + WS_HA))
#define ATT ((bf16_t*)(ws + WS_ATT))
#define MASK ((unsigned*)(ws + WS_MASK))
#define MERGED ((bf16_t*)(ws + WS_MERGED))
#define X1 ((bf16_t*)(ws + WS_X1))
#define X2 ((bf16_t*)(ws + WS_X2))
#define TOKE ((int*)(ws + WS_TOKE))
#define TOKG ((float*)(ws + WS_TOKG))
#define TOKP ((int*)(ws + WS_TOKP))
#define TOKS ((int*)(ws + WS_TOKS))
#define BLKE ((int*)(ws + WS_BLKE))
#define SLOTTOK ((int*)(ws + WS_XS))
#define BCNT ((int*)(ws + WS_BCNT))
    const int lo = args.ph_lo, hi = args.ph_hi;
#define IN(k) ((KIND < 0 || ((k) == 0 ? KIND == 100 : KIND == ((k) - 1) % 11)) && lo <= (k) && (k) < hi)
#define SEAM(k) do { if (KIND < 0 && IN(k) && IN((k) + 1)) { if (DEPTH == 2) xcd_barrier_bg(bar, lds); else xcd_barrier(bar); } } while (0)
    XcdBarrier bar; bar.bar = (unsigned*)(args.ws + WS_CTL) + CW_BAR; bar.x = 0; bar.st = nullptr;
    if (KIND < 0) {
        volatile LAS unsigned* xbw = (volatile LAS unsigned*)((LAS unsigned char*)lds + (LDS_BYTES - 16));
        if (tid == 0) { xbw[0] = 0u; xbw[1] = 0u; xbw[2] = 0u; xbw[3] = 0u; }
        __syncthreads();
        bar = xcd_barrier_post((unsigned*)(args.ws + WS_CTL) + CW_BAR, xbw);
    }

    if (IN(0)) for (int prep_ = 0; prep_ < probe_reps(100); ++prep_) {
        WS_OPAQUE();
        {
            bf16_t* lt = (bf16_t*)lds;
            f32x4 v[8];
            constexpr bool BGL1 = (DEPTH == 2 && KIND < 0); constexpr int CJ_P0 = BGL1 ? CJ_PH0 : CJ_TOTAL;
            int J = blockIdx.x;
            CvtJob cur = cvt_job(J < CJ_P0 ? (BGL1 ? ph0_job_index(J) : J) : 0, args.in, ws);
            if (J < CJ_P0) cvt_load(cur, tid, v);
            __syncthreads();
            for (; J < CJ_P0; J += G) {
                {
                    const int i = tid >> 3, c0 = (tid & 7) * 32;
#pragma unroll
                    for (int q = 0; q < 8; q += 2) { u32x4 w; w.x = pg8::cvt_pk_bf16(v[q][0], v[q][1]); w.y = pg8::cvt_pk_bf16(v[q][2], v[q][3]); w.z = pg8::cvt_pk_bf16(v[q + 1][0], v[q + 1][1]); w.w = pg8::cvt_pk_bf16(v[q + 1][2], v[q + 1][3]);
                        *(u32x4*)(lt + i * 264 + c0 + 4 * q) = w; }
                }
                __syncthreads();
                const CvtJob me = cur;
                if (J + G < CJ_P0) { cur = cvt_job(BGL1 ? ph0_job_index(J + G) : J + G, args.in, ws); cvt_load(cur, tid, v); }
                {
                    const int n = tid & 255, kh = tid >> 8;
                    unsigned w[16];
#pragma unroll
                    for (int q = 0; q < 16; ++q) w[q] = (unsigned)lt[(kh * 32 + 2 * q) * 264 + n] | ((unsigned)lt[(kh * 32 + 2 * q + 1) * 264 + n] << 16);
                    bf16_t* dp = me.dst + (size_t)n * me.K + kh * 32;
#pragma unroll
                    for (int q = 0; q < 4; ++q) { u32x4 o; o.x = w[4 * q]; o.y = w[4 * q + 1]; o.z = w[4 * q + 2]; o.w = w[4 * q + 3]; *(u32x4*)(dp + 8 * q) = o; }
                }
                __syncthreads();
            }
        }
        {
            float* ca = (float*)lds;
            float* red = ca + NB * D;
            __syncthreads();
            {
                f32x4 cv[8];
#pragma unroll
                for (int i = 0; i < 8; ++i) cv[i] = *(const f32x4*)(args.in[I_C] + 4 * (tid + NTHREADS * i));
#pragma unroll
                for (int i = 0; i < 8; ++i) { f32x4 o; o[0] = cv[i][0] * sigmoidf_(cv[i][0]); o[1] = cv[i][1] * sigmoidf_(cv[i][1]); o[2] = cv[i][2] * sigmoidf_(cv[i][2]); o[3] = cv[i][3] * sigmoidf_(cv[i][3]); *(f32x4*)(ca + 4 * (tid + NTHREADS * i)) = o; }
            }
            __syncthreads();
            for (int u = blockIdx.x; u < DEPTH * NMOD / 48; u += G) {
                const int cq = tid % 12, kg = tid / 12;
                const int ln0 = u * 48, l = ln0 / NMOD, n0 = ln0 % NMOD;
                f32x4 acc[NB];
#pragma unroll
                for (int b = 0; b < NB; ++b) acc[b] = (f32x4){0.f, 0.f, 0.f, 0.f};
                if (kg < 40) {
                    const float* w = args.in[I_WADA] + (size_t)l * D * NMOD + n0 + 4 * cq;
#pragma unroll
                    for (int hb = 0; hb < 2; ++hb) {
                        f32x4 wv[13];
#pragma unroll
                        for (int i = 0; i < 13; ++i) { const int k = kg + 40 * (13 * hb + i); wv[i] = *(const f32x4*)(w + (size_t)(k < D ? k : kg) * NMOD); }
#pragma unroll
                        for (int i = 0; i < 13; ++i) { const int k = kg + 40 * (13 * hb + i); if (k < D) {
#pragma unroll
                            for (int b = 0; b < NB; ++b) acc[b] += ca[b * D + k] * wv[i]; } }
                    }
                }
#pragma unroll
                for (int half = 0; half < 2; ++half) {
                    if (kg < 40) {
#pragma unroll
                        for (int b = 0; b < 8; ++b) *(f32x4*)(red + (kg * 8 + b) * 48 + 4 * cq) = acc[8 * half + b];
                    }
                    __syncthreads();
                    for (int o = tid; o < 8 * 48; o += NTHREADS) { const int b = o / 48, jj = o % 48; float a = 0.f;
#pragma unroll 8
                        for (int q = 0; q < 40; ++q) a += red[(q * 8 + b) * 48 + jj];
                        const int n2 = n0 + jj;
                        MOD[((size_t)l * NB + 8 * half + b) * NMOD + n2] = a + args.in[I_BADA][(size_t)l * NMOD + n2]; }
                    __syncthreads();
                }
            }
        }
        if (blockIdx.x == G - 1) {
            for (int j = tid; j < 512; j += NTHREADS) { const float a0 = args.in[I_LBL][j], a1 = args.in[I_LBL][512 + j]; LB[j] = 0.f; LB[512 + j] = 1.0f / (1.0f + __expf(a0 - a1)); }
        }
    }

    SEAM(0);
    if (PROBE_GROUP == 13 && KIND < 0) { for (int i = 0; i < 20; ++i) xcd_barrier(bar); }
#pragma unroll
    for (int l = 0; l < DEPTH; ++l) {
        const int P = 1 + 11 * l;
#define mod (MOD + (size_t)l * NB * NMOD)
        if (IN(P + 0) && l == 0) {
            WS_OPAQUE();
            const float* nw = args.in[I_NMW] + (size_t)l * D;
            for (int grp = blockIdx.x * NWAVES + wave; grp < T / 16; grp += G * NWAVES) {
                const int tok0 = grp * 16, b = tok0 >> 11;
                f32x4 ca4[4], cb4[4];
#pragma unroll
                for (int i = 0; i < 4; ++i) { const int c = (lane + 64 * i) * 4; ca4[i] = *(const f32x4*)(nw + c) * (1.0f + *(const f32x4*)(mod + (size_t)b * NMOD + D + c)); cb4[i] = *(const f32x4*)(mod + (size_t)b * NMOD + c); }
                f32x4 vn[4];
#pragma unroll
                for (int i = 0; i < 4; ++i) vn[i] = *(const f32x4*)(args.in[I_X] + (size_t)tok0 * D + (lane + 64 * i) * 4);
                for (int j = 0; j < 16; ++j) {
                    const int row = tok0 + j; f32x4 v[4]; float ss = 0.f;
#pragma unroll
                    for (int i = 0; i < 4; ++i) { v[i] = vn[i]; ss += v[i][0] * v[i][0] + v[i][1] * v[i][1] + v[i][2] * v[i][2] + v[i][3] * v[i][3]; }
                    { const int rn = j < 15 ? row + 1 : row;
#pragma unroll
                      for (int i = 0; i < 4; ++i) vn[i] = *(const f32x4*)(args.in[I_X] + (size_t)rn * D + (lane + 64 * i) * 4); }
                    ss = wave_sum(ss); const float r = rsqrtf(ss * (1.0f / D) + EPS);
#pragma unroll
                    for (int i = 0; i < 4; ++i) { const int c = (lane + 64 * i) * 4;
                        const f32x4 hv = v[i] * r * ca4[i] + cb4[i];
                        *(unsigned long long*)(H + (size_t)row * D + c) = (unsigned long long)pg8::cvt_pk_bf16(hv[0], hv[1]) | ((unsigned long long)pg8::cvt_pk_bf16(hv[2], hv[3]) << 32);
                        *(unsigned long long*)(X2 + (size_t)row * D + c) = (unsigned long long)pg8::cvt_pk_bf16(v[i][0], v[i][1]) | ((unsigned long long)pg8::cvt_pk_bf16(v[i][2], v[i][3]) << 32); }
                }
            }
        }
        if (l == 0) SEAM(P + 0);
        if (IN(P + 1)) for (int prep_ = 0; prep_ < probe_reps(1); ++prep_) {
            WS_OPAQUE();
            pg8::Gemm g{H, WIN + (size_t)l * ZLD * D, T, ZLD, D}; pg8::StaticOrder S; S.init(T, ZLD, G, (int)blockIdx.x);
            pg8::EpiZ E{ZB, ZLD};
            pg8::gemm_phase(lds3, tid, g, S, E);
        }
        SEAM(P + 1);
        if (IN(P + 2)) for (int prep_ = 0; prep_ < probe_reps(2); ++prep_) {
            WS_OPAQUE();
            {
                for (int wt = blockIdx.x * NWAVES + wave; wt < (T / 64) * 8; wt += G * NWAVES) {
                    const int rg = wt >> 3, dg = wt & 7; const int row = rg * 64 + lane, bb = row >> 11, sidx = row & 2047;
                    const u32x4 w = *(const u32x4*)(ZB + (size_t)row * ZLD + C_VB + dg * 8);
                    bf16_t* vp = VBT + ((size_t)bb * 64 + dg * 8) * SEQ + sidx;
                    vp[0] = (bf16_t)(w.x & 0xffffu); vp[SEQ] = (bf16_t)(w.x >> 16); vp[2 * SEQ] = (bf16_t)(w.y & 0xffffu); vp[3 * SEQ] = (bf16_t)(w.y >> 16);
                    vp[4 * SEQ] = (bf16_t)(w.z & 0xffffu); vp[5 * SEQ] = (bf16_t)(w.z >> 16); vp[6 * SEQ] = (bf16_t)(w.w & 0xffffu); vp[7 * SEQ] = (bf16_t)(w.w >> 16);
                }
            }
            for (int it = blockIdx.x; it < NB * 4 * 32; it += G) {
                int tid_p = threadIdx.x; asm volatile("" : "+v"(tid_p));
                hgrn_prep_item(ZB, LB + l * 512, QEG, KEG, KETG, HVEC, (float*)lds, it >> 7, (it >> 5) & 3, it & 31, tid_p);
            }
            {
                unsigned* sc = (unsigned*)lds; bf16_t* iring = (bf16_t*)(sc + 16 * 2048);
                int* tk = (int*)(lds + LDS_BYTES - 64);
                for (;;) {
                    __syncthreads();
                    if (tid == 0) *tk = (int)atomicAdd(&ctl[CW_Q + l + 8 * prep_], 1u);
                    __syncthreads();
                    const int ticket = *tk;
                    if (ticket >= T / 16) break;
                    int tid_q = threadIdx.x; asm volatile("" : "+v"(tid_q));
                    const int u = ticket; const int b = u & 15, q16 = 127 - (u >> 4), t0 = q16 * 16;
                    if (t0 < 256) {
                        for (int i = tid_q; i < 16 * 64; i += NTHREADS) { const int qq = i >> 6, w = i & 63, n = t0 + qq + 1, lo_ = w * 32;
                            unsigned mm = 0u; if (n >= lo_ + 32) mm = 0xffffffffu; else if (n > lo_) mm = (1u << (n - lo_)) - 1u; MASK[(size_t)(b * SEQ + t0 + qq) * 64 + w] = mm; }
                    } else indexer_unit(ZB, MASK, sc, iring, b, t0, tid_q);
                }
                __syncthreads();
            }
        }
        SEAM(P + 2);
        if (IN(P + 3)) for (int prep_ = 0; prep_ < probe_reps(3); ++prep_) {
            WS_OPAQUE();
            {
                float* tb = (float*)lds;
                int* tk = (int*)(lds + LDS_BYTES - 64);
                const float* hnw = args.in[I_HNW] + (size_t)l * 512;
                bool tb_ok = false;
                for (;;) {
                    __syncthreads();
                    if (tid == 0) *tk = (int)atomicAdd(&ctl[CW_Q + 2 + l + 8 * prep_], 1u);
                    __syncthreads();
                    const int ticket = *tk;
                    if (ticket >= NB * 4 + T / 32) break;
                    int tid_q = threadIdx.x; asm volatile("" : "+v"(tid_q));
                    if (ticket < NB * 4) { hgrn_item(ZB, QEG, KEG, KETG, HVEC, hnw, HA, lds, ticket >> 2, ticket & 3, tid_q); tb_ok = false; continue; }
                    if (!tb_ok) { for (int i = tid_q; i < 1024; i += NTHREADS) tb[i] = 1.4426950408889634f * args.in[I_RELB][(int)T5_BUCKET[i >> 3] * 8 + (i & 7)]; __syncthreads(); tb_ok = true; }
                    const int u = ticket - NB * 4; const int b = u & 15, qt = 63 - (u >> 4);
                    attn_block(ZB, VBT, MASK, HA, tb, (bf16_t*)(tb + 1024), b, qt, tid_q);
                }
                __syncthreads();
            }
        }
        SEAM(P + 3);
        if (IN(P + 4)) for (int prep_ = 0; prep_ < probe_reps(4); ++prep_) {
            WS_OPAQUE();
            pg8::StaticOrder S; S.init(T, D, G, (int)blockIdx.x);
            pg8::Gemm g{HA, WPA + (size_t)l * D * D, T, D, D}; pg8::EpiMergeF E{MERGED, ZB + C_GTA, ZB + C_GTB}; pg8::gemm_phase(lds3, tid, g, S, E);
        }
        SEAM(P + 4);
        if (IN(P + 5)) for (int prep_ = 0; prep_ < probe_reps(5); ++prep_) {
            WS_OPAQUE();
            pg8::Gemm g{MERGED, WOUT + (size_t)l * D * D, T, D, D}; pg8::StaticOrder S; S.init(T, D, G, (int)blockIdx.x);
            pg8::EpiOutG E{X2, X1, mod + 2 * D}; pg8::gemm_phase(lds3, tid, g, S, E);
        }
        SEAM(P + 5);
        if (IN(P + 6)) for (int prep_ = 0; prep_ < probe_reps(6); ++prep_) {
            WS_OPAQUE();
            const float* nw = args.in[I_NFW] + (size_t)l * D; const float* wr = args.in[I_WR] + (size_t)l * D * NE; const float* br = args.in[I_BR] + (size_t)l * NE;
            constexpr int WTLD = 260;
            float* WT = (float*)lds; float* CAl = WT + 128 * WTLD; float* CBl = CAl + D; float* C0 = CBl + D; unsigned* cntl = (unsigned*)(C0 + NE); float* c0s = (float*)(cntl + NE);
            __syncthreads();
            if (tid < NE) cntl[tid] = 0u;
            const int li = lane & 15, kk = lane >> 4;
            for (int it = 0; (blockIdx.x + it * G) * 128 < T; ++it) {
                const int tokbase = (blockIdx.x + it * G) * 128, b = tokbase >> 11;
                __syncthreads();
                for (int k = tid; k < D; k += NTHREADS) { CAl[k] = nw[k] * (1.0f + mod[(size_t)b * NMOD + 4 * D + k]); CBl[k] = mod[(size_t)b * NMOD + 3 * D + k]; }
                __syncthreads();
                {   const int q = tid & 7; float c0p[4] = {0.f, 0.f, 0.f, 0.f};
#pragma unroll 1
                    for (int i8 = 0; i8 < 16; i8 += 8) {
                    f32x4 w16[8];
#pragma unroll
                    for (int ii = 0; ii < 8; ++ii) w16[ii] = *(const f32x4*)(wr + (size_t)((tid + NTHREADS * (i8 + ii)) >> 3) * NE + 4 * q);
#pragma unroll
                    for (int ii = 0; ii < 8; ++ii) { const int k = (tid + NTHREADS * (i8 + ii)) >> 3, kq = k >> 8, sx = k & 255; const f32x4 w4 = w16[ii]; const float ca = CAl[k], cb = CBl[k];
#pragma unroll
                        for (int j = 0; j < 4; ++j) { WT[(kq * 32 + 4 * q + j) * WTLD + sx] = ca * w4[j]; c0p[j] += cb * w4[j]; } }
                    }
#pragma unroll
                    for (int j = 0; j < 4; ++j) c0s[(tid >> 3) * NE + 4 * q + j] = c0p[j]; }
                __syncthreads();
                if (tid < NE) { float a = br[tid]; for (int r2 = 0; r2 < 64; ++r2) a += c0s[r2 * NE + tid]; C0[tid] = a; }
                __syncthreads();
                const int tok = tokbase + wave * 16 + li;
                const bf16_t* xrow = X1 + (size_t)tok * D + 256 * kk;
                const float* wt0 = WT + (kk * 32 + li) * WTLD; const float* wt1 = wt0 + 16 * WTLD;
                f32x4 d0a = {0.f, 0.f, 0.f, 0.f}, d0b = d0a, d1a = d0a, d1b = d0a; float ss = 0.f;
                u32x4 xwb[2][8];
#pragma unroll
                for (int u = 0; u < 8; ++u) xwb[0][u] = *(const u32x4*)(xrow + 8 * u);
#pragma unroll
                for (int ub = 0; ub < 32; ub += 8) {
                    u32x4 (&xw)[8] = xwb[(ub >> 3) & 1];
                    if (ub + 8 < 32) {
#pragma unroll
                        for (int u = 0; u < 8; ++u) xwb[((ub >> 3) + 1) & 1][u] = *(const u32x4*)(xrow + 8 * (ub + 8 + u)); }
#pragma unroll
                    for (int u = 0; u < 8; ++u) {
                        f32x4 xlo, xhi; pg8::bf8_to_f32(xw[u], xlo, xhi);
                        const f32x4 a00 = *(const f32x4*)(wt0 + 8 * (ub + u)), a01 = *(const f32x4*)(wt0 + 8 * (ub + u) + 4), a10 = *(const f32x4*)(wt1 + 8 * (ub + u)), a11 = *(const f32x4*)(wt1 + 8 * (ub + u) + 4);
#pragma unroll
                        for (int j = 0; j < 4; ++j) { d0a = __builtin_amdgcn_mfma_f32_16x16x4f32(a00[j], xlo[j], d0a, 0, 0, 0); d1a = __builtin_amdgcn_mfma_f32_16x16x4f32(a10[j], xlo[j], d1a, 0, 0, 0); }
#pragma unroll
                        for (int j = 0; j < 4; ++j) { d0b = __builtin_amdgcn_mfma_f32_16x16x4f32(a01[j], xhi[j], d0b, 0, 0, 0); d1b = __builtin_amdgcn_mfma_f32_16x16x4f32(a11[j], xhi[j], d1b, 0, 0, 0); }
                        ss += xlo[0] * xlo[0] + xlo[1] * xlo[1] + xlo[2] * xlo[2] + xlo[3] * xlo[3] + xhi[0] * xhi[0] + xhi[1] * xhi[1] + xhi[2] * xhi[2] + xhi[3] * xhi[3];
                    }
                }
                ss += __shfl_xor(ss, 16); ss += __shfl_xor(ss, 32);
                const float r = rsqrtf(ss * (1.0f / D) + EPS);
                float lg[8]; int eid[8];
#pragma unroll
                for (int j = 0; j < 4; ++j) { lg[j] = r * (d0a[j] + d0b[j]) + C0[4 * kk + j]; lg[4 + j] = r * (d1a[j] + d1b[j]) + C0[16 + 4 * kk + j]; eid[j] = 4 * kk + j; eid[4 + j] = 16 + 4 * kk + j; }
                float tv[4]; int ti[4];
#pragma unroll
                for (int k = 0; k < 4; ++k) {
                    float bv = lg[0]; int bi = eid[0];
#pragma unroll
                    for (int j = 1; j < 8; ++j) { const bool take = lg[j] > bv; bv = take ? lg[j] : bv; bi = take ? eid[j] : bi; }
#pragma unroll
                    for (int o = 16; o <= 32; o <<= 1) { const float ov = __shfl_xor(bv, o); const int oi = __shfl_xor(bi, o); const bool take = (ov > bv) | ((ov == bv) & (oi < bi)); bv = take ? ov : bv; bi = take ? oi : bi; }
                    tv[k] = bv; ti[k] = bi;
#pragma unroll
                    for (int j = 0; j < 8; ++j) lg[j] = (eid[j] == bi) ? -INFINITY : lg[j];
                }
                const float e1 = __expf(tv[1] - tv[0]), e2 = __expf(tv[2] - tv[0]), e3 = __expf(tv[3] - tv[0]); const float inv = 1.0f / (1.0f + e1 + e2 + e3);
                {   const int ee = kk == 0 ? ti[0] : kk == 1 ? ti[1] : kk == 2 ? ti[2] : ti[3]; const float gg = (kk == 0 ? 1.0f : kk == 1 ? e1 : kk == 2 ? e2 : e3) * inv;
                    TOKE[tok * 4 + kk] = ee; TOKG[tok * 4 + kk] = gg; TOKP[tok * 4 + kk] = (int)atomicAdd(&cntl[ee], 1u); }
                bf16_t* hrow = H + (size_t)tok * D + 256 * kk; const float* cal = CAl + 256 * kk; const float* cbl = CBl + 256 * kk;
#pragma unroll
                for (int u = 0; u < 8; ++u) xwb[0][u] = *(const u32x4*)(xrow + 8 * u);
#pragma unroll
                for (int ub = 0; ub < 32; ub += 8) {
                    u32x4 (&xw)[8] = xwb[(ub >> 3) & 1];
                    if (ub + 8 < 32) {
#pragma unroll
                        for (int u = 0; u < 8; ++u) xwb[((ub >> 3) + 1) & 1][u] = *(const u32x4*)(xrow + 8 * (ub + 8 + u)); }
#pragma unroll
                    for (int u = 0; u < 8; ++u) {
                        f32x4 xlo, xhi; pg8::bf8_to_f32(xw[u], xlo, xhi);
                        const f32x4 ca0 = *(const f32x4*)(cal + 8 * (ub + u)), ca1 = *(const f32x4*)(cal + 8 * (ub + u) + 4), cb0 = *(const f32x4*)(cbl + 8 * (ub + u)), cb1 = *(const f32x4*)(cbl + 8 * (ub + u) + 4);
                        const f32x4 h0 = xlo * r * ca0 + cb0, h1 = xhi * r * ca1 + cb1;
                        u32x4 w; w.x = pg8::cvt_pk_bf16(h0[0], h0[1]); w.y = pg8::cvt_pk_bf16(h0[2], h0[3]); w.z = pg8::cvt_pk_bf16(h1[0], h1[1]); w.w = pg8::cvt_pk_bf16(h1[2], h1[3]);
                        *(u32x4*)(hrow + 8 * (ub + u)) = w;
                    }
                }
            }
            __syncthreads();
            if (tid < NE) BCNT[blockIdx.x * NE + tid] = (int)cntl[tid];
        }
        SEAM(P + 6);
        if (IN(P + 7)) for (int prep_ = 0; prep_ < probe_reps(7); ++prep_) {
            WS_OPAQUE();
            int* ps = (int*)lds; int* tot = ps + 64; int* basel = tot + 32; int* pall = basel + 32; int* pbef = pall + 16 * NE;
            __syncthreads();
            {
                const int e = tid & 31, pt = tid >> 5, per = (G + 15) / 16; int sa = 0, sb = 0;
                for (int bb = pt * per; bb < (pt + 1) * per && bb < G; ++bb) { const int c = BCNT[bb * NE + e]; sa += c; sb += bb < (int)blockIdx.x ? c : 0; }
                pall[pt * NE + e] = sa; pbef[pt * NE + e] = sb;
            }
            __syncthreads();
            if (tid < NE) { int sa = 0, sb = 0; for (int pt = 0; pt < 16; ++pt) { sa += pall[pt * NE + tid]; sb += pbef[pt * NE + tid]; } tot[tid] = sa; basel[tid] = sb; }
            __syncthreads();
            if (tid == 0) { int a = 0; for (int e = 0; e < NE; ++e) { ps[e] = a; a += ((tot[e] + 255) / 256) * 256; } ps[NE] = a; }
            __syncthreads();
            const int gt = blockIdx.x * NTHREADS + tid, gn = G * NTHREADS;
            for (int grp = blockIdx.x * NWAVES + wave; grp < T / 16; grp += G * NWAVES) {
                const int tok0 = grp * 16;
                const int e_l = TOKE[tok0 * 4 + lane]; const int slot_l = ps[e_l] + basel[e_l] + TOKP[tok0 * 4 + lane];
                TOKS[tok0 * 4 + lane] = slot_l; SLOTTOK[slot_l] = tok0 + (lane >> 2);
            }
            {
                for (int e = blockIdx.x; e < NE; e += G) { if (tid < 256) { const int si = tot[e] + tid; if (si < ps[e + 1] - ps[e]) SLOTTOK[ps[e] + si] = 0; } }
                if (blockIdx.x == G - 1) { const int end8 = ((ps[NE] / 256 + 7) & ~7) * 256; for (int i = ps[NE] + tid; i < end8; i += NTHREADS) SLOTTOK[i] = 0; }
            }
            const int nblk = ps[NE] / 256, nblk8 = (nblk + 7) & ~7;
            for (int mb = gt; mb < nblk8; mb += gn) { int e = 0; if (mb < nblk) { while (e < NE - 1 && mb * 256 >= ps[e + 1]) ++e; } BLKE[mb] = e; }
            if (gt == 0) ctl[CW_NBLK + l] = (unsigned)nblk8;
            __syncthreads();
        }
        if (KIND < 0 && DEPTH == 2 && l == 1 && IN(P + 7)) bg_convert(lds, (int)threadIdx.x, false, 0u, 0u, BG_C);
        SEAM(P + 7);
        if (IN(P + 8)) for (int prep_ = 0; prep_ < probe_reps(8); ++prep_) {
            WS_OPAQUE();
            const int nblk = __builtin_amdgcn_readfirstlane((int)ctl[CW_NBLK + l]);
            PG8_LAS int* const blk_l = (PG8_LAS int*)(lds3 + pg8::STAGE_BYTES);
            for (int i = tid; i < nblk; i += NTHREADS) blk_l[i] = BLKE[i];
            __syncthreads();
            pg8::Gemm g{H, W1 + (size_t)l * NE * 2 * DFF * D, nblk * 256, 2 * DFF, D}; pg8::MoeOrder<8, true> S; S.init(nblk, G, (int)blockIdx.x, blk_l, SLOTTOK);
            pg8::EpiSwigluG E{ACT, args.in[I_B1] + (size_t)l * NE * 2 * DFF}; pg8::gemm_phase(lds3, tid, g, S, E);
        }
        if (KIND < 0 && DEPTH == 2 && IN(P + 8)) bg_convert(lds, (int)threadIdx.x, false, 0u, 0u, l == 0 ? BG_A : BG_E);
        SEAM(P + 8);
        if (IN(P + 9)) for (int prep_ = 0; prep_ < probe_reps(9); ++prep_) {
            WS_OPAQUE();
            const int nblk = __builtin_amdgcn_readfirstlane((int)ctl[CW_NBLK + l]);
            PG8_LAS int* const blk_l = (PG8_LAS int*)(lds3 + pg8::STAGE_BYTES);
            for (int i = tid; i < nblk; i += NTHREADS) blk_l[i] = BLKE[i];
            __syncthreads();
            pg8::Gemm g{ACT, W2 + (size_t)l * NE * D * DFF, nblk * 256, D, DFF}; pg8::MoeOrder<4, false, true> S; S.init(nblk, G, (int)blockIdx.x, blk_l);
            pg8::EpiYG E{Y, args.in[I_B2] + (size_t)l * NE * D}; pg8::gemm_phase(lds3, tid, g, S, E);
        }
        SEAM(P + 9);
        if (IN(P + 10)) for (int prep_ = 0; prep_ < probe_reps(10); ++prep_) {
            WS_OPAQUE();
            const bool last = (l == DEPTH - 1);
            const float* nw = last ? args.in[I_FNW] : args.in[I_NMW] + (size_t)(l + 1) * D;
            const float* modn = MOD + (size_t)(l + 1) * NB * NMOD;
            for (int grp = blockIdx.x * NWAVES + wave; grp < T / 16; grp += G * NWAVES) {
                const int tok0 = grp * 16, b = tok0 >> 11;
                const int slot_l = TOKS[tok0 * 4 + lane]; const float g_l = TOKG[tok0 * 4 + lane];
                f32x4 gf4[4], ca4[4], cb4[4];
#pragma unroll
                for (int i = 0; i < 4; ++i) { const int c = (lane + 64 * i) * 4; gf4[i] = *(const f32x4*)(mod + (size_t)b * NMOD + 5 * D + c); const f32x4 w4 = *(const f32x4*)(nw + c);
                    if (last) { ca4[i] = w4; cb4[i] = (f32x4){0.f, 0.f, 0.f, 0.f}; } else { ca4[i] = w4 * (1.0f + *(const f32x4*)(modn + (size_t)b * NMOD + D + c)); cb4[i] = *(const f32x4*)(modn + (size_t)b * NMOD + c); } }
                unsigned long long xa[4], ya[4][4], xb[4], yb[4][4];
#define CB_LOAD(XR, YR, J) do { const int tk_ = tok0 + (J); \
        _Pragma("unroll") for (int i = 0; i < 4; ++i) XR[i] = *(const unsigned long long*)(X1 + (size_t)tk_ * D + (lane + 64 * i) * 4); \
        _Pragma("unroll") for (int k = 0; k < 4; ++k) { const int slot = __shfl(slot_l, 4 * (J) + k); \
            _Pragma("unroll") for (int i = 0; i < 4; ++i) YR[k][i] = *(const unsigned long long*)(Y + (size_t)slot * D + (lane + 64 * i) * 4); } } while (0)
#define CB_DO(XR, YR, J) do { const int tok = tok0 + (J); f32x4 v[4]; float gk[4]; \
        _Pragma("unroll") for (int k = 0; k < 4; ++k) gk[k] = __shfl(g_l, 4 * (J) + k); \
        float ss = 0.f; \
        _Pragma("unroll") for (int i = 0; i < 4; ++i) { const unsigned x0 = (unsigned)XR[i], x1w = (unsigned)(XR[i] >> 32); \
            v[i][0] = __uint_as_float(x0 << 16); v[i][1] = __uint_as_float(x0 & 0xffff0000u); v[i][2] = __uint_as_float(x1w << 16); v[i][3] = __uint_as_float(x1w & 0xffff0000u); \
            f32x4 a = {0.f, 0.f, 0.f, 0.f}; \
            _Pragma("unroll") for (int k = 0; k < 4; ++k) { const unsigned y0 = (unsigned)YR[k][i], y1 = (unsigned)(YR[k][i] >> 32); \
                f32x4 y; y[0] = __uint_as_float(y0 << 16); y[1] = __uint_as_float(y0 & 0xffff0000u); y[2] = __uint_as_float(y1 << 16); y[3] = __uint_as_float(y1 & 0xffff0000u); a += gk[k] * y; } \
            v[i] = v[i] + gf4[i] * a; ss += v[i][0] * v[i][0] + v[i][1] * v[i][1] + v[i][2] * v[i][2] + v[i][3] * v[i][3]; } \
        ss = wave_sum(ss); const float r = rsqrtf(ss * (1.0f / D) + EPS); \
        _Pragma("unroll") for (int i = 0; i < 4; ++i) { const int c = (lane + 64 * i) * 4; \
            if (last) { *(f32x4*)(args.out + (size_t)tok * D + c) = v[i] * r * ca4[i]; } \
            else { *(unsigned long long*)(X2 + (size_t)tok * D + c) = (unsigned long long)pg8::cvt_pk_bf16(v[i][0], v[i][1]) | ((unsigned long long)pg8::cvt_pk_bf16(v[i][2], v[i][3]) << 32); \
                const f32x4 hv = v[i] * r * ca4[i] + cb4[i]; \
                *(unsigned long long*)(H + (size_t)tok * D + c) = (unsigned long long)pg8::cvt_pk_bf16(hv[0], hv[1]) | ((unsigned long long)pg8::cvt_pk_bf16(hv[2], hv[3]) << 32); } } } while (0)
                CB_LOAD(xa, ya, 0);
                for (int j = 0; j < 16; j += 2) {
                    CB_LOAD(xb, yb, j + 1);
                    CB_DO(xa, ya, j);
                    if (j + 2 < 16) CB_LOAD(xa, ya, j + 2);
                    CB_DO(xb, yb, j + 1);
                }
#undef CB_LOAD
#undef CB_DO
            }
        }
        if (KIND < 0 && DEPTH == 2 && l == 0 && IN(P + 10)) bg_convert(lds, (int)threadIdx.x, false, 0u, 0u, BG_B);
        SEAM(P + 10);
    }
#undef IN
}

constexpr int N_PHASES = 1 + 11 * DEPTH;
typedef void (*kern_t)(Args);
template <int K> static kern_t kern_of() { return fwd<K>; }
static kern_t kern_for(int kind) {
    switch (kind) { case 0: return fwd<0>; case 1: return fwd<1>; case 2: return fwd<2>; case 3: return fwd<3>; case 4: return fwd<4>; case 5: return fwd<5>;
                    case 6: return fwd<6>; case 7: return fwd<7>; case 8: return fwd<8>; case 9: return fwd<9>; case 10: return fwd<10>; default: return fwd<100>; }
}

extern "C" void kernel_launch(void* const* d_in, const int* in_sizes, int n_in, void* d_out, int out_size, void* d_ws, size_t ws_size, hipStream_t stream) {
    static int grid = 0;
    if (grid == 0) {
        if (n_in != 20 || out_size != T * D || ws_size < WS_END) { fprintf(stderr, "kernel_launch: unexpected problem (n_in %d, out %d, ws %zu, need %zu)\n", n_in, out_size, ws_size, (size_t)WS_END); grid = -1; return; }
        int dev = 0, cus = 0;
        if (hipGetDevice(&dev) != hipSuccess || hipDeviceGetAttribute(&cus, hipDeviceAttributeMultiprocessorCount, dev) != hipSuccess) { grid = -1; return; }
        for (int k = 0; k <= 12; ++k) {
            if (hipFuncSetAttribute((const void*)(k == 12 ? (kern_t)fwd<-1> : kern_for(k)), hipFuncAttributeMaxDynamicSharedMemorySize, LDS_BYTES) != hipSuccess) { fprintf(stderr, "kernel_launch: hipFuncSetAttribute failed\n"); grid = -1; return; }
        }
        grid = cus > 0 ? cus : 256;
    }
    if (grid < 0) return;
    (void)hipMemsetAsync((char*)d_ws + WS_CTL, 0, CTL_BYTES, stream);
    Args a{};
    for (int i = 0; i < 20; ++i) a.in[i] = (const float*)d_in[i];
    a.out = (float*)d_out; a.ws = (unsigned char*)d_ws;
#if defined(MULTI_LAUNCH)
    for (int p = 0; p < N_PHASES; ++p) {
        if (p == 1 + 11) continue;
        a.ph_lo = p; a.ph_hi = p + 1;
        const int kind = p == 0 ? 11 : (p - 1) % 11;
        hipLaunchKernelGGL(kern_for(kind), dim3(grid), dim3(NTHREADS), LDS_BYTES, stream, a);
    }
#else
    a.ph_lo = 0; a.ph_hi = N_PHASES;
    hipLaunchKernelGGL(fwd<-1>, dim3(grid), dim3(NTHREADS), LDS_BYTES, stream, a);
#endif
}
```
